# Optimizing an MI355X kernel written in HIP

```python
import jax, jax.numpy as jnp
from jax import lax
import numpy as np


D_MODEL = 1024
BATCH = 16
SEQ = 4096
DEPTH = 2

GRID_W = 64
CTX_LEN = 256
ROPE_THETA = 10000.0
EPS = 1e-6
Q_BLOCK = 128

MLA_HEADS = 4
MLA_NOPE = 64
MLA_ROPE = 32
MLA_V = 64
MLA_Q_LORA = 256
MLA_KV_LORA = 128
MLA_SCALE = (MLA_NOPE + MLA_ROPE) ** -0.5
GQA_HEADS = 4
GQA_KV_HEADS = 2
GQA_HD = 64
NA_HEADS = 4
NA_HD = 64
NA_WIN_R = 8
NA_WIN_C = 16
RET_HEADS = 4
RET_DK = 64
RET_DV = 64
RET_CHUNK = 128
N_BRANCH = 4
BRANCH_W = 256
PEER_HEADS = 8
PEER_N_KEYS = 128
PEER_N_EXPERTS = PEER_N_KEYS * PEER_N_KEYS
PEER_TOPK = 16
PEER_DK = 128
PEER_BLOCK = 128

IN_SIZES = (MLA_Q_LORA, MLA_KV_LORA, MLA_ROPE,
            GQA_HEADS * GQA_HD, GQA_KV_HEADS * GQA_HD, GQA_KV_HEADS * GQA_HD,
            NA_HEADS * NA_HD, NA_HEADS * NA_HD, NA_HEADS * NA_HD,
            RET_HEADS * RET_DK, RET_HEADS * RET_DK, RET_HEADS * RET_DV,
            RET_HEADS * RET_DV, RET_HEADS * RET_DV,
            N_BRANCH * D_MODEL)
IN_COLS = sum(IN_SIZES)
IN_OFFSETS = tuple(int(v) for v in np.cumsum(IN_SIZES)[:-1])

kernel_name = 'hybrid_parallel_mla_gqa_natten_retention_peer'


def rmsnorm(x, w):
    xf = x.astype(jnp.float32)
    y = xf * lax.rsqrt(jnp.mean(xf * xf, axis=-1, keepdims=True) + EPS)
    return y.astype(x.dtype) * w


def rope_1d(x, pos):
    half = x.shape[-1] // 2
    freqs = ROPE_THETA ** (-jnp.arange(half, dtype=jnp.float32) / half)
    ang = pos[:, None] * freqs[None, :]
    cos = jnp.cos(ang)[:, None, :].astype(x.dtype)
    sin = jnp.sin(ang)[:, None, :].astype(x.dtype)
    x1, x2 = x[..., :half], x[..., half:]
    return jnp.concatenate([x1 * cos - x2 * sin, x1 * sin + x2 * cos], axis=-1)


def axial_rope(x, row, col):
    half = x.shape[-1] // 2
    return jnp.concatenate([rope_1d(x[..., :half], row), rope_1d(x[..., half:], col)], axis=-1)


def attend(q, k, v, scale):
    s = jnp.einsum('bqhgd,bkhd->bhgqk', q, k).astype(jnp.float32) * scale
    p = jax.nn.softmax(s, axis=-1).astype(v.dtype)
    return jnp.einsum('bhgqk,bkhe->bqhge', p, v)


def block_attend(q, k, v, scale):
    B, S = q.shape[:2]
    nb = S // Q_BLOCK
    qb = jnp.moveaxis(q.reshape((B, nb, Q_BLOCK) + q.shape[2:]), 1, 0)
    o = lax.map(lambda qi: attend(qi, k, v, scale), qb)
    return jnp.moveaxis(o, 0, 1).reshape((B, S) + o.shape[3:])


def neighbourhood_attend(q, k, v, k_ctx, v_ctx, bias):
    B, S, H, d = q.shape
    rows = S // GRID_W
    wr = min(NA_WIN_R, rows)
    wc = NA_WIN_C
    scale = d ** -0.5
    qg = q.reshape(B, rows, GRID_W, H, d)
    kg = k.reshape(B, rows, GRID_W, H, d)
    vg = v.reshape(B, rows, GRID_W, H, d)
    cols = np.arange(GRID_W)
    col_start = np.clip(cols - wc // 2, 0, GRID_W - wc)
    col_idx = col_start[:, None] + np.arange(wc)[None, :]
    rel_c = col_idx - cols[:, None] + (NA_WIN_C - 1)

    def one_row(args):
        r, q_r = args
        rs = jnp.clip(r - wr // 2, 0, rows - wr)
        k_rows = lax.dynamic_slice_in_dim(kg, rs, wr, axis=1)
        v_rows = lax.dynamic_slice_in_dim(vg, rs, wr, axis=1)
        k_win = k_rows[:, :, col_idx]
        v_win = v_rows[:, :, col_idx]
        rel_r = rs + jnp.arange(wr) - r + (NA_WIN_R - 1)
        b = bias[:, rel_r[None, :, None], rel_c[:, None, :]]
        s_win = jnp.einsum('bchd,brcwhd->bhcrw', q_r, k_win).astype(jnp.float32) * scale + b.astype(jnp.float32)
        s_ctx = jnp.einsum('bchd,bkhd->bhck', q_r, k_ctx).astype(jnp.float32) * scale
        s = jnp.concatenate([s_win.reshape(B, H, GRID_W, wr * wc), s_ctx], axis=-1)
        p = jax.nn.softmax(s, axis=-1).astype(v.dtype)
        p_win = p[..., :wr * wc].reshape(B, H, GRID_W, wr, wc)
        p_ctx = p[..., wr * wc:]
        return (jnp.einsum('bhcrw,brcwhd->bchd', p_win, v_win)
                + jnp.einsum('bhck,bkhd->bchd', p_ctx, v_ctx))

    o = lax.map(one_row, (jnp.arange(rows), jnp.moveaxis(qg, 1, 0)))
    return jnp.moveaxis(o, 0, 1).reshape(B, S, H * d)


def retention_scan(q, k, v, log_gamma, s0):
    B, H, L, _ = q.shape
    C = RET_CHUNK
    nc = L // C
    idx = jnp.arange(C, dtype=jnp.float32)
    diff = idx[:, None] - idx[None, :]
    decay = jnp.where(diff >= 0, jnp.exp(log_gamma[:, None, None] * jnp.maximum(diff, 0.0)), 0.0)
    q_decay = jnp.exp(log_gamma[:, None] * (idx + 1.0))[None, :, :, None]
    k_decay = jnp.exp(log_gamma[:, None] * (C - 1.0 - idx))[None, :, :, None]
    chunk_decay = jnp.exp(log_gamma * C)[None, :, None, None]

    def chunks(t):
        return jnp.moveaxis(t.reshape(B, H, nc, C, t.shape[-1]), 2, 0)

    def step(state, qkv):
        qc, kc, vc = qkv
        inner = jnp.einsum('bhnd,bhmd->bhnm', qc, kc) * decay
        o = (jnp.einsum('bhnm,bhme->bhne', inner, vc)
             + jnp.einsum('bhnd,bhde->bhne', qc, state) * q_decay)
        state = state * chunk_decay + jnp.einsum('bhmd,bhme->bhde', kc * k_decay, vc)
        return state, o

    state, o = lax.scan(step, s0, (chunks(q), chunks(k), chunks(v)))
    return jnp.moveaxis(o, 0, 2).reshape(B, H, L, -1), state


def head_groupnorm(o, w):
    B, H, L, dv = o.shape
    mu = jnp.mean(o, axis=-1, keepdims=True)
    var = jnp.mean(jnp.square(o - mu), axis=-1, keepdims=True)
    y = (o - mu) * lax.rsqrt(var + EPS)
    return jnp.moveaxis(y, 1, 2).reshape(B, L, H * dv) * w.astype(jnp.float32)


def retention_mixer(ret_x, ret_c, decay_logit, gn_w, need_ctx):
    def heads(t, d):
        B, L, _ = t.shape
        return jnp.moveaxis(t.reshape(B, L, RET_HEADS, d), 1, 2).astype(jnp.float32)

    def prep(r):
        q, k, v, gf, gb = r
        return heads(q, RET_DK), heads(k, RET_DK) * (RET_DK ** -0.5), heads(v, RET_DV), gf, gb

    qx, kx, vx, gfx, gbx = prep(ret_x)
    qc, kc, vc, gfc, gbc = prep(ret_c)
    log_g = jax.nn.log_sigmoid(decay_logit.astype(jnp.float32))
    flip = lambda t: jnp.flip(t, axis=2)
    s0 = jnp.zeros((qc.shape[0], RET_HEADS, RET_DK, RET_DV), jnp.float32)
    oc_f, st_f = retention_scan(qc, kc, vc, log_g[0], s0)
    oc_b, st_b = retention_scan(flip(qc), flip(kc), flip(vc), log_g[1], s0)
    ox_f, _ = retention_scan(qx, kx, vx, log_g[0], st_f)
    ox_b, _ = retention_scan(flip(qx), flip(kx), flip(vx), log_g[1], st_b)

    def combine(of, ob, gf, gb):
        y = (head_groupnorm(of, gn_w) * jax.nn.silu(gf.astype(jnp.float32))
             + head_groupnorm(flip(ob), gn_w) * jax.nn.silu(gb.astype(jnp.float32)))
        return y.astype(gf.dtype)

    yx = combine(ox_f, ox_b, gfx, gbx)
    yc = combine(oc_f, oc_b, gfc, gbc) if need_ctx else None
    return yx, yc


def stream_heads(proj, pos, mla_qn, mla_wuq, mla_kvn, mla_wukv, gqa_qn, gqa_kn):
    (cq, ckv, kpe, gq, gk, gv, nq, nk, nv, rq, rk, rv, rgf, rgb, gates) = jnp.split(proj, IN_OFFSETS, axis=-1)
    B, L = proj.shape[:2]
    qa = (rmsnorm(cq, mla_qn) @ mla_wuq).reshape(B, L, MLA_HEADS, MLA_NOPE + MLA_ROPE)
    kva = (rmsnorm(ckv, mla_kvn) @ mla_wukv).reshape(B, L, MLA_HEADS, MLA_NOPE + MLA_V)
    q_nope, q_pe = qa[..., :MLA_NOPE], qa[..., MLA_NOPE:]
    k_nope, v_a = kva[..., :MLA_NOPE], kva[..., MLA_NOPE:]
    k_pe = kpe[:, :, None, :]
    gq = rmsnorm(gq.reshape(B, L, GQA_HEADS, GQA_HD), gqa_qn)
    gk = rmsnorm(gk.reshape(B, L, GQA_KV_HEADS, GQA_HD), gqa_kn)
    if pos is not None:
        row, col = pos
        q_pe = axial_rope(q_pe, row, col)
        k_pe = axial_rope(k_pe, row, col)
        gq = axial_rope(gq, row, col)
        gk = axial_rope(gk, row, col)
    q_a = jnp.concatenate([q_nope, q_pe], axis=-1)[:, :, :, None, :]
    k_a = jnp.concatenate([k_nope, jnp.broadcast_to(k_pe, (B, L, MLA_HEADS, MLA_ROPE))], axis=-1)
    mla = (q_a, k_a, v_a)
    gqa = (gq.reshape(B, L, GQA_KV_HEADS, GQA_HEADS // GQA_KV_HEADS, GQA_HD), gk,
           gv.reshape(B, L, GQA_KV_HEADS, GQA_HD))
    na = (nq.reshape(B, L, NA_HEADS, NA_HD), nk.reshape(B, L, NA_HEADS, NA_HD),
          nv.reshape(B, L, NA_HEADS, NA_HD))
    ret = (rq, rk, rv, rgf, rgb)
    return mla, gqa, na, ret, gates


def merge_branches(outs, gates, w_branch, w_out):
    g = jnp.split(gates, N_BRANCH, axis=-1)
    acc = jax.nn.sigmoid(g[0]) * (outs[0] @ w_branch[0])
    for i in range(1, N_BRANCH):
        acc = acc + jax.nn.sigmoid(g[i]) * (outs[i] @ w_branch[i])
    return acc @ w_out


def hybrid_mixer(hx, hc, pos, w_in, mla_qn, mla_wuq, mla_kvn, mla_wukv, gqa_qn, gqa_kn,
                 na_bias, ret_decay_logit, ret_gn_w, w_branch, w_out, need_ctx):
    wts = (mla_qn, mla_wuq, mla_kvn, mla_wukv, gqa_qn, gqa_kn)
    mla_x, gqa_x, na_x, ret_x, gates_x = stream_heads(hx @ w_in, pos, *wts)
    mla_c, gqa_c, na_c, ret_c, gates_c = stream_heads(hc @ w_in, None, *wts)
    B, S = hx.shape[:2]
    cat = lambda a, b: jnp.concatenate([a, b], axis=1)
    oa = block_attend(mla_x[0], cat(mla_c[1], mla_x[1]), cat(mla_c[2], mla_x[2]), MLA_SCALE)
    ob = block_attend(gqa_x[0], cat(gqa_c[1], gqa_x[1]), cat(gqa_c[2], gqa_x[2]), GQA_HD ** -0.5)
    oc = neighbourhood_attend(na_x[0], na_x[1], na_x[2], na_c[1], na_c[2], na_bias)
    od, od_c = retention_mixer(ret_x, ret_c, ret_decay_logit, ret_gn_w, need_ctx)
    yx = merge_branches((oa.reshape(B, S, -1), ob.reshape(B, S, -1), oc, od), gates_x, w_branch, w_out)
    yc = None
    if need_ctx:
        L = hc.shape[1]
        ca = block_attend(mla_c[0], mla_c[1], mla_c[2], MLA_SCALE).reshape(B, L, -1)
        cb = block_attend(gqa_c[0], gqa_c[1], gqa_c[2], GQA_HD ** -0.5).reshape(B, L, -1)
        cc = block_attend(na_c[0][:, :, :, None, :], na_c[1], na_c[2], NA_HD ** -0.5).reshape(B, L, -1)
        yc = merge_branches((ca, cb, cc, od_c), gates_c, w_branch, w_out)
    return yx, yc


def peer_ffn(h, w_q, keys, u, v):
    B, L, D = h.shape
    nb = (B * L) // PEER_BLOCK
    xb = h.reshape(nb, PEER_BLOCK, D)

    def one_block(xt):
        q = (xt @ w_q).reshape(PEER_BLOCK, PEER_HEADS, 2, PEER_DK // 2)
        s = jnp.einsum('thpd,hpkd->thpk', q, keys).astype(jnp.float32)
        s1, i1 = lax.top_k(s[:, :, 0], PEER_TOPK)
        s2, i2 = lax.top_k(s[:, :, 1], PEER_TOPK)
        cand = (s1[..., :, None] + s2[..., None, :]).reshape(PEER_BLOCK, PEER_HEADS, PEER_TOPK * PEER_TOPK)
        cand_idx = (i1[..., :, None] * PEER_N_KEYS + i2[..., None, :]).reshape(PEER_BLOCK, PEER_HEADS, PEER_TOPK * PEER_TOPK)
        top_s, top_pos = lax.top_k(cand, PEER_TOPK)
        eidx = jnp.take_along_axis(cand_idx, top_pos, axis=-1)
        g = jax.nn.softmax(top_s, axis=-1)
        act = jax.nn.gelu(jnp.einsum('td,thkd->thk', xt, u[eidx]).astype(jnp.float32), approximate=False)
        return jnp.einsum('thk,thkd->td', (g * act).astype(xt.dtype), v[eidx])

    return lax.map(one_block, xb).reshape(B, L, D)


def setup_inputs(seed: int = 0) -> dict:
    key = jax.random.key(seed)
    ks = jax.random.split(key, 26)
    f32 = jnp.float32
    D = D_MODEL

    def nrm(k, shape, scale):
        return jax.random.normal(k, shape, f32) * scale

    gam = 1.0 - 2.0 ** (-5.0 - jnp.arange(RET_HEADS, dtype=f32))
    base_logit = jnp.log(gam) - jnp.log1p(-gam)
    return {
        'x': nrm(ks[0], (BATCH, SEQ, D), 1.0),
        'c': nrm(ks[1], (BATCH, D), 1.0),
        'ctx': nrm(ks[2], (BATCH, CTX_LEN, D), 1.0),
        'c_ctx': nrm(ks[3], (D,), 1.0),
        'mod_w': nrm(ks[4], (DEPTH, D, 6 * D), 0.5 * D ** -0.5),
        'mod_b': nrm(ks[5], (DEPTH, 6 * D), 0.01),
        'norm1_w': 1.0 + nrm(ks[6], (DEPTH, D), 0.02),
        'norm2_w': 1.0 + nrm(ks[7], (DEPTH, D), 0.02),
        'w_in': nrm(ks[8], (DEPTH, D, IN_COLS), D ** -0.5),
        'mla_q_norm': 1.0 + nrm(ks[9], (DEPTH, MLA_Q_LORA), 0.02),
        'mla_w_uq': nrm(ks[10], (DEPTH, MLA_Q_LORA, MLA_HEADS * (MLA_NOPE + MLA_ROPE)), MLA_Q_LORA ** -0.5),
        'mla_kv_norm': 1.0 + nrm(ks[11], (DEPTH, MLA_KV_LORA), 0.02),
        'mla_w_ukv': nrm(ks[12], (DEPTH, MLA_KV_LORA, MLA_HEADS * (MLA_NOPE + MLA_V)), MLA_KV_LORA ** -0.5),
        'gqa_q_norm': 1.0 + nrm(ks[13], (DEPTH, GQA_HD), 0.02),
        'gqa_k_norm': 1.0 + nrm(ks[14], (DEPTH, GQA_HD), 0.02),
        'na_bias': nrm(ks[15], (DEPTH, NA_HEADS, 2 * NA_WIN_R - 1, 2 * NA_WIN_C - 1), 0.1),
        'ret_decay_logit': base_logit[None, None, :] + nrm(ks[16], (DEPTH, 2, RET_HEADS), 0.1),
        'ret_gn_w': 1.0 + nrm(ks[17], (DEPTH, RET_HEADS * RET_DV), 0.02),
        'w_branch': nrm(ks[18], (DEPTH, N_BRANCH, BRANCH_W, D), BRANCH_W ** -0.5),
        'w_out': nrm(ks[19], (DEPTH, D, D), D ** -0.5),
        'peer_w_q': nrm(ks[20], (DEPTH, D, PEER_HEADS * PEER_DK), D ** -0.5),
        'peer_keys': nrm(ks[21], (DEPTH, PEER_HEADS, 2, PEER_N_KEYS, PEER_DK // 2), (PEER_DK // 2) ** -0.5),
        'peer_u': nrm(ks[22], (DEPTH, PEER_N_EXPERTS, D), D ** -0.5),
        'peer_v': nrm(ks[23], (DEPTH, PEER_N_EXPERTS, D), PEER_HEADS ** -0.5),
        'final_norm_w': 1.0 + nrm(ks[24], (D,), 0.02),
    }


def reference(x, c, ctx, c_ctx, mod_w, mod_b, norm1_w, norm2_w, w_in, mla_q_norm, mla_w_uq,
              mla_kv_norm, mla_w_ukv, gqa_q_norm, gqa_k_norm, na_bias, ret_decay_logit, ret_gn_w,
              w_branch, w_out, peer_w_q, peer_keys, peer_u, peer_v, final_norm_w):
    S = x.shape[1]
    t = jnp.arange(S)
    pos = ((t // GRID_W).astype(jnp.float32), (t % GRID_W).astype(jnp.float32))
    for l in range(DEPTH):
        need_ctx = l < DEPTH - 1
        mx = (jax.nn.silu(c) @ mod_w[l] + mod_b[l])[:, None, :]
        mc = (jax.nn.silu(c_ctx) @ mod_w[l] + mod_b[l])[None, None, :]
        sh1x, sc1x, g1x, sh2x, sc2x, g2x = jnp.split(mx, 6, axis=-1)
        sh1c, sc1c, g1c, sh2c, sc2c, g2c = jnp.split(mc, 6, axis=-1)
        hx = rmsnorm(x, norm1_w[l]) * (1.0 + sc1x) + sh1x
        hc = rmsnorm(ctx, norm1_w[l]) * (1.0 + sc1c) + sh1c
        yx, yc = hybrid_mixer(hx, hc, pos, w_in[l], mla_q_norm[l], mla_w_uq[l], mla_kv_norm[l],
                              mla_w_ukv[l], gqa_q_norm[l], gqa_k_norm[l], na_bias[l],
                              ret_decay_logit[l], ret_gn_w[l], w_branch[l], w_out[l], need_ctx)
        x = x + g1x * yx
        hx2 = rmsnorm(x, norm2_w[l]) * (1.0 + sc2x) + sh2x
        x = x + g2x * peer_ffn(hx2, peer_w_q[l], peer_keys[l], peer_u[l], peer_v[l])
        if need_ctx:
            ctx = ctx + g1c * yc
            hc2 = rmsnorm(ctx, norm2_w[l]) * (1.0 + sc2c) + sh2c
            ctx = ctx + g2c * peer_ffn(hc2, peer_w_q[l], peer_keys[l], peer_u[l], peer_v[l])
    return rmsnorm(x, final_norm_w)
```

```cpp
#include <hip/hip_runtime.h>
#include <stdint.h>
#include <stdio.h>

#ifndef MK_ONE_LAUNCH
#define MK_ONE_LAUNCH 1
#endif

#define DM 1024
#define NBATCH 16
#define SEQ 4096
#define CTXL 256
#define LTOK 4352
#define IN_COLS 7072
#define NPROJ 7168
#define PLD 3072
#define NB 8
#define NGROUP (NBATCH / NB)
#define TG (NB * LTOK)
#define NTHREADS 512
#define LDS_BYTES 131648
#define EPSF 1e-6f

#define C_CQ 0
#define C_CKV 256
#define C_KPE 384
#define C_GQ 416
#define C_GK 672
#define C_GV 800
#define C_NQ 928
#define C_NK 1184
#define C_NV 1440
#define C_RQ 1696
#define C_RK 1952
#define C_RV 2208
#define C_RGF 2464
#define C_RGB 2720
#define C_GATE 2976

#define LAS __attribute__((address_space(3)))
typedef unsigned short bf16_t;
typedef short bf16x8 __attribute__((ext_vector_type(8)));
typedef float f32x4 __attribute__((ext_vector_type(4)));
typedef float f32x2 __attribute__((ext_vector_type(2)));
typedef __bf16 bf16x2_t __attribute__((ext_vector_type(2)));
typedef unsigned u32x4 __attribute__((ext_vector_type(4)));
typedef unsigned u32x2 __attribute__((ext_vector_type(2)));
typedef float f32x16 __attribute__((ext_vector_type(16)));
typedef short s16x4 __attribute__((ext_vector_type(4)));

__device__ __forceinline__ unsigned pack_bf16(float lo, float hi) { f32x2 v = {lo, hi}; bf16x2_t b = __builtin_convertvector(v, bf16x2_t); return __builtin_bit_cast(unsigned, b); }
__device__ __forceinline__ bf16_t f2bf(float f) { return (bf16_t)(pack_bf16(f, 0.f) & 0xffffu); }
__device__ __forceinline__ float bf2f(bf16_t b) { return __uint_as_float(((unsigned)b) << 16); }
__device__ __forceinline__ float bflo(unsigned w) { return __uint_as_float(w << 16); }
__device__ __forceinline__ float bfhi(unsigned w) { return __uint_as_float(w & 0xffff0000u); }
#define PEER_USCALE 128.f
#define PEER_VSCALE 16.f
__device__ __forceinline__ float clamp448(float x) { return fminf(fmaxf(x, -448.f), 448.f); }
__device__ __forceinline__ unsigned pack_fp8x4(f32x4 v, float sc) {
    int w = 0;
    w = __builtin_amdgcn_cvt_pk_fp8_f32(clamp448(v[0] * sc), clamp448(v[1] * sc), w, false);
    w = __builtin_amdgcn_cvt_pk_fp8_f32(clamp448(v[2] * sc), clamp448(v[3] * sc), w, true);
    return (unsigned)w;
}

template <int M> __device__ __forceinline__ float xor_swz(float v) { return __int_as_float(__builtin_amdgcn_ds_swizzle(__float_as_int(v), (M << 10) | 0x1f)); }
template <int M> __device__ __forceinline__ unsigned xor_swz_u(unsigned v) { return (unsigned)__builtin_amdgcn_ds_swizzle((int)v, (M << 10) | 0x1f); }
__device__ __forceinline__ float sum_xor32(float v) { const u32x2 r = __builtin_amdgcn_permlane32_swap(__float_as_uint(v), __float_as_uint(v), false, false); return __uint_as_float(r.x) + __uint_as_float(r.y); }
__device__ __forceinline__ float max_xor32(float v) { const u32x2 r = __builtin_amdgcn_permlane32_swap(__float_as_uint(v), __float_as_uint(v), false, false); return fmaxf(__uint_as_float(r.x), __uint_as_float(r.y)); }
__device__ __forceinline__ unsigned get_xor32_u(unsigned v, bool upper) { const u32x2 r = __builtin_amdgcn_permlane32_swap(v, v, false, false); return upper ? r.x : r.y; }
__device__ __forceinline__ float wave_max(float v) {
    v = fmaxf(v, xor_swz<1>(v)); v = fmaxf(v, xor_swz<2>(v)); v = fmaxf(v, xor_swz<4>(v)); v = fmaxf(v, xor_swz<8>(v)); v = fmaxf(v, xor_swz<16>(v));
    return max_xor32(v);
}
__device__ __forceinline__ float wave_sum(float v) {
    v += xor_swz<1>(v); v += xor_swz<2>(v); v += xor_swz<4>(v); v += xor_swz<8>(v); v += xor_swz<16>(v);
    return sum_xor32(v);
}
extern __shared__ __attribute__((aligned(16))) char smem[];
#define WIDTAB_OFF 64
__device__ __forceinline__ unsigned hw_wave_slot() { return (unsigned)__builtin_amdgcn_s_getreg((5 << 11) | 4) & 63u; }
__device__ __forceinline__ void tid_setup() {
    if ((threadIdx.x & 63) == 0) ((volatile LAS int*)(smem + WIDTAB_OFF))[hw_wave_slot()] = (int)(threadIdx.x >> 6);
    __syncthreads();
}
__device__ __forceinline__ int get_tid() {
    int lane; asm volatile("v_mbcnt_lo_u32_b32 %0, -1, 0\n\tv_mbcnt_hi_u32_b32 %0, -1, %0" : "=v"(lane));
    int w = ((volatile LAS int*)(smem + WIDTAB_OFF))[hw_wave_slot()];
    w = __builtin_amdgcn_readfirstlane(w);
    int t = (w << 6) | lane; asm volatile("" : "+v"(t)); return t;
}
__device__ __forceinline__ float siluf(float x) { return x * __builtin_amdgcn_rcpf(1.f + __builtin_amdgcn_exp2f(x * -1.4426950408889634f)); }
__device__ __forceinline__ float sigmf(float x) { return __builtin_amdgcn_rcpf(1.f + __builtin_amdgcn_exp2f(x * -1.4426950408889634f)); }

#define XB_TMO      128
#define XB_XCNT(j)  (256  + 64 * (j))
#define XB_XSUB(j)  (1280 + 64 * (j))
#define XB_XGEN(j)  (2304 + 64 * (j))
#define XB_TOP      3328
#define XB_TOPGEN   3392
#define XCD_BAR_WORDS 3456
#define XB_SPIN_CAP (1u << 18)

__device__ __forceinline__ unsigned xb_ld(unsigned* p)              { return __hip_atomic_load(p, __ATOMIC_RELAXED, __HIP_MEMORY_SCOPE_AGENT); }
__device__ __forceinline__ unsigned xb_add(unsigned* p, unsigned v) { return __hip_atomic_fetch_add(p, v, __ATOMIC_RELAXED, __HIP_MEMORY_SCOPE_AGENT); }
__device__ __forceinline__ unsigned xb_xcc_id() { return (unsigned)__builtin_amdgcn_s_getreg((3 << 11) | 20) & 0xFu; }
#define XB_SPIN(cond, bar) do { unsigned _sp = 0; while (cond) { __builtin_amdgcn_s_sleep(1); \
    if ((++_sp & 255u) == 0u) { if (xb_ld(&(bar)[XB_TMO])) break; if (_sp > XB_SPIN_CAP) { atomicAdd(&(bar)[XB_TMO], 1u); break; } } } } while (0)

struct XcdBarrier { unsigned* bar; unsigned x; volatile LAS unsigned* st; };

__device__ __forceinline__ XcdBarrier xcd_barrier_post(unsigned* bar, volatile LAS unsigned* st) {
    XcdBarrier b; b.bar = bar; b.x = xb_xcc_id(); b.st = st;
    if (get_tid() == 0) (void)xb_add(&bar[XB_XCNT(b.x)], 1u);
    return b;
}
__device__ __forceinline__ void xcd_barrier_complete(unsigned* bar, unsigned x, unsigned& nloc, unsigned& nx) {
    const unsigned G = gridDim.x * gridDim.y * gridDim.z;
    unsigned sum, cnt, mine, sp = 0u;
    for (;;) {
        sum = 0u; cnt = 0u; mine = 0u;
#pragma unroll
        for (unsigned j = 0; j < 16; ++j) { const unsigned c = xb_ld(&bar[XB_XCNT(j)]); sum += c; cnt += (c > 0u) ? 1u : 0u; mine = (j == x) ? c : mine; }
        if (sum == G) break;
        __builtin_amdgcn_s_sleep(1);
        if ((++sp & 255u) == 0u) { if (xb_ld(&bar[XB_TMO])) break; if (sp > XB_SPIN_CAP) { atomicAdd(&bar[XB_TMO], 1u); break; } }
    }
    nloc = mine > 0u ? mine : 1u; nx = cnt > 0u ? cnt : 1u;
}
__device__ __forceinline__ void xcd_barrier(const XcdBarrier& b) {
    asm volatile("s_waitcnt vmcnt(0)" ::: "memory");
    __syncthreads();
    if (get_tid() == 0) {
        unsigned* bar = b.bar;
        __builtin_amdgcn_s_waitcnt(0);
        unsigned nloc = b.st[0], nx = b.st[1];
        if (nloc == 0u) { xcd_barrier_complete(bar, b.x, nloc, nx); b.st[0] = nloc; b.st[1] = nx; }
        const unsigned old = xb_add(&bar[XB_XSUB(b.x)], 1u);
        const unsigned gen = old / nloc;
        if (old + 1u == (gen + 1u) * nloc) {
            __builtin_amdgcn_fence(__ATOMIC_RELEASE, "agent");
            asm volatile("s_waitcnt vmcnt(0)" ::: "memory");
            const unsigned og = xb_add(&bar[XB_TOP], 1u);
            const unsigned tg = og / nx;
            if (og + 1u == (tg + 1u) * nx) xb_add(&bar[XB_TOPGEN], 1u);
            else XB_SPIN(xb_ld(&bar[XB_TOPGEN]) == tg, bar);
            __builtin_amdgcn_fence(__ATOMIC_ACQUIRE, "agent");
            xb_add(&bar[XB_XGEN(b.x)], 1u);
            asm volatile("s_waitcnt vmcnt(0)" ::: "memory");
        } else {
            XB_SPIN(xb_ld(&bar[XB_XGEN(b.x)]) == gen, bar);
            __builtin_amdgcn_fence(__ATOMIC_ACQUIRE, "agent");
            asm volatile("s_waitcnt vmcnt(0)" ::: "memory");
        }
    }
    __syncthreads();
}

struct Params {
    const float *x, *c, *ctx, *c_ctx, *mod_w, *mod_b, *norm1_w, *norm2_w, *w_in, *mla_qn, *mla_wuq, *mla_kvn, *mla_wukv,
                *gqa_qn, *gqa_kn, *na_bias, *ret_logit, *ret_gnw, *w_branch, *w_out, *peer_wq, *peer_keys, *peer_u, *peer_v, *final_w;
    float* out;
    char* ws;
};
typedef const __attribute__((address_space(4))) Params* KP;
__device__ __forceinline__ KP get_kp() { KP kp = (KP)__builtin_amdgcn_kernarg_segment_ptr(); asm volatile("" : "+s"(kp)); return kp; }

constexpr size_t al256c(size_t x) { return (x + 255) & ~(size_t)255; }
constexpr size_t WS_BAR = 0;
constexpr size_t WS_CNT = WS_BAR + al256c(XCD_BAR_WORDS * 4);
constexpr size_t WS_ZERO_END = WS_CNT + al256c(8 * 8 * 64 * 4);
constexpr size_t WS_MOD = WS_ZERO_END;
constexpr size_t WS_CTXS = WS_MOD + al256c((size_t)2 * 17 * 6144 * 4);
constexpr size_t WS_WINT = WS_CTXS + al256c((size_t)NBATCH * CTXL * DM * 4);
constexpr size_t WS_WUQT = WS_WINT + al256c((size_t)2 * NPROJ * DM * 2);
constexpr size_t WS_WUKVT = WS_WUQT + al256c((size_t)2 * 384 * 256 * 2);
constexpr size_t WS_WBT = WS_WUKVT + al256c((size_t)2 * 512 * 128 * 2);
constexpr size_t WS_WOUTT = WS_WBT + al256c((size_t)2 * 4 * DM * 256 * 2);
constexpr size_t WS_WQT = WS_WOUTT + al256c((size_t)2 * DM * DM * 2);
constexpr size_t WS_H = WS_WQT + al256c((size_t)2 * DM * DM * 2);
constexpr size_t WS_PROJ = WS_H + al256c((size_t)NGROUP * TG * DM * 2);
#define HG(p_, g_) (((bf16_t*)((p_)->ws + WS_H)) + (size_t)(g_) * TG * DM)
constexpr size_t WS_GATE8 = WS_PROJ + al256c((size_t)TG * PLD * 2);
constexpr size_t WS_QRAW = WS_GATE8 + al256c((size_t)TG * 4096);
constexpr size_t WS_KVRAW = WS_QRAW + al256c((size_t)TG * 384 * 2);
constexpr size_t WS_QA = WS_KVRAW + al256c((size_t)TG * 512 * 2);
constexpr size_t WS_KA = WS_QA + al256c((size_t)TG * 384 * 2);
constexpr size_t WS_VA = WS_KA + al256c((size_t)TG * 384 * 2);
constexpr size_t WS_GQ = WS_VA + al256c((size_t)TG * 256 * 2);
constexpr size_t WS_GK = WS_GQ + al256c((size_t)TG * 256 * 2);
constexpr size_t WS_OUTS = WS_GK + al256c((size_t)TG * 128 * 2);
constexpr size_t WS_ACC = WS_QRAW;
constexpr size_t WS_PQ = WS_OUTS;
constexpr size_t WS_RKV = WS_OUTS + al256c((size_t)4 * TG * 256 * 2);
constexpr size_t WS_UB = WS_RKV + al256c((size_t)NB * 4 * 2 * 34 * 4096 * 4);
constexpr size_t WS_VB = WS_UB + al256c((size_t)2 * 16384 * DM);
constexpr size_t WS_KEYB = WS_VB + al256c((size_t)2 * 16384 * DM);
constexpr size_t WS_USC = WS_UB + (size_t)2 * 16384 * (DM / 2);
constexpr size_t WS_VSC = WS_VB + (size_t)2 * 16384 * (DM / 2);
constexpr size_t WS_TOTAL = WS_KEYB + al256c((size_t)2 * 8 * 2 * 128 * 64 * 2);

#define G_BM 256
#define G_BN 128
#define G_BK 64
#define G_LDP 144
#define G_ABYTES (G_BM * G_LDP)
#define G_BBYTES (G_BN * G_LDP)
#define G_STAGE (G_ABYTES + G_BBYTES)

template <int MI>
__device__ __forceinline__ void gemm_tile(const bf16_t* __restrict__ A, int lda, const bf16_t* __restrict__ Bt, int ldb, int K,
                                          f32x4 (&acc)[MI][4], char* lds)
{
    constexpr int NA = MI;
    const int tid = get_tid(), lane = tid & 63, wid = tid >> 6, wm = wid >> 1, wn = wid & 1, fr = lane & 15, fq = lane >> 4;
    const int nk = K / G_BK;
    u32x4 ra[NA], rb[2];
    const int arow = tid >> 3, akc = tid & 7;
    const bf16_t* ag = A + (size_t)arow * lda + akc * 8;
    const bf16_t* bg = Bt + (size_t)arow * ldb + akc * 8;
    const int a_l = arow * G_LDP + akc * 16;
#pragma unroll
    for (int i = 0; i < NA; ++i) ra[i] = *(const u32x4*)(ag + (size_t)(64 * i) * lda);
#pragma unroll
    for (int i = 0; i < 2; ++i) rb[i] = *(const u32x4*)(bg + (size_t)(64 * i) * ldb);
    __syncthreads();
#pragma unroll
    for (int i = 0; i < NA; ++i) *(u32x4*)(lds + a_l + i * 64 * G_LDP) = ra[i];
#pragma unroll
    for (int i = 0; i < 2; ++i) *(u32x4*)(lds + G_ABYTES + a_l + i * 64 * G_LDP) = rb[i];
    __syncthreads();
    const int aoff = (wm * 16 * MI + fr) * G_LDP + fq * 16;
    const int boff = G_ABYTES + (wn * 64 + fr) * G_LDP + fq * 16;
    for (int kt = 0; kt < nk; ++kt) {
        const int cur = (kt & 1) * G_STAGE, nxt = ((kt + 1) & 1) * G_STAGE;
        const bool more = (kt + 1 < nk);
        if (more) {
#pragma unroll
            for (int i = 0; i < NA; ++i) ra[i] = *(const u32x4*)(ag + (size_t)(64 * i) * lda + (kt + 1) * G_BK);
#pragma unroll
            for (int i = 0; i < 2; ++i) rb[i] = *(const u32x4*)(bg + (size_t)(64 * i) * ldb + (kt + 1) * G_BK);
        }
#pragma unroll
        for (int ks = 0; ks < 2; ++ks) {
            bf16x8 af[MI], bfr[4];
#pragma unroll
            for (int mi = 0; mi < MI; ++mi) af[mi] = *(const bf16x8*)(lds + cur + aoff + mi * 16 * G_LDP + ks * 64);
#pragma unroll
            for (int ni = 0; ni < 4; ++ni) bfr[ni] = *(const bf16x8*)(lds + cur + boff + ni * 16 * G_LDP + ks * 64);
#pragma unroll
            for (int mi = 0; mi < MI; ++mi)
#pragma unroll
                for (int ni = 0; ni < 4; ++ni) acc[mi][ni] = __builtin_amdgcn_mfma_f32_16x16x32_bf16(bfr[ni], af[mi], acc[mi][ni], 0, 0, 0);
        }
        if (more) {
#pragma unroll
            for (int i = 0; i < NA; ++i) *(u32x4*)(lds + nxt + a_l + i * 64 * G_LDP) = ra[i];
#pragma unroll
            for (int i = 0; i < 2; ++i) *(u32x4*)(lds + nxt + G_ABYTES + a_l + i * 64 * G_LDP) = rb[i];
        }
        __syncthreads();
    }
}

template <int MI>
__device__ __forceinline__ void zero_acc(f32x4 (&acc)[MI][4]) {
#pragma unroll
    for (int i = 0; i < MI; ++i)
#pragma unroll
        for (int j = 0; j < 4; ++j) acc[i][j] = (f32x4){0.f, 0.f, 0.f, 0.f};
}

template <class Epi>
__device__ __forceinline__ void gemm_phase(const bf16_t* A, int lda, const bf16_t* Bt, int ldb, int M, int N, int K, const Epi& epi, char* lds, int bid, int nblk)
{
    const int tid = get_tid(), lane = tid & 63, wid = tid >> 6, wm = wid >> 1, wn = wid & 1, fr = lane & 15, fq = lane >> 4;
    const int tn = N / G_BN, total = (M / G_BM) * tn;
    for (int t = bid; t < total; t += nblk) {
        const int pm = t / tn, pn = t % tn;
        f32x4 acc[4][4]; zero_acc(acc);
        gemm_tile<4>(A + (size_t)pm * G_BM * lda, lda, Bt + (size_t)pn * G_BN * ldb, ldb, K, acc, lds);
#pragma unroll
        for (int mi = 0; mi < 4; ++mi)
#pragma unroll
            for (int ni = 0; ni < 4; ++ni) epi(pm * G_BM + wm * 64 + mi * 16 + fr, pn * G_BN + wn * 64 + ni * 16 + fq * 4, acc[mi][ni]);
    }
}

__device__ __forceinline__ void store_bf16x4(bf16_t* p, f32x4 v) { u32x2 w; w.x = pack_bf16(v[0], v[1]); w.y = pack_bf16(v[2], v[3]); *(u32x2*)p = w; }


namespace pg8 {
#define PG8_LAS __attribute__((address_space(3)))
typedef unsigned short bf16_t;
typedef short bf16x8 __attribute__((ext_vector_type(8)));
typedef float f32x4 __attribute__((ext_vector_type(4)));
typedef unsigned u32x4 __attribute__((ext_vector_type(4)));
constexpr int BM = 256, BK = 64, HALF = 128, HTB = HALF * BK * 2  , STAGE_BYTES = 8 * HTB, NXCD = 8, WGM = 8;

__host__ __device__ __forceinline__ int lds_byte(int r, int c) { const int st = (r >> 4) * 2 + (c >> 5), rr = r & 15, cc = c & 31, ob = rr * 64 + cc * 2; return st * 1024 + (ob ^ (((ob >> 9) & 1) << 5)); }
__host__ __device__ __forceinline__ void stage_rc(int b, int& R, int& C) { const int st = b / 1024, sb = b % 1024, swz = sb ^ (((sb >> 9) & 1) << 5); R = (st >> 1) * 16 + swz / 64; C = (st & 1) * 32 + (swz % 64) / 2; }
__host__ __device__ __forceinline__ int perm32(int rho) { const int n = rho >> 4, i = rho & 15; return 8 * (i >> 2) + 4 * n + (i & 3); }

struct Unit { int pm, pn; };
struct Gemm { const bf16_t* A; const bf16_t* Bt; int M, N, K; };

struct StaticOrder {
    int nM, nN, nwg, G, c, lim;
    __host__ __device__ void init(int M, int N, int G_, int c_) { nM = M / BM; nN = N / BM; nwg = nM * nN; G = G_; c = c_; lim = nwg; }
    __host__ __device__ void map(int L, Unit& u) const {
        int wgid = L; { const int q = nwg / NXCD, r = nwg % NXCD, xcd = wgid % NXCD, off = wgid / NXCD; wgid = (xcd < r ? xcd * (q + 1) : r * (q + 1) + (xcd - r) * q) + off; }
        const int nig = WGM * nN, gid = wgid / nig, fm = gid * WGM, gsz = (nM - fm) < WGM ? (nM - fm) : WGM;
        u.pm = fm + ((wgid % nig) % gsz); u.pn = (wgid % nig) / gsz;
    }
    __host__ __device__ bool next(int i, Unit& u) const {
        const long L = (long)i * G + c; if (L >= lim) return false;
        map((int)L, u); return true;
    }
    __device__ __forceinline__ void a_ready(const Unit&) const {}
    __device__ __forceinline__ void done(const Unit&) const {}
};
template <class Epi, class Sched, bool ALIGN_EPI = false, bool SP2 = false>
__device__ __forceinline__ void gemm_phase(PG8_LAS unsigned char* lds, const Gemm g, const Sched& S, const Epi& E) {
    const int tid = get_tid(), wid = __builtin_amdgcn_readfirstlane(tid >> 6), lane = tid & 63, wr = wid >> 2, wc = wid & 3, fr = lane & 15, fq = lane >> 4;
    const int K = g.K, nt = K / BK;
    unsigned voffA[2], voffB[2];
#pragma unroll
    for (int i = 0; i < 2; ++i) { int R, C; stage_rc(tid * 16 + i * 8192, R, C); const int Rb = Epi::PERM ? ((R & ~31) + perm32(R & 31)) : R;
        voffA[i] = (unsigned)(R * K + C) * 2u; voffB[i] = (unsigned)(Rb * K + C) * 2u; }
    const size_t kstep = (size_t)(BK * 2);
    const size_t hstep = (size_t)HALF * K * 2;
    const size_t tstep = 2 * hstep;
    const unsigned ldsw = (unsigned)wid * 1024u;
    const int aoff = lds_byte(wr * 64 + fr, fq * 8), boff = lds_byte(wc * 32 + fr, fq * 8);
#define PG8_SA(b, h) (((b) * 2 + (h)) * HTB)
#define PG8_SB(b, h) ((4 + (b) * 2 + (h)) * HTB)
#define PG8_STAGE(bufoff, gbase, voff) do { _Pragma("unroll") for (int _i = 0; _i < 2; ++_i) \
        __builtin_amdgcn_global_load_lds((const unsigned*)((const char*)(gbase) + (voff)[_i]), (PG8_LAS unsigned*)(lds + (bufoff) + ldsw + _i * 8192), 16, 0, 0); } while (0)
#define PG8_LDA(dst, b, h) do { _Pragma("unroll") for (int m = 0; m < 4; ++m) _Pragma("unroll") for (int k = 0; k < 2; ++k) dst[m][k] = *(const PG8_LAS bf16x8*)(lds + PG8_SA(b, h) + aoff + m * 2048 + k * 1024); } while (0)
#define PG8_LDB(dst, b, h) do { _Pragma("unroll") for (int n = 0; n < 2; ++n) _Pragma("unroll") for (int k = 0; k < 2; ++k) dst[n][k] = *(const PG8_LAS bf16x8*)(lds + PG8_SB(b, h) + boff + n * 2048 + k * 1024); } while (0)
#define PG8_MMA(ai, bj, At, Bt) do { __builtin_amdgcn_s_setprio(1); _Pragma("unroll") for (int m = 0; m < 4; ++m) _Pragma("unroll") for (int n = 0; n < 2; ++n) _Pragma("unroll") for (int k = 0; k < 2; ++k) \
        acc[ai][bj][m][n] = __builtin_amdgcn_mfma_f32_16x16x32_bf16(Bt[n][k], At[m][k], acc[ai][bj][m][n], 0, 0, 0); __builtin_amdgcn_s_setprio(0); } while (0)
#define PG8_WAIT_V(n) asm volatile("s_waitcnt vmcnt(" #n ")" ::: "memory")
#define PG8_WAIT_L(n) asm volatile("s_waitcnt lgkmcnt(" #n ")" ::: "memory")
#define PG8_BAR __builtin_amdgcn_s_barrier()
#define PG8_SCHED __builtin_amdgcn_sched_barrier(0)
    Unit cur, nxt; int ui = 0;
    if (!S.next(0, cur)) return;
    f32x4 acc[2][2][4][2];
#pragma unroll
    for (int a = 0; a < 2; ++a)
#pragma unroll
        for (int b = 0; b < 2; ++b)
#pragma unroll
            for (int m = 0; m < 4; ++m)
#pragma unroll
                for (int n = 0; n < 2; ++n) acc[a][b][m][n] = (f32x4){0.f, 0.f, 0.f, 0.f};
    bf16x8 At[4][2], B0[2][2], B1[2][2];
    const char* cA = (const char*)g.A + (size_t)cur.pm * tstep; const char* cB = (const char*)g.Bt + (size_t)cur.pn * tstep;
    S.a_ready(cur);
    if constexpr (SP2) {
        PG8_STAGE(PG8_SB(0, 0), cB, voffB); PG8_STAGE(PG8_SB(0, 1), cB + hstep, voffB); PG8_STAGE(PG8_SA(0, 0), cA, voffA); PG8_STAGE(PG8_SA(0, 1), cA + hstep, voffA);
        if (wr == 1) PG8_BAR;
        PG8_WAIT_V(2); PG8_BAR;
        PG8_STAGE(PG8_SB(1, 0), cB + kstep, voffB); PG8_STAGE(PG8_SA(1, 0), cA + kstep, voffA); PG8_STAGE(PG8_SB(1, 1), cB + hstep + kstep, voffB);
        PG8_WAIT_V(6); PG8_BAR;
    } else {
        PG8_STAGE(PG8_SB(0, 0), cB, voffB); PG8_STAGE(PG8_SA(0, 0), cA, voffA); PG8_STAGE(PG8_SB(0, 1), cB + hstep, voffB); PG8_STAGE(PG8_SA(0, 1), cA + hstep, voffA);
        if (wr == 1) PG8_BAR;
        PG8_WAIT_V(4); PG8_BAR;
        PG8_STAGE(PG8_SB(1, 0), cB + kstep, voffB); PG8_STAGE(PG8_SA(1, 0), cA + kstep, voffA); PG8_STAGE(PG8_SB(1, 1), cB + hstep + kstep, voffB);
        PG8_WAIT_V(6); PG8_BAR;
    }
    for (;;) {
        const bool has_next = S.next(ui + 1, nxt);
        const char* nA = has_next ? (const char*)g.A + (size_t)nxt.pm * tstep : cA; const char* nB = has_next ? (const char*)g.Bt + (size_t)nxt.pn * tstep : cB;
        for (int t = 0; t < nt; t += 2) {
            const bool last = (t == nt - 2);
            const char* a1 = cA + (size_t)(t + 1) * kstep;
            const char* a2 = last ? nA : cA + (size_t)(t + 2) * kstep; const char* b2 = last ? nB : cB + (size_t)(t + 2) * kstep;
            const char* a3 = a2 + kstep; const char* b3 = b2 + kstep;
            if (last && has_next) S.a_ready(nxt);
            if constexpr (SP2) {
            PG8_LDB(B0, 0, 0); PG8_LDB(B1, 0, 1); PG8_SCHED; PG8_LDA(At, 0, 0); PG8_STAGE(PG8_SA(1, 1), a1 + hstep, voffA);
            PG8_WAIT_V(8); PG8_WAIT_L(0); PG8_BAR; PG8_MMA(0, 0, At, B0); PG8_MMA(0, 1, At, B1); PG8_BAR; PG8_SCHED;
            PG8_LDA(At, 0, 1); PG8_STAGE(PG8_SB(0, 0), b2, voffB); PG8_STAGE(PG8_SB(0, 1), b2 + hstep, voffB); PG8_STAGE(PG8_SA(0, 0), a2, voffA);
            PG8_WAIT_V(8); PG8_WAIT_L(0); PG8_BAR; PG8_MMA(1, 0, At, B0); PG8_MMA(1, 1, At, B1); PG8_BAR; PG8_SCHED;
            PG8_LDB(B0, 1, 0); PG8_LDB(B1, 1, 1); PG8_SCHED; PG8_LDA(At, 1, 0); PG8_STAGE(PG8_SA(0, 1), a2 + hstep, voffA);
            PG8_WAIT_V(8); PG8_WAIT_L(0); PG8_BAR; PG8_MMA(0, 0, At, B0); PG8_MMA(0, 1, At, B1); PG8_BAR; PG8_SCHED;
            PG8_LDA(At, 1, 1); PG8_STAGE(PG8_SB(1, 0), b3, voffB); PG8_STAGE(PG8_SB(1, 1), b3 + hstep, voffB); PG8_STAGE(PG8_SA(1, 0), a3, voffA);
            PG8_WAIT_V(8); PG8_WAIT_L(0); PG8_BAR; PG8_MMA(1, 0, At, B0); PG8_MMA(1, 1, At, B1); PG8_BAR; PG8_SCHED;
            } else {
            PG8_LDB(B0, 0, 0); PG8_SCHED; PG8_LDA(At, 0, 0); PG8_STAGE(PG8_SA(1, 1), a1 + hstep, voffA);
            PG8_WAIT_L(8); PG8_BAR; PG8_WAIT_L(0); PG8_MMA(0, 0, At, B0); PG8_BAR; PG8_SCHED;
            PG8_LDB(B1, 0, 1); PG8_STAGE(PG8_SB(0, 0), b2, voffB);
            PG8_BAR; PG8_WAIT_L(0); PG8_MMA(0, 1, At, B1); PG8_BAR;
            PG8_LDA(At, 0, 1); PG8_STAGE(PG8_SA(0, 0), a2, voffA);
            PG8_BAR; PG8_WAIT_L(0); PG8_MMA(1, 0, At, B0); PG8_BAR; PG8_SCHED;
            PG8_STAGE(PG8_SB(0, 1), b2 + hstep, voffB);
            PG8_WAIT_V(6); PG8_BAR; PG8_MMA(1, 1, At, B1); PG8_BAR;
            PG8_LDB(B0, 1, 0); PG8_SCHED; PG8_LDA(At, 1, 0); PG8_STAGE(PG8_SA(0, 1), a2 + hstep, voffA);
            PG8_WAIT_L(8); PG8_BAR; PG8_WAIT_L(0); PG8_MMA(0, 0, At, B0); PG8_BAR; PG8_SCHED;
            PG8_LDB(B1, 1, 1); PG8_STAGE(PG8_SB(1, 0), b3, voffB);
            PG8_BAR; PG8_WAIT_L(0); PG8_MMA(0, 1, At, B1); PG8_BAR;
            PG8_LDA(At, 1, 1); PG8_STAGE(PG8_SA(1, 0), a3, voffA);
            PG8_BAR; PG8_WAIT_L(0); PG8_MMA(1, 0, At, B0); PG8_BAR; PG8_SCHED;
            PG8_STAGE(PG8_SB(1, 1), b3 + hstep, voffB);
            PG8_WAIT_V(6); PG8_BAR; PG8_MMA(1, 1, At, B1); PG8_BAR;
            }
        }
        if constexpr (ALIGN_EPI) { if (wr == 0) PG8_BAR; }
        if constexpr (!Epi::AFTER_DRAIN) { E(acc, cur, wr, wc, fr, fq); S.done(cur); }
        if (!has_next) break;
#pragma unroll
        for (int a = 0; a < 2; ++a)
#pragma unroll
            for (int b = 0; b < 2; ++b)
#pragma unroll
                for (int m = 0; m < 4; ++m)
#pragma unroll
                    for (int n = 0; n < 2; ++n) acc[a][b][m][n] = (f32x4){0.f, 0.f, 0.f, 0.f};
        cur = nxt; cA = nA; cB = nB; ++ui;
        if constexpr (ALIGN_EPI) { if (wr == 1) PG8_BAR; }
    }
    PG8_WAIT_V(0);
    if constexpr (!ALIGN_EPI) { if (wr == 0) PG8_BAR; }
    PG8_BAR;
    if constexpr (Epi::AFTER_DRAIN) { E.fused(acc, cur, wr, wc, fr, fq, lds, wid, lane); S.done(cur); }
#undef PG8_SA
#undef PG8_SB
#undef PG8_STAGE
#undef PG8_LDA
#undef PG8_LDB
#undef PG8_MMA
#undef PG8_WAIT_V
#undef PG8_WAIT_L
#undef PG8_BAR
#undef PG8_SCHED
}
}

template <class F> struct Epi4 {
    static constexpr bool PERM = false, AFTER_DRAIN = false; F f;
    __device__ __forceinline__ void operator()(const f32x4 (&acc)[2][2][4][2], const pg8::Unit& u, int wr, int wc, int fr, int fq) const {
#pragma unroll
        for (int ai = 0; ai < 2; ++ai)
#pragma unroll
            for (int m = 0; m < 4; ++m)
#pragma unroll
                for (int bj = 0; bj < 2; ++bj)
#pragma unroll
                    for (int n = 0; n < 2; ++n) f(u.pm * 256 + ai * 128 + wr * 64 + m * 16 + fr, u.pn * 256 + bj * 128 + wc * 32 + n * 16 + fq * 4, acc[ai][bj][m][n]);
    }
};
template <class F> struct Epi8 {
    static constexpr bool PERM = true, AFTER_DRAIN = false; F f;
    __device__ __forceinline__ void operator()(const f32x4 (&acc)[2][2][4][2], const pg8::Unit& u, int wr, int wc, int fr, int fq) const {
#pragma unroll
        for (int ai = 0; ai < 2; ++ai)
#pragma unroll
            for (int m = 0; m < 4; ++m)
#pragma unroll
                for (int bj = 0; bj < 2; ++bj) f(u.pm * 256 + ai * 128 + wr * 64 + m * 16 + fr, u.pn * 256 + bj * 128 + wc * 32 + fq * 8, acc[ai][bj][m][0], acc[ai][bj][m][1]);
    }
};
template <class E>
__device__ __forceinline__ void big_gemm(const bf16_t* A, const bf16_t* Bt, int M, int N, int K, const E& e, char* lds, int bid, int nblk) {
    pg8::StaticOrder so; so.init(M, N, nblk, bid);
    pg8::gemm_phase<E, pg8::StaticOrder, true, true>((PG8_LAS unsigned char*)lds, pg8::Gemm{A, Bt, M, N, K}, so, e);
}

template <class F4>
__device__ __forceinline__ void gemm_tail64(const bf16_t* __restrict__ A, const bf16_t* __restrict__ Bt, int row0, int col0, const F4& f, char* lds)
{
    const int tid = get_tid(), lane = tid & 63, wid = tid >> 6, wm = wid >> 1, wn = wid & 1, fr = lane & 15, fq = lane >> 4;
    const int arow = tid >> 3, akc = tid & 7, a_l = arow * G_LDP + akc * 16;
    const int aoff = (wm * 16 + fr) * G_LDP + fq * 16, boff = G_ABYTES + (wn * 64 + fr) * G_LDP + fq * 16;
    const bf16_t* ag = A + ((size_t)row0 + arow) * DM + akc * 8;
    const bf16_t* bg = Bt + ((size_t)col0 + arow) * DM + akc * 8;
    f32x4 acc[4];
#pragma unroll
    for (int ni = 0; ni < 4; ++ni) acc[ni] = (f32x4){0.f, 0.f, 0.f, 0.f};
    u32x4 sa[8], sb[8][2];
#define GT_LOAD(S_, KT) do { sa[S_] = *(const u32x4*)(ag + (KT) * 64); sb[S_][0] = *(const u32x4*)(bg + (KT) * 64); sb[S_][1] = *(const u32x4*)(bg + (size_t)64 * DM + (KT) * 64); } while (0)
#define GT_STORE(S_, BO) do { *(u32x4*)(lds + (BO) + a_l) = sa[S_]; *(u32x4*)(lds + (BO) + G_ABYTES + a_l) = sb[S_][0]; *(u32x4*)(lds + (BO) + G_ABYTES + a_l + 64 * G_LDP) = sb[S_][1]; } while (0)
    GT_LOAD(0, 0); GT_LOAD(1, 1); GT_LOAD(2, 2); GT_LOAD(3, 3); GT_LOAD(4, 4); GT_LOAD(5, 5); GT_LOAD(6, 6); GT_LOAD(7, 7);
    __syncthreads();
    GT_STORE(0, 0);
    __syncthreads();
#pragma unroll
    for (int kt = 0; kt < 16; ++kt) {
        const int cur = (kt & 1) * G_STAGE, nxt = ((kt + 1) & 1) * G_STAGE;
        if (kt + 8 < 16) GT_LOAD(kt & 7, kt + 8);
#pragma unroll
        for (int ks = 0; ks < 2; ++ks) {
            const bf16x8 af = *(const bf16x8*)(lds + cur + aoff + ks * 64);
            bf16x8 bfr[4];
#pragma unroll
            for (int ni = 0; ni < 4; ++ni) bfr[ni] = *(const bf16x8*)(lds + cur + boff + ni * 16 * G_LDP + ks * 64);
#pragma unroll
            for (int ni = 0; ni < 4; ++ni) acc[ni] = __builtin_amdgcn_mfma_f32_16x16x32_bf16(bfr[ni], af, acc[ni], 0, 0, 0);
        }
        if (kt + 1 < 16) GT_STORE((kt + 1) & 7, nxt);
        __syncthreads();
    }
#undef GT_LOAD
#undef GT_STORE
#pragma unroll
    for (int ni = 0; ni < 4; ++ni) f(row0 + wm * 16 + fr, col0 + wn * 64 + ni * 16 + fq * 4, acc[ni]);
}

template <class E, class F4>
__device__ __forceinline__ void big_gemm_tail(const bf16_t* A, const bf16_t* Bt, int M, int N, const E& e, const F4& f4, char* lds, int bid, int nblk) {
    pg8::StaticOrder so; so.init(M, N, nblk, bid);
    const int rem = so.nwg % nblk;
    const bool split = rem > 0 && rem * 8 <= nblk;
    if (split) so.lim = so.nwg - rem;
    pg8::gemm_phase<E, pg8::StaticOrder, true, true>((PG8_LAS unsigned char*)lds, pg8::Gemm{A, Bt, M, N, DM}, so, e);
    if (split) {
        const bool x8 = (rem % 8) == 0;
        for (int j = bid; j < rem * 8; j += nblk) {
            const int unit = x8 ? (j & 7) + 8 * (j >> 6) : (j >> 3), sub = x8 ? ((j >> 3) & 7) : (j & 7);
            pg8::Unit u; so.map(so.lim + unit, u);
            gemm_tail64(A, Bt, u.pm * 256 + (sub >> 1) * 64, u.pn * 256 + (sub & 1) * 128, f4, lds);
        }
    }
}

__device__ __forceinline__ void transpose_cvt(const float* __restrict__ src, int K, int N, int Npad, bf16_t* __restrict__ dst, const float* __restrict__ kscale, float* lds, int bid, int nblk)
{
    const int tid = get_tid();
    const int tk = K / 64, tn = Npad / 64, total = tk * tn;
    const int lk = tid >> 3, ln = (tid & 7) * 8;
    const int sn = tid >> 3, sk = (tid & 7) * 8;
    for (int t = bid; t < total; t += nblk) {
        const int k0 = (t / tn) * 64, n0 = (t % tn) * 64;
        f32x4 a = (f32x4){0.f, 0.f, 0.f, 0.f}, c = a;
        if (n0 + ln < N) { const float* sp = src + (size_t)(k0 + lk) * N + n0 + ln; a = *(const f32x4*)sp; c = *(const f32x4*)(sp + 4); if (kscale) { const float ks = kscale[k0 + lk]; a *= ks; c *= ks; } }
        __syncthreads();
#pragma unroll
        for (int j = 0; j < 4; ++j) { lds[lk * 65 + ln + j] = a[j]; lds[lk * 65 + ln + 4 + j] = c[j]; }
        __syncthreads();
        u32x4 w;
        w.x = pack_bf16(lds[(sk + 0) * 65 + sn], lds[(sk + 1) * 65 + sn]); w.y = pack_bf16(lds[(sk + 2) * 65 + sn], lds[(sk + 3) * 65 + sn]);
        w.z = pack_bf16(lds[(sk + 4) * 65 + sn], lds[(sk + 5) * 65 + sn]); w.w = pack_bf16(lds[(sk + 6) * 65 + sn], lds[(sk + 7) * 65 + sn]);
        *(u32x4*)(dst + (size_t)(n0 + sn) * K + k0 + sk) = w;
    }
}

__device__ __forceinline__ void phase_prologue(KP p, char* ldsc, int bid, int nblk)
{
    float* lds = (float*)ldsc;
    const int tid = get_tid();
    for (int l = 0; l < 2; ++l) {
        transpose_cvt(p->w_in + (size_t)l * DM * IN_COLS, DM, IN_COLS, NPROJ, ((bf16_t*)(p->ws + WS_WINT)) + (size_t)l * NPROJ * DM, nullptr, lds, bid, nblk);
        transpose_cvt(p->mla_wuq + (size_t)l * 256 * 384, 256, 384, 384, ((bf16_t*)(p->ws + WS_WUQT)) + (size_t)l * 384 * 256, p->mla_qn + l * 256, lds, bid, nblk);
        transpose_cvt(p->mla_wukv + (size_t)l * 128 * 512, 128, 512, 512, ((bf16_t*)(p->ws + WS_WUKVT)) + (size_t)l * 512 * 128, p->mla_kvn + l * 128, lds, bid, nblk);
        for (int i = 0; i < 4; ++i)
            transpose_cvt(p->w_branch + (size_t)(l * 4 + i) * 256 * DM, 256, DM, DM, ((bf16_t*)(p->ws + WS_WBT)) + (size_t)(l * 4 + i) * DM * 256, nullptr, lds, bid, nblk);
        transpose_cvt(p->w_out + (size_t)l * DM * DM, DM, DM, DM, ((bf16_t*)(p->ws + WS_WOUTT)) + (size_t)l * DM * DM, nullptr, lds, bid, nblk);
        transpose_cvt(p->peer_wq + (size_t)l * DM * DM, DM, DM, DM, ((bf16_t*)(p->ws + WS_WQT)) + (size_t)l * DM * DM, nullptr, lds, bid, nblk);
    }
    {
        float* sil = lds;
        float* red = lds + 17 * 1024;
        __syncthreads();
        for (int e = tid; e < 17 * 1024; e += NTHREADS) { const int r = e >> 10, k = e & 1023; const float v = (r < 16) ? p->c[r * 1024 + k] : p->c_ctx[k]; sil[e] = siluf(v); }
        __syncthreads();
        for (int u = bid; u < 2 * 96; u += nblk) {
            const int l = u / 96, j0 = (u % 96) * 64, kg = tid >> 6, j = tid & 63;
            float a[17];
#pragma unroll
            for (int r = 0; r < 17; ++r) a[r] = 0.f;
            const float* w = p->mod_w + (size_t)l * DM * 6144 + j0 + j;
#pragma unroll 1
            for (int k0 = kg * 128; k0 < kg * 128 + 128; k0 += 16) {
                float wv[16];
#pragma unroll
                for (int kk = 0; kk < 16; ++kk) wv[kk] = w[(size_t)(k0 + kk) * 6144];
#pragma unroll
                for (int kk = 0; kk < 16; ++kk)
#pragma unroll
                    for (int r = 0; r < 17; ++r) a[r] += sil[r * 1024 + k0 + kk] * wv[kk];
            }
#pragma unroll
            for (int r = 0; r < 17; ++r) red[(kg * 17 + r) * 64 + j] = a[r];
            __syncthreads();
            for (int e = tid; e < 17 * 64; e += NTHREADS) {
                const int r = e >> 6, jj = e & 63; float s = 0.f;
                for (int q = 0; q < 8; ++q) s += red[(q * 17 + r) * 64 + jj];
                ((float*)(p->ws + WS_MOD))[((size_t)l * 17 + r) * 6144 + j0 + jj] = s + p->mod_b[l * 6144 + j0 + jj];
            }
            __syncthreads();
        }
    }
    {
        const size_t n16 = (size_t)2 * 16384 * DM / 16;
        for (size_t i = (size_t)bid * NTHREADS + tid; i < n16; i += (size_t)nblk * NTHREADS) {
            f32x4 a[4], c[4];
#pragma unroll
            for (int q = 0; q < 4; ++q) { a[q] = ((const f32x4*)p->peer_u)[4 * i + q]; c[q] = ((const f32x4*)p->peer_v)[4 * i + q]; }
            float mu = 0.f, mv = 0.f;
#pragma unroll
            for (int q = 0; q < 4; ++q)
#pragma unroll
                for (int j = 0; j < 4; ++j) { mu = fmaxf(mu, fabsf(a[q][j])); mv = fmaxf(mv, fabsf(c[q][j])); }
            mu = wave_max(mu); mv = wave_max(mv);
            const float su = mu > 0.f ? mu * (1.f / 6.f) : 1.f, sv = mv > 0.f ? mv * (1.f / 6.f) : 1.f, iu = 1.f / su, iv = 1.f / sv;
            u32x2 wu = (u32x2){0u, 0u}, wv = (u32x2){0u, 0u};
#pragma unroll
            for (int q = 0; q < 4; ++q) {
                unsigned tu = wu[q >> 1], tv = wv[q >> 1];
                if ((q & 1) == 0) {
                    tu = __builtin_amdgcn_cvt_scalef32_pk_fp4_f32(tu, a[q][0] * iu, a[q][1] * iu, 1.0f, 0); tu = __builtin_amdgcn_cvt_scalef32_pk_fp4_f32(tu, a[q][2] * iu, a[q][3] * iu, 1.0f, 1);
                    tv = __builtin_amdgcn_cvt_scalef32_pk_fp4_f32(tv, c[q][0] * iv, c[q][1] * iv, 1.0f, 0); tv = __builtin_amdgcn_cvt_scalef32_pk_fp4_f32(tv, c[q][2] * iv, c[q][3] * iv, 1.0f, 1);
                } else {
                    tu = __builtin_amdgcn_cvt_scalef32_pk_fp4_f32(tu, a[q][0] * iu, a[q][1] * iu, 1.0f, 2); tu = __builtin_amdgcn_cvt_scalef32_pk_fp4_f32(tu, a[q][2] * iu, a[q][3] * iu, 1.0f, 3);
                    tv = __builtin_amdgcn_cvt_scalef32_pk_fp4_f32(tv, c[q][0] * iv, c[q][1] * iv, 1.0f, 2); tv = __builtin_amdgcn_cvt_scalef32_pk_fp4_f32(tv, c[q][2] * iv, c[q][3] * iv, 1.0f, 3);
                }
                wu[q >> 1] = tu; wv[q >> 1] = tv;
            }
            ((u32x2*)(p->ws + WS_UB))[i] = wu; ((u32x2*)(p->ws + WS_VB))[i] = wv;
            if ((tid & 63) == 0) { ((float*)(p->ws + WS_USC))[i >> 6] = su; ((float*)(p->ws + WS_VSC))[i >> 6] = sv; }
        }
        const size_t k8 = (size_t)2 * 8 * 2 * 128 * 64 / 8;
        for (size_t i = (size_t)bid * NTHREADS + tid; i < k8; i += (size_t)nblk * NTHREADS) {
            const f32x4 a = ((const f32x4*)p->peer_keys)[2 * i], b = ((const f32x4*)p->peer_keys)[2 * i + 1];
            u32x4 w; w.x = pack_bf16(a[0], a[1]); w.y = pack_bf16(a[2], a[3]); w.z = pack_bf16(b[0], b[1]); w.w = pack_bf16(b[2], b[3]);
            ((u32x4*)(p->ws + WS_KEYB))[i] = w;
        }
    }
}

__device__ __forceinline__ const float* state_row(KP p, int g, int r, int& modrow, bool from_input) {
    const int bl = r / LTOK, t = r - bl * LTOK, b = g * NB + bl;
    if (t < CTXL) { modrow = 16; return (from_input ? p->ctx : (const float*)(p->ws + WS_CTXS)) + ((size_t)b * CTXL + t) * DM; }
    modrow = b; return (from_input ? p->x : (const float*)p->out) + ((size_t)b * SEQ + (t - CTXL)) * DM;
}

__device__ __forceinline__ void phase_norm(KP p, int l, int g, int which, int bid, int nblk)
{
    const int lane = get_tid() & 63, wid = get_tid() >> 6;
    const float* nw = (which ? p->norm2_w : p->norm1_w) + l * DM;
    const int shoff = which ? 3072 : 0, scoff = which ? 4096 : 1024;
    for (int r = bid * 8 + wid; r < TG; r += nblk * 8) {
        int mr; const float* src = state_row(p, g, r, mr, l == 0 && which == 0);
        const float* md = ((float*)(p->ws + WS_MOD)) + ((size_t)l * 17 + mr) * 6144;
        f32x4 v[4]; float ss = 0.f;
#pragma unroll
        for (int i = 0; i < 4; ++i) { v[i] = *(const f32x4*)(src + i * 256 + lane * 4); ss += v[i][0] * v[i][0] + v[i][1] * v[i][1] + v[i][2] * v[i][2] + v[i][3] * v[i][3]; }
        ss = wave_sum(ss);
        const float rstd = rsqrtf(ss * (1.f / DM) + EPSF);
#pragma unroll
        for (int i = 0; i < 4; ++i) {
            const int c = i * 256 + lane * 4;
            const f32x4 w = *(const f32x4*)(nw + c), sc = *(const f32x4*)(md + scoff + c), sh = *(const f32x4*)(md + shoff + c);
            f32x4 y;
#pragma unroll
            for (int j = 0; j < 4; ++j) y[j] = v[i][j] * rstd * w[j] * (1.f + sc[j]) + sh[j];
            store_bf16x4(HG(p, g) + (size_t)r * DM + c, y);
        }
    }
}

struct EpiProj8 {
    bf16_t* O; unsigned char* G8;
    __device__ __forceinline__ void operator()(int row, int col, f32x4 a, f32x4 b) const {
        if (col >= C_GATE) {
            const int gi = col - C_GATE; if (gi >= 4096) return;
            unsigned w0 = 0u, w1 = 0u;
#pragma unroll
            for (int j = 0; j < 4; ++j) {
                w0 |= (unsigned)__builtin_amdgcn_cvt_pk_u8_f32(sigmf(a[j]) * 255.f, j, 0);
                w1 |= (unsigned)__builtin_amdgcn_cvt_pk_u8_f32(sigmf(b[j]) * 255.f, j, 0);
            }
            const int gp_ = (gi & ~63) | (((gi >> 2) & 3) << 4) | (((gi >> 4) & 3) << 2);
            *(unsigned*)(G8 + (size_t)row * 4096 + gp_) = w0; *(unsigned*)(G8 + (size_t)row * 4096 + gp_ + 16) = w1;
            return;
        }
        if (col >= C_NQ && col < C_NK) { a *= (0.125f * 1.4426950408889634f); b *= (0.125f * 1.4426950408889634f); }
        u32x4 w; w.x = pack_bf16(a[0], a[1]); w.y = pack_bf16(a[2], a[3]); w.z = pack_bf16(b[0], b[1]); w.w = pack_bf16(b[2], b[3]);
        *(u32x4*)(O + (size_t)row * PLD + col) = w;
    }
};
struct EpiStore8 { bf16_t* O; int ld;
    __device__ __forceinline__ void operator()(int row, int col, f32x4 a, f32x4 b) const {
        u32x4 w; w.x = pack_bf16(a[0], a[1]); w.y = pack_bf16(a[2], a[3]); w.z = pack_bf16(b[0], b[1]); w.w = pack_bf16(b[2], b[3]);
        *(u32x4*)(O + (size_t)row * ld + col) = w; } };
struct EpiStore { bf16_t* O; int ld; __device__ __forceinline__ void operator()(int row, int col, f32x4 v) const { store_bf16x4(O + (size_t)row * ld + col, v); } };

__device__ __forceinline__ float log_sigmoidf(float x) { return fminf(x, 0.f) - log1pf(__expf(-fabsf(x))); }

__device__ __forceinline__ int ret_jb(int rb) { return rb == 0 ? 1 : (rb == 1 ? 0 : 35 - rb); }

__device__ __forceinline__ bf16x8 tr_frag_nat(const char* img, int PT, int k0, int col0, int lane) {
    const int i16 = lane & 15, blk = (lane >> 4) & 1, h5 = lane >> 5, q4 = i16 >> 2, p4 = i16 & 3;
    const char* a = img + (k0 + 8 * h5 + q4) * PT + (col0 + 16 * blk) * 2 + 8 * p4;
    const s16x4 lo = __builtin_amdgcn_ds_read_tr16_b64_v4i16((LAS s16x4*)a), hi = __builtin_amdgcn_ds_read_tr16_b64_v4i16((LAS s16x4*)(a + 4 * PT));
    return __builtin_shufflevector(lo, hi, 0, 1, 2, 3, 4, 5, 6, 7);
}
__device__ __forceinline__ bf16x8 tr_frag_acc(const char* img, int PT, int k0, int col0, int lane) {
    const int i16 = lane & 15, blk = (lane >> 4) & 1, h5 = lane >> 5, q4 = i16 >> 2, p4 = i16 & 3;
    const char* a = img + (k0 + 4 * h5 + q4) * PT + (col0 + 16 * blk) * 2 + 8 * p4;
    const s16x4 lo = __builtin_amdgcn_ds_read_tr16_b64_v4i16((LAS s16x4*)a), hi = __builtin_amdgcn_ds_read_tr16_b64_v4i16((LAS s16x4*)(a + 8 * PT));
    return __builtin_shufflevector(lo, hi, 0, 1, 2, 3, 4, 5, 6, 7);
}
#define RT_PT 144
__device__ __forceinline__ void ret_kv_unit(KP p, int l, int bl, int h, int rb, char* lds)
{
    const int tid = get_tid(), lane = tid & 63, wid = tid >> 6, r = lane & 31, h5 = lane >> 5;
    const bf16_t* PR = (const bf16_t*)(p->ws + WS_PROJ);
    const size_t R0 = (size_t)bl * LTOK + rb * 128;
    const float lgf = log_sigmoidf(p->ret_logit[(l * 2 + 0) * 4 + h]) * 1.4426950408889634f, lgb = log_sigmoidf(p->ret_logit[(l * 2 + 1) * 4 + h]) * 1.4426950408889634f;
    char* KF = lds; char* KBk = lds + 128 * RT_PT; char* VV = lds + 2 * 128 * RT_PT;
    __syncthreads();
#pragma unroll
    for (int q = 0; q < 2; ++q) {
        const int c = tid + 512 * q, row = c >> 3, cc = c & 7;
        const u32x4 kw = *(const u32x4*)(PR + (R0 + row) * PLD + C_RK + h * 64 + cc * 8), vw = *(const u32x4*)(PR + (R0 + row) * PLD + C_RV + h * 64 + cc * 8);
        const float wf = 0.125f * __builtin_amdgcn_exp2f(lgf * (float)(127 - row)), wb = 0.125f * __builtin_amdgcn_exp2f(lgb * (float)row);
        u32x4 of, ob;
#pragma unroll
        for (int j = 0; j < 4; ++j) { const float lo = bflo(kw[j]), hi = bfhi(kw[j]); of[j] = pack_bf16(lo * wf, hi * wf); ob[j] = pack_bf16(lo * wb, hi * wb); }
        *(u32x4*)(KF + row * RT_PT + cc * 16) = of; *(u32x4*)(KBk + row * RT_PT + cc * 16) = ob; *(u32x4*)(VV + row * RT_PT + cc * 16) = vw;
    }
    __syncthreads();
    const int dir = wid >> 2, dt = (wid >> 1) & 1, et = wid & 1;
    const char* Ks = dir ? KBk : KF;
    f32x16 acc;
#pragma unroll
    for (int i = 0; i < 16; ++i) acc[i] = 0.f;
#pragma unroll
    for (int s2 = 0; s2 < 8; ++s2) {
        const bf16x8 af = tr_frag_nat(Ks, RT_PT, 16 * s2, dt * 32, lane), bfv = tr_frag_nat(VV, RT_PT, 16 * s2, et * 32, lane);
        acc = __builtin_amdgcn_mfma_f32_32x32x16_bf16(af, bfv, acc, 0, 0, 0);
    }
    const int j = dir ? ret_jb(rb) : rb;
    float* dst = ((float*)(p->ws + WS_RKV)) + ((((size_t)bl * 4 + h) * 2 + dir) * 34 + j) * 4096 + et * 32 + r;
#pragma unroll
    for (int i = 0; i < 16; ++i) dst[(dt * 32 + (i & 3) + 8 * (i >> 2) + 4 * h5) * 64] = acc[i];
}

__device__ __forceinline__ void phase_p3a(KP p, int l, int bid, int nblk, char* lds)
{
    gemm_phase(((bf16_t*)(p->ws + WS_PROJ)) + C_CQ, PLD, ((bf16_t*)(p->ws + WS_WUQT)) + (size_t)l * 384 * 256, 256, TG, 384, 256, EpiStore{((bf16_t*)(p->ws + WS_QRAW)), 384}, lds, bid, nblk);
    gemm_phase(((bf16_t*)(p->ws + WS_PROJ)) + C_CKV, PLD, ((bf16_t*)(p->ws + WS_WUKVT)) + (size_t)l * 512 * 128, 128, TG, 512, 128, EpiStore{((bf16_t*)(p->ws + WS_KVRAW)), 512}, lds, bid, nblk);
    for (int u = bid; u < NB * 4 * 34; u += nblk) { const int rb = u % 34, h = (u / 34) & 3, bl = u / 136; ret_kv_unit(p, l, bl, h, rb, lds); }
}

#define LOG2_THETA 13.287712379549449f
__device__ __forceinline__ float rope_freq(int i, int half) { return exp2f(-LOG2_THETA * (float)i / (float)half); }

__device__ __forceinline__ void phase_p3b(KP p, int l, int bid, int nblk)
{
    {
        const int gt = bid * NTHREADS + get_tid();
        for (int it = gt; it < NB * 4 * 2 * 1024; it += nblk * NTHREADS) {
            const int e4 = it & 1023, bhd = it >> 10, dir = bhd & 1, h = (bhd >> 1) & 3;
            const float dec = __builtin_amdgcn_exp2f(log_sigmoidf(p->ret_logit[(l * 2 + dir) * 4 + h]) * 1.4426950408889634f * 128.f);
            f32x4* base = (f32x4*)((float*)(p->ws + WS_RKV) + (size_t)bhd * 34 * 4096) + e4;
            f32x4 st = (f32x4){0.f, 0.f, 0.f, 0.f};
            f32x4 kv[34];
#pragma unroll
            for (int j = 0; j < 34; ++j) kv[j] = base[(size_t)j * 1024];
#pragma unroll
            for (int j = 0; j < 34; ++j) { base[(size_t)j * 1024] = st; st = st * dec + kv[j]; }
        }
    }
    const int lane = get_tid() & 63, wid = get_tid() >> 6;
    const float mla_scale = 0.10206207261596575f * 1.4426950408889634f;
    auto load_row = [&](unsigned (&rw)[40], int r) {
        const bf16_t* pr = ((bf16_t*)(p->ws + WS_PROJ)) + (size_t)r * PLD;
        const bf16_t* qraw = ((bf16_t*)(p->ws + WS_QRAW)) + (size_t)r * 384;
        const bf16_t* kvraw = ((bf16_t*)(p->ws + WS_KVRAW)) + (size_t)r * 512;
#pragma unroll
        for (int i = 0; i < 4; ++i) rw[i] = pr[C_CQ + lane + 64 * i];
#pragma unroll
        for (int i = 0; i < 2; ++i) rw[4 + i] = pr[C_CKV + lane + 64 * i];
#pragma unroll
        for (int i = 0; i < 6; ++i) {
            const int idx = lane + 64 * i, h = idx / 96, d = idx % 96, dd = d >= 64 ? d - 64 : 0;
            rw[6 + i] = qraw[idx];
            rw[12 + i] = qraw[(unsigned)(d >= 64 ? idx - dd + (dd ^ 8) : idx)];
            rw[18 + i] = d < 64 ? kvraw[h * 128 + d] : pr[C_KPE + dd];
            rw[24 + i] = pr[C_KPE + (unsigned)(dd ^ 8)];
        }
#pragma unroll
        for (int i = 0; i < 4; ++i) { const int idx = lane + 64 * i, h = idx >> 6, e = idx & 63; rw[30 + i] = kvraw[h * 128 + 64 + e]; }
#pragma unroll
        for (int hh = 0; hh < 6; ++hh) rw[34 + hh] = pr[(hh < 4 ? C_GQ + hh * 64 : C_GK + (hh - 4) * 64) + lane];
    };
    auto proc_row = [&](const unsigned (&rw)[40], int r) {
        const int t = r % LTOK;
        const bool lat = t >= CTXL;
        const float prow = lat ? (float)((t - CTXL) >> 6) : 0.f, pcol = lat ? (float)((t - CTXL) & 63) : 0.f;
        float sq = 0.f, skv = 0.f;
#pragma unroll
        for (int i = 0; i < 4; ++i) { const float v = bf2f((bf16_t)rw[i]); sq += v * v; }
#pragma unroll
        for (int i = 0; i < 2; ++i) { const float v = bf2f((bf16_t)rw[4 + i]); skv += v * v; }
        sq = wave_sum(sq); skv = wave_sum(skv);
        const float rq = rsqrtf(sq * (1.f / 256.f) + EPSF), rkv = rsqrtf(skv * (1.f / 128.f) + EPSF);
#pragma unroll
        for (int i = 0; i < 6; ++i) {
            const int idx = lane + 64 * i, d = idx % 96;
            float qv = bf2f((bf16_t)rw[6 + i]), kv = bf2f((bf16_t)rw[18 + i]);
            if (d < 64) kv *= rkv;
            else if (lat) {
                const int dd = d - 64, blk = dd >> 4, w = dd & 15, fi = w & 7; const bool first = w < 8;
                const float rev = (blk ? pcol : prow) * rope_freq(fi, 8) * 0.15915494309189535f; const float sn = __builtin_amdgcn_sinf(rev), cs = __builtin_amdgcn_cosf(rev);
                const float qo = bf2f((bf16_t)rw[12 + i]), ko = bf2f((bf16_t)rw[24 + i]);
                qv = first ? (qv * cs - qo * sn) : (qo * sn + qv * cs);
                kv = first ? (kv * cs - ko * sn) : (ko * sn + kv * cs);
            }
            ((bf16_t*)(p->ws + WS_QA))[(size_t)r * 384 + idx] = f2bf(qv * rq * mla_scale);
            ((bf16_t*)(p->ws + WS_KA))[(size_t)r * 384 + idx] = f2bf(kv);
        }
#pragma unroll
        for (int i = 0; i < 4; ++i) ((bf16_t*)(p->ws + WS_VA))[(size_t)r * 256 + lane + 64 * i] = f2bf(bf2f((bf16_t)rw[30 + i]) * rkv);
        const int blk = lane >> 5, w = lane & 31, fi = w & 15; const bool first = w < 16;
        float sn = 0.f, cs = 1.f;
        if (lat) { const float rev = (blk ? pcol : prow) * rope_freq(fi, 16) * 0.15915494309189535f; sn = __builtin_amdgcn_sinf(rev); cs = __builtin_amdgcn_cosf(rev); }
        const float nwq = p->gqa_qn[l * 64 + lane], nwk = p->gqa_kn[l * 64 + lane];
#pragma unroll
        for (int hh = 0; hh < 6; ++hh) {
            const bool isq = hh < 4;
            const float v = bf2f((bf16_t)rw[34 + hh]);
            const float ss = wave_sum(v * v);
            const float n = v * rsqrtf(ss * (1.f / 64.f) + EPSF) * (isq ? nwq : nwk);
            const float other = xor_swz<16>(n);
            float val = n;
            if (lat) val = first ? (n * cs - other * sn) : (other * sn + n * cs);
            if (isq) ((bf16_t*)(p->ws + WS_GQ))[(size_t)r * 256 + hh * 64 + lane] = f2bf(val * (0.125f * 1.4426950408889634f));
            else ((bf16_t*)(p->ws + WS_GK))[(size_t)r * 128 + (hh - 4) * 64 + lane] = f2bf(val);
        }
    };
    const int rstep = nblk * 8;
    int r = bid * 8 + wid;
    if (r < TG) {
        unsigned ra[40], rb[40];
        load_row(ra, r);
        for (;;) {
            const bool m1 = r + rstep < TG;
            if (m1) load_row(rb, r + rstep);
            proc_row(ra, r);
            if (!m1) break;
            r += rstep;
            const bool m2 = r + rstep < TG;
            if (m2) load_row(ra, r + rstep);
            proc_row(rb, r);
            if (!m2) break;
            r += rstep;
        }
    }
}

template <int DQ>
__device__ __forceinline__ void attn_unit(const bf16_t* __restrict__ Qb, int qld, const bf16_t* __restrict__ Kb, int kld, const bf16_t* __restrict__ Vb, int vld,
                                          int nq, int nk, bf16_t* __restrict__ Ob, int old_, char* lds)
{
    constexpr int NS = DQ / 16, CPR = DQ / 8, KP = DQ * 2 + 16, VP = 144, KB = 64 * KP, VB = 64 * VP, STG = KB + VB, KCH = 64 * CPR;
    const int tid = get_tid(), lane = tid & 63, wid = tid >> 6, r = lane & 31, h = lane >> 5;
    int qrow[2]; bool qvalid[2];
    bf16x8 qf[2][NS];
#pragma unroll
    for (int qb = 0; qb < 2; ++qb) {
        qrow[qb] = wid * 64 + qb * 32 + r; qvalid[qb] = qrow[qb] < nq; if (!qvalid[qb]) qrow[qb] = 0;
#pragma unroll
        for (int s2 = 0; s2 < NS; ++s2) qf[qb][s2] = *(const bf16x8*)(Qb + (size_t)qrow[qb] * qld + 16 * s2 + 8 * h);
    }
    f32x16 o0[2], o1[2];
    float m[2] = {0.f, 0.f}, l[2] = {0.f, 0.f};
#pragma unroll
    for (int qb = 0; qb < 2; ++qb)
#pragma unroll
        for (int i = 0; i < 16; ++i) { o0[qb][i] = 0.f; o1[qb][i] = 0.f; }
    const int kr0 = tid / CPR, kc0 = tid % CPR, kr1 = (tid + 512) / CPR, kc1 = (tid + 512) % CPR; const bool k1 = (tid + 512) < KCH;
    const int vr = tid >> 3, vc = tid & 7;
    const bf16_t* kg0 = Kb + (size_t)kr0 * kld + kc0 * 8; const bf16_t* kg1 = Kb + (size_t)kr1 * kld + kc1 * 8; const bf16_t* vg = Vb + (size_t)vr * vld + vc * 8;
    const int kl0 = kr0 * KP + kc0 * 16, kl1 = kr1 * KP + kc1 * 16, vl = KB + vr * VP + vc * 16;
    u32x4 rk0, rk1 = (u32x4){0u, 0u, 0u, 0u}, rv;
    rk0 = *(const u32x4*)kg0; if (k1) rk1 = *(const u32x4*)kg1; rv = *(const u32x4*)vg;
    __syncthreads();
    *(u32x4*)(lds + kl0) = rk0; if (k1) *(u32x4*)(lds + kl1) = rk1; *(u32x4*)(lds + vl) = rv;
    __syncthreads();
    const int i16 = lane & 15, blk = (lane >> 4) & 1, q4 = i16 >> 2, p4 = i16 & 3;
    const int koff = r * KP + 16 * h, voff = KB + (4 * h + q4) * VP + 32 * blk + 8 * p4;
    const int nt = nk >> 6;
    for (int kt = 0; kt < nt; ++kt) {
        const int cur = (kt & 1) * STG, nxt = ((kt + 1) & 1) * STG;
        const bool more = kt + 1 < nt;
        if (more) {
            const size_t adv = (size_t)(kt + 1) * 64;
            rk0 = *(const u32x4*)(kg0 + adv * kld); if (k1) rk1 = *(const u32x4*)(kg1 + adv * kld); rv = *(const u32x4*)(vg + adv * vld);
        }
#pragma unroll
        for (int sub = 0; sub < 2; ++sub) {
            f32x16 sq[2];
#pragma unroll
            for (int i = 0; i < 16; ++i) { sq[0][i] = 0.f; sq[1][i] = 0.f; }
#pragma unroll
            for (int g0 = 0; g0 < NS; g0 += 4) {
                bf16x8 kfr[4];
#pragma unroll
                for (int s2 = 0; s2 < 4; ++s2) if (g0 + s2 < NS) kfr[s2] = *(const bf16x8*)(lds + cur + koff + sub * 32 * KP + (g0 + s2) * 32);
#pragma unroll
                for (int s2 = 0; s2 < 4; ++s2) if (g0 + s2 < NS) {
                    sq[0] = __builtin_amdgcn_mfma_f32_32x32x16_bf16(kfr[s2], qf[0][g0 + s2], sq[0], 0, 0, 0);
                    sq[1] = __builtin_amdgcn_mfma_f32_32x32x16_bf16(kfr[s2], qf[1][g0 + s2], sq[1], 0, 0, 0);
                }
            }
            bf16x8 vfr[2][2];
#pragma unroll
            for (int s2 = 0; s2 < 1; ++s2) {
                const int vb = cur + voff + (sub * 32 + 16 * s2) * VP;
                const s16x4 lo0 = __builtin_amdgcn_ds_read_tr16_b64_v4i16((LAS s16x4*)(lds + vb));
                const s16x4 hi0 = __builtin_amdgcn_ds_read_tr16_b64_v4i16((LAS s16x4*)(lds + vb + 8 * VP));
                const s16x4 lo1 = __builtin_amdgcn_ds_read_tr16_b64_v4i16((LAS s16x4*)(lds + vb + 64));
                const s16x4 hi1 = __builtin_amdgcn_ds_read_tr16_b64_v4i16((LAS s16x4*)(lds + vb + 8 * VP + 64));
                vfr[s2][0] = __builtin_shufflevector(lo0, hi0, 0, 1, 2, 3, 4, 5, 6, 7); vfr[s2][1] = __builtin_shufflevector(lo1, hi1, 0, 1, 2, 3, 4, 5, 6, 7);
            }
            bf16x8 pf[2][2];
#pragma unroll
            for (int qb = 0; qb < 2; ++qb) {
                f32x16& st = sq[qb];
                if (__builtin_amdgcn_ballot_w64(m[qb] != 0.f) != 0ull) {
#pragma unroll
                    for (int i = 0; i < 16; ++i) st[i] -= m[qb];
                }
                float mx = fmaxf(fmaxf(st[0], st[1]), fmaxf(st[2], st[3]));
#pragma unroll
                for (int i = 4; i < 16; i += 4) mx = fmaxf(mx, fmaxf(fmaxf(st[i], st[i + 1]), fmaxf(st[i + 2], st[i + 3])));
                { const u32x2 sw = __builtin_amdgcn_permlane32_swap(__float_as_uint(mx), __float_as_uint(mx), false, false); mx = fmaxf(__uint_as_float(sw.x), __uint_as_float(sw.y)); }
                const bool first = (kt == 0) && (sub == 0);
                const bool mv = mx > 24.f || (first && mx < -24.f);
                if (__builtin_amdgcn_ballot_w64(mv) != 0ull) {
                    const float dlt = mv ? mx : 0.f, alpha = __builtin_amdgcn_exp2f(-dlt);
                    m[qb] += dlt; l[qb] *= alpha;
#pragma unroll
                    for (int i = 0; i < 16; ++i) { st[i] -= dlt; o0[qb][i] *= alpha; o1[qb][i] *= alpha; }
                }
                float rs = 0.f;
#pragma unroll
                for (int i = 0; i < 16; ++i) { st[i] = __builtin_amdgcn_exp2f(st[i]); rs += st[i]; }
                l[qb] += rs;
                u32x4 pw0, pw1;
                pw0.x = pack_bf16(st[0], st[1]); pw0.y = pack_bf16(st[2], st[3]); pw0.z = pack_bf16(st[4], st[5]); pw0.w = pack_bf16(st[6], st[7]);
                pw1.x = pack_bf16(st[8], st[9]); pw1.y = pack_bf16(st[10], st[11]); pw1.z = pack_bf16(st[12], st[13]); pw1.w = pack_bf16(st[14], st[15]);
                pf[qb][0] = __builtin_bit_cast(bf16x8, pw0); pf[qb][1] = __builtin_bit_cast(bf16x8, pw1);
            }
            {
                const int vb = cur + voff + (sub * 32 + 16) * VP;
                const s16x4 lo0 = __builtin_amdgcn_ds_read_tr16_b64_v4i16((LAS s16x4*)(lds + vb));
                const s16x4 hi0 = __builtin_amdgcn_ds_read_tr16_b64_v4i16((LAS s16x4*)(lds + vb + 8 * VP));
                const s16x4 lo1 = __builtin_amdgcn_ds_read_tr16_b64_v4i16((LAS s16x4*)(lds + vb + 64));
                const s16x4 hi1 = __builtin_amdgcn_ds_read_tr16_b64_v4i16((LAS s16x4*)(lds + vb + 8 * VP + 64));
                vfr[1][0] = __builtin_shufflevector(lo0, hi0, 0, 1, 2, 3, 4, 5, 6, 7); vfr[1][1] = __builtin_shufflevector(lo1, hi1, 0, 1, 2, 3, 4, 5, 6, 7);
            }
#pragma unroll
            for (int s2 = 0; s2 < 2; ++s2)
#pragma unroll
                for (int qb = 0; qb < 2; ++qb) {
                    o0[qb] = __builtin_amdgcn_mfma_f32_32x32x16_bf16(vfr[s2][0], pf[qb][s2], o0[qb], 0, 0, 0);
                    o1[qb] = __builtin_amdgcn_mfma_f32_32x32x16_bf16(vfr[s2][1], pf[qb][s2], o1[qb], 0, 0, 0);
                }
        }
        if (more) { *(u32x4*)(lds + nxt + kl0) = rk0; if (k1) *(u32x4*)(lds + nxt + kl1) = rk1; *(u32x4*)(lds + nxt + vl) = rv; }
        __syncthreads();
    }
#pragma unroll
    for (int qb = 0; qb < 2; ++qb) {
        float lt = sum_xor32(l[qb]);
        if (qvalid[qb]) {
            const float inv = 1.f / lt;
            bf16_t* op = Ob + (size_t)qrow[qb] * old_ + 4 * h;
#pragma unroll
            for (int g4 = 0; g4 < 4; ++g4) {
                store_bf16x4(op + 8 * g4, (f32x4){o0[qb][4 * g4] * inv, o0[qb][4 * g4 + 1] * inv, o0[qb][4 * g4 + 2] * inv, o0[qb][4 * g4 + 3] * inv});
                store_bf16x4(op + 32 + 8 * g4, (f32x4){o1[qb][4 * g4] * inv, o1[qb][4 * g4 + 1] * inv, o1[qb][4 * g4 + 2] * inv, o1[qb][4 * g4 + 3] * inv});
            }
        }
    }
}

__device__ __forceinline__ void ld8(const bf16_t* p, float (&o)[8]) {
    const u32x4 w = *(const u32x4*)p;
    o[0] = bflo(w.x); o[1] = bfhi(w.x); o[2] = bflo(w.y); o[3] = bfhi(w.y); o[4] = bflo(w.z); o[5] = bfhi(w.z); o[6] = bflo(w.w); o[7] = bfhi(w.w);
}

__device__ __forceinline__ void na_unit(KP p, int l, int bl, int h, int rg, char* lds)
{
    constexpr int KP_ = 144, VP = 144, KB = 64 * KP_, VB = 64 * VP, STG = KB + VB, LBIAS = 2 * STG;
    const int tid = get_tid(), lane = tid & 63, wid = tid >> 6, r = lane & 31, h5 = lane >> 5;
    const bf16_t* PR = (const bf16_t*)(p->ws + WS_PROJ);
    const size_t Rb = (size_t)bl * LTOK;
    const int grow = rg * 4 + (wid >> 1), c = (wid & 1) * 32 + r;
    const int rs = min(max(grow - 4, 0), 56), cs = min(max(c - 8, 0), 48);
    const int Rlo = min(max(rg * 4 - 4, 0), 56), Rhi = min(max(rg * 4 + 3 - 4, 0), 56) + 7, nrow = Rhi - Rlo + 1, nt = nrow + 4;
    const size_t qrow = Rb + CTXL + (size_t)grow * 64 + c;
    bf16x8 qf[4];
#pragma unroll
    for (int s2 = 0; s2 < 4; ++s2) qf[s2] = *(const bf16x8*)(PR + qrow * PLD + C_NQ + h * 64 + 16 * s2 + 8 * h5);
    f32x16 o0, o1;
#pragma unroll
    for (int i = 0; i < 16; ++i) { o0[i] = 0.f; o1[i] = 0.f; }
    float m = -1e30f, lsum = 0.f;
    const int kr = tid >> 3, kc = tid & 7;
    const int kl = kr * KP_ + kc * 16, vl = KB + kr * VP + kc * 16;
    auto tile_row = [&](int t) -> size_t { return t < nrow ? Rb + CTXL + (size_t)(Rlo + t) * 64 : Rb + (size_t)(t - nrow) * 64; };
    u32x4 rk, rv;
    { const size_t R = tile_row(0) + kr; rk = *(const u32x4*)(PR + R * PLD + C_NK + h * 64 + kc * 8); rv = *(const u32x4*)(PR + R * PLD + C_NV + h * 64 + kc * 8); }
    __syncthreads();
    *(u32x4*)(lds + kl) = rk; *(u32x4*)(lds + vl) = rv;
    { float* sb = (float*)(lds + LBIAS); const float* bias = p->na_bias + ((size_t)l * 4 + h) * 465; if (tid < 465) sb[tid] = bias[tid] * 1.4426950408889634f; }
    __syncthreads();
    const float* sb = (const float*)(lds + LBIAS);
    const int i16 = lane & 15, blk = (lane >> 4) & 1, q4 = i16 >> 2, p4 = i16 & 3;
    const int koff = r * KP_ + 16 * h5, voff = KB + (4 * h5 + q4) * VP + 32 * blk + 8 * p4;
    for (int t = 0; t < nt; ++t) {
        const int cur = (t & 1) * STG, nxt = ((t + 1) & 1) * STG;
        const bool more = t + 1 < nt;
        if (more) { const size_t R = tile_row(t + 1) + kr; rk = *(const u32x4*)(PR + R * PLD + C_NK + h * 64 + kc * 8); rv = *(const u32x4*)(PR + R * PLD + C_NV + h * 64 + kc * 8); }
        const bool win = t < nrow; const int R = Rlo + t;
        const bool mine = !win || (R >= rs && R <= rs + 7);
        if (mine) {
#pragma unroll
            for (int sub = 0; sub < 2; ++sub) {
                f32x16 st;
#pragma unroll
                for (int i = 0; i < 16; ++i) st[i] = 0.f;
#pragma unroll
                for (int s2 = 0; s2 < 4; ++s2) {
                    const bf16x8 kf = *(const bf16x8*)(lds + cur + koff + sub * 32 * KP_ + s2 * 32);
                    st = __builtin_amdgcn_mfma_f32_32x32x16_bf16(kf, qf[s2], st, 0, 0, 0);
                }
                if (win) {
                    const int brow = (R - grow + 7) * 31 + 15 - c;
#pragma unroll
                    for (int i = 0; i < 16; ++i) {
                        const int kcol = sub * 32 + (i & 3) + 8 * (i >> 2) + 4 * h5;
                        const bool ok = kcol >= cs && kcol < cs + 16;
                        const float bv = sb[ok ? brow + kcol : 0];
                        st[i] = ok ? st[i] + bv : -INFINITY;
                    }
                }
                float mx = fmaxf(fmaxf(st[0], st[1]), fmaxf(st[2], st[3]));
#pragma unroll
                for (int i = 4; i < 16; i += 4) mx = fmaxf(mx, fmaxf(fmaxf(st[i], st[i + 1]), fmaxf(st[i + 2], st[i + 3])));
                mx = max_xor32(mx);
                const float mn = fmaxf(m, mx), alpha = __builtin_amdgcn_exp2f(m - mn);
                m = mn;
                float rsum = 0.f;
#pragma unroll
                for (int i = 0; i < 16; ++i) { st[i] = __builtin_amdgcn_exp2f(st[i] - mn); rsum += st[i]; }
                lsum = lsum * alpha + rsum;
#pragma unroll
                for (int i = 0; i < 16; ++i) { o0[i] *= alpha; o1[i] *= alpha; }
                u32x4 pw0, pw1;
                pw0.x = pack_bf16(st[0], st[1]); pw0.y = pack_bf16(st[2], st[3]); pw0.z = pack_bf16(st[4], st[5]); pw0.w = pack_bf16(st[6], st[7]);
                pw1.x = pack_bf16(st[8], st[9]); pw1.y = pack_bf16(st[10], st[11]); pw1.z = pack_bf16(st[12], st[13]); pw1.w = pack_bf16(st[14], st[15]);
                const bf16x8 pf0 = __builtin_bit_cast(bf16x8, pw0), pf1 = __builtin_bit_cast(bf16x8, pw1);
#pragma unroll
                for (int s2 = 0; s2 < 2; ++s2) {
                    const int vb = cur + voff + (sub * 32 + 16 * s2) * VP;
                    const s16x4 lo0 = __builtin_amdgcn_ds_read_tr16_b64_v4i16((LAS s16x4*)(lds + vb));
                    const s16x4 hi0 = __builtin_amdgcn_ds_read_tr16_b64_v4i16((LAS s16x4*)(lds + vb + 8 * VP));
                    const s16x4 lo1 = __builtin_amdgcn_ds_read_tr16_b64_v4i16((LAS s16x4*)(lds + vb + 64));
                    const s16x4 hi1 = __builtin_amdgcn_ds_read_tr16_b64_v4i16((LAS s16x4*)(lds + vb + 8 * VP + 64));
                    const bf16x8 vf0 = __builtin_shufflevector(lo0, hi0, 0, 1, 2, 3, 4, 5, 6, 7), vf1 = __builtin_shufflevector(lo1, hi1, 0, 1, 2, 3, 4, 5, 6, 7);
                    o0 = __builtin_amdgcn_mfma_f32_32x32x16_bf16(vf0, s2 ? pf1 : pf0, o0, 0, 0, 0);
                    o1 = __builtin_amdgcn_mfma_f32_32x32x16_bf16(vf1, s2 ? pf1 : pf0, o1, 0, 0, 0);
                }
            }
        }
        if (more) { *(u32x4*)(lds + nxt + kl) = rk; *(u32x4*)(lds + nxt + vl) = rv; }
        __syncthreads();
    }
    lsum = sum_xor32(lsum);
    const float inv = 1.f / lsum;
    bf16_t* op = ((bf16_t*)(p->ws + WS_OUTS)) + ((size_t)2 * TG + qrow) * 256 + h * 64 + 4 * h5;
#pragma unroll
    for (int g4 = 0; g4 < 4; ++g4) {
        store_bf16x4(op + 8 * g4, (f32x4){o0[4 * g4] * inv, o0[4 * g4 + 1] * inv, o0[4 * g4 + 2] * inv, o0[4 * g4 + 3] * inv});
        store_bf16x4(op + 32 + 8 * g4, (f32x4){o1[4 * g4] * inv, o1[4 * g4 + 1] * inv, o1[4 * g4 + 2] * inv, o1[4 * g4 + 3] * inv});
    }
}

__device__ __forceinline__ void ret_out_unit(KP p, int l, int bl, int h, int rb, char* lds)
{
    const int tid = get_tid(), lane = tid & 63, wid = tid >> 6, r = lane & 31, h5 = lane >> 5;
    const bf16_t* PR = (const bf16_t*)(p->ws + WS_PROJ);
    const size_t R0 = (size_t)bl * LTOK + rb * 128;
    const float lgf = log_sigmoidf(p->ret_logit[(l * 2 + 0) * 4 + h]) * 1.4426950408889634f, lgb = log_sigmoidf(p->ret_logit[(l * 2 + 1) * 4 + h]) * 1.4426950408889634f;
    char* KK = lds; char* VV = lds + 128 * RT_PT; char* SS = lds + 2 * 128 * RT_PT;
    float* YB = (float*)lds;
    __syncthreads();
#pragma unroll
    for (int q = 0; q < 2; ++q) {
        const int c = tid + 512 * q, row = c >> 3, cc = c & 7;
        const u32x4 kw = *(const u32x4*)(PR + (R0 + row) * PLD + C_RK + h * 64 + cc * 8), vw = *(const u32x4*)(PR + (R0 + row) * PLD + C_RV + h * 64 + cc * 8);
        u32x4 ok;
#pragma unroll
        for (int j = 0; j < 4; ++j) ok[j] = pack_bf16(bflo(kw[j]) * 0.125f, bfhi(kw[j]) * 0.125f);
        *(u32x4*)(KK + row * RT_PT + cc * 16) = ok; *(u32x4*)(VV + row * RT_PT + cc * 16) = vw;
    }
    {
        const int jf = rb, jb = ret_jb(rb);
#pragma unroll
        for (int q = 0; q < 2; ++q) {
            const int e = tid + 512 * q, dir = e >> 9, dk = (e >> 3) & 63, e0 = (e & 7) * 8, j = dir ? jb : jf;
            const float* src = ((float*)(p->ws + WS_RKV)) + ((((size_t)bl * 4 + h) * 2 + dir) * 34 + j) * 4096 + dk * 64 + e0;
            const f32x4 s0 = *(const f32x4*)src, s1 = *(const f32x4*)(src + 4);
            u32x4 o; o.x = pack_bf16(s0[0], s0[1]); o.y = pack_bf16(s0[2], s0[3]); o.z = pack_bf16(s1[0], s1[1]); o.w = pack_bf16(s1[2], s1[3]);
            *(u32x4*)(SS + (dir * 64 + dk) * RT_PT + e0 * 2) = o;
        }
    }
    __syncthreads();
    const int dir = wid >> 2, mt = wid & 3;
    const float lg = dir ? lgb : lgf;
    const int qi = mt * 32 + r;
    bf16x8 qf[4];
#pragma unroll
    for (int s2 = 0; s2 < 4; ++s2) qf[s2] = *(const bf16x8*)(PR + (R0 + qi) * PLD + C_RQ + h * 64 + 16 * s2 + 8 * h5);
    f32x16 o0, o1;
#pragma unroll
    for (int i = 0; i < 16; ++i) { o0[i] = 0.f; o1[i] = 0.f; }
    {
        const char* Sd = SS + dir * 64 * RT_PT;
#pragma unroll
        for (int s2 = 0; s2 < 4; ++s2) {
            const bf16x8 a0 = tr_frag_nat(Sd, RT_PT, 16 * s2, 0, lane), a1 = tr_frag_nat(Sd, RT_PT, 16 * s2, 32, lane);
            o0 = __builtin_amdgcn_mfma_f32_32x32x16_bf16(a0, qf[s2], o0, 0, 0, 0);
            o1 = __builtin_amdgcn_mfma_f32_32x32x16_bf16(a1, qf[s2], o1, 0, 0, 0);
        }
        const int pos = dir ? 127 - qi : qi;
        const float qd = __builtin_amdgcn_exp2f(lg * (float)(pos + 1));
#pragma unroll
        for (int i = 0; i < 16; ++i) { o0[i] *= qd; o1[i] *= qd; }
    }
    const int kt0 = dir ? mt : 0, kt1 = dir ? 3 : mt;
    for (int kt = kt0; kt <= kt1; ++kt) {
        f32x16 st;
#pragma unroll
        for (int i = 0; i < 16; ++i) st[i] = 0.f;
#pragma unroll
        for (int s2 = 0; s2 < 4; ++s2) {
            const bf16x8 kf = *(const bf16x8*)(KK + (kt * 32 + r) * RT_PT + s2 * 32 + 16 * h5);
            st = __builtin_amdgcn_mfma_f32_32x32x16_bf16(kf, qf[s2], st, 0, 0, 0);
        }
#pragma unroll
        for (int i = 0; i < 16; ++i) {
            const int ki = kt * 32 + (i & 3) + 8 * (i >> 2) + 4 * h5;
            const int diff = dir ? ki - qi : qi - ki;
            st[i] = diff >= 0 ? st[i] * __builtin_amdgcn_exp2f(lg * (float)diff) : 0.f;
        }
        u32x4 pw0, pw1;
        pw0.x = pack_bf16(st[0], st[1]); pw0.y = pack_bf16(st[2], st[3]); pw0.z = pack_bf16(st[4], st[5]); pw0.w = pack_bf16(st[6], st[7]);
        pw1.x = pack_bf16(st[8], st[9]); pw1.y = pack_bf16(st[10], st[11]); pw1.z = pack_bf16(st[12], st[13]); pw1.w = pack_bf16(st[14], st[15]);
        const bf16x8 pf0 = __builtin_bit_cast(bf16x8, pw0), pf1 = __builtin_bit_cast(bf16x8, pw1);
#pragma unroll
        for (int s2 = 0; s2 < 2; ++s2) {
            const bf16x8 v0 = tr_frag_acc(VV, RT_PT, kt * 32 + 16 * s2, 0, lane), v1 = tr_frag_acc(VV, RT_PT, kt * 32 + 16 * s2, 32, lane);
            o0 = __builtin_amdgcn_mfma_f32_32x32x16_bf16(v0, s2 ? pf1 : pf0, o0, 0, 0, 0);
            o1 = __builtin_amdgcn_mfma_f32_32x32x16_bf16(v1, s2 ? pf1 : pf0, o1, 0, 0, 0);
        }
    }
    float sm = 0.f;
#pragma unroll
    for (int i = 0; i < 16; ++i) sm += o0[i] + o1[i];
    sm = sum_xor32(sm);
    const float mu = sm * (1.f / 64.f);
    float vs = 0.f;
#pragma unroll
    for (int i = 0; i < 16; ++i) { const float a0 = o0[i] - mu, a1 = o1[i] - mu; vs += a0 * a0 + a1 * a1; }
    vs = sum_xor32(vs);
    const float rstd = rsqrtf(vs * (1.f / 64.f) + EPSF);
    const bf16_t* gp = PR + (R0 + qi) * PLD + (dir ? C_RGB : C_RGF) + h * 64 + 4 * h5;
    const float* gw = p->ret_gnw + l * 256 + h * 64 + 4 * h5;
    __syncthreads();
#pragma unroll
    for (int t = 0; t < 2; ++t)
#pragma unroll
        for (int g4 = 0; g4 < 4; ++g4) {
            const u32x2 gg = *(const u32x2*)(gp + 32 * t + 8 * g4); const f32x4 ww = *(const f32x4*)(gw + 32 * t + 8 * g4);
            const float g0 = bflo(gg.x), g1 = bfhi(gg.x), g2 = bflo(gg.y), g3 = bfhi(gg.y);
            f32x4 y;
            y[0] = ((t ? o1[4 * g4] : o0[4 * g4]) - mu) * rstd * ww[0] * siluf(g0);
            y[1] = ((t ? o1[4 * g4 + 1] : o0[4 * g4 + 1]) - mu) * rstd * ww[1] * siluf(g1);
            y[2] = ((t ? o1[4 * g4 + 2] : o0[4 * g4 + 2]) - mu) * rstd * ww[2] * siluf(g2);
            y[3] = ((t ? o1[4 * g4 + 3] : o0[4 * g4 + 3]) - mu) * rstd * ww[3] * siluf(g3);
            *(f32x4*)(YB + (dir * 128 + qi) * 68 + 32 * t + 8 * g4 + 4 * h5) = y;
        }
    __syncthreads();
#pragma unroll
    for (int q = 0; q < 2; ++q) {
        const int e = tid + 512 * q, row = e >> 3, c8 = (e & 7) * 8;
        const f32x4 a0 = *(const f32x4*)(YB + row * 68 + c8), a1 = *(const f32x4*)(YB + row * 68 + c8 + 4), b0 = *(const f32x4*)(YB + (128 + row) * 68 + c8), b1 = *(const f32x4*)(YB + (128 + row) * 68 + c8 + 4);
        u32x4 o; o.x = pack_bf16(a0[0] + b0[0], a0[1] + b0[1]); o.y = pack_bf16(a0[2] + b0[2], a0[3] + b0[3]); o.z = pack_bf16(a1[0] + b1[0], a1[1] + b1[1]); o.w = pack_bf16(a1[2] + b1[2], a1[3] + b1[3]);
        *(u32x4*)(((bf16_t*)(p->ws + WS_OUTS)) + ((size_t)3 * TG + R0 + row) * 256 + h * 64 + c8) = o;
    }
}

#define U_MLA (NB * 32)
#define U_GQA (NB * 32)
#define U_NA (NB * 64)
#define U_RET (NB * 136)
#define U_CTX (NB * 12)
__device__ __forceinline__ int wq_next(unsigned* counter, LAS unsigned* wq) {
    __syncthreads();
    if (get_tid() == 0) *wq = atomicAdd(counter, 1u);
    __syncthreads();
    return (int)*wq;
}
__device__ __forceinline__ void phase_p4(KP p, int l, int g, char* ldsc, int bid, int nblk)
{
    float* lds = (float*)ldsc;
    LAS unsigned* wq = (LAS unsigned*)(smem + 32);
    unsigned* counter = ((unsigned*)(p->ws + WS_CNT)) + (l * NGROUP + g) * 64 * 8;
    (void)bid; (void)nblk;
    for (;;) {
        const int u = wq_next(counter, wq); if (u >= U_MLA) break;
        const int qb = u & 7, h = (u >> 3) & 3, bl = u >> 5; const size_t Rb = (size_t)bl * LTOK, Rq = Rb + CTXL + qb * 512;
        attn_unit<96>(((bf16_t*)(p->ws + WS_QA)) + Rq * 384 + h * 96, 384, ((bf16_t*)(p->ws + WS_KA)) + Rb * 384 + h * 96, 384, ((bf16_t*)(p->ws + WS_VA)) + Rb * 256 + h * 64, 256, 512, LTOK, ((bf16_t*)(p->ws + WS_OUTS)) + ((size_t)0 * TG + Rq) * 256 + h * 64, 256, ldsc);
    }
    for (;;) {
        const int u = wq_next(counter + 64, wq); if (u >= U_GQA) break;
        const int qb = u & 7, h = (u >> 3) & 3, bl = u >> 5; const size_t Rb = (size_t)bl * LTOK, Rq = Rb + CTXL + qb * 512; const int kvh = h >> 1;
        attn_unit<64>(((bf16_t*)(p->ws + WS_GQ)) + Rq * 256 + h * 64, 256, ((bf16_t*)(p->ws + WS_GK)) + Rb * 128 + kvh * 64, 128, ((bf16_t*)(p->ws + WS_PROJ)) + Rb * PLD + C_GV + kvh * 64, PLD, 512, LTOK, ((bf16_t*)(p->ws + WS_OUTS)) + ((size_t)1 * TG + Rq) * 256 + h * 64, 256, ldsc);
    }
    for (;;) {
        const int u = wq_next(counter + 128, wq); if (u >= U_NA) break;
        na_unit(p, l, u >> 6, (u >> 4) & 3, u & 15, ldsc);
    }
    for (;;) {
        const int u = wq_next(counter + 192, wq); if (u >= U_RET) break;
        const int rb = u % 34, h = (u / 34) & 3, bl = u / 136; ret_out_unit(p, l, bl, h, rb, ldsc);
    }
    if (l == 0) {
        for (;;) {
            const int u = wq_next(counter + 256, wq); if (u >= NB * 4) break;
            const int h = u & 3, bl = u >> 2; const size_t Rb = (size_t)bl * LTOK;
            attn_unit<96>(((bf16_t*)(p->ws + WS_QA)) + Rb * 384 + h * 96, 384, ((bf16_t*)(p->ws + WS_KA)) + Rb * 384 + h * 96, 384, ((bf16_t*)(p->ws + WS_VA)) + Rb * 256 + h * 64, 256, 256, CTXL, ((bf16_t*)(p->ws + WS_OUTS)) + ((size_t)0 * TG + Rb) * 256 + h * 64, 256, ldsc);
        }
        for (;;) {
            const int u = wq_next(counter + 320, wq); if (u >= NB * 8) break;
            const int ty = u & 1, h = (u >> 1) & 3, bl = u >> 3; const size_t Rb = (size_t)bl * LTOK;
            const bf16_t* Q = ty ? ((bf16_t*)(p->ws + WS_PROJ)) + Rb * PLD + C_NQ + h * 64 : ((bf16_t*)(p->ws + WS_GQ)) + Rb * 256 + h * 64;
            const bf16_t* K = ty ? ((bf16_t*)(p->ws + WS_PROJ)) + Rb * PLD + C_NK + h * 64 : ((bf16_t*)(p->ws + WS_GK)) + Rb * 128 + (h >> 1) * 64;
            const bf16_t* V = ty ? ((bf16_t*)(p->ws + WS_PROJ)) + Rb * PLD + C_NV + h * 64 : ((bf16_t*)(p->ws + WS_PROJ)) + Rb * PLD + C_GV + (h >> 1) * 64;
            attn_unit<64>(Q, ty ? PLD : 256, K, ty ? PLD : 128, V, PLD, 256, CTXL, ((bf16_t*)(p->ws + WS_OUTS)) + ((size_t)(1 + ty) * TG + Rb) * 256 + h * 64, 256, ldsc);
        }
    }
}

template <int MI>
__device__ __forceinline__ void p5_tile(KP p, int l, char* lds, int pm, int pn, int rsub)
{
    const int tid = get_tid(), lane = tid & 63, wid = tid >> 6, wm = wid >> 1, wn = wid & 1, fr = lane & 15, fq = lane >> 4;
    const int arow = tid >> 3, akc = tid & 7, a_l = arow * G_LDP + akc * 16;
    const int aoff = (wm * 16 * MI + fr) * G_LDP + fq * 16, boff = G_ABYTES + (wn * 64 + fr) * G_LDP + fq * 16;
    const bf16_t* OUTS = (const bf16_t*)(p->ws + WS_OUTS);
    const bf16_t* WB = (const bf16_t*)(p->ws + WS_WBT) + (size_t)l * 4 * DM * 256;
    const int rbase = pm * 256 + rsub;
    {
        const bf16_t* ag = OUTS + ((size_t)rbase + arow) * 256 + akc * 8;
        const bf16_t* bg = WB + ((size_t)pn * G_BN + arow) * 256 + akc * 8;
        const unsigned char* gp = (const unsigned char*)(p->ws + WS_GATE8) + (size_t)(rbase + wm * 16 * MI + fr) * 4096 + pn * G_BN + wn * 64 + fq * 16;
        f32x4 acc[MI][4]; zero_acc<MI>(acc);
        u32x2 totp[MI][4];
#pragma unroll
        for (int mi = 0; mi < MI; ++mi)
#pragma unroll
            for (int ni = 0; ni < 4; ++ni) totp[mi][ni] = (u32x2){0u, 0u};
        u32x4 sa[2][MI], sb[2][2];
        u32x4 gwv[MI];
#define P5_LOAD(SET, KT) do { const bf16_t* a2_ = ag + (size_t)((KT) >> 2) * TG * 256 + ((KT) & 3) * 64; const bf16_t* b2_ = bg + (size_t)((KT) >> 2) * DM * 256 + ((KT) & 3) * 64; \
            _Pragma("unroll") for (int i_ = 0; i_ < MI; ++i_) sa[SET][i_] = *(const u32x4*)(a2_ + (size_t)(64 * i_) * 256); \
            _Pragma("unroll") for (int i_ = 0; i_ < 2; ++i_) sb[SET][i_] = *(const u32x4*)(b2_ + (size_t)(64 * i_) * 256); } while (0)
#define P5_STORE(SET, BO) do { \
            _Pragma("unroll") for (int i_ = 0; i_ < MI; ++i_) *(u32x4*)(lds + (BO) + a_l + i_ * 64 * G_LDP) = sa[SET][i_]; \
            _Pragma("unroll") for (int i_ = 0; i_ < 2; ++i_) *(u32x4*)(lds + (BO) + G_ABYTES + a_l + i_ * 64 * G_LDP) = sb[SET][i_]; } while (0)
        P5_LOAD(0, 0);
        __syncthreads();
        P5_STORE(0, 0);
        P5_LOAD(0, 1); P5_LOAD(1, 2);
        __syncthreads();
#pragma unroll 1
        for (int sg = 0; sg < 4; ++sg) {
#pragma unroll
            for (int q4 = 0; q4 < 4; ++q4) {
                const int par = q4 & 1, kt = 4 * sg + q4, cur = par * G_STAGE, nxt = (par ^ 1) * G_STAGE;
#pragma unroll
                for (int ks = 0; ks < 2; ++ks) {
                    bf16x8 af[MI], bfr[4];
#pragma unroll
                    for (int mi = 0; mi < MI; ++mi) af[mi] = *(const bf16x8*)(lds + cur + aoff + mi * 16 * G_LDP + ks * 64);
#pragma unroll
                    for (int ni = 0; ni < 4; ++ni) bfr[ni] = *(const bf16x8*)(lds + cur + boff + ni * 16 * G_LDP + ks * 64);
#pragma unroll
                    for (int mi = 0; mi < MI; ++mi)
#pragma unroll
                        for (int ni = 0; ni < 4; ++ni) acc[mi][ni] = __builtin_amdgcn_mfma_f32_16x16x32_bf16(bfr[ni], af[mi], acc[mi][ni], 0, 0, 0);
                }
                if (q4 == 1) {
#pragma unroll
                    for (int mi = 0; mi < MI; ++mi)
                        gwv[mi] = *(const u32x4*)(gp + (size_t)(mi * 16) * 4096 + sg * DM);
                    __builtin_amdgcn_sched_barrier(0);
                }
                P5_STORE(par, nxt);
                { const int kn = (kt + 3 < 16) ? kt + 3 : 15; P5_LOAD(par, kn); }
                __syncthreads();
                if (q4 == 3) {
                    __builtin_amdgcn_sched_barrier(0);
#pragma unroll
                    for (int mi = 0; mi < MI; ++mi)
#pragma unroll
                        for (int ni = 0; ni < 4; ++ni) {
                            const unsigned gw = gwv[mi][ni];
                            const u32x2 tp = totp[mi][ni];
                            const float t0 = fmaf((float)((gw >> 0) & 255u), acc[mi][ni][0], bflo(tp.x)), t1 = fmaf((float)((gw >> 8) & 255u), acc[mi][ni][1], bfhi(tp.x));
                            const float t2 = fmaf((float)((gw >> 16) & 255u), acc[mi][ni][2], bflo(tp.y)), t3 = fmaf((float)((gw >> 24) & 255u), acc[mi][ni][3], bfhi(tp.y));
                            totp[mi][ni] = (u32x2){pack_bf16(t0, t1), pack_bf16(t2, t3)};
                            acc[mi][ni] = (f32x4){0.f, 0.f, 0.f, 0.f};
                        }
                }
            }
        }
#undef P5_LOAD
#undef P5_STORE
#pragma unroll
        for (int mi = 0; mi < MI; ++mi)
#pragma unroll
            for (int ni = 0; ni < 4; ++ni) {
                const u32x2 tp = totp[mi][ni]; const float k255 = 1.f / 255.f;
                *(u32x2*)(((bf16_t*)(p->ws + WS_ACC)) + (size_t)(rbase + wm * 16 * MI + mi * 16 + fr) * DM + pn * G_BN + wn * 64 + ni * 16 + fq * 4) =
                    (u32x2){pack_bf16(bflo(tp.x) * k255, bfhi(tp.x) * k255), pack_bf16(bflo(tp.y) * k255, bfhi(tp.y) * k255)};
            }
    }
}

__device__ __forceinline__ void phase_p5(KP p, int l, char* lds, int bid, int nblk)
{
    constexpr int tn = DM / G_BN, total = (TG / 256) * tn, NG8 = (TG / 256) / 8;
    const bool xord = (nblk == 256) && (tn == 8) && ((TG / 256) % 8 == 0);
    if (xord) {
        constexpr int NFULL = (NG8 % 4 == 1) ? NG8 / 4 : (NG8 + 3) / 4;
#pragma unroll 1
        for (int it = 0; it < NFULL; ++it) {
            const int g8 = it * 4 + (bid >> 6); if (g8 >= NG8) break;
            p5_tile<4>(p, l, lds, g8 * 8 + (bid & 7), (bid >> 3) & 7, 0);
        }
        if (NG8 % 4 == 1) p5_tile<1>(p, l, lds, (NG8 - 1) * 8 + (bid & 7), (bid >> 3) & 7, (bid >> 6) * 64);
    } else {
        for (int t = bid; t < total; t += nblk) p5_tile<4>(p, l, lds, t / tn, t % tn, 0);
    }
}

struct EpiResid {
    KP p; int l, g, goff;
    __device__ __forceinline__ void operator()(int row, int col, f32x4 v) const {
        const int bl = row / LTOK, t = row - bl * LTOK, b = g * NB + bl;
        float* dst; const float* src; int mr;
        if (t < CTXL) { if (l != 0) return; const size_t o = ((size_t)b * CTXL + t) * DM + col; dst = ((float*)(p->ws + WS_CTXS)) + o; src = p->ctx + o; mr = 16; }
        else { const size_t o = ((size_t)b * SEQ + (t - CTXL)) * DM + col; dst = p->out + o; src = (l == 0) ? p->x + o : (const float*)dst; mr = b; }
        const f32x4 gg = *(const f32x4*)(((float*)(p->ws + WS_MOD)) + ((size_t)l * 17 + mr) * 6144 + goff + col);
        f32x4 s = *(const f32x4*)src;
#pragma unroll
        for (int j = 0; j < 4; ++j) s[j] += gg[j] * v[j];
        *(f32x4*)dst = s;
    }
};

__device__ __forceinline__ void grid_barrier();
#if MK_ONE_LAUNCH
#define P9_GRID_SYNC() grid_barrier()
#else
#define P9_GRID_SYNC() __syncthreads()
#endif
typedef __bf16 bf16pair __attribute__((ext_vector_type(2)));
__device__ __forceinline__ float dot2bf(unsigned a, unsigned b, float c) { return __builtin_amdgcn_fdot2_f32_bf16(__builtin_bit_cast(bf16pair, a), __builtin_bit_cast(bf16pair, b), c, false); }
__device__ __forceinline__ unsigned f2ord(float f) { const unsigned b = __float_as_uint(f); return b ^ ((unsigned)((int)b >> 31) | 0x80000000u); }
__device__ __forceinline__ int mbcnt64(unsigned long long m) { return (int)__builtin_amdgcn_mbcnt_hi((unsigned)(m >> 32), __builtin_amdgcn_mbcnt_lo((unsigned)m, 0u)); }

__device__ __forceinline__ float ord2f(unsigned u) { return __uint_as_float((u & 0x80000000u) ? (u ^ 0x80000000u) : ~u); }

__device__ __forceinline__ void cx_desc(unsigned& a, unsigned& b) { const unsigned hi = a > b ? a : b, lo = a > b ? b : a; a = hi; b = lo; }
template <int N, int OFF, bool DESC, int M>
__device__ __forceinline__ void bitonic_sort(unsigned (&a)[M]) {
#pragma unroll
    for (int k = 2; k <= N; k <<= 1)
#pragma unroll
        for (int j = k >> 1; j > 0; j >>= 1)
#pragma unroll
            for (int i = 0; i < N; ++i) {
                const int l = i ^ j;
                if (l > i) { const bool up = ((i & k) == 0) != DESC; if (up) cx_desc(a[OFF + l], a[OFF + i]); else cx_desc(a[OFF + i], a[OFF + l]); }
            }
}
__device__ __forceinline__ void bitonic_merge16_desc(unsigned (&a)[16]) {
#pragma unroll
    for (int j = 8; j > 0; j >>= 1)
#pragma unroll
        for (int i = 0; i < 16; ++i) { const int l = i ^ j; if (l > i) cx_desc(a[i], a[l]); }
}
template <int XM>
__device__ __forceinline__ void merge_partner16(unsigned (&a)[16], bool upper) {
    unsigned b[16];
#pragma unroll
    for (int i = 0; i < 16; ++i) b[i] = (XM == 32) ? get_xor32_u(a[15 - i], upper) : xor_swz_u<XM & 31>(a[15 - i]);
#pragma unroll
    for (int i = 0; i < 16; ++i) a[i] = a[i] > b[i] ? a[i] : b[i];
    bitonic_merge16_desc(a);
}

#define P9_KEYP 144
#define P9_NTOK 136
#define P9_HG 3
#define P9_LKEY 0
#define P9_LIDX (P9_HG * 2 * 128 * P9_KEYP)
#define P9_LSTASH 0
__device__ __forceinline__ constexpr int p9_pair_i(int pi) {
    return pi < 16 ? 0 : pi < 24 ? 1 : pi < 29 ? 2 : pi < 33 ? 3 : pi < 36 ? 4 : pi < 38 ? 5 : pi < 40 ? 6 : pi < 42 ? 7 : pi < 50 ? pi - 34 : 0;
}
__device__ __forceinline__ constexpr int p9_pair_j(int pi) {
    return pi < 16 ? pi : pi < 24 ? pi - 16 : pi < 29 ? pi - 24 : pi < 33 ? pi - 29 : pi < 36 ? pi - 33 : pi < 38 ? pi - 36 : pi < 40 ? pi - 38 : pi < 42 ? pi - 40 : 0;
}
__device__ __forceinline__ void phase_p9(KP p, int l, int g, char* lds, int bid, int nblk)
{
    const int tid = get_tid(), wid = tid >> 6;
    const bf16_t* KEYB = (const bf16_t*)(p->ws + WS_KEYB) + (size_t)l * 8 * 2 * 128 * 64;
    const bf16_t* PQ = (const bf16_t*)(p->ws + WS_PQ);
    unsigned* stash = (unsigned*)(lds + P9_LSTASH);
    const int nit = (TG / P9_NTOK + nblk - 1) / nblk;
    for (int it = 0; it < nit; ++it) {
        const int blk = bid + it * nblk;
        if (blk >= TG / P9_NTOK) { P9_GRID_SYNC(); P9_GRID_SYNC(); continue; }
        const int row0 = blk * P9_NTOK;
        unsigned* gst = (unsigned*)(p->ws + WS_PROJ) + (size_t)row0 * 128;
#pragma unroll 1
        for (int h0 = 0; h0 < 8; h0 += P9_HG) {
            const int nh = (8 - h0) < P9_HG ? (8 - h0) : P9_HG;
            __syncthreads();
            for (int c = tid; c < nh * 2048; c += NTHREADS) { const int row = c >> 3, cc = c & 7;
                *(u32x4*)(lds + P9_LKEY + row * P9_KEYP + cc * 16) = *(const u32x4*)(KEYB + ((size_t)h0 * 256 + row) * 64 + cc * 8); }
            __syncthreads();
#pragma unroll 1
            for (int item = wid; item < 9 * nh; item += 8) {
                const int tile = item % 9, hh = item / 9, h = h0 + hh;
                const int LK = P9_LKEY + hh * 256 * P9_KEYP;
                const int tidh = get_tid(), tk = tidh & 15, qd = (tidh >> 4) & 3;
                const int ntile = (P9_NTOK - 16 * tile) < 16 ? (P9_NTOK - 16 * tile) : 16;
                const int trow = row0 + 16 * tile + (tk < ntile ? tk : ntile - 1);
                unsigned* idxl = (unsigned*)(lds + P9_LIDX) + (wid * 16 + tk) * 33;
                unsigned top[2][16];
#pragma unroll
                for (int pp = 0; pp < 2; ++pp) {
                    f32x4 acc[8];
#pragma unroll
                    for (int t = 0; t < 8; ++t) acc[t] = (f32x4){0.f, 0.f, 0.f, 0.f};
#pragma unroll
                    for (int ks = 0; ks < 2; ++ks) {
                        const bf16x8 qfr = *(const bf16x8*)(PQ + (size_t)trow * DM + h * 128 + pp * 64 + ks * 32 + qd * 8);
#pragma unroll
                        for (int t = 0; t < 8; ++t) {
                            const bf16x8 kfr = *(const bf16x8*)(lds + LK + (pp * 128 + t * 16 + tk) * P9_KEYP + ks * 64 + qd * 16);
                            acc[t] = __builtin_amdgcn_mfma_f32_16x16x32_bf16(kfr, qfr, acc[t], 0, 0, 0);
                        }
                    }
                    unsigned ck[32];
#pragma unroll
                    for (int t = 0; t < 8; ++t)
#pragma unroll
                        for (int jj = 0; jj < 4; ++jj) ck[t * 4 + jj] = (f2ord(acc[t][jj]) & 0xFFFFFF80u) | (unsigned)(16 * t + jj) | ((unsigned)qd << 2);
                    bitonic_sort<16, 0, true>(ck);
                    bitonic_sort<16, 16, false>(ck);
                    unsigned (&tp)[16] = top[pp];
#pragma unroll
                    for (int i = 0; i < 16; ++i) tp[i] = ck[i] > ck[16 + i] ? ck[i] : ck[16 + i];
                    bitonic_merge16_desc(tp);
                    merge_partner16<16>(tp, false); merge_partner16<32>(tp, (qd & 2) != 0);
                    if (qd == 0) {
#pragma unroll
                        for (int i = 0; i < 16; ++i) idxl[pp * 16 + i] = tp[i] & 127u;
                    }
                }
                float v1[16], v2[16];
#pragma unroll
                for (int i = 0; i < 16; ++i) { v1[i] = ord2f(top[0][i] & 0xFFFFFF80u); v2[i] = ord2f(top[1][i] & 0xFFFFFF80u); }
                unsigned cand[16];
#pragma unroll
                for (int n = 0; n < 13; ++n) {
                    const unsigned k0 = (f2ord(v1[p9_pair_i(4 * n)] + v2[p9_pair_j(4 * n)]) & 0xFFFFFF00u) | (unsigned)(p9_pair_i(4 * n) * 16 + p9_pair_j(4 * n));
                    const unsigned k1 = (f2ord(v1[p9_pair_i(4 * n + 1)] + v2[p9_pair_j(4 * n + 1)]) & 0xFFFFFF00u) | (unsigned)(p9_pair_i(4 * n + 1) * 16 + p9_pair_j(4 * n + 1));
                    const unsigned k2 = (4 * n + 2 < 50) ? ((f2ord(v1[p9_pair_i(4 * n + 2)] + v2[p9_pair_j(4 * n + 2)]) & 0xFFFFFF00u) | (unsigned)(p9_pair_i(4 * n + 2) * 16 + p9_pair_j(4 * n + 2))) : 0u;
                    const unsigned k3 = (4 * n + 3 < 50) ? ((f2ord(v1[p9_pair_i(4 * n + 3)] + v2[p9_pair_j(4 * n + 3)]) & 0xFFFFFF00u) | (unsigned)(p9_pair_i(4 * n + 3) * 16 + p9_pair_j(4 * n + 3))) : 0u;
                    cand[n] = qd == 0 ? k0 : (qd == 1 ? k1 : (qd == 2 ? k2 : k3));
                }
                cand[13] = 0u; cand[14] = 0u; cand[15] = 0u;
                bitonic_sort<16, 0, true>(cand);
                merge_partner16<16>(cand, false); merge_partner16<32>(cand, (qd & 2) != 0);
                const float mx = ord2f(cand[0] & 0xFFFFFF00u);
                float ex[16], den = 0.f;
#pragma unroll
                for (int k = 0; k < 16; ++k) { ex[k] = __expf(ord2f(cand[k] & 0xFFFFFF00u) - mx); den += ex[k]; }
                const float inv = 1.f / den;
                if (qd == 0 && tk < ntile) {
#pragma unroll
                    for (int k = 0; k < 16; ++k) {
                        const unsigned e = idxl[(cand[k] >> 4) & 15u] * 128u + idxl[16 + (cand[k] & 15u)];
                        gst[((16 * tile + tk) * 8 + h) * 16 + k] = (e << 16) | (unsigned)f2bf(ex[k] * inv);
                    }
                }
            }
        }
        P9_GRID_SYNC();
        {
            const u32x4* src = (const u32x4*)gst; u32x4* dstl = (u32x4*)(lds + P9_LSTASH);
            for (int c = get_tid(); c < P9_NTOK * 128 / 4; c += NTHREADS) dstl[c] = src[c];
            __syncthreads();
        }
        {
            const int tid2 = get_tid(), lane = tid2 & 63, wid2 = tid2 >> 6;
            KP p2 = get_kp();
            const unsigned char* UB = (const unsigned char*)(p2->ws + WS_UB) + (size_t)l * 16384 * (DM / 2);
            const float* USC = (const float*)(p2->ws + WS_USC) + (size_t)l * 16384; const float* VSC = (const float*)(p2->ws + WS_VSC) + (size_t)l * 16384;
            const bf16_t* Hh = HG(p2, g);
#pragma unroll 1
            for (int slot = wid2; slot < P9_NTOK; slot += 8) {
                const int r = row0 + slot;
                if ((r % LTOK) < CTXL && l != 0) continue;
                const u32x4 x0 = *(const u32x4*)(Hh + (size_t)r * DM + lane * 16), x1 = *(const u32x4*)(Hh + (size_t)r * DM + lane * 16 + 8);
#pragma unroll 1
                for (int h = 0; h < 8; ++h) {
                    unsigned* st = stash + (slot * 8 + h) * 16;
                    float d[16];
                    const int kk = (lane >> 2) & 15;
                    const unsigned sk = st[kk];
                    const float su = USC[sk >> 16], svs = VSC[sk >> 16];
                    {
                        u32x2 ua[16];
#pragma unroll
                        for (int k = 0; k < 16; ++k) ua[k] = *(const u32x2*)(UB + (size_t)(st[k] >> 16) * (DM / 2) + lane * 8);
#pragma unroll
                        for (int k = 0; k < 16; ++k) {
                            float a = 0.f;
#define P9_UDOT(XW, UW, B) { const unsigned xw_ = (XW); a = __builtin_amdgcn_fdot2_f32_bf16(__builtin_bit_cast(bf16pair, xw_), __builtin_amdgcn_cvt_scalef32_pk_bf16_fp4((UW), 1.0f, B), a, false); }
                            { const unsigned u0_ = ua[k].x, u1_ = ua[k].y;
                              P9_UDOT(x0.x, u0_, 0) P9_UDOT(x0.y, u0_, 1) P9_UDOT(x0.z, u0_, 2) P9_UDOT(x0.w, u0_, 3)
                              P9_UDOT(x1.x, u1_, 0) P9_UDOT(x1.y, u1_, 1) P9_UDOT(x1.z, u1_, 2) P9_UDOT(x1.w, u1_, 3) }
#undef P9_UDOT
                            d[k] = a;
                        }
                    }
                    float r8[8], r4[4], r2[2], r1;
#pragma unroll
                    for (int i = 0; i < 8; ++i) { const u32x2 sw = __builtin_amdgcn_permlane32_swap(__float_as_uint(d[i]), __float_as_uint(d[i + 8]), false, false); r8[i] = __uint_as_float(sw.x) + __uint_as_float(sw.y); }
#pragma unroll
                    for (int i = 0; i < 4; ++i) { const u32x2 sw = __builtin_amdgcn_permlane16_swap(__float_as_uint(r8[i]), __float_as_uint(r8[i + 4]), false, false); r4[i] = __uint_as_float(sw.x) + __uint_as_float(sw.y); }
                    { const bool bb = (lane & 8) != 0;
#pragma unroll
                      for (int i = 0; i < 2; ++i) { const float snd = bb ? r4[i] : r4[i + 2], keep = bb ? r4[i + 2] : r4[i]; r2[i] = keep + xor_swz<8>(snd); } }
                    { const bool bb = (lane & 4) != 0; const float snd = bb ? r2[0] : r2[1], keep = bb ? r2[1] : r2[0]; r1 = keep + xor_swz<4>(snd); }
                    r1 += xor_swz<2>(r1); r1 += xor_swz<1>(r1);
                    r1 *= su;
                    const float cf = bflo(sk) * 0.5f * r1 * (1.f + erff(r1 * 0.70710678118654752f)) * svs;
                    if ((lane & 3) == 0) st[kk] = (sk & 0xffff0000u) | (unsigned)f2bf(cf);
                }
            }
        }
        P9_GRID_SYNC();
        {
            const int tid2 = get_tid(), lane = tid2 & 63, wid2 = tid2 >> 6;
            KP p2 = get_kp();
            const unsigned char* VB = (const unsigned char*)(p2->ws + WS_VB) + (size_t)l * 16384 * (DM / 2);
#pragma unroll 1
            for (int slot = wid2; slot < P9_NTOK; slot += 8) {
                const int r = row0 + slot;
                const int bl = r / LTOK, t = r - bl * LTOK, b = g * NB + bl;
                if (t < CTXL && l != 0) continue;
                float* dst; int mr;
                if (t < CTXL) { dst = ((float*)(p2->ws + WS_CTXS)) + ((size_t)b * CTXL + t) * DM; mr = 16; } else { dst = p2->out + ((size_t)b * SEQ + (t - CTXL)) * DM; mr = b; }
                const float* g2 = ((float*)(p2->ws + WS_MOD)) + ((size_t)l * 17 + mr) * 6144 + 5120;
                f32x4 sv[4];
#pragma unroll
                for (int i = 0; i < 4; ++i) sv[i] = *(const f32x4*)(dst + lane * 16 + i * 4);
                float outv[16];
#pragma unroll
                for (int i = 0; i < 16; ++i) outv[i] = 0.f;
#pragma unroll 1
                for (int h = 0; h < 8; ++h) {
                    const unsigned* st = stash + (slot * 8 + h) * 16;
                    u32x2 va[16]; unsigned sk[16];
#pragma unroll
                    for (int k = 0; k < 16; ++k) { sk[k] = st[k]; va[k] = *(const u32x2*)(VB + (size_t)(sk[k] >> 16) * (DM / 2) + lane * 8); }
#pragma unroll
                    for (int k = 0; k < 16; ++k) {
                        const float ck = bflo(sk[k]);
#define P9_VFMA(W, B) { const f32x2 t_ = __builtin_amdgcn_cvt_scalef32_pk_f32_fp4(va[k][W], 1.0f, B); outv[8 * (W) + 2 * (B)] += ck * t_.x; outv[8 * (W) + 2 * (B) + 1] += ck * t_.y; }
                        P9_VFMA(0, 0) P9_VFMA(0, 1) P9_VFMA(0, 2) P9_VFMA(0, 3) P9_VFMA(1, 0) P9_VFMA(1, 1) P9_VFMA(1, 2) P9_VFMA(1, 3)
#undef P9_VFMA
                        if ((k & 3) == 3) __builtin_amdgcn_sched_barrier(0);
                    }
                }
                const int lane = get_tid() & 63;
                float ss = 0.f;
#pragma unroll
                for (int i = 0; i < 4; ++i) {
                    const f32x4 gg = *(const f32x4*)(g2 + lane * 16 + i * 4);
#pragma unroll
                    for (int jj = 0; jj < 4; ++jj) { sv[i][jj] += gg[jj] * outv[i * 4 + jj]; ss += sv[i][jj] * sv[i][jj]; }
                }
                if (l == 0) {
                    const float rstd0 = rsqrtf(wave_sum(ss) * (1.f / DM) + EPSF);
                    const float* md1 = ((float*)(p2->ws + WS_MOD)) + ((size_t)17 + mr) * 6144;
                    bf16_t* hrow = HG(p2, g) + (size_t)r * DM + lane * 16;
#pragma unroll
                    for (int i = 0; i < 4; ++i) {
                        const int c = lane * 16 + i * 4;
                        const f32x4 w1 = *(const f32x4*)(p2->norm1_w + DM + c), sc = *(const f32x4*)(md1 + 1024 + c), sh = *(const f32x4*)(md1 + c);
                        f32x4 y;
#pragma unroll
                        for (int jj = 0; jj < 4; ++jj) y[jj] = sv[i][jj] * rstd0 * w1[jj] * (1.f + sc[jj]) + sh[jj];
                        store_bf16x4(hrow + i * 4, y);
                    }
                }
                if (l == 1) {
                    ss = wave_sum(ss);
                    const float rstd = rsqrtf(ss * (1.f / DM) + EPSF);
#pragma unroll
                    for (int i = 0; i < 4; ++i) { const f32x4 fw = *(const f32x4*)(p2->final_w + lane * 16 + i * 4);
#pragma unroll
                        for (int jj = 0; jj < 4; ++jj) sv[i][jj] *= rstd * fw[jj]; }
                }
#pragma unroll
                for (int i = 0; i < 4; ++i) *(f32x4*)(dst + lane * 16 + i * 4) = sv[i];
            }
        }
    }
}

__device__ __forceinline__ void phase_final(KP p, int bid, int nblk)
{
    const int lane = get_tid() & 63, wid = get_tid() >> 6;
    for (int r = bid * 8 + wid; r < NBATCH * SEQ; r += nblk * 8) {
        float* src = p->out + (size_t)r * DM;
        f32x4 v[4]; float ss = 0.f;
#pragma unroll
        for (int i = 0; i < 4; ++i) { v[i] = *(const f32x4*)(src + i * 256 + lane * 4); ss += v[i][0] * v[i][0] + v[i][1] * v[i][1] + v[i][2] * v[i][2] + v[i][3] * v[i][3]; }
        ss = wave_sum(ss);
        const float rstd = rsqrtf(ss * (1.f / DM) + EPSF);
#pragma unroll
        for (int i = 0; i < 4; ++i) {
            const f32x4 w = *(const f32x4*)(p->final_w + i * 256 + lane * 4);
            f32x4 y;
#pragma unroll
            for (int j = 0; j < 4; ++j) y[j] = v[i][j] * rstd * w[j];
            *(f32x4*)(src + i * 256 + lane * 4) = y;
        }
    }
}

template <int PH>
__device__ __forceinline__ void run_phase(KP p, int l, int g, char* lds, int bid, int nblk)
{
    asm volatile("" : "+s"(l), "+s"(g), "+s"(bid), "+s"(nblk));
    if constexpr (PH == 0) phase_prologue(p, lds, bid, nblk);
    if constexpr (PH == 1) { for (int gg = 0; gg < NGROUP; ++gg) phase_norm(p, 0, gg, 0, bid, nblk); }
    if constexpr (PH == 2) big_gemm(HG(p, g), ((bf16_t*)(p->ws + WS_WINT)) + (size_t)l * NPROJ * DM, TG, NPROJ, DM, Epi8<EpiProj8>{EpiProj8{((bf16_t*)(p->ws + WS_PROJ)), (unsigned char*)(p->ws + WS_GATE8)}}, lds, bid, nblk);
    if constexpr (PH == 3) phase_p3a(p, l, bid, nblk, lds);
    if constexpr (PH == 4) phase_p3b(p, l, bid, nblk);
    if constexpr (PH == 6) phase_p4(p, l, g, lds, bid, nblk);
    if constexpr (PH == 7) phase_p5(p, l, lds, bid, nblk);
    if constexpr (PH == 8) big_gemm_tail(((bf16_t*)(p->ws + WS_ACC)), ((bf16_t*)(p->ws + WS_WOUTT)) + (size_t)l * DM * DM, TG, DM, Epi4<EpiResid>{EpiResid{p, l, g, 2048}}, EpiResid{p, l, g, 2048}, lds, bid, nblk);
    if constexpr (PH == 9) phase_norm(p, l, g, 1, bid, nblk);
    if constexpr (PH == 10) big_gemm_tail(HG(p, g), ((bf16_t*)(p->ws + WS_WQT)) + (size_t)l * DM * DM, TG, DM, Epi8<EpiStore8>{EpiStore8{((bf16_t*)(p->ws + WS_PQ)), DM}}, EpiStore{((bf16_t*)(p->ws + WS_PQ)), DM}, lds, bid, nblk);
    if constexpr (PH == 11) phase_p9(p, l, g, lds, bid, nblk);
    if constexpr (PH == 12) phase_final(p, bid, nblk);
}


__device__ __forceinline__ void grid_barrier() {
    XcdBarrier b; b.bar = (unsigned*)(get_kp()->ws + WS_BAR); b.x = xb_xcc_id(); b.st = (volatile LAS unsigned*)smem;
    xcd_barrier(b);
}

template <int PH>
__global__ void __launch_bounds__(NTHREADS, 2) k_phase(Params p_unused, int l, int g)
{
    (void)p_unused;
    tid_setup();
    run_phase<PH>(get_kp(), l, g, smem + 512, blockIdx.x, gridDim.x);
}

#if MK_ONE_LAUNCH
__global__ void __launch_bounds__(NTHREADS, 2) k_mega(Params p_unused)
{
    (void)p_unused;
    tid_setup();
    if (get_tid() == 0) *(uint4*)smem = make_uint4(0u, 0u, 0u, 0u);
    __syncthreads();
    (void)xcd_barrier_post((unsigned*)(get_kp()->ws + WS_BAR), (volatile LAS unsigned*)smem);
    char* lds = smem + 512;
    const int bid = blockIdx.x, nblk = gridDim.x;
    run_phase<0>(get_kp(), 0, 0, lds, bid, nblk);
    grid_barrier();
#define MK_LG(L_, G_) do { \
        run_phase<2>(get_kp(), L_, G_, lds, bid, nblk); grid_barrier(); \
        run_phase<3>(get_kp(), L_, G_, lds, bid, nblk); grid_barrier(); \
        run_phase<4>(get_kp(), L_, G_, lds, bid, nblk); grid_barrier(); \
        run_phase<6>(get_kp(), L_, G_, lds, bid, nblk); grid_barrier(); \
        run_phase<7>(get_kp(), L_, G_, lds, bid, nblk); grid_barrier(); \
        run_phase<8>(get_kp(), L_, G_, lds, bid, nblk); grid_barrier(); \
        run_phase<9>(get_kp(), L_, G_, lds, bid, nblk); grid_barrier(); \
        run_phase<10>(get_kp(), L_, G_, lds, bid, nblk); grid_barrier(); \
        run_phase<11>(get_kp(), L_, G_, lds, bid, nblk); grid_barrier(); } while (0)
    run_phase<1>(get_kp(), 0, 0, lds, bid, nblk); grid_barrier();
    static_assert(NGROUP == 2, "phase program written out for two groups");
    MK_LG(0, 0); MK_LG(0, 1); MK_LG(1, 0); MK_LG(1, 1);
#undef MK_LG
}
#endif

static inline size_t al256(size_t x) { return (x + 255) & ~(size_t)255; }

template <int PH>
static void launch_phase(const Params& p, int l, int g, int grid, hipStream_t s)
{
    static bool attr = false;
    if (!attr) { (void)hipFuncSetAttribute((const void*)k_phase<PH>, hipFuncAttributeMaxDynamicSharedMemorySize, LDS_BYTES); attr = true; }
    hipLaunchKernelGGL(k_phase<PH>, dim3(grid), dim3(NTHREADS), LDS_BYTES, s, p, l, g);
}

extern "C" void kernel_launch(void* const* d_in, const int* in_sizes, int n_in, void* d_out, int out_size, void* d_ws, size_t ws_size, hipStream_t stream)
{
    (void)in_sizes; (void)n_in; (void)out_size;
    Params p{};
    p.x = (const float*)d_in[0]; p.c = (const float*)d_in[1]; p.ctx = (const float*)d_in[2]; p.c_ctx = (const float*)d_in[3];
    p.mod_w = (const float*)d_in[4]; p.mod_b = (const float*)d_in[5]; p.norm1_w = (const float*)d_in[6]; p.norm2_w = (const float*)d_in[7];
    p.w_in = (const float*)d_in[8]; p.mla_qn = (const float*)d_in[9]; p.mla_wuq = (const float*)d_in[10]; p.mla_kvn = (const float*)d_in[11];
    p.mla_wukv = (const float*)d_in[12]; p.gqa_qn = (const float*)d_in[13]; p.gqa_kn = (const float*)d_in[14]; p.na_bias = (const float*)d_in[15];
    p.ret_logit = (const float*)d_in[16]; p.ret_gnw = (const float*)d_in[17]; p.w_branch = (const float*)d_in[18]; p.w_out = (const float*)d_in[19];
    p.peer_wq = (const float*)d_in[20]; p.peer_keys = (const float*)d_in[21]; p.peer_u = (const float*)d_in[22]; p.peer_v = (const float*)d_in[23];
    p.final_w = (const float*)d_in[24];
    p.out = (float*)d_out;
    p.ws = (char*)d_ws;
    if (WS_TOTAL > ws_size) { fprintf(stderr, "workspace too small: need %zu have %zu\n", (size_t)WS_TOTAL, ws_size); return; }
    (void)hipMemsetAsync(d_ws, 0, WS_ZERO_END, stream);

    static int ncu = 0;
    if (!ncu) { int dev = 0; (void)hipGetDevice(&dev); (void)hipDeviceGetAttribute(&ncu, hipDeviceAttributeMultiprocessorCount, dev); if (ncu <= 0) ncu = 256; }
#if MK_ONE_LAUNCH
    static bool attr = false;
    if (!attr) { (void)hipFuncSetAttribute((const void*)k_mega, hipFuncAttributeMaxDynamicSharedMemorySize, LDS_BYTES); attr = true; }
    hipLaunchKernelGGL(k_mega, dim3(ncu), dim3(NTHREADS), LDS_BYTES, stream, p);
#else
    const int grid = ncu;
    launch_phase<0>(p, 0, 0, grid, stream);
    for (int l = 0; l < 2; ++l)
        for (int g = 0; g < NGROUP; ++g) {
            if (l == 0 && g == 0) launch_phase<1>(p, l, g, grid, stream);
            launch_phase<2>(p, l, g, grid, stream);
            launch_phase<3>(p, l, g, grid, stream);
            launch_phase<4>(p, l, g, grid, stream);
            launch_phase<6>(p, l, g, grid, stream);
            launch_phase<7>(p, l, g, grid, stream);
            launch_phase<8>(p, l, g, grid, stream);
            launch_phase<9>(p, l, g, grid, stream);
            launch_phase<10>(p, l, g, grid, stream);
            launch_phase<11>(p, l, g, grid, stream);
        }
#endif
}
```

```cpp
#include <hip/hip_runtime.h>
#include <stdint.h>
#include <stdio.h>

#ifndef MK_ONE_LAUNCH
#define MK_ONE_LAUNCH 1
#endif

#define DM 1024
#define NBATCH 16
#define SEQ 4096
#define CTXL 256
#define LTOK 4352
#define IN_COLS 7072
#define NPROJ 7168
#define PLD 3072
#define NB 8
#define NGROUP (NBATCH / NB)
#define TG (NB * LTOK)
#define NTHREADS 512
#define LDS_BYTES 131648
#define EPSF 1e-6f

#define C_CQ 0
#define C_CKV 256
#define C_KPE 384
#define C_GQ 416
#define C_GK 672
#define C_GV 800
#define C_NQ 928
#define C_NK 1184
#define C_NV 1440
#define C_RQ 1696
#define C_RK 1952
#define C_RV 2208
#define C_RGF 2464
#define C_RGB 2720
#define C_GATE 2976

#define LAS __attribute__((address_space(3)))
typedef unsigned short bf16_t;
typedef short bf16x8 __attribute__((ext_vector_type(8)));
typedef float f32x4 __attribute__((ext_vector_type(4)));
typedef float f32x2 __attribute__((ext_vector_type(2)));
typedef __bf16 bf16x2_t __attribute__((ext_vector_type(2)));
typedef unsigned u32x4 __attribute__((ext_vector_type(4)));
typedef unsigned u32x2 __attribute__((ext_vector_type(2)));
typedef float f32x16 __attribute__((ext_vector_type(16)));
typedef short s16x4 __attribute__((ext_vector_type(4)));

__device__ __forceinline__ unsigned pack_bf16(float lo, float hi) { f32x2 v = {lo, hi}; bf16x2_t b = __builtin_convertvector(v, bf16x2_t); return __builtin_bit_cast(unsigned, b); }
__device__ __forceinline__ bf16_t f2bf(float f) { return (bf16_t)(pack_bf16(f, 0.f) & 0xffffu); }
__device__ __forceinline__ float bf2f(bf16_t b) { return __uint_as_float(((unsigned)b) << 16); }
__device__ __forceinline__ float bflo(unsigned w) { return __uint_as_float(w << 16); }
__device__ __forceinline__ float bfhi(unsigned w) { return __uint_as_float(w & 0xffff0000u); }
#define PEER_USCALE 128.f
#define PEER_VSCALE 16.f
__device__ __forceinline__ float clamp448(float x) { return fminf(fmaxf(x, -448.f), 448.f); }
__device__ __forceinline__ unsigned pack_fp8x4(f32x4 v, float sc) {
    int w = 0;
    w = __builtin_amdgcn_cvt_pk_fp8_f32(clamp448(v[0] * sc), clamp448(v[1] * sc), w, false);
    w = __builtin_amdgcn_cvt_pk_fp8_f32(clamp448(v[2] * sc), clamp448(v[3] * sc), w, true);
    return (unsigned)w;
}

template <int M> __device__ __forceinline__ float xor_swz(float v) { return __int_as_float(__builtin_amdgcn_ds_swizzle(__float_as_int(v), (M << 10) | 0x1f)); }
template <int M> __device__ __forceinline__ unsigned xor_swz_u(unsigned v) { return (unsigned)__builtin_amdgcn_ds_swizzle((int)v, (M << 10) | 0x1f); }
__device__ __forceinline__ float sum_xor32(float v) { const u32x2 r = __builtin_amdgcn_permlane32_swap(__float_as_uint(v), __float_as_uint(v), false, false); return __uint_as_float(r.x) + __uint_as_float(r.y); }
__device__ __forceinline__ float max_xor32(float v) { const u32x2 r = __builtin_amdgcn_permlane32_swap(__float_as_uint(v), __float_as_uint(v), false, false); return fmaxf(__uint_as_float(r.x), __uint_as_float(r.y)); }
__device__ __forceinline__ unsigned get_xor32_u(unsigned v, bool upper) { const u32x2 r = __builtin_amdgcn_permlane32_swap(v, v, false, false); return upper ? r.x : r.y; }
__device__ __forceinline__ float wave_max(float v) {
    v = fmaxf(v, xor_swz<1>(v)); v = fmaxf(v, xor_swz<2>(v)); v = fmaxf(v, xor_swz<4>(v)); v = fmaxf(v, xor_swz<8>(v)); v = fmaxf(v, xor_swz<16>(v));
    return max_xor32(v);
}
__device__ __forceinline__ float wave_sum(float v) {
    v += xor_swz<1>(v); v += xor_swz<2>(v); v += xor_swz<4>(v); v += xor_swz<8>(v); v += xor_swz<16>(v);
    return sum_xor32(v);
}
extern __shared__ __attribute__((aligned(16))) char smem[];
#define WIDTAB_OFF 64
__device__ __forceinline__ unsigned hw_wave_slot() { return (unsigned)__builtin_amdgcn_s_getreg((5 << 11) | 4) & 63u; }
__device__ __forceinline__ void tid_setup() {
    if ((threadIdx.x & 63) == 0) ((volatile LAS int*)(smem + WIDTAB_OFF))[hw_wave_slot()] = (int)(threadIdx.x >> 6);
    __syncthreads();
}
__device__ __forceinline__ int get_tid() {
    int lane; asm volatile("v_mbcnt_lo_u32_b32 %0, -1, 0\n\tv_mbcnt_hi_u32_b32 %0, -1, %0" : "=v"(lane));
    int w = ((volatile LAS int*)(smem + WIDTAB_OFF))[hw_wave_slot()];
    w = __builtin_amdgcn_readfirstlane(w);
    int t = (w << 6) | lane; asm volatile("" : "+v"(t)); return t;
}
__device__ __forceinline__ float siluf(float x) { return x * __builtin_amdgcn_rcpf(1.f + __builtin_amdgcn_exp2f(x * -1.4426950408889634f)); }
__device__ __forceinline__ float sigmf(float x) { return __builtin_amdgcn_rcpf(1.f + __builtin_amdgcn_exp2f(x * -1.4426950408889634f)); }

#define XB_TMO      128
#define XB_XCNT(j)  (256  + 64 * (j))
#define XB_XSUB(j)  (1280 + 64 * (j))
#define XB_XGEN(j)  (2304 + 64 * (j))
#define XB_TOP      3328
#define XB_TOPGEN   3392
#define XCD_BAR_WORDS 3456
#define XB_SPIN_CAP (1u << 18)

__device__ __forceinline__ unsigned xb_ld(unsigned* p)              { return __hip_atomic_load(p, __ATOMIC_RELAXED, __HIP_MEMORY_SCOPE_AGENT); }
__device__ __forceinline__ unsigned xb_add(unsigned* p, unsigned v) { return __hip_atomic_fetch_add(p, v, __ATOMIC_RELAXED, __HIP_MEMORY_SCOPE_AGENT); }
__device__ __forceinline__ unsigned xb_xcc_id() { return (unsigned)__builtin_amdgcn_s_getreg((3 << 11) | 20) & 0xFu; }
#define XB_SPIN(cond, bar) do { unsigned _sp = 0; while (cond) { __builtin_amdgcn_s_sleep(1); \
    if ((++_sp & 255u) == 0u) { if (xb_ld(&(bar)[XB_TMO])) break; if (_sp > XB_SPIN_CAP) { atomicAdd(&(bar)[XB_TMO], 1u); break; } } } } while (0)

struct XcdBarrier { unsigned* bar; unsigned x; volatile LAS unsigned* st; };

__device__ __forceinline__ XcdBarrier xcd_barrier_post(unsigned* bar, volatile LAS unsigned* st) {
    XcdBarrier b; b.bar = bar; b.x = xb_xcc_id(); b.st = st;
    if (get_tid() == 0) (void)xb_add(&bar[XB_XCNT(b.x)], 1u);
    return b;
}
__device__ __forceinline__ void xcd_barrier_complete(unsigned* bar, unsigned x, unsigned& nloc, unsigned& nx) {
    const unsigned G = gridDim.x * gridDim.y * gridDim.z;
    unsigned sum, cnt, mine, sp = 0u;
    for (;;) {
        sum = 0u; cnt = 0u; mine = 0u;
#pragma unroll
        for (unsigned j = 0; j < 16; ++j) { const unsigned c = xb_ld(&bar[XB_XCNT(j)]); sum += c; cnt += (c > 0u) ? 1u : 0u; mine = (j == x) ? c : mine; }
        if (sum == G) break;
        __builtin_amdgcn_s_sleep(1);
        if ((++sp & 255u) == 0u) { if (xb_ld(&bar[XB_TMO])) break; if (sp > XB_SPIN_CAP) { atomicAdd(&bar[XB_TMO], 1u); break; } }
    }
    nloc = mine > 0u ? mine : 1u; nx = cnt > 0u ? cnt : 1u;
}
__device__ __forceinline__ void xcd_barrier(const XcdBarrier& b) {
    asm volatile("s_waitcnt vmcnt(0)" ::: "memory");
    __syncthreads();
    if (get_tid() == 0) {
        unsigned* bar = b.bar;
        __builtin_amdgcn_s_waitcnt(0);
        unsigned nloc = b.st[0], nx = b.st[1];
        if (nloc == 0u) { xcd_barrier_complete(bar, b.x, nloc, nx); b.st[0] = nloc; b.st[1] = nx; }
        const unsigned old = xb_add(&bar[XB_XSUB(b.x)], 1u);
        const unsigned gen = old / nloc;
        if (old + 1u == (gen + 1u) * nloc) {
            __builtin_amdgcn_fence(__ATOMIC_RELEASE, "agent");
            asm volatile("s_waitcnt vmcnt(0)" ::: "memory");
            const unsigned og = xb_add(&bar[XB_TOP], 1u);
            const unsigned tg = og / nx;
            if (og + 1u == (tg + 1u) * nx) xb_add(&bar[XB_TOPGEN], 1u);
            else XB_SPIN(xb_ld(&bar[XB_TOPGEN]) == tg, bar);
            __builtin_amdgcn_fence(__ATOMIC_ACQUIRE, "agent");
            xb_add(&bar[XB_XGEN(b.x)], 1u);
            asm volatile("s_waitcnt vmcnt(0)" ::: "memory");
        } else {
            XB_SPIN(xb_ld(&bar[XB_XGEN(b.x)]) == gen, bar);
            __builtin_amdgcn_fence(__ATOMIC_ACQUIRE, "agent");
            asm volatile("s_waitcnt vmcnt(0)" ::: "memory");
        }
    }
    __syncthreads();
}

struct Params {
    const float *x, *c, *ctx, *c_ctx, *mod_w, *mod_b, *norm1_w, *norm2_w, *w_in, *mla_qn, *mla_wuq, *mla_kvn, *mla_wukv,
                *gqa_qn, *gqa_kn, *na_bias, *ret_logit, *ret_gnw, *w_branch, *w_out, *peer_wq, *peer_keys, *peer_u, *peer_v, *final_w;
    float* out;
    char* ws;
};
typedef const __attribute__((address_space(4))) Params* KP;
__device__ __forceinline__ KP get_kp() { KP kp = (KP)__builtin_amdgcn_kernarg_segment_ptr(); asm volatile("" : "+s"(kp)); return kp; }

constexpr size_t al256c(size_t x) { return (x + 255) & ~(size_t)255; }
constexpr size_t WS_BAR = 0;
constexpr size_t WS_CNT = WS_BAR + al256c(XCD_BAR_WORDS * 4);
constexpr size_t WS_ZERO_END = WS_CNT + al256c(8 * 8 * 64 * 4);
constexpr size_t WS_MOD = WS_ZERO_END;
constexpr size_t WS_CTXS = WS_MOD + al256c((size_t)2 * 17 * 6144 * 4);
constexpr size_t WS_WINT = WS_CTXS + al256c((size_t)NBATCH * CTXL * DM * 4);
constexpr size_t WS_WUQT = WS_WINT + al256c((size_t)2 * NPROJ * DM * 2);
constexpr size_t WS_WUKVT = WS_WUQT + al256c((size_t)2 * 384 * 256 * 2);
constexpr size_t WS_WBT = WS_WUKVT + al256c((size_t)2 * 512 * 128 * 2);
constexpr size_t WS_WOUTT = WS_WBT + al256c((size_t)2 * 4 * DM * 256 * 2);
constexpr size_t WS_WQT = WS_WOUTT + al256c((size_t)2 * DM * DM * 2);
constexpr size_t WS_H = WS_WQT + al256c((size_t)2 * DM * DM * 2);
constexpr size_t WS_PROJ = WS_H + al256c((size_t)NGROUP * TG * DM * 2);
#define HG(p_, g_) (((bf16_t*)((p_)->ws + WS_H)) + (size_t)(g_) * TG * DM)
constexpr size_t WS_GATE8 = WS_PROJ + al256c((size_t)TG * PLD * 2);
constexpr size_t WS_QRAW = WS_GATE8 + al256c((size_t)TG * 4096);
constexpr size_t WS_KVRAW = WS_QRAW + al256c((size_t)TG * 384 * 2);
constexpr size_t WS_QA = WS_KVRAW + al256c((size_t)TG * 512 * 2);
constexpr size_t WS_KA = WS_QA + al256c((size_t)TG * 384 * 2);
constexpr size_t WS_VA = WS_KA + al256c((size_t)TG * 384 * 2);
constexpr size_t WS_GQ = WS_VA + al256c((size_t)TG * 256 * 2);
constexpr size_t WS_GK = WS_GQ + al256c((size_t)TG * 256 * 2);
constexpr size_t WS_OUTS = WS_GK + al256c((size_t)TG * 128 * 2);
constexpr size_t WS_ACC = WS_QRAW;
constexpr size_t WS_PQ = WS_OUTS;
constexpr size_t WS_RKV = WS_OUTS + al256c((size_t)4 * TG * 256 * 2);
constexpr size_t WS_UB = WS_RKV + al256c((size_t)NB * 4 * 2 * 34 * 4096 * 4);
constexpr size_t WS_VB = WS_UB + al256c((size_t)2 * 16384 * DM);
constexpr size_t WS_KEYB = WS_VB + al256c((size_t)2 * 16384 * DM);
constexpr size_t WS_USC = WS_UB + (size_t)2 * 16384 * (DM / 2);
constexpr size_t WS_VSC = WS_VB + (size_t)2 * 16384 * (DM / 2);
constexpr size_t WS_TOTAL = WS_KEYB + al256c((size_t)2 * 8 * 2 * 128 * 64 * 2);

#define G_BM 256
#define G_BN 128
#define G_BK 64
#define G_LDP 144
#define G_ABYTES (G_BM * G_LDP)
#define G_BBYTES (G_BN * G_LDP)
#define G_STAGE (G_ABYTES + G_BBYTES)

template <int MI>
__device__ __forceinline__ void gemm_tile(const bf16_t* __restrict__ A, int lda, const bf16_t* __restrict__ Bt, int ldb, int K,
                                          f32x4 (&acc)[MI][4], char* lds)
{
    constexpr int NA = MI;
    const int tid = get_tid(), lane = tid & 63, wid = tid >> 6, wm = wid >> 1, wn = wid & 1, fr = lane & 15, fq = lane >> 4;
    const int nk = K / G_BK;
    u32x4 ra[NA], rb[2];
    const int arow = tid >> 3, akc = tid & 7;
    const bf16_t* ag = A + (size_t)arow * lda + akc * 8;
    const bf16_t* bg = Bt + (size_t)arow * ldb + akc * 8;
    const int a_l = arow * G_LDP + akc * 16;
#pragma unroll
    for (int i = 0; i < NA; ++i) ra[i] = *(const u32x4*)(ag + (size_t)(64 * i) * lda);
#pragma unroll
    for (int i = 0; i < 2; ++i) rb[i] = *(const u32x4*)(bg + (size_t)(64 * i) * ldb);
    __syncthreads();
#pragma unroll
    for (int i = 0; i < NA; ++i) *(u32x4*)(lds + a_l + i * 64 * G_LDP) = ra[i];
#pragma unroll
    for (int i = 0; i < 2; ++i) *(u32x4*)(lds + G_ABYTES + a_l + i * 64 * G_LDP) = rb[i];
    __syncthreads();
    const int aoff = (wm * 16 * MI + fr) * G_LDP + fq * 16;
    const int boff = G_ABYTES + (wn * 64 + fr) * G_LDP + fq * 16;
    for (int kt = 0; kt < nk; ++kt) {
        const int cur = (kt & 1) * G_STAGE, nxt = ((kt + 1) & 1) * G_STAGE;
        const bool more = (kt + 1 < nk);
        if (more) {
#pragma unroll
            for (int i = 0; i < NA; ++i) ra[i] = *(const u32x4*)(ag + (size_t)(64 * i) * lda + (kt + 1) * G_BK);
#pragma unroll
            for (int i = 0; i < 2; ++i) rb[i] = *(const u32x4*)(bg + (size_t)(64 * i) * ldb + (kt + 1) * G_BK);
        }
#pragma unroll
        for (int ks = 0; ks < 2; ++ks) {
            bf16x8 af[MI], bfr[4];
#pragma unroll
            for (int mi = 0; mi < MI; ++mi) af[mi] = *(const bf16x8*)(lds + cur + aoff + mi * 16 * G_LDP + ks * 64);
#pragma unroll
            for (int ni = 0; ni < 4; ++ni) bfr[ni] = *(const bf16x8*)(lds + cur + boff + ni * 16 * G_LDP + ks * 64);
#pragma unroll
            for (int mi = 0; mi < MI; ++mi)
#pragma unroll
                for (int ni = 0; ni < 4; ++ni) acc[mi][ni] = __builtin_amdgcn_mfma_f32_16x16x32_bf16(bfr[ni], af[mi], acc[mi][ni], 0, 0, 0);
        }
        if (more) {
#pragma unroll
            for (int i = 0; i < NA; ++i) *(u32x4*)(lds + nxt + a_l + i * 64 * G_LDP) = ra[i];
#pragma unroll
            for (int i = 0; i < 2; ++i) *(u32x4*)(lds + nxt + G_ABYTES + a_l + i * 64 * G_LDP) = rb[i];
        }
        __syncthreads();
    }
}

template <int MI>
__device__ __forceinline__ void zero_acc(f32x4 (&acc)[MI][4]) {
#pragma unroll
    for (int i = 0; i < MI; ++i)
#pragma unroll
        for (int j = 0; j < 4; ++j) acc[i][j] = (f32x4){0.f, 0.f, 0.f, 0.f};
}

template <class Epi>
__device__ __forceinline__ void gemm_phase(const bf16_t* A, int lda, const bf16_t* Bt, int ldb, int M, int N, int K, const Epi& epi, char* lds, int bid, int nblk)
{
    const int tid = get_tid(), lane = tid & 63, wid = tid >> 6, wm = wid >> 1, wn = wid & 1, fr = lane & 15, fq = lane >> 4;
    const int tn = N / G_BN, total = (M / G_BM) * tn;
    for (int t = bid; t < total; t += nblk) {
        const int pm = t / tn, pn = t % tn;
        f32x4 acc[4][4]; zero_acc(acc);
        gemm_tile<4>(A + (size_t)pm * G_BM * lda, lda, Bt + (size_t)pn * G_BN * ldb, ldb, K, acc, lds);
#pragma unroll
        for (int mi = 0; mi < 4; ++mi)
#pragma unroll
            for (int ni = 0; ni < 4; ++ni) epi(pm * G_BM + wm * 64 + mi * 16 + fr, pn * G_BN + wn * 64 + ni * 16 + fq * 4, acc[mi][ni]);
    }
}

__device__ __forceinline__ void store_bf16x4(bf16_t* p, f32x4 v) { u32x2 w; w.x = pack_bf16(v[0], v[1]); w.y = pack_bf16(v[2], v[3]); *(u32x2*)p = w; }


namespace pg8 {
#define PG8_LAS __attribute__((address_space(3)))
typedef unsigned short bf16_t;
typedef short bf16x8 __attribute__((ext_vector_type(8)));
typedef float f32x4 __attribute__((ext_vector_type(4)));
typedef unsigned u32x4 __attribute__((ext_vector_type(4)));
constexpr int BM = 256, BK = 64, HALF = 128, HTB = HALF * BK * 2  , STAGE_BYTES = 8 * HTB, NXCD = 8, WGM = 8;

__host__ __device__ __forceinline__ int lds_byte(int r, int c) { const int st = (r >> 4) * 2 + (c >> 5), rr = r & 15, cc = c & 31, ob = rr * 64 + cc * 2; return st * 1024 + (ob ^ (((ob >> 9) & 1) << 5)); }
__host__ __device__ __forceinline__ void stage_rc(int b, int& R, int& C) { const int st = b / 1024, sb = b % 1024, swz = sb ^ (((sb >> 9) & 1) << 5); R = (st >> 1) * 16 + swz / 64; C = (st & 1) * 32 + (swz % 64) / 2; }
__host__ __device__ __forceinline__ int perm32(int rho) { const int n = rho >> 4, i = rho & 15; return 8 * (i >> 2) + 4 * n + (i & 3); }

struct Unit { int pm, pn; };
struct Gemm { const bf16_t* A; const bf16_t* Bt; int M, N, K; };

struct StaticOrder {
    int nM, nN, nwg, G, c, lim;
    __host__ __device__ void init(int M, int N, int G_, int c_) { nM = M / BM; nN = N / BM; nwg = nM * nN; G = G_; c = c_; lim = nwg; }
    __host__ __device__ void map(int L, Unit& u) const {
        int wgid = L; { const int q = nwg / NXCD, r = nwg % NXCD, xcd = wgid % NXCD, off = wgid / NXCD; wgid = (xcd < r ? xcd * (q + 1) : r * (q + 1) + (xcd - r) * q) + off; }
        const int nig = WGM * nN, gid = wgid / nig, fm = gid * WGM, gsz = (nM - fm) < WGM ? (nM - fm) : WGM;
        u.pm = fm + ((wgid % nig) % gsz); u.pn = (wgid % nig) / gsz;
    }
    __host__ __device__ bool next(int i, Unit& u) const {
        const long L = (long)i * G + c; if (L >= lim) return false;
        map((int)L, u); return true;
    }
    __device__ __forceinline__ void a_ready(const Unit&) const {}
    __device__ __forceinline__ void done(const Unit&) const {}
};
template <class Epi, class Sched, bool ALIGN_EPI = false, bool SP2 = false>
__device__ __forceinline__ void gemm_phase(PG8_LAS unsigned char* lds, const Gemm g, const Sched& S, const Epi& E) {
    const int tid = get_tid(), wid = __builtin_amdgcn_readfirstlane(tid >> 6), lane = tid & 63, wr = wid >> 2, wc = wid & 3, fr = lane & 15, fq = lane >> 4;
    const int K = g.K, nt = K / BK;
    unsigned voffA[2], voffB[2];
#pragma unroll
    for (int i = 0; i < 2; ++i) { int R, C; stage_rc(tid * 16 + i * 8192, R, C); const int Rb = Epi::PERM ? ((R & ~31) + perm32(R & 31)) : R;
        voffA[i] = (unsigned)(R * K + C) * 2u; voffB[i] = (unsigned)(Rb * K + C) * 2u; }
    const size_t kstep = (size_t)(BK * 2);
    const size_t hstep = (size_t)HALF * K * 2;
    const size_t tstep = 2 * hstep;
    const unsigned ldsw = (unsigned)wid * 1024u;
    const int aoff = lds_byte(wr * 64 + fr, fq * 8), boff = lds_byte(wc * 32 + fr, fq * 8);
#define PG8_SA(b, h) (((b) * 2 + (h)) * HTB)
#define PG8_SB(b, h) ((4 + (b) * 2 + (h)) * HTB)
#define PG8_STAGE(bufoff, gbase, voff) do { _Pragma("unroll") for (int _i = 0; _i < 2; ++_i) \
        __builtin_amdgcn_global_load_lds((const unsigned*)((const char*)(gbase) + (voff)[_i]), (PG8_LAS unsigned*)(lds + (bufoff) + ldsw + _i * 8192), 16, 0, 0); } while (0)
#define PG8_LDA(dst, b, h) do { _Pragma("unroll") for (int m = 0; m < 4; ++m) _Pragma("unroll") for (int k = 0; k < 2; ++k) dst[m][k] = *(const PG8_LAS bf16x8*)(lds + PG8_SA(b, h) + aoff + m * 2048 + k * 1024); } while (0)
#define PG8_LDB(dst, b, h) do { _Pragma("unroll") for (int n = 0; n < 2; ++n) _Pragma("unroll") for (int k = 0; k < 2; ++k) dst[n][k] = *(const PG8_LAS bf16x8*)(lds + PG8_SB(b, h) + boff + n * 2048 + k * 1024); } while (0)
#define PG8_MMA(ai, bj, At, Bt) do { __builtin_amdgcn_s_setprio(1); _Pragma("unroll") for (int m = 0; m < 4; ++m) _Pragma("unroll") for (int n = 0; n < 2; ++n) _Pragma("unroll") for (int k = 0; k < 2; ++k) \
        acc[ai][bj][m][n] = __builtin_amdgcn_mfma_f32_16x16x32_bf16(Bt[n][k], At[m][k], acc[ai][bj][m][n], 0, 0, 0); __builtin_amdgcn_s_setprio(0); } while (0)
#define PG8_WAIT_V(n) asm volatile("s_waitcnt vmcnt(" #n ")" ::: "memory")
#define PG8_WAIT_L(n) asm volatile("s_waitcnt lgkmcnt(" #n ")" ::: "memory")
#define PG8_BAR __builtin_amdgcn_s_barrier()
#define PG8_SCHED __builtin_amdgcn_sched_barrier(0)
    Unit cur, nxt; int ui = 0;
    if (!S.next(0, cur)) return;
    f32x4 acc[2][2][4][2];
#pragma unroll
    for (int a = 0; a < 2; ++a)
#pragma unroll
        for (int b = 0; b < 2; ++b)
#pragma unroll
            for (int m = 0; m < 4; ++m)
#pragma unroll
                for (int n = 0; n < 2; ++n) acc[a][b][m][n] = (f32x4){0.f, 0.f, 0.f, 0.f};
    bf16x8 At[4][2], B0[2][2], B1[2][2];
    const char* cA = (const char*)g.A + (size_t)cur.pm * tstep; const char* cB = (const char*)g.Bt + (size_t)cur.pn * tstep;
    S.a_ready(cur);
    if constexpr (SP2) {
        PG8_STAGE(PG8_SB(0, 0), cB, voffB); PG8_STAGE(PG8_SB(0, 1), cB + hstep, voffB); PG8_STAGE(PG8_SA(0, 0), cA, voffA); PG8_STAGE(PG8_SA(0, 1), cA + hstep, voffA);
        if (wr == 1) PG8_BAR;
        PG8_WAIT_V(2); PG8_BAR;
        PG8_STAGE(PG8_SB(1, 0), cB + kstep, voffB); PG8_STAGE(PG8_SA(1, 0), cA + kstep, voffA); PG8_STAGE(PG8_SB(1, 1), cB + hstep + kstep, voffB);
        PG8_WAIT_V(6); PG8_BAR;
    } else {
        PG8_STAGE(PG8_SB(0, 0), cB, voffB); PG8_STAGE(PG8_SA(0, 0), cA, voffA); PG8_STAGE(PG8_SB(0, 1), cB + hstep, voffB); PG8_STAGE(PG8_SA(0, 1), cA + hstep, voffA);
        if (wr == 1) PG8_BAR;
        PG8_WAIT_V(4); PG8_BAR;
        PG8_STAGE(PG8_SB(1, 0), cB + kstep, voffB); PG8_STAGE(PG8_SA(1, 0), cA + kstep, voffA); PG8_STAGE(PG8_SB(1, 1), cB + hstep + kstep, voffB);
        PG8_WAIT_V(6); PG8_BAR;
    }
    for (;;) {
        const bool has_next = S.next(ui + 1, nxt);
        const char* nA = has_next ? (const char*)g.A + (size_t)nxt.pm * tstep : cA; const char* nB = has_next ? (const char*)g.Bt + (size_t)nxt.pn * tstep : cB;
        for (int t = 0; t < nt; t += 2) {
            const bool last = (t == nt - 2);
            const char* a1 = cA + (size_t)(t + 1) * kstep;
            const char* a2 = last ? nA : cA + (size_t)(t + 2) * kstep; const char* b2 = last ? nB : cB + (size_t)(t + 2) * kstep;
            const char* a3 = a2 + kstep; const char* b3 = b2 + kstep;
            if (last && has_next) S.a_ready(nxt);
            if constexpr (SP2) {
            PG8_LDB(B0, 0, 0); PG8_LDB(B1, 0, 1); PG8_SCHED; PG8_LDA(At, 0, 0); PG8_STAGE(PG8_SA(1, 1), a1 + hstep, voffA);
            PG8_WAIT_V(8); PG8_WAIT_L(0); PG8_BAR; PG8_MMA(0, 0, At, B0); PG8_MMA(0, 1, At, B1); PG8_BAR; PG8_SCHED;
            PG8_LDA(At, 0, 1); PG8_STAGE(PG8_SB(0, 0), b2, voffB); PG8_STAGE(PG8_SB(0, 1), b2 + hstep, voffB); PG8_STAGE(PG8_SA(0, 0), a2, voffA);
            PG8_WAIT_V(8); PG8_WAIT_L(0); PG8_BAR; PG8_MMA(1, 0, At, B0); PG8_MMA(1, 1, At, B1); PG8_BAR; PG8_SCHED;
            PG8_LDB(B0, 1, 0); PG8_LDB(B1, 1, 1); PG8_SCHED; PG8_LDA(At, 1, 0); PG8_STAGE(PG8_SA(0, 1), a2 + hstep, voffA);
            PG8_WAIT_V(8); PG8_WAIT_L(0); PG8_BAR; PG8_MMA(0, 0, At, B0); PG8_MMA(0, 1, At, B1); PG8_BAR; PG8_SCHED;
            PG8_LDA(At, 1, 1); PG8_STAGE(PG8_SB(1, 0), b3, voffB); PG8_STAGE(PG8_SB(1, 1), b3 + hstep, voffB); PG8_STAGE(PG8_SA(1, 0), a3, voffA);
            PG8_WAIT_V(8); PG8_WAIT_L(0); PG8_BAR; PG8_MMA(1, 0, At, B0); PG8_MMA(1, 1, At, B1); PG8_BAR; PG8_SCHED;
            } else {
            PG8_LDB(B0, 0, 0); PG8_SCHED; PG8_LDA(At, 0, 0); PG8_STAGE(PG8_SA(1, 1), a1 + hstep, voffA);
            PG8_WAIT_L(8); PG8_BAR; PG8_WAIT_L(0); PG8_MMA(0, 0, At, B0); PG8_BAR; PG8_SCHED;
            PG8_LDB(B1, 0, 1); PG8_STAGE(PG8_SB(0, 0), b2, voffB);
            PG8_BAR; PG8_WAIT_L(0); PG8_MMA(0, 1, At, B1); PG8_BAR;
            PG8_LDA(At, 0, 1); PG8_STAGE(PG8_SA(0, 0), a2, voffA);
            PG8_BAR; PG8_WAIT_L(0); PG8_MMA(1, 0, At, B0); PG8_BAR; PG8_SCHED;
            PG8_STAGE(PG8_SB(0, 1), b2 + hstep, voffB);
            PG8_WAIT_V(6); PG8_BAR; PG8_MMA(1, 1, At, B1); PG8_BAR;
            PG8_LDB(B0, 1, 0); PG8_SCHED; PG8_LDA(At, 1, 0); PG8_STAGE(PG8_SA(0, 1), a2 + hstep, voffA);
            PG8_WAIT_L(8); PG8_BAR; PG8_WAIT_L(0); PG8_MMA(0, 0, At, B0); PG8_BAR; PG8_SCHED;
            PG8_LDB(B1, 1, 1); PG8_STAGE(PG8_SB(1, 0), b3, voffB);
            PG8_BAR; PG8_WAIT_L(0); PG8_MMA(0, 1, At, B1); PG8_BAR;
            PG8_LDA(At, 1, 1); PG8_STAGE(PG8_SA(1, 0), a3, voffA);
            PG8_BAR; PG8_WAIT_L(0); PG8_MMA(1, 0, At, B0); PG8_BAR; PG8_SCHED;
            PG8_STAGE(PG8_SB(1, 1), b3 + hstep, voffB);
            PG8_WAIT_V(6); PG8_BAR; PG8_MMA(1, 1, At, B1); PG8_BAR;
            }
        }
        if constexpr (ALIGN_EPI) { if (wr == 0) PG8_BAR; }
        if constexpr (!Epi::AFTER_DRAIN) { E(acc, cur, wr, wc, fr, fq); S.done(cur); }
        if (!has_next) break;
#pragma unroll
        for (int a = 0; a < 2; ++a)
#pragma unroll
            for (int b = 0; b < 2; ++b)
#pragma unroll
                for (int m = 0; m < 4; ++m)
#pragma unroll
                    for (int n = 0; n < 2; ++n) acc[a][b][m][n] = (f32x4){0.f, 0.f, 0.f, 0.f};
        cur = nxt; cA = nA; cB = nB; ++ui;
        if constexpr (ALIGN_EPI) { if (wr == 1) PG8_BAR; }
    }
    PG8_WAIT_V(0);
    if constexpr (!ALIGN_EPI) { if (wr == 0) PG8_BAR; }
    PG8_BAR;
    if constexpr (Epi::AFTER_DRAIN) { E.fused(acc, cur, wr, wc, fr, fq, lds, wid, lane); S.done(cur); }
#undef PG8_SA
#undef PG8_SB
#undef PG8_STAGE
#undef PG8_LDA
#undef PG8_LDB
#undef PG8_MMA
#undef PG8_WAIT_V
#undef PG8_WAIT_L
#undef PG8_BAR
#undef PG8_SCHED
}
}

template <class F> struct Epi4 {
    static constexpr bool PERM = false, AFTER_DRAIN = false; F f;
    __device__ __forceinline__ void operator()(const f32x4 (&acc)[2][2][4][2], const pg8::Unit& u, int wr, int wc, int fr, int fq) const {
#pragma unroll
        for (int ai = 0; ai < 2; ++ai)
#pragma unroll
            for (int m = 0; m < 4; ++m)
#pragma unroll
                for (int bj = 0; bj < 2; ++bj)
#pragma unroll
                    for (int n = 0; n < 2; ++n) f(u.pm * 256 + ai * 128 + wr * 64 + m * 16 + fr, u.pn * 256 + bj * 128 + wc * 32 + n * 16 + fq * 4, acc[ai][bj][m][n]);
    }
};
template <class F> struct Epi8 {
    static constexpr bool PERM = true, AFTER_DRAIN = false; F f;
    __device__ __forceinline__ void operator()(const f32x4 (&acc)[2][2][4][2], const pg8::Unit& u, int wr, int wc, int fr, int fq) const {
#pragma unroll
        for (int ai = 0; ai < 2; ++ai)
#pragma unroll
            for (int m = 0; m < 4; ++m)
#pragma unroll
                for (int bj = 0; bj < 2; ++bj) f(u.pm * 256 + ai * 128 + wr * 64 + m * 16 + fr, u.pn * 256 + bj * 128 + wc * 32 + fq * 8, acc[ai][bj][m][0], acc[ai][bj][m][1]);
    }
};
template <class E>
__device__ __forceinline__ void big_gemm(const bf16_t* A, const bf16_t* Bt, int M, int N, int K, const E& e, char* lds, int bid, int nblk) {
    pg8::StaticOrder so; so.init(M, N, nblk, bid);
    pg8::gemm_phase<E, pg8::StaticOrder, true, true>((PG8_LAS unsigned char*)lds, pg8::Gemm{A, Bt, M, N, K}, so, e);
}

template <class F4>
__device__ __forceinline__ void gemm_tail64(const bf16_t* __restrict__ A, const bf16_t* __restrict__ Bt, int row0, int col0, const F4& f, char* lds)
{
    const int tid = get_tid(), lane = tid & 63, wid = tid >> 6, wm = wid >> 1, wn = wid & 1, fr = lane & 15, fq = lane >> 4;
    const int arow = tid >> 3, akc = tid & 7, a_l = arow * G_LDP + akc * 16;
    const int aoff = (wm * 16 + fr) * G_LDP + fq * 16, boff = G_ABYTES + (wn * 64 + fr) * G_LDP + fq * 16;
    const bf16_t* ag = A + ((size_t)row0 + arow) * DM + akc * 8;
    const bf16_t* bg = Bt + ((size_t)col0 + arow) * DM + akc * 8;
    f32x4 acc[4];
#pragma unroll
    for (int ni = 0; ni < 4; ++ni) acc[ni] = (f32x4){0.f, 0.f, 0.f, 0.f};
    u32x4 sa[4], sb[4][2];
#define GT_LOAD(S_, KT) do { sa[S_] = *(const u32x4*)(ag + (KT) * 64); sb[S_][0] = *(const u32x4*)(bg + (KT) * 64); sb[S_][1] = *(const u32x4*)(bg + (size_t)64 * DM + (KT) * 64); } while (0)
#define GT_STORE(S_, BO) do { *(u32x4*)(lds + (BO) + a_l) = sa[S_]; *(u32x4*)(lds + (BO) + G_ABYTES + a_l) = sb[S_][0]; *(u32x4*)(lds + (BO) + G_ABYTES + a_l + 64 * G_LDP) = sb[S_][1]; } while (0)
    GT_LOAD(0, 0); GT_LOAD(1, 1); GT_LOAD(2, 2); GT_LOAD(3, 3);
    __syncthreads();
    GT_STORE(0, 0);
    __syncthreads();
#pragma unroll
    for (int kt = 0; kt < 16; ++kt) {
        const int cur = (kt & 1) * G_STAGE, nxt = ((kt + 1) & 1) * G_STAGE;
        if (kt + 4 < 16) GT_LOAD(kt & 3, kt + 4);
#pragma unroll
        for (int ks = 0; ks < 2; ++ks) {
            const bf16x8 af = *(const bf16x8*)(lds + cur + aoff + ks * 64);
            bf16x8 bfr[4];
#pragma unroll
            for (int ni = 0; ni < 4; ++ni) bfr[ni] = *(const bf16x8*)(lds + cur + boff + ni * 16 * G_LDP + ks * 64);
#pragma unroll
            for (int ni = 0; ni < 4; ++ni) acc[ni] = __builtin_amdgcn_mfma_f32_16x16x32_bf16(bfr[ni], af, acc[ni], 0, 0, 0);
        }
        if (kt + 1 < 16) GT_STORE((kt + 1) & 3, nxt);
        __syncthreads();
    }
#undef GT_LOAD
#undef GT_STORE
#pragma unroll
    for (int ni = 0; ni < 4; ++ni) f(row0 + wm * 16 + fr, col0 + wn * 64 + ni * 16 + fq * 4, acc[ni]);
}

template <class E, class F4>
__device__ __forceinline__ void big_gemm_tail(const bf16_t* A, const bf16_t* Bt, int M, int N, const E& e, const F4& f4, char* lds, int bid, int nblk) {
    pg8::StaticOrder so; so.init(M, N, nblk, bid);
    const int rem = so.nwg % nblk;
    const bool split = rem > 0 && rem * 8 <= nblk;
    if (split) so.lim = so.nwg - rem;
    pg8::gemm_phase<E, pg8::StaticOrder, true, true>((PG8_LAS unsigned char*)lds, pg8::Gemm{A, Bt, M, N, DM}, so, e);
    if (split) {
        const bool x8 = (rem % 8) == 0;
        for (int j = bid; j < rem * 8; j += nblk) {
            const int unit = x8 ? (j & 7) + 8 * (j >> 6) : (j >> 3), sub = x8 ? ((j >> 3) & 7) : (j & 7);
            pg8::Unit u; so.map(so.lim + unit, u);
            gemm_tail64(A, Bt, u.pm * 256 + (sub >> 1) * 64, u.pn * 256 + (sub & 1) * 128, f4, lds);
        }
    }
}

__device__ __forceinline__ void transpose_cvt(const float* __restrict__ src, int K, int N, int Npad, bf16_t* __restrict__ dst, const float* __restrict__ kscale, float* lds, int bid, int nblk)
{
    const int tid = get_tid();
    const int tk = K / 64, tn = Npad / 64, total = tk * tn;
    const int lk = tid >> 3, ln = (tid & 7) * 8;
    const int sn = tid >> 3, sk = (tid & 7) * 8;
    for (int t = bid; t < total; t += nblk) {
        const int k0 = (t / tn) * 64, n0 = (t % tn) * 64;
        f32x4 a = (f32x4){0.f, 0.f, 0.f, 0.f}, c = a;
        if (n0 + ln < N) { const float* sp = src + (size_t)(k0 + lk) * N + n0 + ln; a = *(const f32x4*)sp; c = *(const f32x4*)(sp + 4); if (kscale) { const float ks = kscale[k0 + lk]; a *= ks; c *= ks; } }
        __syncthreads();
#pragma unroll
        for (int j = 0; j < 4; ++j) { lds[lk * 65 + ln + j] = a[j]; lds[lk * 65 + ln + 4 + j] = c[j]; }
        __syncthreads();
        u32x4 w;
        w.x = pack_bf16(lds[(sk + 0) * 65 + sn], lds[(sk + 1) * 65 + sn]); w.y = pack_bf16(lds[(sk + 2) * 65 + sn], lds[(sk + 3) * 65 + sn]);
        w.z = pack_bf16(lds[(sk + 4) * 65 + sn], lds[(sk + 5) * 65 + sn]); w.w = pack_bf16(lds[(sk + 6) * 65 + sn], lds[(sk + 7) * 65 + sn]);
        *(u32x4*)(dst + (size_t)(n0 + sn) * K + k0 + sk) = w;
    }
}

__device__ __forceinline__ void phase_prologue(KP p, char* ldsc, int bid, int nblk)
{
    float* lds = (float*)ldsc;
    const int tid = get_tid();
    for (int l = 0; l < 2; ++l) {
        transpose_cvt(p->w_in + (size_t)l * DM * IN_COLS, DM, IN_COLS, NPROJ, ((bf16_t*)(p->ws + WS_WINT)) + (size_t)l * NPROJ * DM, nullptr, lds, bid, nblk);
        transpose_cvt(p->mla_wuq + (size_t)l * 256 * 384, 256, 384, 384, ((bf16_t*)(p->ws + WS_WUQT)) + (size_t)l * 384 * 256, p->mla_qn + l * 256, lds, bid, nblk);
        transpose_cvt(p->mla_wukv + (size_t)l * 128 * 512, 128, 512, 512, ((bf16_t*)(p->ws + WS_WUKVT)) + (size_t)l * 512 * 128, p->mla_kvn + l * 128, lds, bid, nblk);
        for (int i = 0; i < 4; ++i)
            transpose_cvt(p->w_branch + (size_t)(l * 4 + i) * 256 * DM, 256, DM, DM, ((bf16_t*)(p->ws + WS_WBT)) + (size_t)(l * 4 + i) * DM * 256, nullptr, lds, bid, nblk);
        transpose_cvt(p->w_out + (size_t)l * DM * DM, DM, DM, DM, ((bf16_t*)(p->ws + WS_WOUTT)) + (size_t)l * DM * DM, nullptr, lds, bid, nblk);
        transpose_cvt(p->peer_wq + (size_t)l * DM * DM, DM, DM, DM, ((bf16_t*)(p->ws + WS_WQT)) + (size_t)l * DM * DM, nullptr, lds, bid, nblk);
    }
    {
        float* sil = lds;
        float* red = lds + 17 * 1024;
        __syncthreads();
        for (int e = tid; e < 17 * 1024; e += NTHREADS) { const int r = e >> 10, k = e & 1023; const float v = (r < 16) ? p->c[r * 1024 + k] : p->c_ctx[k]; sil[e] = siluf(v); }
        __syncthreads();
        for (int u = bid; u < 2 * 96; u += nblk) {
            const int l = u / 96, j0 = (u % 96) * 64, kg = tid >> 6, j = tid & 63;
            float a[17];
#pragma unroll
            for (int r = 0; r < 17; ++r) a[r] = 0.f;
            const float* w = p->mod_w + (size_t)l * DM * 6144 + j0 + j;
#pragma unroll 1
            for (int k0 = kg * 128; k0 < kg * 128 + 128; k0 += 16) {
                float wv[16];
#pragma unroll
                for (int kk = 0; kk < 16; ++kk) wv[kk] = w[(size_t)(k0 + kk) * 6144];
#pragma unroll
                for (int kk = 0; kk < 16; ++kk)
#pragma unroll
                    for (int r = 0; r < 17; ++r) a[r] += sil[r * 1024 + k0 + kk] * wv[kk];
            }
#pragma unroll
            for (int r = 0; r < 17; ++r) red[(kg * 17 + r) * 64 + j] = a[r];
            __syncthreads();
            for (int e = tid; e < 17 * 64; e += NTHREADS) {
                const int r = e >> 6, jj = e & 63; float s = 0.f;
                for (int q = 0; q < 8; ++q) s += red[(q * 17 + r) * 64 + jj];
                ((float*)(p->ws + WS_MOD))[((size_t)l * 17 + r) * 6144 + j0 + jj] = s + p->mod_b[l * 6144 + j0 + jj];
            }
            __syncthreads();
        }
    }
    {
        const size_t n16 = (size_t)2 * 16384 * DM / 16;
        for (size_t i = (size_t)bid * NTHREADS + tid; i < n16; i += (size_t)nblk * NTHREADS) {
            f32x4 a[4], c[4];
#pragma unroll
            for (int q = 0; q < 4; ++q) { a[q] = ((const f32x4*)p->peer_u)[4 * i + q]; c[q] = ((const f32x4*)p->peer_v)[4 * i + q]; }
            float mu = 0.f, mv = 0.f;
#pragma unroll
            for (int q = 0; q < 4; ++q)
#pragma unroll
                for (int j = 0; j < 4; ++j) { mu = fmaxf(mu, fabsf(a[q][j])); mv = fmaxf(mv, fabsf(c[q][j])); }
            mu = wave_max(mu); mv = wave_max(mv);
            const float su = mu > 0.f ? mu * (1.f / 6.f) : 1.f, sv = mv > 0.f ? mv * (1.f / 6.f) : 1.f, iu = 1.f / su, iv = 1.f / sv;
            u32x2 wu = (u32x2){0u, 0u}, wv = (u32x2){0u, 0u};
#pragma unroll
            for (int q = 0; q < 4; ++q) {
                unsigned tu = wu[q >> 1], tv = wv[q >> 1];
                if ((q & 1) == 0) {
                    tu = __builtin_amdgcn_cvt_scalef32_pk_fp4_f32(tu, a[q][0] * iu, a[q][1] * iu, 1.0f, 0); tu = __builtin_amdgcn_cvt_scalef32_pk_fp4_f32(tu, a[q][2] * iu, a[q][3] * iu, 1.0f, 1);
                    tv = __builtin_amdgcn_cvt_scalef32_pk_fp4_f32(tv, c[q][0] * iv, c[q][1] * iv, 1.0f, 0); tv = __builtin_amdgcn_cvt_scalef32_pk_fp4_f32(tv, c[q][2] * iv, c[q][3] * iv, 1.0f, 1);
                } else {
                    tu = __builtin_amdgcn_cvt_scalef32_pk_fp4_f32(tu, a[q][0] * iu, a[q][1] * iu, 1.0f, 2); tu = __builtin_amdgcn_cvt_scalef32_pk_fp4_f32(tu, a[q][2] * iu, a[q][3] * iu, 1.0f, 3);
                    tv = __builtin_amdgcn_cvt_scalef32_pk_fp4_f32(tv, c[q][0] * iv, c[q][1] * iv, 1.0f, 2); tv = __builtin_amdgcn_cvt_scalef32_pk_fp4_f32(tv, c[q][2] * iv, c[q][3] * iv, 1.0f, 3);
                }
                wu[q >> 1] = tu; wv[q >> 1] = tv;
            }
            ((u32x2*)(p->ws + WS_UB))[i] = wu; ((u32x2*)(p->ws + WS_VB))[i] = wv;
            if ((tid & 63) == 0) { ((float*)(p->ws + WS_USC))[i >> 6] = su; ((float*)(p->ws + WS_VSC))[i >> 6] = sv; }
        }
        const size_t k8 = (size_t)2 * 8 * 2 * 128 * 64 / 8;
        for (size_t i = (size_t)bid * NTHREADS + tid; i < k8; i += (size_t)nblk * NTHREADS) {
            const f32x4 a = ((const f32x4*)p->peer_keys)[2 * i], b = ((const f32x4*)p->peer_keys)[2 * i + 1];
            u32x4 w; w.x = pack_bf16(a[0], a[1]); w.y = pack_bf16(a[2], a[3]); w.z = pack_bf16(b[0], b[1]); w.w = pack_bf16(b[2], b[3]);
            ((u32x4*)(p->ws + WS_KEYB))[i] = w;
        }
    }
}

__device__ __forceinline__ const float* state_row(KP p, int g, int r, int& modrow, bool from_input) {
    const int bl = r / LTOK, t = r - bl * LTOK, b = g * NB + bl;
    if (t < CTXL) { modrow = 16; return (from_input ? p->ctx : (const float*)(p->ws + WS_CTXS)) + ((size_t)b * CTXL + t) * DM; }
    modrow = b; return (from_input ? p->x : (const float*)p->out) + ((size_t)b * SEQ + (t - CTXL)) * DM;
}

__device__ __forceinline__ void phase_norm(KP p, int l, int g, int which, int bid, int nblk)
{
    const int lane = get_tid() & 63, wid = get_tid() >> 6;
    const float* nw = (which ? p->norm2_w : p->norm1_w) + l * DM;
    const int shoff = which ? 3072 : 0, scoff = which ? 4096 : 1024;
    for (int r = bid * 8 + wid; r < TG; r += nblk * 8) {
        int mr; const float* src = state_row(p, g, r, mr, l == 0 && which == 0);
        const float* md = ((float*)(p->ws + WS_MOD)) + ((size_t)l * 17 + mr) * 6144;
        f32x4 v[4]; float ss = 0.f;
#pragma unroll
        for (int i = 0; i < 4; ++i) { v[i] = *(const f32x4*)(src + i * 256 + lane * 4); ss += v[i][0] * v[i][0] + v[i][1] * v[i][1] + v[i][2] * v[i][2] + v[i][3] * v[i][3]; }
        ss = wave_sum(ss);
        const float rstd = rsqrtf(ss * (1.f / DM) + EPSF);
#pragma unroll
        for (int i = 0; i < 4; ++i) {
            const int c = i * 256 + lane * 4;
            const f32x4 w = *(const f32x4*)(nw + c), sc = *(const f32x4*)(md + scoff + c), sh = *(const f32x4*)(md + shoff + c);
            f32x4 y;
#pragma unroll
            for (int j = 0; j < 4; ++j) y[j] = v[i][j] * rstd * w[j] * (1.f + sc[j]) + sh[j];
            store_bf16x4(HG(p, g) + (size_t)r * DM + c, y);
        }
    }
}

struct EpiProj8 {
    bf16_t* O; unsigned char* G8;
    __device__ __forceinline__ void operator()(int row, int col, f32x4 a, f32x4 b) const {
        if (col >= C_GATE) {
            const int gi = col - C_GATE; if (gi >= 4096) return;
            unsigned w0 = 0u, w1 = 0u;
#pragma unroll
            for (int j = 0; j < 4; ++j) {
                w0 |= (unsigned)__builtin_amdgcn_cvt_pk_u8_f32(sigmf(a[j]) * 255.f, j, 0);
                w1 |= (unsigned)__builtin_amdgcn_cvt_pk_u8_f32(sigmf(b[j]) * 255.f, j, 0);
            }
            const int gp_ = (gi & ~63) | (((gi >> 2) & 3) << 4) | (((gi >> 4) & 3) << 2);
            *(unsigned*)(G8 + (size_t)row * 4096 + gp_) = w0; *(unsigned*)(G8 + (size_t)row * 4096 + gp_ + 16) = w1;
            return;
        }
        if (col >= C_NQ && col < C_NK) { a *= (0.125f * 1.4426950408889634f); b *= (0.125f * 1.4426950408889634f); }
        u32x4 w; w.x = pack_bf16(a[0], a[1]); w.y = pack_bf16(a[2], a[3]); w.z = pack_bf16(b[0], b[1]); w.w = pack_bf16(b[2], b[3]);
        *(u32x4*)(O + (size_t)row * PLD + col) = w;
    }
};
struct EpiStore8 { bf16_t* O; int ld;
    __device__ __forceinline__ void operator()(int row, int col, f32x4 a, f32x4 b) const {
        u32x4 w; w.x = pack_bf16(a[0], a[1]); w.y = pack_bf16(a[2], a[3]); w.z = pack_bf16(b[0], b[1]); w.w = pack_bf16(b[2], b[3]);
        *(u32x4*)(O + (size_t)row * ld + col) = w; } };
struct EpiStore { bf16_t* O; int ld; __device__ __forceinline__ void operator()(int row, int col, f32x4 v) const { store_bf16x4(O + (size_t)row * ld + col, v); } };

__device__ __forceinline__ float log_sigmoidf(float x) { return fminf(x, 0.f) - log1pf(__expf(-fabsf(x))); }

__device__ __forceinline__ int ret_jb(int rb) { return rb == 0 ? 1 : (rb == 1 ? 0 : 35 - rb); }

__device__ __forceinline__ bf16x8 tr_frag_nat(const char* img, int PT, int k0, int col0, int lane) {
    const int i16 = lane & 15, blk = (lane >> 4) & 1, h5 = lane >> 5, q4 = i16 >> 2, p4 = i16 & 3;
    const char* a = img + (k0 + 8 * h5 + q4) * PT + (col0 + 16 * blk) * 2 + 8 * p4;
    const s16x4 lo = __builtin_amdgcn_ds_read_tr16_b64_v4i16((LAS s16x4*)a), hi = __builtin_amdgcn_ds_read_tr16_b64_v4i16((LAS s16x4*)(a + 4 * PT));
    return __builtin_shufflevector(lo, hi, 0, 1, 2, 3, 4, 5, 6, 7);
}
__device__ __forceinline__ bf16x8 tr_frag_acc(const char* img, int PT, int k0, int col0, int lane) {
    const int i16 = lane & 15, blk = (lane >> 4) & 1, h5 = lane >> 5, q4 = i16 >> 2, p4 = i16 & 3;
    const char* a = img + (k0 + 4 * h5 + q4) * PT + (col0 + 16 * blk) * 2 + 8 * p4;
    const s16x4 lo = __builtin_amdgcn_ds_read_tr16_b64_v4i16((LAS s16x4*)a), hi = __builtin_amdgcn_ds_read_tr16_b64_v4i16((LAS s16x4*)(a + 8 * PT));
    return __builtin_shufflevector(lo, hi, 0, 1, 2, 3, 4, 5, 6, 7);
}
#define RT_PT 144
__device__ __forceinline__ void ret_kv_unit(KP p, int l, int bl, int h, int rb, char* lds)
{
    const int tid = get_tid(), lane = tid & 63, wid = tid >> 6, r = lane & 31, h5 = lane >> 5;
    const bf16_t* PR = (const bf16_t*)(p->ws + WS_PROJ);
    const size_t R0 = (size_t)bl * LTOK + rb * 128;
    const float lgf = log_sigmoidf(p->ret_logit[(l * 2 + 0) * 4 + h]) * 1.4426950408889634f, lgb = log_sigmoidf(p->ret_logit[(l * 2 + 1) * 4 + h]) * 1.4426950408889634f;
    char* KF = lds; char* KBk = lds + 128 * RT_PT; char* VV = lds + 2 * 128 * RT_PT;
    __syncthreads();
#pragma unroll
    for (int q = 0; q < 2; ++q) {
        const int c = tid + 512 * q, row = c >> 3, cc = c & 7;
        const u32x4 kw = *(const u32x4*)(PR + (R0 + row) * PLD + C_RK + h * 64 + cc * 8), vw = *(const u32x4*)(PR + (R0 + row) * PLD + C_RV + h * 64 + cc * 8);
        const float wf = 0.125f * __builtin_amdgcn_exp2f(lgf * (float)(127 - row)), wb = 0.125f * __builtin_amdgcn_exp2f(lgb * (float)row);
        u32x4 of, ob;
#pragma unroll
        for (int j = 0; j < 4; ++j) { const float lo = bflo(kw[j]), hi = bfhi(kw[j]); of[j] = pack_bf16(lo * wf, hi * wf); ob[j] = pack_bf16(lo * wb, hi * wb); }
        *(u32x4*)(KF + row * RT_PT + cc * 16) = of; *(u32x4*)(KBk + row * RT_PT + cc * 16) = ob; *(u32x4*)(VV + row * RT_PT + cc * 16) = vw;
    }
    __syncthreads();
    const int dir = wid >> 2, dt = (wid >> 1) & 1, et = wid & 1;
    const char* Ks = dir ? KBk : KF;
    f32x16 acc;
#pragma unroll
    for (int i = 0; i < 16; ++i) acc[i] = 0.f;
#pragma unroll
    for (int s2 = 0; s2 < 8; ++s2) {
        const bf16x8 af = tr_frag_nat(Ks, RT_PT, 16 * s2, dt * 32, lane), bfv = tr_frag_nat(VV, RT_PT, 16 * s2, et * 32, lane);
        acc = __builtin_amdgcn_mfma_f32_32x32x16_bf16(af, bfv, acc, 0, 0, 0);
    }
    const int j = dir ? ret_jb(rb) : rb;
    float* dst = ((float*)(p->ws + WS_RKV)) + ((((size_t)bl * 4 + h) * 2 + dir) * 34 + j) * 4096 + et * 32 + r;
#pragma unroll
    for (int i = 0; i < 16; ++i) dst[(dt * 32 + (i & 3) + 8 * (i >> 2) + 4 * h5) * 64] = acc[i];
}

__device__ __forceinline__ void phase_p3a(KP p, int l, int bid, int nblk, char* lds)
{
    gemm_phase(((bf16_t*)(p->ws + WS_PROJ)) + C_CQ, PLD, ((bf16_t*)(p->ws + WS_WUQT)) + (size_t)l * 384 * 256, 256, TG, 384, 256, EpiStore{((bf16_t*)(p->ws + WS_QRAW)), 384}, lds, bid, nblk);
    gemm_phase(((bf16_t*)(p->ws + WS_PROJ)) + C_CKV, PLD, ((bf16_t*)(p->ws + WS_WUKVT)) + (size_t)l * 512 * 128, 128, TG, 512, 128, EpiStore{((bf16_t*)(p->ws + WS_KVRAW)), 512}, lds, bid, nblk);
    for (int u = bid; u < NB * 4 * 34; u += nblk) { const int rb = u % 34, h = (u / 34) & 3, bl = u / 136; ret_kv_unit(p, l, bl, h, rb, lds); }
}

#define LOG2_THETA 13.287712379549449f
__device__ __forceinline__ float rope_freq(int i, int half) { return exp2f(-LOG2_THETA * (float)i / (float)half); }

__device__ __forceinline__ void phase_p3b(KP p, int l, int bid, int nblk)
{
    {
        const int gt = bid * NTHREADS + get_tid();
        for (int it = gt; it < NB * 4 * 2 * 1024; it += nblk * NTHREADS) {
            const int e4 = it & 1023, bhd = it >> 10, dir = bhd & 1, h = (bhd >> 1) & 3;
            const float dec = __builtin_amdgcn_exp2f(log_sigmoidf(p->ret_logit[(l * 2 + dir) * 4 + h]) * 1.4426950408889634f * 128.f);
            f32x4* base = (f32x4*)((float*)(p->ws + WS_RKV) + (size_t)bhd * 34 * 4096) + e4;
            f32x4 st = (f32x4){0.f, 0.f, 0.f, 0.f};
            f32x4 kv[34];
#pragma unroll
            for (int j = 0; j < 34; ++j) kv[j] = base[(size_t)j * 1024];
#pragma unroll
            for (int j = 0; j < 34; ++j) { base[(size_t)j * 1024] = st; st = st * dec + kv[j]; }
        }
    }
    const int lane = get_tid() & 63, wid = get_tid() >> 6;
    const float mla_scale = 0.10206207261596575f * 1.4426950408889634f;
    auto load_row = [&](unsigned (&rw)[40], int r) {
        const bf16_t* pr = ((bf16_t*)(p->ws + WS_PROJ)) + (size_t)r * PLD;
        const bf16_t* qraw = ((bf16_t*)(p->ws + WS_QRAW)) + (size_t)r * 384;
        const bf16_t* kvraw = ((bf16_t*)(p->ws + WS_KVRAW)) + (size_t)r * 512;
#pragma unroll
        for (int i = 0; i < 4; ++i) rw[i] = pr[C_CQ + lane + 64 * i];
#pragma unroll
        for (int i = 0; i < 2; ++i) rw[4 + i] = pr[C_CKV + lane + 64 * i];
#pragma unroll
        for (int i = 0; i < 6; ++i) {
            const int idx = lane + 64 * i, h = idx / 96, d = idx % 96, dd = d >= 64 ? d - 64 : 0;
            rw[6 + i] = qraw[idx];
            rw[12 + i] = qraw[(unsigned)(d >= 64 ? idx - dd + (dd ^ 8) : idx)];
            rw[18 + i] = d < 64 ? kvraw[h * 128 + d] : pr[C_KPE + dd];
            rw[24 + i] = pr[C_KPE + (unsigned)(dd ^ 8)];
        }
#pragma unroll
        for (int i = 0; i < 4; ++i) { const int idx = lane + 64 * i, h = idx >> 6, e = idx & 63; rw[30 + i] = kvraw[h * 128 + 64 + e]; }
#pragma unroll
        for (int hh = 0; hh < 6; ++hh) rw[34 + hh] = pr[(hh < 4 ? C_GQ + hh * 64 : C_GK + (hh - 4) * 64) + lane];
    };
    auto proc_row = [&](const unsigned (&rw)[40], int r) {
        const int t = r % LTOK;
        const bool lat = t >= CTXL;
        const float prow = lat ? (float)((t - CTXL) >> 6) : 0.f, pcol = lat ? (float)((t - CTXL) & 63) : 0.f;
        float sq = 0.f, skv = 0.f;
#pragma unroll
        for (int i = 0; i < 4; ++i) { const float v = bf2f((bf16_t)rw[i]); sq += v * v; }
#pragma unroll
        for (int i = 0; i < 2; ++i) { const float v = bf2f((bf16_t)rw[4 + i]); skv += v * v; }
        sq = wave_sum(sq); skv = wave_sum(skv);
        const float rq = rsqrtf(sq * (1.f / 256.f) + EPSF), rkv = rsqrtf(skv * (1.f / 128.f) + EPSF);
#pragma unroll
        for (int i = 0; i < 6; ++i) {
            const int idx = lane + 64 * i, d = idx % 96;
            float qv = bf2f((bf16_t)rw[6 + i]), kv = bf2f((bf16_t)rw[18 + i]);
            if (d < 64) kv *= rkv;
            else if (lat) {
                const int dd = d - 64, blk = dd >> 4, w = dd & 15, fi = w & 7; const bool first = w < 8;
                const float rev = (blk ? pcol : prow) * rope_freq(fi, 8) * 0.15915494309189535f; const float sn = __builtin_amdgcn_sinf(rev), cs = __builtin_amdgcn_cosf(rev);
                const float qo = bf2f((bf16_t)rw[12 + i]), ko = bf2f((bf16_t)rw[24 + i]);
                qv = first ? (qv * cs - qo * sn) : (qo * sn + qv * cs);
                kv = first ? (kv * cs - ko * sn) : (ko * sn + kv * cs);
            }
            ((bf16_t*)(p->ws + WS_QA))[(size_t)r * 384 + idx] = f2bf(qv * rq * mla_scale);
            ((bf16_t*)(p->ws + WS_KA))[(size_t)r * 384 + idx] = f2bf(kv);
        }
#pragma unroll
        for (int i = 0; i < 4; ++i) ((bf16_t*)(p->ws + WS_VA))[(size_t)r * 256 + lane + 64 * i] = f2bf(bf2f((bf16_t)rw[30 + i]) * rkv);
        const int blk = lane >> 5, w = lane & 31, fi = w & 15; const bool first = w < 16;
        float sn = 0.f, cs = 1.f;
        if (lat) { const float rev = (blk ? pcol : prow) * rope_freq(fi, 16) * 0.15915494309189535f; sn = __builtin_amdgcn_sinf(rev); cs = __builtin_amdgcn_cosf(rev); }
        const float nwq = p->gqa_qn[l * 64 + lane], nwk = p->gqa_kn[l * 64 + lane];
#pragma unroll
        for (int hh = 0; hh < 6; ++hh) {
            const bool isq = hh < 4;
            const float v = bf2f((bf16_t)rw[34 + hh]);
            const float ss = wave_sum(v * v);
            const float n = v * rsqrtf(ss * (1.f / 64.f) + EPSF) * (isq ? nwq : nwk);
            const float other = xor_swz<16>(n);
            float val = n;
            if (lat) val = first ? (n * cs - other * sn) : (other * sn + n * cs);
            if (isq) ((bf16_t*)(p->ws + WS_GQ))[(size_t)r * 256 + hh * 64 + lane] = f2bf(val * (0.125f * 1.4426950408889634f));
            else ((bf16_t*)(p->ws + WS_GK))[(size_t)r * 128 + (hh - 4) * 64 + lane] = f2bf(val);
        }
    };
    const int rstep = nblk * 8;
    int r = bid * 8 + wid;
    if (r < TG) {
        unsigned ra[40], rb[40];
        load_row(ra, r);
        for (;;) {
            const bool m1 = r + rstep < TG;
            if (m1) load_row(rb, r + rstep);
            proc_row(ra, r);
            if (!m1) break;
            r += rstep;
            const bool m2 = r + rstep < TG;
            if (m2) load_row(ra, r + rstep);
            proc_row(rb, r);
            if (!m2) break;
            r += rstep;
        }
    }
}

template <int DQ>
__device__ __forceinline__ void attn_unit(const bf16_t* __restrict__ Qb, int qld, const bf16_t* __restrict__ Kb, int kld, const bf16_t* __restrict__ Vb, int vld,
                                          int nq, int nk, bf16_t* __restrict__ Ob, int old_, char* lds)
{
    constexpr int NS = DQ / 16, CPR = DQ / 8, KP = DQ * 2 + 16, VP = 144, KB = 64 * KP, VB = 64 * VP, STG = KB + VB, KCH = 64 * CPR;
    const int tid = get_tid(), lane = tid & 63, wid = tid >> 6, r = lane & 31, h = lane >> 5;
    int qrow[2]; bool qvalid[2];
    bf16x8 qf[2][NS];
#pragma unroll
    for (int qb = 0; qb < 2; ++qb) {
        qrow[qb] = wid * 64 + qb * 32 + r; qvalid[qb] = qrow[qb] < nq; if (!qvalid[qb]) qrow[qb] = 0;
#pragma unroll
        for (int s2 = 0; s2 < NS; ++s2) qf[qb][s2] = *(const bf16x8*)(Qb + (size_t)qrow[qb] * qld + 16 * s2 + 8 * h);
    }
    f32x16 o0[2], o1[2];
    float m[2] = {0.f, 0.f}, l[2] = {0.f, 0.f};
#pragma unroll
    for (int qb = 0; qb < 2; ++qb)
#pragma unroll
        for (int i = 0; i < 16; ++i) { o0[qb][i] = 0.f; o1[qb][i] = 0.f; }
    const int kr0 = tid / CPR, kc0 = tid % CPR, kr1 = (tid + 512) / CPR, kc1 = (tid + 512) % CPR; const bool k1 = (tid + 512) < KCH;
    const int vr = tid >> 3, vc = tid & 7;
    const bf16_t* kg0 = Kb + (size_t)kr0 * kld + kc0 * 8; const bf16_t* kg1 = Kb + (size_t)kr1 * kld + kc1 * 8; const bf16_t* vg = Vb + (size_t)vr * vld + vc * 8;
    const int kl0 = kr0 * KP + kc0 * 16, kl1 = kr1 * KP + kc1 * 16, vl = KB + vr * VP + vc * 16;
    u32x4 rk0, rk1 = (u32x4){0u, 0u, 0u, 0u}, rv;
    rk0 = *(const u32x4*)kg0; if (k1) rk1 = *(const u32x4*)kg1; rv = *(const u32x4*)vg;
    __syncthreads();
    *(u32x4*)(lds + kl0) = rk0; if (k1) *(u32x4*)(lds + kl1) = rk1; *(u32x4*)(lds + vl) = rv;
    __syncthreads();
    const int i16 = lane & 15, blk = (lane >> 4) & 1, q4 = i16 >> 2, p4 = i16 & 3;
    const int koff = r * KP + 16 * h, voff = KB + (4 * h + q4) * VP + 32 * blk + 8 * p4;
    const int nt = nk >> 6;
    for (int kt = 0; kt < nt; ++kt) {
        const int cur = (kt & 1) * STG, nxt = ((kt + 1) & 1) * STG;
        const bool more = kt + 1 < nt;
        if (more) {
            const size_t adv = (size_t)(kt + 1) * 64;
            rk0 = *(const u32x4*)(kg0 + adv * kld); if (k1) rk1 = *(const u32x4*)(kg1 + adv * kld); rv = *(const u32x4*)(vg + adv * vld);
        }
#pragma unroll
        for (int sub = 0; sub < 2; ++sub) {
            f32x16 sq[2];
#pragma unroll
            for (int i = 0; i < 16; ++i) { sq[0][i] = 0.f; sq[1][i] = 0.f; }
#pragma unroll
            for (int g0 = 0; g0 < NS; g0 += 4) {
                bf16x8 kfr[4];
#pragma unroll
                for (int s2 = 0; s2 < 4; ++s2) if (g0 + s2 < NS) kfr[s2] = *(const bf16x8*)(lds + cur + koff + sub * 32 * KP + (g0 + s2) * 32);
#pragma unroll
                for (int s2 = 0; s2 < 4; ++s2) if (g0 + s2 < NS) {
                    sq[0] = __builtin_amdgcn_mfma_f32_32x32x16_bf16(kfr[s2], qf[0][g0 + s2], sq[0], 0, 0, 0);
                    sq[1] = __builtin_amdgcn_mfma_f32_32x32x16_bf16(kfr[s2], qf[1][g0 + s2], sq[1], 0, 0, 0);
                }
            }
            bf16x8 vfr[2][2];
#pragma unroll
            for (int s2 = 0; s2 < 1; ++s2) {
                const int vb = cur + voff + (sub * 32 + 16 * s2) * VP;
                const s16x4 lo0 = __builtin_amdgcn_ds_read_tr16_b64_v4i16((LAS s16x4*)(lds + vb));
                const s16x4 hi0 = __builtin_amdgcn_ds_read_tr16_b64_v4i16((LAS s16x4*)(lds + vb + 8 * VP));
                const s16x4 lo1 = __builtin_amdgcn_ds_read_tr16_b64_v4i16((LAS s16x4*)(lds + vb + 64));
                const s16x4 hi1 = __builtin_amdgcn_ds_read_tr16_b64_v4i16((LAS s16x4*)(lds + vb + 8 * VP + 64));
                vfr[s2][0] = __builtin_shufflevector(lo0, hi0, 0, 1, 2, 3, 4, 5, 6, 7); vfr[s2][1] = __builtin_shufflevector(lo1, hi1, 0, 1, 2, 3, 4, 5, 6, 7);
            }
            bf16x8 pf[2][2];
#pragma unroll
            for (int qb = 0; qb < 2; ++qb) {
                f32x16& st = sq[qb];
                if (__builtin_amdgcn_ballot_w64(m[qb] != 0.f) != 0ull) {
#pragma unroll
                    for (int i = 0; i < 16; ++i) st[i] -= m[qb];
                }
                float mx = fmaxf(fmaxf(st[0], st[1]), fmaxf(st[2], st[3]));
#pragma unroll
                for (int i = 4; i < 16; i += 4) mx = fmaxf(mx, fmaxf(fmaxf(st[i], st[i + 1]), fmaxf(st[i + 2], st[i + 3])));
                { const u32x2 sw = __builtin_amdgcn_permlane32_swap(__float_as_uint(mx), __float_as_uint(mx), false, false); mx = fmaxf(__uint_as_float(sw.x), __uint_as_float(sw.y)); }
                const bool first = (kt == 0) && (sub == 0);
                const bool mv = mx > 24.f || (first && mx < -24.f);
                if (__builtin_amdgcn_ballot_w64(mv) != 0ull) {
                    const float dlt = mv ? mx : 0.f, alpha = __builtin_amdgcn_exp2f(-dlt);
                    m[qb] += dlt; l[qb] *= alpha;
#pragma unroll
                    for (int i = 0; i < 16; ++i) { st[i] -= dlt; o0[qb][i] *= alpha; o1[qb][i] *= alpha; }
                }
                float rs = 0.f;
#pragma unroll
                for (int i = 0; i < 16; ++i) { st[i] = __builtin_amdgcn_exp2f(st[i]); rs += st[i]; }
                l[qb] += rs;
                u32x4 pw0, pw1;
                pw0.x = pack_bf16(st[0], st[1]); pw0.y = pack_bf16(st[2], st[3]); pw0.z = pack_bf16(st[4], st[5]); pw0.w = pack_bf16(st[6], st[7]);
                pw1.x = pack_bf16(st[8], st[9]); pw1.y = pack_bf16(st[10], st[11]); pw1.z = pack_bf16(st[12], st[13]); pw1.w = pack_bf16(st[14], st[15]);
                pf[qb][0] = __builtin_bit_cast(bf16x8, pw0); pf[qb][1] = __builtin_bit_cast(bf16x8, pw1);
            }
            {
                const int vb = cur + voff + (sub * 32 + 16) * VP;
                const s16x4 lo0 = __builtin_amdgcn_ds_read_tr16_b64_v4i16((LAS s16x4*)(lds + vb));
                const s16x4 hi0 = __builtin_amdgcn_ds_read_tr16_b64_v4i16((LAS s16x4*)(lds + vb + 8 * VP));
                const s16x4 lo1 = __builtin_amdgcn_ds_read_tr16_b64_v4i16((LAS s16x4*)(lds + vb + 64));
                const s16x4 hi1 = __builtin_amdgcn_ds_read_tr16_b64_v4i16((LAS s16x4*)(lds + vb + 8 * VP + 64));
                vfr[1][0] = __builtin_shufflevector(lo0, hi0, 0, 1, 2, 3, 4, 5, 6, 7); vfr[1][1] = __builtin_shufflevector(lo1, hi1, 0, 1, 2, 3, 4, 5, 6, 7);
            }
#pragma unroll
            for (int s2 = 0; s2 < 2; ++s2)
#pragma unroll
                for (int qb = 0; qb < 2; ++qb) {
                    o0[qb] = __builtin_amdgcn_mfma_f32_32x32x16_bf16(vfr[s2][0], pf[qb][s2], o0[qb], 0, 0, 0);
                    o1[qb] = __builtin_amdgcn_mfma_f32_32x32x16_bf16(vfr[s2][1], pf[qb][s2], o1[qb], 0, 0, 0);
                }
        }
        if (more) { *(u32x4*)(lds + nxt + kl0) = rk0; if (k1) *(u32x4*)(lds + nxt + kl1) = rk1; *(u32x4*)(lds + nxt + vl) = rv; }
        __syncthreads();
    }
#pragma unroll
    for (int qb = 0; qb < 2; ++qb) {
        float lt = sum_xor32(l[qb]);
        if (qvalid[qb]) {
            const float inv = 1.f / lt;
            bf16_t* op = Ob + (size_t)qrow[qb] * old_ + 4 * h;
#pragma unroll
            for (int g4 = 0; g4 < 4; ++g4) {
                store_bf16x4(op + 8 * g4, (f32x4){o0[qb][4 * g4] * inv, o0[qb][4 * g4 + 1] * inv, o0[qb][4 * g4 + 2] * inv, o0[qb][4 * g4 + 3] * inv});
                store_bf16x4(op + 32 + 8 * g4, (f32x4){o1[qb][4 * g4] * inv, o1[qb][4 * g4 + 1] * inv, o1[qb][4 * g4 + 2] * inv, o1[qb][4 * g4 + 3] * inv});
            }
        }
    }
}

__device__ __forceinline__ void ld8(const bf16_t* p, float (&o)[8]) {
    const u32x4 w = *(const u32x4*)p;
    o[0] = bflo(w.x); o[1] = bfhi(w.x); o[2] = bflo(w.y); o[3] = bfhi(w.y); o[4] = bflo(w.z); o[5] = bfhi(w.z); o[6] = bflo(w.w); o[7] = bfhi(w.w);
}

__device__ __forceinline__ void na_unit(KP p, int l, int bl, int h, int rg, char* lds)
{
    constexpr int KP_ = 144, VP = 144, KB = 64 * KP_, VB = 64 * VP, STG = KB + VB, LBIAS = 2 * STG;
    const int tid = get_tid(), lane = tid & 63, wid = tid >> 6, r = lane & 31, h5 = lane >> 5;
    const bf16_t* PR = (const bf16_t*)(p->ws + WS_PROJ);
    const size_t Rb = (size_t)bl * LTOK;
    const int grow = rg * 4 + (wid >> 1), c = (wid & 1) * 32 + r;
    const int rs = min(max(grow - 4, 0), 56), cs = min(max(c - 8, 0), 48);
    const int Rlo = min(max(rg * 4 - 4, 0), 56), Rhi = min(max(rg * 4 + 3 - 4, 0), 56) + 7, nrow = Rhi - Rlo + 1, nt = nrow + 4;
    const size_t qrow = Rb + CTXL + (size_t)grow * 64 + c;
    bf16x8 qf[4];
#pragma unroll
    for (int s2 = 0; s2 < 4; ++s2) qf[s2] = *(const bf16x8*)(PR + qrow * PLD + C_NQ + h * 64 + 16 * s2 + 8 * h5);
    f32x16 o0, o1;
#pragma unroll
    for (int i = 0; i < 16; ++i) { o0[i] = 0.f; o1[i] = 0.f; }
    float m = -1e30f, lsum = 0.f;
    const int kr = tid >> 3, kc = tid & 7;
    const int kl = kr * KP_ + kc * 16, vl = KB + kr * VP + kc * 16;
    auto tile_row = [&](int t) -> size_t { return t < nrow ? Rb + CTXL + (size_t)(Rlo + t) * 64 : Rb + (size_t)(t - nrow) * 64; };
    u32x4 rk, rv;
    { const size_t R = tile_row(0) + kr; rk = *(const u32x4*)(PR + R * PLD + C_NK + h * 64 + kc * 8); rv = *(const u32x4*)(PR + R * PLD + C_NV + h * 64 + kc * 8); }
    __syncthreads();
    *(u32x4*)(lds + kl) = rk; *(u32x4*)(lds + vl) = rv;
    { float* sb = (float*)(lds + LBIAS); const float* bias = p->na_bias + ((size_t)l * 4 + h) * 465; if (tid < 465) sb[tid] = bias[tid] * 1.4426950408889634f; }
    __syncthreads();
    const float* sb = (const float*)(lds + LBIAS);
    const int i16 = lane & 15, blk = (lane >> 4) & 1, q4 = i16 >> 2, p4 = i16 & 3;
    const int koff = r * KP_ + 16 * h5, voff = KB + (4 * h5 + q4) * VP + 32 * blk + 8 * p4;
    for (int t = 0; t < nt; ++t) {
        const int cur = (t & 1) * STG, nxt = ((t + 1) & 1) * STG;
        const bool more = t + 1 < nt;
        if (more) { const size_t R = tile_row(t + 1) + kr; rk = *(const u32x4*)(PR + R * PLD + C_NK + h * 64 + kc * 8); rv = *(const u32x4*)(PR + R * PLD + C_NV + h * 64 + kc * 8); }
        const bool win = t < nrow; const int R = Rlo + t;
        const bool mine = !win || (R >= rs && R <= rs + 7);
        if (mine) {
#pragma unroll
            for (int sub = 0; sub < 2; ++sub) {
                f32x16 st;
#pragma unroll
                for (int i = 0; i < 16; ++i) st[i] = 0.f;
#pragma unroll
                for (int s2 = 0; s2 < 4; ++s2) {
                    const bf16x8 kf = *(const bf16x8*)(lds + cur + koff + sub * 32 * KP_ + s2 * 32);
                    st = __builtin_amdgcn_mfma_f32_32x32x16_bf16(kf, qf[s2], st, 0, 0, 0);
                }
                if (win) {
                    const int brow = (R - grow + 7) * 31 + 15 - c;
#pragma unroll
                    for (int i = 0; i < 16; ++i) {
                        const int kcol = sub * 32 + (i & 3) + 8 * (i >> 2) + 4 * h5;
                        const bool ok = kcol >= cs && kcol < cs + 16;
                        const float bv = sb[ok ? brow + kcol : 0];
                        st[i] = ok ? st[i] + bv : -INFINITY;
                    }
                }
                float mx = fmaxf(fmaxf(st[0], st[1]), fmaxf(st[2], st[3]));
#pragma unroll
                for (int i = 4; i < 16; i += 4) mx = fmaxf(mx, fmaxf(fmaxf(st[i], st[i + 1]), fmaxf(st[i + 2], st[i + 3])));
                mx = max_xor32(mx);
                const float mn = fmaxf(m, mx), alpha = __builtin_amdgcn_exp2f(m - mn);
                m = mn;
                float rsum = 0.f;
#pragma unroll
                for (int i = 0; i < 16; ++i) { st[i] = __builtin_amdgcn_exp2f(st[i] - mn); rsum += st[i]; }
                lsum = lsum * alpha + rsum;
#pragma unroll
                for (int i = 0; i < 16; ++i) { o0[i] *= alpha; o1[i] *= alpha; }
                u32x4 pw0, pw1;
                pw0.x = pack_bf16(st[0], st[1]); pw0.y = pack_bf16(st[2], st[3]); pw0.z = pack_bf16(st[4], st[5]); pw0.w = pack_bf16(st[6], st[7]);
                pw1.x = pack_bf16(st[8], st[9]); pw1.y = pack_bf16(st[10], st[11]); pw1.z = pack_bf16(st[12], st[13]); pw1.w = pack_bf16(st[14], st[15]);
                const bf16x8 pf0 = __builtin_bit_cast(bf16x8, pw0), pf1 = __builtin_bit_cast(bf16x8, pw1);
#pragma unroll
                for (int s2 = 0; s2 < 2; ++s2) {
                    const int vb = cur + voff + (sub * 32 + 16 * s2) * VP;
                    const s16x4 lo0 = __builtin_amdgcn_ds_read_tr16_b64_v4i16((LAS s16x4*)(lds + vb));
                    const s16x4 hi0 = __builtin_amdgcn_ds_read_tr16_b64_v4i16((LAS s16x4*)(lds + vb + 8 * VP));
                    const s16x4 lo1 = __builtin_amdgcn_ds_read_tr16_b64_v4i16((LAS s16x4*)(lds + vb + 64));
                    const s16x4 hi1 = __builtin_amdgcn_ds_read_tr16_b64_v4i16((LAS s16x4*)(lds + vb + 8 * VP + 64));
                    const bf16x8 vf0 = __builtin_shufflevector(lo0, hi0, 0, 1, 2, 3, 4, 5, 6, 7), vf1 = __builtin_shufflevector(lo1, hi1, 0, 1, 2, 3, 4, 5, 6, 7);
                    o0 = __builtin_amdgcn_mfma_f32_32x32x16_bf16(vf0, s2 ? pf1 : pf0, o0, 0, 0, 0);
                    o1 = __builtin_amdgcn_mfma_f32_32x32x16_bf16(vf1, s2 ? pf1 : pf0, o1, 0, 0, 0);
                }
            }
        }
        if (more) { *(u32x4*)(lds + nxt + kl) = rk; *(u32x4*)(lds + nxt + vl) = rv; }
        __syncthreads();
    }
    lsum = sum_xor32(lsum);
    const float inv = 1.f / lsum;
    bf16_t* op = ((bf16_t*)(p->ws + WS_OUTS)) + ((size_t)2 * TG + qrow) * 256 + h * 64 + 4 * h5;
#pragma unroll
    for (int g4 = 0; g4 < 4; ++g4) {
        store_bf16x4(op + 8 * g4, (f32x4){o0[4 * g4] * inv, o0[4 * g4 + 1] * inv, o0[4 * g4 + 2] * inv, o0[4 * g4 + 3] * inv});
        store_bf16x4(op + 32 + 8 * g4, (f32x4){o1[4 * g4] * inv, o1[4 * g4 + 1] * inv, o1[4 * g4 + 2] * inv, o1[4 * g4 + 3] * inv});
    }
}

__device__ __forceinline__ void ret_out_unit(KP p, int l, int bl, int h, int rb, char* lds)
{
    const int tid = get_tid(), lane = tid & 63, wid = tid >> 6, r = lane & 31, h5 = lane >> 5;
    const bf16_t* PR = (const bf16_t*)(p->ws + WS_PROJ);
    const size_t R0 = (size_t)bl * LTOK + rb * 128;
    const float lgf = log_sigmoidf(p->ret_logit[(l * 2 + 0) * 4 + h]) * 1.4426950408889634f, lgb = log_sigmoidf(p->ret_logit[(l * 2 + 1) * 4 + h]) * 1.4426950408889634f;
    char* KK = lds; char* VV = lds + 128 * RT_PT; char* SS = lds + 2 * 128 * RT_PT;
    float* YB = (float*)lds;
    __syncthreads();
#pragma unroll
    for (int q = 0; q < 2; ++q) {
        const int c = tid + 512 * q, row = c >> 3, cc = c & 7;
        const u32x4 kw = *(const u32x4*)(PR + (R0 + row) * PLD + C_RK + h * 64 + cc * 8), vw = *(const u32x4*)(PR + (R0 + row) * PLD + C_RV + h * 64 + cc * 8);
        u32x4 ok;
#pragma unroll
        for (int j = 0; j < 4; ++j) ok[j] = pack_bf16(bflo(kw[j]) * 0.125f, bfhi(kw[j]) * 0.125f);
        *(u32x4*)(KK + row * RT_PT + cc * 16) = ok; *(u32x4*)(VV + row * RT_PT + cc * 16) = vw;
    }
    {
        const int jf = rb, jb = ret_jb(rb);
#pragma unroll
        for (int q = 0; q < 2; ++q) {
            const int e = tid + 512 * q, dir = e >> 9, dk = (e >> 3) & 63, e0 = (e & 7) * 8, j = dir ? jb : jf;
            const float* src = ((float*)(p->ws + WS_RKV)) + ((((size_t)bl * 4 + h) * 2 + dir) * 34 + j) * 4096 + dk * 64 + e0;
            const f32x4 s0 = *(const f32x4*)src, s1 = *(const f32x4*)(src + 4);
            u32x4 o; o.x = pack_bf16(s0[0], s0[1]); o.y = pack_bf16(s0[2], s0[3]); o.z = pack_bf16(s1[0], s1[1]); o.w = pack_bf16(s1[2], s1[3]);
            *(u32x4*)(SS + (dir * 64 + dk) * RT_PT + e0 * 2) = o;
        }
    }
    __syncthreads();
    const int dir = wid >> 2, mt = wid & 3;
    const float lg = dir ? lgb : lgf;
    const int qi = mt * 32 + r;
    bf16x8 qf[4];
#pragma unroll
    for (int s2 = 0; s2 < 4; ++s2) qf[s2] = *(const bf16x8*)(PR + (R0 + qi) * PLD + C_RQ + h * 64 + 16 * s2 + 8 * h5);
    f32x16 o0, o1;
#pragma unroll
    for (int i = 0; i < 16; ++i) { o0[i] = 0.f; o1[i] = 0.f; }
    {
        const char* Sd = SS + dir * 64 * RT_PT;
#pragma unroll
        for (int s2 = 0; s2 < 4; ++s2) {
            const bf16x8 a0 = tr_frag_nat(Sd, RT_PT, 16 * s2, 0, lane), a1 = tr_frag_nat(Sd, RT_PT, 16 * s2, 32, lane);
            o0 = __builtin_amdgcn_mfma_f32_32x32x16_bf16(a0, qf[s2], o0, 0, 0, 0);
            o1 = __builtin_amdgcn_mfma_f32_32x32x16_bf16(a1, qf[s2], o1, 0, 0, 0);
        }
        const int pos = dir ? 127 - qi : qi;
        const float qd = __builtin_amdgcn_exp2f(lg * (float)(pos + 1));
#pragma unroll
        for (int i = 0; i < 16; ++i) { o0[i] *= qd; o1[i] *= qd; }
    }
    const int kt0 = dir ? mt : 0, kt1 = dir ? 3 : mt;
    for (int kt = kt0; kt <= kt1; ++kt) {
        f32x16 st;
#pragma unroll
        for (int i = 0; i < 16; ++i) st[i] = 0.f;
#pragma unroll
        for (int s2 = 0; s2 < 4; ++s2) {
            const bf16x8 kf = *(const bf16x8*)(KK + (kt * 32 + r) * RT_PT + s2 * 32 + 16 * h5);
            st = __builtin_amdgcn_mfma_f32_32x32x16_bf16(kf, qf[s2], st, 0, 0, 0);
        }
#pragma unroll
        for (int i = 0; i < 16; ++i) {
            const int ki = kt * 32 + (i & 3) + 8 * (i >> 2) + 4 * h5;
            const int diff = dir ? ki - qi : qi - ki;
            st[i] = diff >= 0 ? st[i] * __builtin_amdgcn_exp2f(lg * (float)diff) : 0.f;
        }
        u32x4 pw0, pw1;
        pw0.x = pack_bf16(st[0], st[1]); pw0.y = pack_bf16(st[2], st[3]); pw0.z = pack_bf16(st[4], st[5]); pw0.w = pack_bf16(st[6], st[7]);
        pw1.x = pack_bf16(st[8], st[9]); pw1.y = pack_bf16(st[10], st[11]); pw1.z = pack_bf16(st[12], st[13]); pw1.w = pack_bf16(st[14], st[15]);
        const bf16x8 pf0 = __builtin_bit_cast(bf16x8, pw0), pf1 = __builtin_bit_cast(bf16x8, pw1);
#pragma unroll
        for (int s2 = 0; s2 < 2; ++s2) {
            const bf16x8 v0 = tr_frag_acc(VV, RT_PT, kt * 32 + 16 * s2, 0, lane), v1 = tr_frag_acc(VV, RT_PT, kt * 32 + 16 * s2, 32, lane);
            o0 = __builtin_amdgcn_mfma_f32_32x32x16_bf16(v0, s2 ? pf1 : pf0, o0, 0, 0, 0);
            o1 = __builtin_amdgcn_mfma_f32_32x32x16_bf16(v1, s2 ? pf1 : pf0, o1, 0, 0, 0);
        }
    }
    float sm = 0.f;
#pragma unroll
    for (int i = 0; i < 16; ++i) sm += o0[i] + o1[i];
    sm = sum_xor32(sm);
    const float mu = sm * (1.f / 64.f);
    float vs = 0.f;
#pragma unroll
    for (int i = 0; i < 16; ++i) { const float a0 = o0[i] - mu, a1 = o1[i] - mu; vs += a0 * a0 + a1 * a1; }
    vs = sum_xor32(vs);
    const float rstd = rsqrtf(vs * (1.f / 64.f) + EPSF);
    const bf16_t* gp = PR + (R0 + qi) * PLD + (dir ? C_RGB : C_RGF) + h * 64 + 4 * h5;
    const float* gw = p->ret_gnw + l * 256 + h * 64 + 4 * h5;
    __syncthreads();
#pragma unroll
    for (int t = 0; t < 2; ++t)
#pragma unroll
        for (int g4 = 0; g4 < 4; ++g4) {
            const u32x2 gg = *(const u32x2*)(gp + 32 * t + 8 * g4); const f32x4 ww = *(const f32x4*)(gw + 32 * t + 8 * g4);
            const float g0 = bflo(gg.x), g1 = bfhi(gg.x), g2 = bflo(gg.y), g3 = bfhi(gg.y);
            f32x4 y;
            y[0] = ((t ? o1[4 * g4] : o0[4 * g4]) - mu) * rstd * ww[0] * siluf(g0);
            y[1] = ((t ? o1[4 * g4 + 1] : o0[4 * g4 + 1]) - mu) * rstd * ww[1] * siluf(g1);
            y[2] = ((t ? o1[4 * g4 + 2] : o0[4 * g4 + 2]) - mu) * rstd * ww[2] * siluf(g2);
            y[3] = ((t ? o1[4 * g4 + 3] : o0[4 * g4 + 3]) - mu) * rstd * ww[3] * siluf(g3);
            *(f32x4*)(YB + (dir * 128 + qi) * 68 + 32 * t + 8 * g4 + 4 * h5) = y;
        }
    __syncthreads();
#pragma unroll
    for (int q = 0; q < 2; ++q) {
        const int e = tid + 512 * q, row = e >> 3, c8 = (e & 7) * 8;
        const f32x4 a0 = *(const f32x4*)(YB + row * 68 + c8), a1 = *(const f32x4*)(YB + row * 68 + c8 + 4), b0 = *(const f32x4*)(YB + (128 + row) * 68 + c8), b1 = *(const f32x4*)(YB + (128 + row) * 68 + c8 + 4);
        u32x4 o; o.x = pack_bf16(a0[0] + b0[0], a0[1] + b0[1]); o.y = pack_bf16(a0[2] + b0[2], a0[3] + b0[3]); o.z = pack_bf16(a1[0] + b1[0], a1[1] + b1[1]); o.w = pack_bf16(a1[2] + b1[2], a1[3] + b1[3]);
        *(u32x4*)(((bf16_t*)(p->ws + WS_OUTS)) + ((size_t)3 * TG + R0 + row) * 256 + h * 64 + c8) = o;
    }
}

#define U_MLA (NB * 32)
#define U_GQA (NB * 32)
#define U_NA (NB * 64)
#define U_RET (NB * 136)
#define U_CTX (NB * 12)
__device__ __forceinline__ int wq_next(unsigned* counter, LAS unsigned* wq) {
    __syncthreads();
    if (get_tid() == 0) *wq = atomicAdd(counter, 1u);
    __syncthreads();
    return (int)*wq;
}
__device__ __forceinline__ void phase_p4(KP p, int l, int g, char* ldsc, int bid, int nblk)
{
    float* lds = (float*)ldsc;
    LAS unsigned* wq = (LAS unsigned*)(smem + 32);
    unsigned* counter = ((unsigned*)(p->ws + WS_CNT)) + (l * NGROUP + g) * 64 * 8;
    (void)bid; (void)nblk;
    for (;;) {
        const int u = wq_next(counter, wq); if (u >= U_MLA) break;
        const int qb = u & 7, h = (u >> 3) & 3, bl = u >> 5; const size_t Rb = (size_t)bl * LTOK, Rq = Rb + CTXL + qb * 512;
        attn_unit<96>(((bf16_t*)(p->ws + WS_QA)) + Rq * 384 + h * 96, 384, ((bf16_t*)(p->ws + WS_KA)) + Rb * 384 + h * 96, 384, ((bf16_t*)(p->ws + WS_VA)) + Rb * 256 + h * 64, 256, 512, LTOK, ((bf16_t*)(p->ws + WS_OUTS)) + ((size_t)0 * TG + Rq) * 256 + h * 64, 256, ldsc);
    }
    for (;;) {
        const int u = wq_next(counter + 64, wq); if (u >= U_GQA) break;
        const int qb = u & 7, h = (u >> 3) & 3, bl = u >> 5; const size_t Rb = (size_t)bl * LTOK, Rq = Rb + CTXL + qb * 512; const int kvh = h >> 1;
        attn_unit<64>(((bf16_t*)(p->ws + WS_GQ)) + Rq * 256 + h * 64, 256, ((bf16_t*)(p->ws + WS_GK)) + Rb * 128 + kvh * 64, 128, ((bf16_t*)(p->ws + WS_PROJ)) + Rb * PLD + C_GV + kvh * 64, PLD, 512, LTOK, ((bf16_t*)(p->ws + WS_OUTS)) + ((size_t)1 * TG + Rq) * 256 + h * 64, 256, ldsc);
    }
    for (;;) {
        const int u = wq_next(counter + 128, wq); if (u >= U_NA) break;
        na_unit(p, l, u >> 6, (u >> 4) & 3, u & 15, ldsc);
    }
    for (;;) {
        const int u = wq_next(counter + 192, wq); if (u >= U_RET) break;
        const int rb = u % 34, h = (u / 34) & 3, bl = u / 136; ret_out_unit(p, l, bl, h, rb, ldsc);
    }
    if (l == 0) {
        for (;;) {
            const int u = wq_next(counter + 256, wq); if (u >= NB * 4) break;
            const int h = u & 3, bl = u >> 2; const size_t Rb = (size_t)bl * LTOK;
            attn_unit<96>(((bf16_t*)(p->ws + WS_QA)) + Rb * 384 + h * 96, 384, ((bf16_t*)(p->ws + WS_KA)) + Rb * 384 + h * 96, 384, ((bf16_t*)(p->ws + WS_VA)) + Rb * 256 + h * 64, 256, 256, CTXL, ((bf16_t*)(p->ws + WS_OUTS)) + ((size_t)0 * TG + Rb) * 256 + h * 64, 256, ldsc);
        }
        for (;;) {
            const int u = wq_next(counter + 320, wq); if (u >= NB * 8) break;
            const int ty = u & 1, h = (u >> 1) & 3, bl = u >> 3; const size_t Rb = (size_t)bl * LTOK;
            const bf16_t* Q = ty ? ((bf16_t*)(p->ws + WS_PROJ)) + Rb * PLD + C_NQ + h * 64 : ((bf16_t*)(p->ws + WS_GQ)) + Rb * 256 + h * 64;
            const bf16_t* K = ty ? ((bf16_t*)(p->ws + WS_PROJ)) + Rb * PLD + C_NK + h * 64 : ((bf16_t*)(p->ws + WS_GK)) + Rb * 128 + (h >> 1) * 64;
            const bf16_t* V = ty ? ((bf16_t*)(p->ws + WS_PROJ)) + Rb * PLD + C_NV + h * 64 : ((bf16_t*)(p->ws + WS_PROJ)) + Rb * PLD + C_GV + (h >> 1) * 64;
            attn_unit<64>(Q, ty ? PLD : 256, K, ty ? PLD : 128, V, PLD, 256, CTXL, ((bf16_t*)(p->ws + WS_OUTS)) + ((size_t)(1 + ty) * TG + Rb) * 256 + h * 64, 256, ldsc);
        }
    }
}

template <int MI>
__device__ __forceinline__ void p5_tile(KP p, int l, char* lds, int pm, int pn, int rsub)
{
    const int tid = get_tid(), lane = tid & 63, wid = tid >> 6, wm = wid >> 1, wn = wid & 1, fr = lane & 15, fq = lane >> 4;
    const int arow = tid >> 3, akc = tid & 7, a_l = arow * G_LDP + akc * 16;
    const int aoff = (wm * 16 * MI + fr) * G_LDP + fq * 16, boff = G_ABYTES + (wn * 64 + fr) * G_LDP + fq * 16;
    const bf16_t* OUTS = (const bf16_t*)(p->ws + WS_OUTS);
    const bf16_t* WB = (const bf16_t*)(p->ws + WS_WBT) + (size_t)l * 4 * DM * 256;
    const int rbase = pm * 256 + rsub;
    {
        const bf16_t* ag = OUTS + ((size_t)rbase + arow) * 256 + akc * 8;
        const bf16_t* bg = WB + ((size_t)pn * G_BN + arow) * 256 + akc * 8;
        const unsigned char* gp = (const unsigned char*)(p->ws + WS_GATE8) + (size_t)(rbase + wm * 16 * MI + fr) * 4096 + pn * G_BN + wn * 64 + fq * 16;
        f32x4 acc[MI][4]; zero_acc<MI>(acc);
        u32x2 totp[MI][4];
#pragma unroll
        for (int mi = 0; mi < MI; ++mi)
#pragma unroll
            for (int ni = 0; ni < 4; ++ni) totp[mi][ni] = (u32x2){0u, 0u};
        u32x4 sa[2][MI], sb[2][2];
        u32x4 gwv[MI];
#define P5_LOAD(SET, KT) do { const bf16_t* a2_ = ag + (size_t)((KT) >> 2) * TG * 256 + ((KT) & 3) * 64; const bf16_t* b2_ = bg + (size_t)((KT) >> 2) * DM * 256 + ((KT) & 3) * 64; \
            _Pragma("unroll") for (int i_ = 0; i_ < MI; ++i_) sa[SET][i_] = *(const u32x4*)(a2_ + (size_t)(64 * i_) * 256); \
            _Pragma("unroll") for (int i_ = 0; i_ < 2; ++i_) sb[SET][i_] = *(const u32x4*)(b2_ + (size_t)(64 * i_) * 256); } while (0)
#define P5_STORE(SET, BO) do { \
            _Pragma("unroll") for (int i_ = 0; i_ < MI; ++i_) *(u32x4*)(lds + (BO) + a_l + i_ * 64 * G_LDP) = sa[SET][i_]; \
            _Pragma("unroll") for (int i_ = 0; i_ < 2; ++i_) *(u32x4*)(lds + (BO) + G_ABYTES + a_l + i_ * 64 * G_LDP) = sb[SET][i_]; } while (0)
        P5_LOAD(0, 0);
        __syncthreads();
        P5_STORE(0, 0);
        P5_LOAD(0, 1); P5_LOAD(1, 2);
        __syncthreads();
#pragma unroll 1
        for (int sg = 0; sg < 4; ++sg) {
#pragma unroll
            for (int q4 = 0; q4 < 4; ++q4) {
                const int par = q4 & 1, kt = 4 * sg + q4, cur = par * G_STAGE, nxt = (par ^ 1) * G_STAGE;
#pragma unroll
                for (int ks = 0; ks < 2; ++ks) {
                    bf16x8 af[MI], bfr[4];
#pragma unroll
                    for (int mi = 0; mi < MI; ++mi) af[mi] = *(const bf16x8*)(lds + cur + aoff + mi * 16 * G_LDP + ks * 64);
#pragma unroll
                    for (int ni = 0; ni < 4; ++ni) bfr[ni] = *(const bf16x8*)(lds + cur + boff + ni * 16 * G_LDP + ks * 64);
#pragma unroll
                    for (int mi = 0; mi < MI; ++mi)
#pragma unroll
                        for (int ni = 0; ni < 4; ++ni) acc[mi][ni] = __builtin_amdgcn_mfma_f32_16x16x32_bf16(bfr[ni], af[mi], acc[mi][ni], 0, 0, 0);
                }
                if (q4 == 1) {
#pragma unroll
                    for (int mi = 0; mi < MI; ++mi)
                        gwv[mi] = *(const u32x4*)(gp + (size_t)(mi * 16) * 4096 + sg * DM);
                    __builtin_amdgcn_sched_barrier(0);
                }
                P5_STORE(par, nxt);
                { const int kn = (kt + 3 < 16) ? kt + 3 : 15; P5_LOAD(par, kn); }
                __syncthreads();
                if (q4 == 3) {
                    __builtin_amdgcn_sched_barrier(0);
#pragma unroll
                    for (int mi = 0; mi < MI; ++mi)
#pragma unroll
                        for (int ni = 0; ni < 4; ++ni) {
                            const unsigned gw = gwv[mi][ni];
                            const u32x2 tp = totp[mi][ni];
                            const float t0 = fmaf((float)((gw >> 0) & 255u), acc[mi][ni][0], bflo(tp.x)), t1 = fmaf((float)((gw >> 8) & 255u), acc[mi][ni][1], bfhi(tp.x));
                            const float t2 = fmaf((float)((gw >> 16) & 255u), acc[mi][ni][2], bflo(tp.y)), t3 = fmaf((float)((gw >> 24) & 255u), acc[mi][ni][3], bfhi(tp.y));
                            totp[mi][ni] = (u32x2){pack_bf16(t0, t1), pack_bf16(t2, t3)};
                            acc[mi][ni] = (f32x4){0.f, 0.f, 0.f, 0.f};
                        }
                }
            }
        }
#undef P5_LOAD
#undef P5_STORE
#pragma unroll
        for (int mi = 0; mi < MI; ++mi)
#pragma unroll
            for (int ni = 0; ni < 4; ++ni) {
                const u32x2 tp = totp[mi][ni]; const float k255 = 1.f / 255.f;
                *(u32x2*)(((bf16_t*)(p->ws + WS_ACC)) + (size_t)(rbase + wm * 16 * MI + mi * 16 + fr) * DM + pn * G_BN + wn * 64 + ni * 16 + fq * 4) =
                    (u32x2){pack_bf16(bflo(tp.x) * k255, bfhi(tp.x) * k255), pack_bf16(bflo(tp.y) * k255, bfhi(tp.y) * k255)};
            }
    }
}

__device__ __forceinline__ void phase_p5(KP p, int l, char* lds, int bid, int nblk)
{
    constexpr int tn = DM / G_BN, total = (TG / 256) * tn, NG8 = (TG / 256) / 8;
    const bool xord = (nblk == 256) && (tn == 8) && ((TG / 256) % 8 == 0);
    if (xord) {
        constexpr int NFULL = (NG8 % 4 == 1) ? NG8 / 4 : (NG8 + 3) / 4;
#pragma unroll 1
        for (int it = 0; it < NFULL; ++it) {
            const int g8 = it * 4 + (bid >> 6); if (g8 >= NG8) break;
            p5_tile<4>(p, l, lds, g8 * 8 + (bid & 7), (bid >> 3) & 7, 0);
        }
        if (NG8 % 4 == 1) p5_tile<1>(p, l, lds, (NG8 - 1) * 8 + (bid & 7), (bid >> 3) & 7, (bid >> 6) * 64);
    } else {
        for (int t = bid; t < total; t += nblk) p5_tile<4>(p, l, lds, t / tn, t % tn, 0);
    }
}

struct EpiResid {
    KP p; int l, g, goff;
    __device__ __forceinline__ void operator()(int row, int col, f32x4 v) const {
        const int bl = row / LTOK, t = row - bl * LTOK, b = g * NB + bl;
        float* dst; const float* src; int mr;
        if (t < CTXL) { if (l != 0) return; const size_t o = ((size_t)b * CTXL + t) * DM + col; dst = ((float*)(p->ws + WS_CTXS)) + o; src = p->ctx + o; mr = 16; }
        else { const size_t o = ((size_t)b * SEQ + (t - CTXL)) * DM + col; dst = p->out + o; src = (l == 0) ? p->x + o : (const float*)dst; mr = b; }
        const f32x4 gg = *(const f32x4*)(((float*)(p->ws + WS_MOD)) + ((size_t)l * 17 + mr) * 6144 + goff + col);
        f32x4 s = *(const f32x4*)src;
#pragma unroll
        for (int j = 0; j < 4; ++j) s[j] += gg[j] * v[j];
        *(f32x4*)dst = s;
    }
};

__device__ __forceinline__ void grid_barrier();
#if MK_ONE_LAUNCH
#define P9_GRID_SYNC() grid_barrier()
#else
#define P9_GRID_SYNC() __syncthreads()
#endif
typedef __bf16 bf16pair __attribute__((ext_vector_type(2)));
__device__ __forceinline__ float dot2bf(unsigned a, unsigned b, float c) { return __builtin_amdgcn_fdot2_f32_bf16(__builtin_bit_cast(bf16pair, a), __builtin_bit_cast(bf16pair, b), c, false); }
__device__ __forceinline__ unsigned f2ord(float f) { const unsigned b = __float_as_uint(f); return b ^ ((unsigned)((int)b >> 31) | 0x80000000u); }
__device__ __forceinline__ int mbcnt64(unsigned long long m) { return (int)__builtin_amdgcn_mbcnt_hi((unsigned)(m >> 32), __builtin_amdgcn_mbcnt_lo((unsigned)m, 0u)); }

__device__ __forceinline__ float ord2f(unsigned u) { return __uint_as_float((u & 0x80000000u) ? (u ^ 0x80000000u) : ~u); }

__device__ __forceinline__ void cx_desc(unsigned& a, unsigned& b) { const unsigned hi = a > b ? a : b, lo = a > b ? b : a; a = hi; b = lo; }
template <int N, int OFF, bool DESC, int M>
__device__ __forceinline__ void bitonic_sort(unsigned (&a)[M]) {
#pragma unroll
    for (int k = 2; k <= N; k <<= 1)
#pragma unroll
        for (int j = k >> 1; j > 0; j >>= 1)
#pragma unroll
            for (int i = 0; i < N; ++i) {
                const int l = i ^ j;
                if (l > i) { const bool up = ((i & k) == 0) != DESC; if (up) cx_desc(a[OFF + l], a[OFF + i]); else cx_desc(a[OFF + i], a[OFF + l]); }
            }
}
__device__ __forceinline__ void bitonic_merge16_desc(unsigned (&a)[16]) {
#pragma unroll
    for (int j = 8; j > 0; j >>= 1)
#pragma unroll
        for (int i = 0; i < 16; ++i) { const int l = i ^ j; if (l > i) cx_desc(a[i], a[l]); }
}
template <int XM>
__device__ __forceinline__ void merge_partner16(unsigned (&a)[16], bool upper) {
    unsigned b[16];
#pragma unroll
    for (int i = 0; i < 16; ++i) b[i] = (XM == 32) ? get_xor32_u(a[15 - i], upper) : xor_swz_u<XM & 31>(a[15 - i]);
#pragma unroll
    for (int i = 0; i < 16; ++i) a[i] = a[i] > b[i] ? a[i] : b[i];
    bitonic_merge16_desc(a);
}

#define P9_KEYP 144
#define P9_NTOK 136
#define P9_HG 3
#define P9_LKEY 0
#define P9_LIDX (P9_HG * 2 * 128 * P9_KEYP)
#define P9_LSTASH 0
__device__ __forceinline__ constexpr int p9_pair_i(int pi) {
    return pi < 16 ? 0 : pi < 24 ? 1 : pi < 29 ? 2 : pi < 33 ? 3 : pi < 36 ? 4 : pi < 38 ? 5 : pi < 40 ? 6 : pi < 42 ? 7 : pi < 50 ? pi - 34 : 0;
}
__device__ __forceinline__ constexpr int p9_pair_j(int pi) {
    return pi < 16 ? pi : pi < 24 ? pi - 16 : pi < 29 ? pi - 24 : pi < 33 ? pi - 29 : pi < 36 ? pi - 33 : pi < 38 ? pi - 36 : pi < 40 ? pi - 38 : pi < 42 ? pi - 40 : 0;
}
__device__ __forceinline__ void phase_p9(KP p, int l, int g, char* lds, int bid, int nblk)
{
    const int tid = get_tid(), wid = tid >> 6;
    const bf16_t* KEYB = (const bf16_t*)(p->ws + WS_KEYB) + (size_t)l * 8 * 2 * 128 * 64;
    const bf16_t* PQ = (const bf16_t*)(p->ws + WS_PQ);
    unsigned* stash = (unsigned*)(lds + P9_LSTASH);
    const int nit = (TG / P9_NTOK + nblk - 1) / nblk;
    for (int it = 0; it < nit; ++it) {
        const int blk = bid + it * nblk;
        if (blk >= TG / P9_NTOK) { P9_GRID_SYNC(); P9_GRID_SYNC(); continue; }
        const int row0 = blk * P9_NTOK;
        unsigned* gst = (unsigned*)(p->ws + WS_PROJ) + (size_t)row0 * 128;
#pragma unroll 1
        for (int h0 = 0; h0 < 8; h0 += P9_HG) {
            const int nh = (8 - h0) < P9_HG ? (8 - h0) : P9_HG;
            __syncthreads();
            for (int c = tid; c < nh * 2048; c += NTHREADS) { const int row = c >> 3, cc = c & 7;
                *(u32x4*)(lds + P9_LKEY + row * P9_KEYP + cc * 16) = *(const u32x4*)(KEYB + ((size_t)h0 * 256 + row) * 64 + cc * 8); }
            __syncthreads();
#pragma unroll 1
            for (int item = wid; item < 9 * nh; item += 8) {
                const int tile = item % 9, hh = item / 9, h = h0 + hh;
                const int LK = P9_LKEY + hh * 256 * P9_KEYP;
                const int tidh = get_tid(), tk = tidh & 15, qd = (tidh >> 4) & 3;
                const int ntile = (P9_NTOK - 16 * tile) < 16 ? (P9_NTOK - 16 * tile) : 16;
                const int trow = row0 + 16 * tile + (tk < ntile ? tk : ntile - 1);
                unsigned* idxl = (unsigned*)(lds + P9_LIDX) + (wid * 16 + tk) * 33;
                unsigned top[2][16];
#pragma unroll
                for (int pp = 0; pp < 2; ++pp) {
                    f32x4 acc[8];
#pragma unroll
                    for (int t = 0; t < 8; ++t) acc[t] = (f32x4){0.f, 0.f, 0.f, 0.f};
#pragma unroll
                    for (int ks = 0; ks < 2; ++ks) {
                        const bf16x8 qfr = *(const bf16x8*)(PQ + (size_t)trow * DM + h * 128 + pp * 64 + ks * 32 + qd * 8);
#pragma unroll
                        for (int t = 0; t < 8; ++t) {
                            const bf16x8 kfr = *(const bf16x8*)(lds + LK + (pp * 128 + t * 16 + tk) * P9_KEYP + ks * 64 + qd * 16);
                            acc[t] = __builtin_amdgcn_mfma_f32_16x16x32_bf16(kfr, qfr, acc[t], 0, 0, 0);
                        }
                    }
                    unsigned ck[32];
#pragma unroll
                    for (int t = 0; t < 8; ++t)
#pragma unroll
                        for (int jj = 0; jj < 4; ++jj) ck[t * 4 + jj] = (f2ord(acc[t][jj]) & 0xFFFFFF80u) | (unsigned)(16 * t + jj) | ((unsigned)qd << 2);
                    bitonic_sort<16, 0, true>(ck);
                    bitonic_sort<16, 16, false>(ck);
                    unsigned (&tp)[16] = top[pp];
#pragma unroll
                    for (int i = 0; i < 16; ++i) tp[i] = ck[i] > ck[16 + i] ? ck[i] : ck[16 + i];
                    bitonic_merge16_desc(tp);
                    merge_partner16<16>(tp, false); merge_partner16<32>(tp, (qd & 2) != 0);
                    if (qd == 0) {
#pragma unroll
                        for (int i = 0; i < 16; ++i) idxl[pp * 16 + i] = tp[i] & 127u;
                    }
                }
                float v1[16], v2[16];
#pragma unroll
                for (int i = 0; i < 16; ++i) { v1[i] = ord2f(top[0][i] & 0xFFFFFF80u); v2[i] = ord2f(top[1][i] & 0xFFFFFF80u); }
                unsigned cand[16];
#pragma unroll
                for (int n = 0; n < 13; ++n) {
                    const unsigned k0 = (f2ord(v1[p9_pair_i(4 * n)] + v2[p9_pair_j(4 * n)]) & 0xFFFFFF00u) | (unsigned)(p9_pair_i(4 * n) * 16 + p9_pair_j(4 * n));
                    const unsigned k1 = (f2ord(v1[p9_pair_i(4 * n + 1)] + v2[p9_pair_j(4 * n + 1)]) & 0xFFFFFF00u) | (unsigned)(p9_pair_i(4 * n + 1) * 16 + p9_pair_j(4 * n + 1));
                    const unsigned k2 = (4 * n + 2 < 50) ? ((f2ord(v1[p9_pair_i(4 * n + 2)] + v2[p9_pair_j(4 * n + 2)]) & 0xFFFFFF00u) | (unsigned)(p9_pair_i(4 * n + 2) * 16 + p9_pair_j(4 * n + 2))) : 0u;
                    const unsigned k3 = (4 * n + 3 < 50) ? ((f2ord(v1[p9_pair_i(4 * n + 3)] + v2[p9_pair_j(4 * n + 3)]) & 0xFFFFFF00u) | (unsigned)(p9_pair_i(4 * n + 3) * 16 + p9_pair_j(4 * n + 3))) : 0u;
                    cand[n] = qd == 0 ? k0 : (qd == 1 ? k1 : (qd == 2 ? k2 : k3));
                }
                cand[13] = 0u; cand[14] = 0u; cand[15] = 0u;
                bitonic_sort<16, 0, true>(cand);
                merge_partner16<16>(cand, false); merge_partner16<32>(cand, (qd & 2) != 0);
                const float mx = ord2f(cand[0] & 0xFFFFFF00u);
                float ex[16], den = 0.f;
#pragma unroll
                for (int k = 0; k < 16; ++k) { ex[k] = __expf(ord2f(cand[k] & 0xFFFFFF00u) - mx); den += ex[k]; }
                const float inv = 1.f / den;
                if (qd == 0 && tk < ntile) {
#pragma unroll
                    for (int k = 0; k < 16; ++k) {
                        const unsigned e = idxl[(cand[k] >> 4) & 15u] * 128u + idxl[16 + (cand[k] & 15u)];
                        gst[((16 * tile + tk) * 8 + h) * 16 + k] = (e << 16) | (unsigned)f2bf(ex[k] * inv);
                    }
                }
            }
        }
        P9_GRID_SYNC();
        {
            const u32x4* src = (const u32x4*)gst; u32x4* dstl = (u32x4*)(lds + P9_LSTASH);
            for (int c = get_tid(); c < P9_NTOK * 128 / 4; c += NTHREADS) dstl[c] = src[c];
            __syncthreads();
        }
        {
            const int tid2 = get_tid(), lane = tid2 & 63, wid2 = tid2 >> 6;
            KP p2 = get_kp();
            const unsigned char* UB = (const unsigned char*)(p2->ws + WS_UB) + (size_t)l * 16384 * (DM / 2);
            const float* USC = (const float*)(p2->ws + WS_USC) + (size_t)l * 16384; const float* VSC = (const float*)(p2->ws + WS_VSC) + (size_t)l * 16384;
            const bf16_t* Hh = HG(p2, g);
#pragma unroll 1
            for (int slot = wid2; slot < P9_NTOK; slot += 8) {
                const int r = row0 + slot;
                if ((r % LTOK) < CTXL && l != 0) continue;
                const u32x4 x0 = *(const u32x4*)(Hh + (size_t)r * DM + lane * 16), x1 = *(const u32x4*)(Hh + (size_t)r * DM + lane * 16 + 8);
#pragma unroll 1
                for (int h = 0; h < 8; ++h) {
                    unsigned* st = stash + (slot * 8 + h) * 16;
                    float d[16];
                    const int kk = (lane >> 2) & 15;
                    const unsigned sk = st[kk];
                    const float su = USC[sk >> 16], svs = VSC[sk >> 16];
                    {
                        u32x2 ua[16];
#pragma unroll
                        for (int k = 0; k < 16; ++k) ua[k] = *(const u32x2*)(UB + (size_t)(st[k] >> 16) * (DM / 2) + lane * 8);
#pragma unroll
                        for (int k = 0; k < 16; ++k) {
                            float a = 0.f;
#define P9_UDOT(XW, UW, B) { const unsigned xw_ = (XW); a = __builtin_amdgcn_fdot2_f32_bf16(__builtin_bit_cast(bf16pair, xw_), __builtin_amdgcn_cvt_scalef32_pk_bf16_fp4((UW), 1.0f, B), a, false); }
                            { const unsigned u0_ = ua[k].x, u1_ = ua[k].y;
                              P9_UDOT(x0.x, u0_, 0) P9_UDOT(x0.y, u0_, 1) P9_UDOT(x0.z, u0_, 2) P9_UDOT(x0.w, u0_, 3)
                              P9_UDOT(x1.x, u1_, 0) P9_UDOT(x1.y, u1_, 1) P9_UDOT(x1.z, u1_, 2) P9_UDOT(x1.w, u1_, 3) }
#undef P9_UDOT
                            d[k] = a;
                        }
                    }
                    float r8[8], r4[4], r2[2], r1;
#pragma unroll
                    for (int i = 0; i < 8; ++i) { const u32x2 sw = __builtin_amdgcn_permlane32_swap(__float_as_uint(d[i]), __float_as_uint(d[i + 8]), false, false); r8[i] = __uint_as_float(sw.x) + __uint_as_float(sw.y); }
#pragma unroll
                    for (int i = 0; i < 4; ++i) { const u32x2 sw = __builtin_amdgcn_permlane16_swap(__float_as_uint(r8[i]), __float_as_uint(r8[i + 4]), false, false); r4[i] = __uint_as_float(sw.x) + __uint_as_float(sw.y); }
                    { const bool bb = (lane & 8) != 0;
#pragma unroll
                      for (int i = 0; i < 2; ++i) { const float snd = bb ? r4[i] : r4[i + 2], keep = bb ? r4[i + 2] : r4[i]; r2[i] = keep + xor_swz<8>(snd); } }
                    { const bool bb = (lane & 4) != 0; const float snd = bb ? r2[0] : r2[1], keep = bb ? r2[1] : r2[0]; r1 = keep + xor_swz<4>(snd); }
                    r1 += xor_swz<2>(r1); r1 += xor_swz<1>(r1);
                    r1 *= su;
                    const float cf = bflo(sk) * 0.5f * r1 * (1.f + erff(r1 * 0.70710678118654752f)) * svs;
                    if ((lane & 3) == 0) st[kk] = (sk & 0xffff0000u) | (unsigned)f2bf(cf);
                }
            }
        }
        P9_GRID_SYNC();
        {
            const int tid2 = get_tid(), lane = tid2 & 63, wid2 = tid2 >> 6;
            KP p2 = get_kp();
            const unsigned char* VB = (const unsigned char*)(p2->ws + WS_VB) + (size_t)l * 16384 * (DM / 2);
#pragma unroll 1
            for (int slot = wid2; slot < P9_NTOK; slot += 8) {
                const int r = row0 + slot;
                const int bl = r / LTOK, t = r - bl * LTOK, b = g * NB + bl;
                if (t < CTXL && l != 0) continue;
                float* dst; int mr;
                if (t < CTXL) { dst = ((float*)(p2->ws + WS_CTXS)) + ((size_t)b * CTXL + t) * DM; mr = 16; } else { dst = p2->out + ((size_t)b * SEQ + (t - CTXL)) * DM; mr = b; }
                const float* g2 = ((float*)(p2->ws + WS_MOD)) + ((size_t)l * 17 + mr) * 6144 + 5120;
                f32x4 sv[4];
#pragma unroll
                for (int i = 0; i < 4; ++i) sv[i] = *(const f32x4*)(dst + lane * 16 + i * 4);
                float outv[16];
#pragma unroll
                for (int i = 0; i < 16; ++i) outv[i] = 0.f;
#pragma unroll 1
                for (int h = 0; h < 8; ++h) {
                    const unsigned* st = stash + (slot * 8 + h) * 16;
                    u32x2 va[16]; unsigned sk[16];
#pragma unroll
                    for (int k = 0; k < 16; ++k) { sk[k] = st[k]; va[k] = *(const u32x2*)(VB + (size_t)(sk[k] >> 16) * (DM / 2) + lane * 8); }
#pragma unroll
                    for (int k = 0; k < 16; ++k) {
                        const float ck = bflo(sk[k]);
#define P9_VFMA(W, B) { const f32x2 t_ = __builtin_amdgcn_cvt_scalef32_pk_f32_fp4(va[k][W], 1.0f, B); outv[8 * (W) + 2 * (B)] += ck * t_.x; outv[8 * (W) + 2 * (B) + 1] += ck * t_.y; }
                        P9_VFMA(0, 0) P9_VFMA(0, 1) P9_VFMA(0, 2) P9_VFMA(0, 3) P9_VFMA(1, 0) P9_VFMA(1, 1) P9_VFMA(1, 2) P9_VFMA(1, 3)
#undef P9_VFMA
                        if ((k & 3) == 3) __builtin_amdgcn_sched_barrier(0);
                    }
                }
                const int lane = get_tid() & 63;
                float ss = 0.f;
#pragma unroll
                for (int i = 0; i < 4; ++i) {
                    const f32x4 gg = *(const f32x4*)(g2 + lane * 16 + i * 4);
#pragma unroll
                    for (int jj = 0; jj < 4; ++jj) { sv[i][jj] += gg[jj] * outv[i * 4 + jj]; ss += sv[i][jj] * sv[i][jj]; }
                }
                if (l == 0) {
                    const float rstd0 = rsqrtf(wave_sum(ss) * (1.f / DM) + EPSF);
                    const float* md1 = ((float*)(p2->ws + WS_MOD)) + ((size_t)17 + mr) * 6144;
                    bf16_t* hrow = HG(p2, g) + (size_t)r * DM + lane * 16;
#pragma unroll
                    for (int i = 0; i < 4; ++i) {
                        const int c = lane * 16 + i * 4;
                        const f32x4 w1 = *(const f32x4*)(p2->norm1_w + DM + c), sc = *(const f32x4*)(md1 + 1024 + c), sh = *(const f32x4*)(md1 + c);
                        f32x4 y;
#pragma unroll
                        for (int jj = 0; jj < 4; ++jj) y[jj] = sv[i][jj] * rstd0 * w1[jj] * (1.f + sc[jj]) + sh[jj];
                        store_bf16x4(hrow + i * 4, y);
                    }
                }
                if (l == 1) {
                    ss = wave_sum(ss);
                    const float rstd = rsqrtf(ss * (1.f / DM) + EPSF);
#pragma unroll
                    for (int i = 0; i < 4; ++i) { const f32x4 fw = *(const f32x4*)(p2->final_w + lane * 16 + i * 4);
#pragma unroll
                        for (int jj = 0; jj < 4; ++jj) sv[i][jj] *= rstd * fw[jj]; }
                }
#pragma unroll
                for (int i = 0; i < 4; ++i) *(f32x4*)(dst + lane * 16 + i * 4) = sv[i];
            }
        }
    }
}

__device__ __forceinline__ void phase_final(KP p, int bid, int nblk)
{
    const int lane = get_tid() & 63, wid = get_tid() >> 6;
    for (int r = bid * 8 + wid; r < NBATCH * SEQ; r += nblk * 8) {
        float* src = p->out + (size_t)r * DM;
        f32x4 v[4]; float ss = 0.f;
#pragma unroll
        for (int i = 0; i < 4; ++i) { v[i] = *(const f32x4*)(src + i * 256 + lane * 4); ss += v[i][0] * v[i][0] + v[i][1] * v[i][1] + v[i][2] * v[i][2] + v[i][3] * v[i][3]; }
        ss = wave_sum(ss);
        const float rstd = rsqrtf(ss * (1.f / DM) + EPSF);
#pragma unroll
        for (int i = 0; i < 4; ++i) {
            const f32x4 w = *(const f32x4*)(p->final_w + i * 256 + lane * 4);
            f32x4 y;
#pragma unroll
            for (int j = 0; j < 4; ++j) y[j] = v[i][j] * rstd * w[j];
            *(f32x4*)(src + i * 256 + lane * 4) = y;
        }
    }
}

template <int PH>
__device__ __forceinline__ void run_phase(KP p, int l, int g, char* lds, int bid, int nblk)
{
    asm volatile("" : "+s"(l), "+s"(g), "+s"(bid), "+s"(nblk));
    if constexpr (PH == 0) phase_prologue(p, lds, bid, nblk);
    if constexpr (PH == 1) { for (int gg = 0; gg < NGROUP; ++gg) phase_norm(p, 0, gg, 0, bid, nblk); }
    if constexpr (PH == 2) big_gemm(HG(p, g), ((bf16_t*)(p->ws + WS_WINT)) + (size_t)l * NPROJ * DM, TG, NPROJ, DM, Epi8<EpiProj8>{EpiProj8{((bf16_t*)(p->ws + WS_PROJ)), (unsigned char*)(p->ws + WS_GATE8)}}, lds, bid, nblk);
    if constexpr (PH == 3) phase_p3a(p, l, bid, nblk, lds);
    if constexpr (PH == 4) phase_p3b(p, l, bid, nblk);
    if constexpr (PH == 6) phase_p4(p, l, g, lds, bid, nblk);
    if constexpr (PH == 7) phase_p5(p, l, lds, bid, nblk);
    if constexpr (PH == 8) big_gemm_tail(((bf16_t*)(p->ws + WS_ACC)), ((bf16_t*)(p->ws + WS_WOUTT)) + (size_t)l * DM * DM, TG, DM, Epi4<EpiResid>{EpiResid{p, l, g, 2048}}, EpiResid{p, l, g, 2048}, lds, bid, nblk);
    if constexpr (PH == 9) phase_norm(p, l, g, 1, bid, nblk);
    if constexpr (PH == 10) big_gemm_tail(HG(p, g), ((bf16_t*)(p->ws + WS_WQT)) + (size_t)l * DM * DM, TG, DM, Epi8<EpiStore8>{EpiStore8{((bf16_t*)(p->ws + WS_PQ)), DM}}, EpiStore{((bf16_t*)(p->ws + WS_PQ)), DM}, lds, bid, nblk);
    if constexpr (PH == 11) phase_p9(p, l, g, lds, bid, nblk);
    if constexpr (PH == 12) phase_final(p, bid, nblk);
}


__device__ __forceinline__ void grid_barrier() {
    XcdBarrier b; b.bar = (unsigned*)(get_kp()->ws + WS_BAR); b.x = xb_xcc_id(); b.st = (volatile LAS unsigned*)smem;
    xcd_barrier(b);
}

template <int PH>
__global__ void __launch_bounds__(NTHREADS, 2) k_phase(Params p_unused, int l, int g)
{
    (void)p_unused;
    tid_setup();
    run_phase<PH>(get_kp(), l, g, smem + 512, blockIdx.x, gridDim.x);
}

#if MK_ONE_LAUNCH
__global__ void __launch_bounds__(NTHREADS, 2) k_mega(Params p_unused)
{
    (void)p_unused;
    tid_setup();
    if (get_tid() == 0) *(uint4*)smem = make_uint4(0u, 0u, 0u, 0u);
    __syncthreads();
    (void)xcd_barrier_post((unsigned*)(get_kp()->ws + WS_BAR), (volatile LAS unsigned*)smem);
    char* lds = smem + 512;
    const int bid = blockIdx.x, nblk = gridDim.x;
    run_phase<0>(get_kp(), 0, 0, lds, bid, nblk);
    grid_barrier();
#define MK_LG(L_, G_) do { \
        run_phase<2>(get_kp(), L_, G_, lds, bid, nblk); grid_barrier(); \
        run_phase<3>(get_kp(), L_, G_, lds, bid, nblk); grid_barrier(); \
        run_phase<4>(get_kp(), L_, G_, lds, bid, nblk); grid_barrier(); \
        run_phase<6>(get_kp(), L_, G_, lds, bid, nblk); grid_barrier(); \
        run_phase<7>(get_kp(), L_, G_, lds, bid, nblk); grid_barrier(); \
        run_phase<8>(get_kp(), L_, G_, lds, bid, nblk); grid_barrier(); \
        run_phase<9>(get_kp(), L_, G_, lds, bid, nblk); grid_barrier(); \
        run_phase<10>(get_kp(), L_, G_, lds, bid, nblk); grid_barrier(); \
        run_phase<11>(get_kp(), L_, G_, lds, bid, nblk); grid_barrier(); } while (0)
    run_phase<1>(get_kp(), 0, 0, lds, bid, nblk); grid_barrier();
    static_assert(NGROUP == 2, "phase program written out for two groups");
    MK_LG(0, 0); MK_LG(0, 1); MK_LG(1, 0); MK_LG(1, 1);
#undef MK_LG
}
#endif

static inline size_t al256(size_t x) { return (x + 255) & ~(size_t)255; }

template <int PH>
static void launch_phase(const Params& p, int l, int g, int grid, hipStream_t s)
{
    static bool attr = false;
    if (!attr) { (void)hipFuncSetAttribute((const void*)k_phase<PH>, hipFuncAttributeMaxDynamicSharedMemorySize, LDS_BYTES); attr = true; }
    hipLaunchKernelGGL(k_phase<PH>, dim3(grid), dim3(NTHREADS), LDS_BYTES, s, p, l, g);
}

extern "C" void kernel_launch(void* const* d_in, const int* in_sizes, int n_in, void* d_out, int out_size, void* d_ws, size_t ws_size, hipStream_t stream)
{
    (void)in_sizes; (void)n_in; (void)out_size;
    Params p{};
    p.x = (const float*)d_in[0]; p.c = (const float*)d_in[1]; p.ctx = (const float*)d_in[2]; p.c_ctx = (const float*)d_in[3];
    p.mod_w = (const float*)d_in[4]; p.mod_b = (const float*)d_in[5]; p.norm1_w = (const float*)d_in[6]; p.norm2_w = (const float*)d_in[7];
    p.w_in = (const float*)d_in[8]; p.mla_qn = (const float*)d_in[9]; p.mla_wuq = (const float*)d_in[10]; p.mla_kvn = (const float*)d_in[11];
    p.mla_wukv = (const float*)d_in[12]; p.gqa_qn = (const float*)d_in[13]; p.gqa_kn = (const float*)d_in[14]; p.na_bias = (const float*)d_in[15];
    p.ret_logit = (const float*)d_in[16]; p.ret_gnw = (const float*)d_in[17]; p.w_branch = (const float*)d_in[18]; p.w_out = (const float*)d_in[19];
    p.peer_wq = (const float*)d_in[20]; p.peer_keys = (const float*)d_in[21]; p.peer_u = (const float*)d_in[22]; p.peer_v = (const float*)d_in[23];
    p.final_w = (const float*)d_in[24];
    p.out = (float*)d_out;
    p.ws = (char*)d_ws;
    if (WS_TOTAL > ws_size) { fprintf(stderr, "workspace too small: need %zu have %zu\n", (size_t)WS_TOTAL, ws_size); return; }
    (void)hipMemsetAsync(d_ws, 0, WS_ZERO_END, stream);

    static int ncu = 0;
    if (!ncu) { int dev = 0; (void)hipGetDevice(&dev); (void)hipDeviceGetAttribute(&ncu, hipDeviceAttributeMultiprocessorCount, dev); if (ncu <= 0) ncu = 256; }
#if MK_ONE_LAUNCH
    static bool attr = false;
    if (!attr) { (void)hipFuncSetAttribute((const void*)k_mega, hipFuncAttributeMaxDynamicSharedMemorySize, LDS_BYTES); attr = true; }
    hipLaunchKernelGGL(k_mega, dim3(ncu), dim3(NTHREADS), LDS_BYTES, stream, p);
#else
    const int grid = ncu;
    launch_phase<0>(p, 0, 0, grid, stream);
    for (int l = 0; l < 2; ++l)
        for (int g = 0; g < NGROUP; ++g) {
            if (l == 0 && g == 0) launch_phase<1>(p, l, g, grid, stream);
            launch_phase<2>(p, l, g, grid, stream);
            launch_phase<3>(p, l, g, grid, stream);
            launch_phase<4>(p, l, g, grid, stream);
            launch_phase<6>(p, l, g, grid, stream);
            launch_phase<7>(p, l, g, grid, stream);
            launch_phase<8>(p, l, g, grid, stream);
            launch_phase<9>(p, l, g, grid, stream);
            launch_phase<10>(p, l, g, grid, stream);
            launch_phase<11>(p, l, g, grid, stream);
        }
#endif
}
```

```cpp
#include <hip/hip_runtime.h>
#include <stdint.h>
#include <stdio.h>

#ifndef MK_ONE_LAUNCH
#define MK_ONE_LAUNCH 1
#endif

#define DM 1024
#define NBATCH 16
#define SEQ 4096
#define CTXL 256
#define LTOK 4352
#define IN_COLS 7072
#define NPROJ 7168
#define PLD 3072
#define NB 8
#define NGROUP (NBATCH / NB)
#define TG (NB * LTOK)
#define NTHREADS 512
#define LDS_BYTES 131648
#define EPSF 1e-6f

#define C_CQ 0
#define C_CKV 256
#define C_KPE 384
#define C_GQ 416
#define C_GK 672
#define C_GV 800
#define C_NQ 928
#define C_NK 1184
#define C_NV 1440
#define C_RQ 1696
#define C_RK 1952
#define C_RV 2208
#define C_RGF 2464
#define C_RGB 2720
#define C_GATE 2976

#define LAS __attribute__((address_space(3)))
typedef unsigned short bf16_t;
typedef short bf16x8 __attribute__((ext_vector_type(8)));
typedef float f32x4 __attribute__((ext_vector_type(4)));
typedef float f32x2 __attribute__((ext_vector_type(2)));
typedef __bf16 bf16x2_t __attribute__((ext_vector_type(2)));
typedef unsigned u32x4 __attribute__((ext_vector_type(4)));
typedef unsigned u32x2 __attribute__((ext_vector_type(2)));
typedef float f32x16 __attribute__((ext_vector_type(16)));
typedef short s16x4 __attribute__((ext_vector_type(4)));

__device__ __forceinline__ unsigned pack_bf16(float lo, float hi) { f32x2 v = {lo, hi}; bf16x2_t b = __builtin_convertvector(v, bf16x2_t); return __builtin_bit_cast(unsigned, b); }
__device__ __forceinline__ bf16_t f2bf(float f) { return (bf16_t)(pack_bf16(f, 0.f) & 0xffffu); }
__device__ __forceinline__ float bf2f(bf16_t b) { return __uint_as_float(((unsigned)b) << 16); }
__device__ __forceinline__ float bflo(unsigned w) { return __uint_as_float(w << 16); }
__device__ __forceinline__ float bfhi(unsigned w) { return __uint_as_float(w & 0xffff0000u); }
#define PEER_USCALE 128.f
#define PEER_VSCALE 16.f
__device__ __forceinline__ float clamp448(float x) { return fminf(fmaxf(x, -448.f), 448.f); }
__device__ __forceinline__ unsigned pack_fp8x4(f32x4 v, float sc) {
    int w = 0;
    w = __builtin_amdgcn_cvt_pk_fp8_f32(clamp448(v[0] * sc), clamp448(v[1] * sc), w, false);
    w = __builtin_amdgcn_cvt_pk_fp8_f32(clamp448(v[2] * sc), clamp448(v[3] * sc), w, true);
    return (unsigned)w;
}

template <int M> __device__ __forceinline__ float xor_swz(float v) { return __int_as_float(__builtin_amdgcn_ds_swizzle(__float_as_int(v), (M << 10) | 0x1f)); }
template <int M> __device__ __forceinline__ unsigned xor_swz_u(unsigned v) { return (unsigned)__builtin_amdgcn_ds_swizzle((int)v, (M << 10) | 0x1f); }
__device__ __forceinline__ float sum_xor32(float v) { const u32x2 r = __builtin_amdgcn_permlane32_swap(__float_as_uint(v), __float_as_uint(v), false, false); return __uint_as_float(r.x) + __uint_as_float(r.y); }
__device__ __forceinline__ float max_xor32(float v) { const u32x2 r = __builtin_amdgcn_permlane32_swap(__float_as_uint(v), __float_as_uint(v), false, false); return fmaxf(__uint_as_float(r.x), __uint_as_float(r.y)); }
__device__ __forceinline__ unsigned get_xor32_u(unsigned v, bool upper) { const u32x2 r = __builtin_amdgcn_permlane32_swap(v, v, false, false); return upper ? r.x : r.y; }
__device__ __forceinline__ float wave_max(float v) {
    v = fmaxf(v, xor_swz<1>(v)); v = fmaxf(v, xor_swz<2>(v)); v = fmaxf(v, xor_swz<4>(v)); v = fmaxf(v, xor_swz<8>(v)); v = fmaxf(v, xor_swz<16>(v));
    return max_xor32(v);
}
__device__ __forceinline__ float wave_sum(float v) {
    v += xor_swz<1>(v); v += xor_swz<2>(v); v += xor_swz<4>(v); v += xor_swz<8>(v); v += xor_swz<16>(v);
    return sum_xor32(v);
}
extern __shared__ __attribute__((aligned(16))) char smem[];
#define WIDTAB_OFF 64
__device__ __forceinline__ unsigned hw_wave_slot() { return (unsigned)__builtin_amdgcn_s_getreg((5 << 11) | 4) & 63u; }
__device__ __forceinline__ void tid_setup() {
    if ((threadIdx.x & 63) == 0) ((volatile LAS int*)(smem + WIDTAB_OFF))[hw_wave_slot()] = (int)(threadIdx.x >> 6);
    __syncthreads();
}
__device__ __forceinline__ int get_tid() {
    int lane; asm volatile("v_mbcnt_lo_u32_b32 %0, -1, 0\n\tv_mbcnt_hi_u32_b32 %0, -1, %0" : "=v"(lane));
    int w = ((volatile LAS int*)(smem + WIDTAB_OFF))[hw_wave_slot()];
    w = __builtin_amdgcn_readfirstlane(w);
    int t = (w << 6) | lane; asm volatile("" : "+v"(t)); return t;
}
__device__ __forceinline__ float siluf(float x) { return x * __builtin_amdgcn_rcpf(1.f + __builtin_amdgcn_exp2f(x * -1.4426950408889634f)); }
__device__ __forceinline__ float sigmf(float x) { return __builtin_amdgcn_rcpf(1.f + __builtin_amdgcn_exp2f(x * -1.4426950408889634f)); }

#define XB_TMO      128
#define XB_XCNT(j)  (256  + 64 * (j))
#define XB_XSUB(j)  (1280 + 64 * (j))
#define XB_XGEN(j)  (2304 + 64 * (j))
#define XB_TOP      3328
#define XB_TOPGEN   3392
#define XCD_BAR_WORDS 3456
#define XB_SPIN_CAP (1u << 18)

__device__ __forceinline__ unsigned xb_ld(unsigned* p)              { return __hip_atomic_load(p, __ATOMIC_RELAXED, __HIP_MEMORY_SCOPE_AGENT); }
__device__ __forceinline__ unsigned xb_add(unsigned* p, unsigned v) { return __hip_atomic_fetch_add(p, v, __ATOMIC_RELAXED, __HIP_MEMORY_SCOPE_AGENT); }
__device__ __forceinline__ unsigned xb_xcc_id() { return (unsigned)__builtin_amdgcn_s_getreg((3 << 11) | 20) & 0xFu; }
#define XB_SPIN(cond, bar) do { unsigned _sp = 0; while (cond) { __builtin_amdgcn_s_sleep(1); \
    if ((++_sp & 255u) == 0u) { if (xb_ld(&(bar)[XB_TMO])) break; if (_sp > XB_SPIN_CAP) { atomicAdd(&(bar)[XB_TMO], 1u); break; } } } } while (0)

struct XcdBarrier { unsigned* bar; unsigned x; volatile LAS unsigned* st; };

__device__ __forceinline__ XcdBarrier xcd_barrier_post(unsigned* bar, volatile LAS unsigned* st) {
    XcdBarrier b; b.bar = bar; b.x = xb_xcc_id(); b.st = st;
    if (get_tid() == 0) (void)xb_add(&bar[XB_XCNT(b.x)], 1u);
    return b;
}
__device__ __forceinline__ void xcd_barrier_complete(unsigned* bar, unsigned x, unsigned& nloc, unsigned& nx) {
    const unsigned G = gridDim.x * gridDim.y * gridDim.z;
    unsigned sum, cnt, mine, sp = 0u;
    for (;;) {
        sum = 0u; cnt = 0u; mine = 0u;
#pragma unroll
        for (unsigned j = 0; j < 16; ++j) { const unsigned c = xb_ld(&bar[XB_XCNT(j)]); sum += c; cnt += (c > 0u) ? 1u : 0u; mine = (j == x) ? c : mine; }
        if (sum == G) break;
        __builtin_amdgcn_s_sleep(1);
        if ((++sp & 255u) == 0u) { if (xb_ld(&bar[XB_TMO])) break; if (sp > XB_SPIN_CAP) { atomicAdd(&bar[XB_TMO], 1u); break; } }
    }
    nloc = mine > 0u ? mine : 1u; nx = cnt > 0u ? cnt : 1u;
}
__device__ __forceinline__ void xcd_barrier(const XcdBarrier& b) {
    asm volatile("s_waitcnt vmcnt(0)" ::: "memory");
    __syncthreads();
    if (get_tid() == 0) {
        unsigned* bar = b.bar;
        __builtin_amdgcn_s_waitcnt(0);
        unsigned nloc = b.st[0], nx = b.st[1];
        if (nloc == 0u) { xcd_barrier_complete(bar, b.x, nloc, nx); b.st[0] = nloc; b.st[1] = nx; }
        const unsigned old = xb_add(&bar[XB_XSUB(b.x)], 1u);
        const unsigned gen = old / nloc;
        if (old + 1u == (gen + 1u) * nloc) {
            __builtin_amdgcn_fence(__ATOMIC_RELEASE, "agent");
            asm volatile("s_waitcnt vmcnt(0)" ::: "memory");
            const unsigned og = xb_add(&bar[XB_TOP], 1u);
            const unsigned tg = og / nx;
            if (og + 1u == (tg + 1u) * nx) xb_add(&bar[XB_TOPGEN], 1u);
            else XB_SPIN(xb_ld(&bar[XB_TOPGEN]) == tg, bar);
            __builtin_amdgcn_fence(__ATOMIC_ACQUIRE, "agent");
            xb_add(&bar[XB_XGEN(b.x)], 1u);
            asm volatile("s_waitcnt vmcnt(0)" ::: "memory");
        } else {
            XB_SPIN(xb_ld(&bar[XB_XGEN(b.x)]) == gen, bar);
            __builtin_amdgcn_fence(__ATOMIC_ACQUIRE, "agent");
            asm volatile("s_waitcnt vmcnt(0)" ::: "memory");
        }
    }
    __syncthreads();
}

struct Params {
    const float *x, *c, *ctx, *c_ctx, *mod_w, *mod_b, *norm1_w, *norm2_w, *w_in, *mla_qn, *mla_wuq, *mla_kvn, *mla_wukv,
                *gqa_qn, *gqa_kn, *na_bias, *ret_logit, *ret_gnw, *w_branch, *w_out, *peer_wq, *peer_keys, *peer_u, *peer_v, *final_w;
    float* out;
    char* ws;
};
typedef const __attribute__((address_space(4))) Params* KP;
__device__ __forceinline__ KP get_kp() { KP kp = (KP)__builtin_amdgcn_kernarg_segment_ptr(); asm volatile("" : "+s"(kp)); return kp; }

constexpr size_t al256c(size_t x) { return (x + 255) & ~(size_t)255; }
constexpr size_t WS_BAR = 0;
constexpr size_t WS_CNT = WS_BAR + al256c(XCD_BAR_WORDS * 4);
constexpr size_t WS_ZERO_END = WS_CNT + al256c(8 * 8 * 64 * 4);
constexpr size_t WS_MOD = WS_ZERO_END;
constexpr size_t WS_CTXS = WS_MOD + al256c((size_t)2 * 17 * 6144 * 4);
constexpr size_t WS_WINT = WS_CTXS + al256c((size_t)NBATCH * CTXL * DM * 4);
constexpr size_t WS_WUQT = WS_WINT + al256c((size_t)2 * NPROJ * DM * 2);
constexpr size_t WS_WUKVT = WS_WUQT + al256c((size_t)2 * 384 * 256 * 2);
constexpr size_t WS_WBT = WS_WUKVT + al256c((size_t)2 * 512 * 128 * 2);
constexpr size_t WS_WOUTT = WS_WBT + al256c((size_t)2 * 4 * DM * 256 * 2);
constexpr size_t WS_WQT = WS_WOUTT + al256c((size_t)2 * DM * DM * 2);
constexpr size_t WS_H = WS_WQT + al256c((size_t)2 * DM * DM * 2);
constexpr size_t WS_PROJ = WS_H + al256c((size_t)NGROUP * TG * DM * 2);
#define HG(p_, g_) (((bf16_t*)((p_)->ws + WS_H)) + (size_t)(g_) * TG * DM)
constexpr size_t WS_GATE8 = WS_PROJ + al256c((size_t)TG * PLD * 2);
constexpr size_t WS_QRAW = WS_GATE8 + al256c((size_t)TG * 4096);
constexpr size_t WS_KVRAW = WS_QRAW + al256c((size_t)TG * 384 * 2);
constexpr size_t WS_QA = WS_KVRAW + al256c((size_t)TG * 512 * 2);
constexpr size_t WS_KA = WS_QA + al256c((size_t)TG * 384 * 2);
constexpr size_t WS_VA = WS_KA + al256c((size_t)TG * 384 * 2);
constexpr size_t WS_GQ = WS_VA + al256c((size_t)TG * 256 * 2);
constexpr size_t WS_GK = WS_GQ + al256c((size_t)TG * 256 * 2);
constexpr size_t WS_OUTS = WS_GK + al256c((size_t)TG * 128 * 2);
constexpr size_t WS_ACC = WS_QRAW;
constexpr size_t WS_PQ = WS_OUTS;
constexpr size_t WS_RKV = WS_OUTS + al256c((size_t)4 * TG * 256 * 2);
constexpr size_t WS_UB = WS_RKV + al256c((size_t)NB * 4 * 2 * 34 * 4096 * 4);
constexpr size_t WS_VB = WS_UB + al256c((size_t)2 * 16384 * DM);
constexpr size_t WS_KEYB = WS_VB + al256c((size_t)2 * 16384 * DM);
constexpr size_t WS_USC = WS_UB + (size_t)2 * 16384 * (DM / 2);
constexpr size_t WS_VSC = WS_VB + (size_t)2 * 16384 * (DM / 2);
constexpr size_t WS_TOTAL = WS_KEYB + al256c((size_t)2 * 8 * 2 * 128 * 64 * 2);

#define G_BM 256
#define G_BN 128
#define G_BK 64
#define G_LDP 144
#define G_ABYTES (G_BM * G_LDP)
#define G_BBYTES (G_BN * G_LDP)
#define G_STAGE (G_ABYTES + G_BBYTES)

template <int MI>
__device__ __forceinline__ void gemm_tile(const bf16_t* __restrict__ A, int lda, const bf16_t* __restrict__ Bt, int ldb, int K,
                                          f32x4 (&acc)[MI][4], char* lds)
{
    constexpr int NA = MI;
    const int tid = get_tid(), lane = tid & 63, wid = tid >> 6, wm = wid >> 1, wn = wid & 1, fr = lane & 15, fq = lane >> 4;
    const int nk = K / G_BK;
    u32x4 ra[NA], rb[2];
    const int arow = tid >> 3, akc = tid & 7;
    const bf16_t* ag = A + (size_t)arow * lda + akc * 8;
    const bf16_t* bg = Bt + (size_t)arow * ldb + akc * 8;
    const int a_l = arow * G_LDP + akc * 16;
#pragma unroll
    for (int i = 0; i < NA; ++i) ra[i] = *(const u32x4*)(ag + (size_t)(64 * i) * lda);
#pragma unroll
    for (int i = 0; i < 2; ++i) rb[i] = *(const u32x4*)(bg + (size_t)(64 * i) * ldb);
    __syncthreads();
#pragma unroll
    for (int i = 0; i < NA; ++i) *(u32x4*)(lds + a_l + i * 64 * G_LDP) = ra[i];
#pragma unroll
    for (int i = 0; i < 2; ++i) *(u32x4*)(lds + G_ABYTES + a_l + i * 64 * G_LDP) = rb[i];
    __syncthreads();
    const int aoff = (wm * 16 * MI + fr) * G_LDP + fq * 16;
    const int boff = G_ABYTES + (wn * 64 + fr) * G_LDP + fq * 16;
    for (int kt = 0; kt < nk; ++kt) {
        const int cur = (kt & 1) * G_STAGE, nxt = ((kt + 1) & 1) * G_STAGE;
        const bool more = (kt + 1 < nk);
        if (more) {
#pragma unroll
            for (int i = 0; i < NA; ++i) ra[i] = *(const u32x4*)(ag + (size_t)(64 * i) * lda + (kt + 1) * G_BK);
#pragma unroll
            for (int i = 0; i < 2; ++i) rb[i] = *(const u32x4*)(bg + (size_t)(64 * i) * ldb + (kt + 1) * G_BK);
        }
#pragma unroll
        for (int ks = 0; ks < 2; ++ks) {
            bf16x8 af[MI], bfr[4];
#pragma unroll
            for (int mi = 0; mi < MI; ++mi) af[mi] = *(const bf16x8*)(lds + cur + aoff + mi * 16 * G_LDP + ks * 64);
#pragma unroll
            for (int ni = 0; ni < 4; ++ni) bfr[ni] = *(const bf16x8*)(lds + cur + boff + ni * 16 * G_LDP + ks * 64);
#pragma unroll
            for (int mi = 0; mi < MI; ++mi)
#pragma unroll
                for (int ni = 0; ni < 4; ++ni) acc[mi][ni] = __builtin_amdgcn_mfma_f32_16x16x32_bf16(bfr[ni], af[mi], acc[mi][ni], 0, 0, 0);
        }
        if (more) {
#pragma unroll
            for (int i = 0; i < NA; ++i) *(u32x4*)(lds + nxt + a_l + i * 64 * G_LDP) = ra[i];
#pragma unroll
            for (int i = 0; i < 2; ++i) *(u32x4*)(lds + nxt + G_ABYTES + a_l + i * 64 * G_LDP) = rb[i];
        }
        __syncthreads();
    }
}

template <int MI>
__device__ __forceinline__ void zero_acc(f32x4 (&acc)[MI][4]) {
#pragma unroll
    for (int i = 0; i < MI; ++i)
#pragma unroll
        for (int j = 0; j < 4; ++j) acc[i][j] = (f32x4){0.f, 0.f, 0.f, 0.f};
}

template <class Epi>
__device__ __forceinline__ void gemm_phase(const bf16_t* A, int lda, const bf16_t* Bt, int ldb, int M, int N, int K, const Epi& epi, char* lds, int bid, int nblk)
{
    const int tid = get_tid(), lane = tid & 63, wid = tid >> 6, wm = wid >> 1, wn = wid & 1, fr = lane & 15, fq = lane >> 4;
    const int tn = N / G_BN, total = (M / G_BM) * tn;
    for (int t = bid; t < total; t += nblk) {
        const int pm = t / tn, pn = t % tn;
        f32x4 acc[4][4]; zero_acc(acc);
        gemm_tile<4>(A + (size_t)pm * G_BM * lda, lda, Bt + (size_t)pn * G_BN * ldb, ldb, K, acc, lds);
#pragma unroll
        for (int mi = 0; mi < 4; ++mi)
#pragma unroll
            for (int ni = 0; ni < 4; ++ni) epi(pm * G_BM + wm * 64 + mi * 16 + fr, pn * G_BN + wn * 64 + ni * 16 + fq * 4, acc[mi][ni]);
    }
}

__device__ __forceinline__ void store_bf16x4(bf16_t* p, f32x4 v) { u32x2 w; w.x = pack_bf16(v[0], v[1]); w.y = pack_bf16(v[2], v[3]); *(u32x2*)p = w; }


namespace pg8 {
#define PG8_LAS __attribute__((address_space(3)))
typedef unsigned short bf16_t;
typedef short bf16x8 __attribute__((ext_vector_type(8)));
typedef float f32x4 __attribute__((ext_vector_type(4)));
typedef unsigned u32x4 __attribute__((ext_vector_type(4)));
constexpr int BM = 256, BK = 64, HALF = 128, HTB = HALF * BK * 2  , STAGE_BYTES = 8 * HTB, NXCD = 8, WGM = 8;

__host__ __device__ __forceinline__ int lds_byte(int r, int c) { const int st = (r >> 4) * 2 + (c >> 5), rr = r & 15, cc = c & 31, ob = rr * 64 + cc * 2; return st * 1024 + (ob ^ (((ob >> 9) & 1) << 5)); }
__host__ __device__ __forceinline__ void stage_rc(int b, int& R, int& C) { const int st = b / 1024, sb = b % 1024, swz = sb ^ (((sb >> 9) & 1) << 5); R = (st >> 1) * 16 + swz / 64; C = (st & 1) * 32 + (swz % 64) / 2; }
__host__ __device__ __forceinline__ int perm32(int rho) { const int n = rho >> 4, i = rho & 15; return 8 * (i >> 2) + 4 * n + (i & 3); }

struct Unit { int pm, pn; };
struct Gemm { const bf16_t* A; const bf16_t* Bt; int M, N, K; };

struct StaticOrder {
    int nM, nN, nwg, G, c;
    __host__ __device__ void init(int M, int N, int G_, int c_) { nM = M / BM; nN = N / BM; nwg = nM * nN; G = G_; c = c_; }
    __host__ __device__ bool next(int i, Unit& u) const {
        const long L = (long)i * G + c; if (L >= nwg) return false;
        int wgid = (int)L; { const int q = nwg / NXCD, r = nwg % NXCD, xcd = wgid % NXCD, off = wgid / NXCD; wgid = (xcd < r ? xcd * (q + 1) : r * (q + 1) + (xcd - r) * q) + off; }
        const int nig = WGM * nN, gid = wgid / nig, fm = gid * WGM, gsz = (nM - fm) < WGM ? (nM - fm) : WGM;
        u.pm = fm + ((wgid % nig) % gsz); u.pn = (wgid % nig) / gsz; return true;
    }
    __device__ __forceinline__ void a_ready(const Unit&) const {}
    __device__ __forceinline__ void done(const Unit&) const {}
};
template <class Epi, class Sched, bool ALIGN_EPI = false, bool SP2 = false>
__device__ __forceinline__ void gemm_phase(PG8_LAS unsigned char* lds, const Gemm g, const Sched& S, const Epi& E) {
    const int tid = get_tid(), wid = __builtin_amdgcn_readfirstlane(tid >> 6), lane = tid & 63, wr = wid >> 2, wc = wid & 3, fr = lane & 15, fq = lane >> 4;
    const int K = g.K, nt = K / BK;
    unsigned voffA[2], voffB[2];
#pragma unroll
    for (int i = 0; i < 2; ++i) { int R, C; stage_rc(tid * 16 + i * 8192, R, C); const int Rb = Epi::PERM ? ((R & ~31) + perm32(R & 31)) : R;
        voffA[i] = (unsigned)(R * K + C) * 2u; voffB[i] = (unsigned)(Rb * K + C) * 2u; }
    const size_t kstep = (size_t)(BK * 2);
    const size_t hstep = (size_t)HALF * K * 2;
    const size_t tstep = 2 * hstep;
    const unsigned ldsw = (unsigned)wid * 1024u;
    const int aoff = lds_byte(wr * 64 + fr, fq * 8), boff = lds_byte(wc * 32 + fr, fq * 8);
#define PG8_SA(b, h) (((b) * 2 + (h)) * HTB)
#define PG8_SB(b, h) ((4 + (b) * 2 + (h)) * HTB)
#define PG8_STAGE(bufoff, gbase, voff) do { _Pragma("unroll") for (int _i = 0; _i < 2; ++_i) \
        __builtin_amdgcn_global_load_lds((const unsigned*)((const char*)(gbase) + (voff)[_i]), (PG8_LAS unsigned*)(lds + (bufoff) + ldsw + _i * 8192), 16, 0, 0); } while (0)
#define PG8_LDA(dst, b, h) do { _Pragma("unroll") for (int m = 0; m < 4; ++m) _Pragma("unroll") for (int k = 0; k < 2; ++k) dst[m][k] = *(const PG8_LAS bf16x8*)(lds + PG8_SA(b, h) + aoff + m * 2048 + k * 1024); } while (0)
#define PG8_LDB(dst, b, h) do { _Pragma("unroll") for (int n = 0; n < 2; ++n) _Pragma("unroll") for (int k = 0; k < 2; ++k) dst[n][k] = *(const PG8_LAS bf16x8*)(lds + PG8_SB(b, h) + boff + n * 2048 + k * 1024); } while (0)
#define PG8_MMA(ai, bj, At, Bt) do { __builtin_amdgcn_s_setprio(1); _Pragma("unroll") for (int m = 0; m < 4; ++m) _Pragma("unroll") for (int n = 0; n < 2; ++n) _Pragma("unroll") for (int k = 0; k < 2; ++k) \
        acc[ai][bj][m][n] = __builtin_amdgcn_mfma_f32_16x16x32_bf16(Bt[n][k], At[m][k], acc[ai][bj][m][n], 0, 0, 0); __builtin_amdgcn_s_setprio(0); } while (0)
#define PG8_WAIT_V(n) asm volatile("s_waitcnt vmcnt(" #n ")" ::: "memory")
#define PG8_WAIT_L(n) asm volatile("s_waitcnt lgkmcnt(" #n ")" ::: "memory")
#define PG8_BAR __builtin_amdgcn_s_barrier()
#define PG8_SCHED __builtin_amdgcn_sched_barrier(0)
    Unit cur, nxt; int ui = 0;
    if (!S.next(0, cur)) return;
    f32x4 acc[2][2][4][2];
#pragma unroll
    for (int a = 0; a < 2; ++a)
#pragma unroll
        for (int b = 0; b < 2; ++b)
#pragma unroll
            for (int m = 0; m < 4; ++m)
#pragma unroll
                for (int n = 0; n < 2; ++n) acc[a][b][m][n] = (f32x4){0.f, 0.f, 0.f, 0.f};
    bf16x8 At[4][2], B0[2][2], B1[2][2];
    const char* cA = (const char*)g.A + (size_t)cur.pm * tstep; const char* cB = (const char*)g.Bt + (size_t)cur.pn * tstep;
    S.a_ready(cur);
    if constexpr (SP2) {
        PG8_STAGE(PG8_SB(0, 0), cB, voffB); PG8_STAGE(PG8_SB(0, 1), cB + hstep, voffB); PG8_STAGE(PG8_SA(0, 0), cA, voffA); PG8_STAGE(PG8_SA(0, 1), cA + hstep, voffA);
        if (wr == 1) PG8_BAR;
        PG8_WAIT_V(2); PG8_BAR;
        PG8_STAGE(PG8_SB(1, 0), cB + kstep, voffB); PG8_STAGE(PG8_SA(1, 0), cA + kstep, voffA); PG8_STAGE(PG8_SB(1, 1), cB + hstep + kstep, voffB);
        PG8_WAIT_V(6); PG8_BAR;
    } else {
        PG8_STAGE(PG8_SB(0, 0), cB, voffB); PG8_STAGE(PG8_SA(0, 0), cA, voffA); PG8_STAGE(PG8_SB(0, 1), cB + hstep, voffB); PG8_STAGE(PG8_SA(0, 1), cA + hstep, voffA);
        if (wr == 1) PG8_BAR;
        PG8_WAIT_V(4); PG8_BAR;
        PG8_STAGE(PG8_SB(1, 0), cB + kstep, voffB); PG8_STAGE(PG8_SA(1, 0), cA + kstep, voffA); PG8_STAGE(PG8_SB(1, 1), cB + hstep + kstep, voffB);
        PG8_WAIT_V(6); PG8_BAR;
    }
    for (;;) {
        const bool has_next = S.next(ui + 1, nxt);
        const char* nA = has_next ? (const char*)g.A + (size_t)nxt.pm * tstep : cA; const char* nB = has_next ? (const char*)g.Bt + (size_t)nxt.pn * tstep : cB;
        for (int t = 0; t < nt; t += 2) {
            const bool last = (t == nt - 2);
            const char* a1 = cA + (size_t)(t + 1) * kstep;
            const char* a2 = last ? nA : cA + (size_t)(t + 2) * kstep; const char* b2 = last ? nB : cB + (size_t)(t + 2) * kstep;
            const char* a3 = a2 + kstep; const char* b3 = b2 + kstep;
            if (last && has_next) S.a_ready(nxt);
            if constexpr (SP2) {
            PG8_LDB(B0, 0, 0); PG8_LDB(B1, 0, 1); PG8_SCHED; PG8_LDA(At, 0, 0); PG8_STAGE(PG8_SA(1, 1), a1 + hstep, voffA);
            PG8_WAIT_V(8); PG8_WAIT_L(0); PG8_BAR; PG8_MMA(0, 0, At, B0); PG8_MMA(0, 1, At, B1); PG8_BAR; PG8_SCHED;
            PG8_LDA(At, 0, 1); PG8_STAGE(PG8_SB(0, 0), b2, voffB); PG8_STAGE(PG8_SB(0, 1), b2 + hstep, voffB); PG8_STAGE(PG8_SA(0, 0), a2, voffA);
            PG8_WAIT_V(8); PG8_WAIT_L(0); PG8_BAR; PG8_MMA(1, 0, At, B0); PG8_MMA(1, 1, At, B1); PG8_BAR; PG8_SCHED;
            PG8_LDB(B0, 1, 0); PG8_LDB(B1, 1, 1); PG8_SCHED; PG8_LDA(At, 1, 0); PG8_STAGE(PG8_SA(0, 1), a2 + hstep, voffA);
            PG8_WAIT_V(8); PG8_WAIT_L(0); PG8_BAR; PG8_MMA(0, 0, At, B0); PG8_MMA(0, 1, At, B1); PG8_BAR; PG8_SCHED;
            PG8_LDA(At, 1, 1); PG8_STAGE(PG8_SB(1, 0), b3, voffB); PG8_STAGE(PG8_SB(1, 1), b3 + hstep, voffB); PG8_STAGE(PG8_SA(1, 0), a3, voffA);
            PG8_WAIT_V(8); PG8_WAIT_L(0); PG8_BAR; PG8_MMA(1, 0, At, B0); PG8_MMA(1, 1, At, B1); PG8_BAR; PG8_SCHED;
            } else {
            PG8_LDB(B0, 0, 0); PG8_SCHED; PG8_LDA(At, 0, 0); PG8_STAGE(PG8_SA(1, 1), a1 + hstep, voffA);
            PG8_WAIT_L(8); PG8_BAR; PG8_WAIT_L(0); PG8_MMA(0, 0, At, B0); PG8_BAR; PG8_SCHED;
            PG8_LDB(B1, 0, 1); PG8_STAGE(PG8_SB(0, 0), b2, voffB);
            PG8_BAR; PG8_WAIT_L(0); PG8_MMA(0, 1, At, B1); PG8_BAR;
            PG8_LDA(At, 0, 1); PG8_STAGE(PG8_SA(0, 0), a2, voffA);
            PG8_BAR; PG8_WAIT_L(0); PG8_MMA(1, 0, At, B0); PG8_BAR; PG8_SCHED;
            PG8_STAGE(PG8_SB(0, 1), b2 + hstep, voffB);
            PG8_WAIT_V(6); PG8_BAR; PG8_MMA(1, 1, At, B1); PG8_BAR;
            PG8_LDB(B0, 1, 0); PG8_SCHED; PG8_LDA(At, 1, 0); PG8_STAGE(PG8_SA(0, 1), a2 + hstep, voffA);
            PG8_WAIT_L(8); PG8_BAR; PG8_WAIT_L(0); PG8_MMA(0, 0, At, B0); PG8_BAR; PG8_SCHED;
            PG8_LDB(B1, 1, 1); PG8_STAGE(PG8_SB(1, 0), b3, voffB);
            PG8_BAR; PG8_WAIT_L(0); PG8_MMA(0, 1, At, B1); PG8_BAR;
            PG8_LDA(At, 1, 1); PG8_STAGE(PG8_SA(1, 0), a3, voffA);
            PG8_BAR; PG8_WAIT_L(0); PG8_MMA(1, 0, At, B0); PG8_BAR; PG8_SCHED;
            PG8_STAGE(PG8_SB(1, 1), b3 + hstep, voffB);
            PG8_WAIT_V(6); PG8_BAR; PG8_MMA(1, 1, At, B1); PG8_BAR;
            }
        }
        if constexpr (ALIGN_EPI) { if (wr == 0) PG8_BAR; }
        if constexpr (!Epi::AFTER_DRAIN) { E(acc, cur, wr, wc, fr, fq); S.done(cur); }
        if (!has_next) break;
#pragma unroll
        for (int a = 0; a < 2; ++a)
#pragma unroll
            for (int b = 0; b < 2; ++b)
#pragma unroll
                for (int m = 0; m < 4; ++m)
#pragma unroll
                    for (int n = 0; n < 2; ++n) acc[a][b][m][n] = (f32x4){0.f, 0.f, 0.f, 0.f};
        cur = nxt; cA = nA; cB = nB; ++ui;
        if constexpr (ALIGN_EPI) { if (wr == 1) PG8_BAR; }
    }
    PG8_WAIT_V(0);
    if constexpr (!ALIGN_EPI) { if (wr == 0) PG8_BAR; }
    PG8_BAR;
    if constexpr (Epi::AFTER_DRAIN) { E.fused(acc, cur, wr, wc, fr, fq, lds, wid, lane); S.done(cur); }
#undef PG8_SA
#undef PG8_SB
#undef PG8_STAGE
#undef PG8_LDA
#undef PG8_LDB
#undef PG8_MMA
#undef PG8_WAIT_V
#undef PG8_WAIT_L
#undef PG8_BAR
#undef PG8_SCHED
}
}

template <class F> struct Epi4 {
    static constexpr bool PERM = false, AFTER_DRAIN = false; F f;
    __device__ __forceinline__ void operator()(const f32x4 (&acc)[2][2][4][2], const pg8::Unit& u, int wr, int wc, int fr, int fq) const {
#pragma unroll
        for (int ai = 0; ai < 2; ++ai)
#pragma unroll
            for (int m = 0; m < 4; ++m)
#pragma unroll
                for (int bj = 0; bj < 2; ++bj)
#pragma unroll
                    for (int n = 0; n < 2; ++n) f(u.pm * 256 + ai * 128 + wr * 64 + m * 16 + fr, u.pn * 256 + bj * 128 + wc * 32 + n * 16 + fq * 4, acc[ai][bj][m][n]);
    }
};
template <class F> struct Epi8 {
    static constexpr bool PERM = true, AFTER_DRAIN = false; F f;
    __device__ __forceinline__ void operator()(const f32x4 (&acc)[2][2][4][2], const pg8::Unit& u, int wr, int wc, int fr, int fq) const {
#pragma unroll
        for (int ai = 0; ai < 2; ++ai)
#pragma unroll
            for (int m = 0; m < 4; ++m)
#pragma unroll
                for (int bj = 0; bj < 2; ++bj) f(u.pm * 256 + ai * 128 + wr * 64 + m * 16 + fr, u.pn * 256 + bj * 128 + wc * 32 + fq * 8, acc[ai][bj][m][0], acc[ai][bj][m][1]);
    }
};
template <class E>
__device__ __forceinline__ void big_gemm(const bf16_t* A, const bf16_t* Bt, int M, int N, int K, const E& e, char* lds, int bid, int nblk) {
    pg8::StaticOrder so; so.init(M, N, nblk, bid);
    pg8::gemm_phase<E, pg8::StaticOrder, true, true>((PG8_LAS unsigned char*)lds, pg8::Gemm{A, Bt, M, N, K}, so, e);
}

__device__ __forceinline__ void transpose_cvt(const float* __restrict__ src, int K, int N, int Npad, bf16_t* __restrict__ dst, const float* __restrict__ kscale, float* lds, int bid, int nblk)
{
    const int tid = get_tid();
    const int tk = K / 64, tn = Npad / 64, total = tk * tn;
    const int lk = tid >> 3, ln = (tid & 7) * 8;
    const int sn = tid >> 3, sk = (tid & 7) * 8;
    for (int t = bid; t < total; t += nblk) {
        const int k0 = (t / tn) * 64, n0 = (t % tn) * 64;
        f32x4 a = (f32x4){0.f, 0.f, 0.f, 0.f}, c = a;
        if (n0 + ln < N) { const float* sp = src + (size_t)(k0 + lk) * N + n0 + ln; a = *(const f32x4*)sp; c = *(const f32x4*)(sp + 4); if (kscale) { const float ks = kscale[k0 + lk]; a *= ks; c *= ks; } }
        __syncthreads();
#pragma unroll
        for (int j = 0; j < 4; ++j) { lds[lk * 65 + ln + j] = a[j]; lds[lk * 65 + ln + 4 + j] = c[j]; }
        __syncthreads();
        u32x4 w;
        w.x = pack_bf16(lds[(sk + 0) * 65 + sn], lds[(sk + 1) * 65 + sn]); w.y = pack_bf16(lds[(sk + 2) * 65 + sn], lds[(sk + 3) * 65 + sn]);
        w.z = pack_bf16(lds[(sk + 4) * 65 + sn], lds[(sk + 5) * 65 + sn]); w.w = pack_bf16(lds[(sk + 6) * 65 + sn], lds[(sk + 7) * 65 + sn]);
        *(u32x4*)(dst + (size_t)(n0 + sn) * K + k0 + sk) = w;
    }
}

__device__ __forceinline__ void phase_prologue(KP p, char* ldsc, int bid, int nblk)
{
    float* lds = (float*)ldsc;
    const int tid = get_tid();
    for (int l = 0; l < 2; ++l) {
        transpose_cvt(p->w_in + (size_t)l * DM * IN_COLS, DM, IN_COLS, NPROJ, ((bf16_t*)(p->ws + WS_WINT)) + (size_t)l * NPROJ * DM, nullptr, lds, bid, nblk);
        transpose_cvt(p->mla_wuq + (size_t)l * 256 * 384, 256, 384, 384, ((bf16_t*)(p->ws + WS_WUQT)) + (size_t)l * 384 * 256, p->mla_qn + l * 256, lds, bid, nblk);
        transpose_cvt(p->mla_wukv + (size_t)l * 128 * 512, 128, 512, 512, ((bf16_t*)(p->ws + WS_WUKVT)) + (size_t)l * 512 * 128, p->mla_kvn + l * 128, lds, bid, nblk);
        for (int i = 0; i < 4; ++i)
            transpose_cvt(p->w_branch + (size_t)(l * 4 + i) * 256 * DM, 256, DM, DM, ((bf16_t*)(p->ws + WS_WBT)) + (size_t)(l * 4 + i) * DM * 256, nullptr, lds, bid, nblk);
        transpose_cvt(p->w_out + (size_t)l * DM * DM, DM, DM, DM, ((bf16_t*)(p->ws + WS_WOUTT)) + (size_t)l * DM * DM, nullptr, lds, bid, nblk);
        transpose_cvt(p->peer_wq + (size_t)l * DM * DM, DM, DM, DM, ((bf16_t*)(p->ws + WS_WQT)) + (size_t)l * DM * DM, nullptr, lds, bid, nblk);
    }
    {
        float* sil = lds;
        float* red = lds + 17 * 1024;
        __syncthreads();
        for (int e = tid; e < 17 * 1024; e += NTHREADS) { const int r = e >> 10, k = e & 1023; const float v = (r < 16) ? p->c[r * 1024 + k] : p->c_ctx[k]; sil[e] = siluf(v); }
        __syncthreads();
        for (int u = bid; u < 2 * 96; u += nblk) {
            const int l = u / 96, j0 = (u % 96) * 64, kg = tid >> 6, j = tid & 63;
            float a[17];
#pragma unroll
            for (int r = 0; r < 17; ++r) a[r] = 0.f;
            const float* w = p->mod_w + (size_t)l * DM * 6144 + j0 + j;
#pragma unroll 1
            for (int k0 = kg * 128; k0 < kg * 128 + 128; k0 += 16) {
                float wv[16];
#pragma unroll
                for (int kk = 0; kk < 16; ++kk) wv[kk] = w[(size_t)(k0 + kk) * 6144];
#pragma unroll
                for (int kk = 0; kk < 16; ++kk)
#pragma unroll
                    for (int r = 0; r < 17; ++r) a[r] += sil[r * 1024 + k0 + kk] * wv[kk];
            }
#pragma unroll
            for (int r = 0; r < 17; ++r) red[(kg * 17 + r) * 64 + j] = a[r];
            __syncthreads();
            for (int e = tid; e < 17 * 64; e += NTHREADS) {
                const int r = e >> 6, jj = e & 63; float s = 0.f;
                for (int q = 0; q < 8; ++q) s += red[(q * 17 + r) * 64 + jj];
                ((float*)(p->ws + WS_MOD))[((size_t)l * 17 + r) * 6144 + j0 + jj] = s + p->mod_b[l * 6144 + j0 + jj];
            }
            __syncthreads();
        }
    }
    {
        const size_t n16 = (size_t)2 * 16384 * DM / 16;
        for (size_t i = (size_t)bid * NTHREADS + tid; i < n16; i += (size_t)nblk * NTHREADS) {
            f32x4 a[4], c[4];
#pragma unroll
            for (int q = 0; q < 4; ++q) { a[q] = ((const f32x4*)p->peer_u)[4 * i + q]; c[q] = ((const f32x4*)p->peer_v)[4 * i + q]; }
            float mu = 0.f, mv = 0.f;
#pragma unroll
            for (int q = 0; q < 4; ++q)
#pragma unroll
                for (int j = 0; j < 4; ++j) { mu = fmaxf(mu, fabsf(a[q][j])); mv = fmaxf(mv, fabsf(c[q][j])); }
            mu = wave_max(mu); mv = wave_max(mv);
            const float su = mu > 0.f ? mu * (1.f / 6.f) : 1.f, sv = mv > 0.f ? mv * (1.f / 6.f) : 1.f, iu = 1.f / su, iv = 1.f / sv;
            u32x2 wu = (u32x2){0u, 0u}, wv = (u32x2){0u, 0u};
#pragma unroll
            for (int q = 0; q < 4; ++q) {
                unsigned tu = wu[q >> 1], tv = wv[q >> 1];
                if ((q & 1) == 0) {
                    tu = __builtin_amdgcn_cvt_scalef32_pk_fp4_f32(tu, a[q][0] * iu, a[q][1] * iu, 1.0f, 0); tu = __builtin_amdgcn_cvt_scalef32_pk_fp4_f32(tu, a[q][2] * iu, a[q][3] * iu, 1.0f, 1);
                    tv = __builtin_amdgcn_cvt_scalef32_pk_fp4_f32(tv, c[q][0] * iv, c[q][1] * iv, 1.0f, 0); tv = __builtin_amdgcn_cvt_scalef32_pk_fp4_f32(tv, c[q][2] * iv, c[q][3] * iv, 1.0f, 1);
                } else {
                    tu = __builtin_amdgcn_cvt_scalef32_pk_fp4_f32(tu, a[q][0] * iu, a[q][1] * iu, 1.0f, 2); tu = __builtin_amdgcn_cvt_scalef32_pk_fp4_f32(tu, a[q][2] * iu, a[q][3] * iu, 1.0f, 3);
                    tv = __builtin_amdgcn_cvt_scalef32_pk_fp4_f32(tv, c[q][0] * iv, c[q][1] * iv, 1.0f, 2); tv = __builtin_amdgcn_cvt_scalef32_pk_fp4_f32(tv, c[q][2] * iv, c[q][3] * iv, 1.0f, 3);
                }
                wu[q >> 1] = tu; wv[q >> 1] = tv;
            }
            ((u32x2*)(p->ws + WS_UB))[i] = wu; ((u32x2*)(p->ws + WS_VB))[i] = wv;
            if ((tid & 63) == 0) { ((float*)(p->ws + WS_USC))[i >> 6] = su; ((float*)(p->ws + WS_VSC))[i >> 6] = sv; }
        }
        const size_t k8 = (size_t)2 * 8 * 2 * 128 * 64 / 8;
        for (size_t i = (size_t)bid * NTHREADS + tid; i < k8; i += (size_t)nblk * NTHREADS) {
            const f32x4 a = ((const f32x4*)p->peer_keys)[2 * i], b = ((const f32x4*)p->peer_keys)[2 * i + 1];
            u32x4 w; w.x = pack_bf16(a[0], a[1]); w.y = pack_bf16(a[2], a[3]); w.z = pack_bf16(b[0], b[1]); w.w = pack_bf16(b[2], b[3]);
            ((u32x4*)(p->ws + WS_KEYB))[i] = w;
        }
    }
}

__device__ __forceinline__ const float* state_row(KP p, int g, int r, int& modrow, bool from_input) {
    const int bl = r / LTOK, t = r - bl * LTOK, b = g * NB + bl;
    if (t < CTXL) { modrow = 16; return (from_input ? p->ctx : (const float*)(p->ws + WS_CTXS)) + ((size_t)b * CTXL + t) * DM; }
    modrow = b; return (from_input ? p->x : (const float*)p->out) + ((size_t)b * SEQ + (t - CTXL)) * DM;
}

__device__ __forceinline__ void phase_norm(KP p, int l, int g, int which, int bid, int nblk)
{
    const int lane = get_tid() & 63, wid = get_tid() >> 6;
    const float* nw = (which ? p->norm2_w : p->norm1_w) + l * DM;
    const int shoff = which ? 3072 : 0, scoff = which ? 4096 : 1024;
    for (int r = bid * 8 + wid; r < TG; r += nblk * 8) {
        int mr; const float* src = state_row(p, g, r, mr, l == 0 && which == 0);
        const float* md = ((float*)(p->ws + WS_MOD)) + ((size_t)l * 17 + mr) * 6144;
        f32x4 v[4]; float ss = 0.f;
#pragma unroll
        for (int i = 0; i < 4; ++i) { v[i] = *(const f32x4*)(src + i * 256 + lane * 4); ss += v[i][0] * v[i][0] + v[i][1] * v[i][1] + v[i][2] * v[i][2] + v[i][3] * v[i][3]; }
        ss = wave_sum(ss);
        const float rstd = rsqrtf(ss * (1.f / DM) + EPSF);
#pragma unroll
        for (int i = 0; i < 4; ++i) {
            const int c = i * 256 + lane * 4;
            const f32x4 w = *(const f32x4*)(nw + c), sc = *(const f32x4*)(md + scoff + c), sh = *(const f32x4*)(md + shoff + c);
            f32x4 y;
#pragma unroll
            for (int j = 0; j < 4; ++j) y[j] = v[i][j] * rstd * w[j] * (1.f + sc[j]) + sh[j];
            store_bf16x4(HG(p, g) + (size_t)r * DM + c, y);
        }
    }
}

struct EpiProj8 {
    bf16_t* O; unsigned char* G8;
    __device__ __forceinline__ void operator()(int row, int col, f32x4 a, f32x4 b) const {
        if (col >= C_GATE) {
            const int gi = col - C_GATE; if (gi >= 4096) return;
            unsigned w0 = 0u, w1 = 0u;
#pragma unroll
            for (int j = 0; j < 4; ++j) {
                w0 |= (unsigned)__builtin_amdgcn_cvt_pk_u8_f32(sigmf(a[j]) * 255.f, j, 0);
                w1 |= (unsigned)__builtin_amdgcn_cvt_pk_u8_f32(sigmf(b[j]) * 255.f, j, 0);
            }
            const int gp_ = (gi & ~63) | (((gi >> 2) & 3) << 4) | (((gi >> 4) & 3) << 2);
            *(unsigned*)(G8 + (size_t)row * 4096 + gp_) = w0; *(unsigned*)(G8 + (size_t)row * 4096 + gp_ + 16) = w1;
            return;
        }
        if (col >= C_NQ && col < C_NK) { a *= (0.125f * 1.4426950408889634f); b *= (0.125f * 1.4426950408889634f); }
        u32x4 w; w.x = pack_bf16(a[0], a[1]); w.y = pack_bf16(a[2], a[3]); w.z = pack_bf16(b[0], b[1]); w.w = pack_bf16(b[2], b[3]);
        *(u32x4*)(O + (size_t)row * PLD + col) = w;
    }
};
struct EpiStore8 { bf16_t* O; int ld;
    __device__ __forceinline__ void operator()(int row, int col, f32x4 a, f32x4 b) const {
        u32x4 w; w.x = pack_bf16(a[0], a[1]); w.y = pack_bf16(a[2], a[3]); w.z = pack_bf16(b[0], b[1]); w.w = pack_bf16(b[2], b[3]);
        *(u32x4*)(O + (size_t)row * ld + col) = w; } };
struct EpiStore { bf16_t* O; int ld; __device__ __forceinline__ void operator()(int row, int col, f32x4 v) const { store_bf16x4(O + (size_t)row * ld + col, v); } };

__device__ __forceinline__ float log_sigmoidf(float x) { return fminf(x, 0.f) - log1pf(__expf(-fabsf(x))); }

__device__ __forceinline__ int ret_jb(int rb) { return rb == 0 ? 1 : (rb == 1 ? 0 : 35 - rb); }

__device__ __forceinline__ bf16x8 tr_frag_nat(const char* img, int PT, int k0, int col0, int lane) {
    const int i16 = lane & 15, blk = (lane >> 4) & 1, h5 = lane >> 5, q4 = i16 >> 2, p4 = i16 & 3;
    const char* a = img + (k0 + 8 * h5 + q4) * PT + (col0 + 16 * blk) * 2 + 8 * p4;
    const s16x4 lo = __builtin_amdgcn_ds_read_tr16_b64_v4i16((LAS s16x4*)a), hi = __builtin_amdgcn_ds_read_tr16_b64_v4i16((LAS s16x4*)(a + 4 * PT));
    return __builtin_shufflevector(lo, hi, 0, 1, 2, 3, 4, 5, 6, 7);
}
__device__ __forceinline__ bf16x8 tr_frag_acc(const char* img, int PT, int k0, int col0, int lane) {
    const int i16 = lane & 15, blk = (lane >> 4) & 1, h5 = lane >> 5, q4 = i16 >> 2, p4 = i16 & 3;
    const char* a = img + (k0 + 4 * h5 + q4) * PT + (col0 + 16 * blk) * 2 + 8 * p4;
    const s16x4 lo = __builtin_amdgcn_ds_read_tr16_b64_v4i16((LAS s16x4*)a), hi = __builtin_amdgcn_ds_read_tr16_b64_v4i16((LAS s16x4*)(a + 8 * PT));
    return __builtin_shufflevector(lo, hi, 0, 1, 2, 3, 4, 5, 6, 7);
}
#define RT_PT 144
__device__ __forceinline__ void ret_kv_unit(KP p, int l, int bl, int h, int rb, char* lds)
{
    const int tid = get_tid(), lane = tid & 63, wid = tid >> 6, r = lane & 31, h5 = lane >> 5;
    const bf16_t* PR = (const bf16_t*)(p->ws + WS_PROJ);
    const size_t R0 = (size_t)bl * LTOK + rb * 128;
    const float lgf = log_sigmoidf(p->ret_logit[(l * 2 + 0) * 4 + h]) * 1.4426950408889634f, lgb = log_sigmoidf(p->ret_logit[(l * 2 + 1) * 4 + h]) * 1.4426950408889634f;
    char* KF = lds; char* KBk = lds + 128 * RT_PT; char* VV = lds + 2 * 128 * RT_PT;
    __syncthreads();
#pragma unroll
    for (int q = 0; q < 2; ++q) {
        const int c = tid + 512 * q, row = c >> 3, cc = c & 7;
        const u32x4 kw = *(const u32x4*)(PR + (R0 + row) * PLD + C_RK + h * 64 + cc * 8), vw = *(const u32x4*)(PR + (R0 + row) * PLD + C_RV + h * 64 + cc * 8);
        const float wf = 0.125f * __builtin_amdgcn_exp2f(lgf * (float)(127 - row)), wb = 0.125f * __builtin_amdgcn_exp2f(lgb * (float)row);
        u32x4 of, ob;
#pragma unroll
        for (int j = 0; j < 4; ++j) { const float lo = bflo(kw[j]), hi = bfhi(kw[j]); of[j] = pack_bf16(lo * wf, hi * wf); ob[j] = pack_bf16(lo * wb, hi * wb); }
        *(u32x4*)(KF + row * RT_PT + cc * 16) = of; *(u32x4*)(KBk + row * RT_PT + cc * 16) = ob; *(u32x4*)(VV + row * RT_PT + cc * 16) = vw;
    }
    __syncthreads();
    const int dir = wid >> 2, dt = (wid >> 1) & 1, et = wid & 1;
    const char* Ks = dir ? KBk : KF;
    f32x16 acc;
#pragma unroll
    for (int i = 0; i < 16; ++i) acc[i] = 0.f;
#pragma unroll
    for (int s2 = 0; s2 < 8; ++s2) {
        const bf16x8 af = tr_frag_nat(Ks, RT_PT, 16 * s2, dt * 32, lane), bfv = tr_frag_nat(VV, RT_PT, 16 * s2, et * 32, lane);
        acc = __builtin_amdgcn_mfma_f32_32x32x16_bf16(af, bfv, acc, 0, 0, 0);
    }
    const int j = dir ? ret_jb(rb) : rb;
    float* dst = ((float*)(p->ws + WS_RKV)) + ((((size_t)bl * 4 + h) * 2 + dir) * 34 + j) * 4096 + et * 32 + r;
#pragma unroll
    for (int i = 0; i < 16; ++i) dst[(dt * 32 + (i & 3) + 8 * (i >> 2) + 4 * h5) * 64] = acc[i];
}

__device__ __forceinline__ void phase_p3a(KP p, int l, int bid, int nblk, char* lds)
{
    gemm_phase(((bf16_t*)(p->ws + WS_PROJ)) + C_CQ, PLD, ((bf16_t*)(p->ws + WS_WUQT)) + (size_t)l * 384 * 256, 256, TG, 384, 256, EpiStore{((bf16_t*)(p->ws + WS_QRAW)), 384}, lds, bid, nblk);
    gemm_phase(((bf16_t*)(p->ws + WS_PROJ)) + C_CKV, PLD, ((bf16_t*)(p->ws + WS_WUKVT)) + (size_t)l * 512 * 128, 128, TG, 512, 128, EpiStore{((bf16_t*)(p->ws + WS_KVRAW)), 512}, lds, bid, nblk);
    for (int u = bid; u < NB * 4 * 34; u += nblk) { const int rb = u % 34, h = (u / 34) & 3, bl = u / 136; ret_kv_unit(p, l, bl, h, rb, lds); }
}

#define LOG2_THETA 13.287712379549449f
__device__ __forceinline__ float rope_freq(int i, int half) { return exp2f(-LOG2_THETA * (float)i / (float)half); }

__device__ __forceinline__ void phase_p3b(KP p, int l, int bid, int nblk)
{
    {
        const int gt = bid * NTHREADS + get_tid();
        for (int it = gt; it < NB * 4 * 2 * 1024; it += nblk * NTHREADS) {
            const int e4 = it & 1023, bhd = it >> 10, dir = bhd & 1, h = (bhd >> 1) & 3;
            const float dec = __builtin_amdgcn_exp2f(log_sigmoidf(p->ret_logit[(l * 2 + dir) * 4 + h]) * 1.4426950408889634f * 128.f);
            f32x4* base = (f32x4*)((float*)(p->ws + WS_RKV) + (size_t)bhd * 34 * 4096) + e4;
            f32x4 st = (f32x4){0.f, 0.f, 0.f, 0.f};
            f32x4 kv[34];
#pragma unroll
            for (int j = 0; j < 34; ++j) kv[j] = base[(size_t)j * 1024];
#pragma unroll
            for (int j = 0; j < 34; ++j) { base[(size_t)j * 1024] = st; st = st * dec + kv[j]; }
        }
    }
    const int lane = get_tid() & 63, wid = get_tid() >> 6;
    const float mla_scale = 0.10206207261596575f * 1.4426950408889634f;
    auto load_row = [&](unsigned (&rw)[40], int r) {
        const bf16_t* pr = ((bf16_t*)(p->ws + WS_PROJ)) + (size_t)r * PLD;
        const bf16_t* qraw = ((bf16_t*)(p->ws + WS_QRAW)) + (size_t)r * 384;
        const bf16_t* kvraw = ((bf16_t*)(p->ws + WS_KVRAW)) + (size_t)r * 512;
#pragma unroll
        for (int i = 0; i < 4; ++i) rw[i] = pr[C_CQ + lane + 64 * i];
#pragma unroll
        for (int i = 0; i < 2; ++i) rw[4 + i] = pr[C_CKV + lane + 64 * i];
#pragma unroll
        for (int i = 0; i < 6; ++i) {
            const int idx = lane + 64 * i, h = idx / 96, d = idx % 96, dd = d >= 64 ? d - 64 : 0;
            rw[6 + i] = qraw[idx];
            rw[12 + i] = qraw[(unsigned)(d >= 64 ? idx - dd + (dd ^ 8) : idx)];
            rw[18 + i] = d < 64 ? kvraw[h * 128 + d] : pr[C_KPE + dd];
            rw[24 + i] = pr[C_KPE + (unsigned)(dd ^ 8)];
        }
#pragma unroll
        for (int i = 0; i < 4; ++i) { const int idx = lane + 64 * i, h = idx >> 6, e = idx & 63; rw[30 + i] = kvraw[h * 128 + 64 + e]; }
#pragma unroll
        for (int hh = 0; hh < 6; ++hh) rw[34 + hh] = pr[(hh < 4 ? C_GQ + hh * 64 : C_GK + (hh - 4) * 64) + lane];
    };
    auto proc_row = [&](const unsigned (&rw)[40], int r) {
        const int t = r % LTOK;
        const bool lat = t >= CTXL;
        const float prow = lat ? (float)((t - CTXL) >> 6) : 0.f, pcol = lat ? (float)((t - CTXL) & 63) : 0.f;
        float sq = 0.f, skv = 0.f;
#pragma unroll
        for (int i = 0; i < 4; ++i) { const float v = bf2f((bf16_t)rw[i]); sq += v * v; }
#pragma unroll
        for (int i = 0; i < 2; ++i) { const float v = bf2f((bf16_t)rw[4 + i]); skv += v * v; }
        sq = wave_sum(sq); skv = wave_sum(skv);
        const float rq = rsqrtf(sq * (1.f / 256.f) + EPSF), rkv = rsqrtf(skv * (1.f / 128.f) + EPSF);
#pragma unroll
        for (int i = 0; i < 6; ++i) {
            const int idx = lane + 64 * i, d = idx % 96;
            float qv = bf2f((bf16_t)rw[6 + i]), kv = bf2f((bf16_t)rw[18 + i]);
            if (d < 64) kv *= rkv;
            else if (lat) {
                const int dd = d - 64, blk = dd >> 4, w = dd & 15, fi = w & 7; const bool first = w < 8;
                const float rev = (blk ? pcol : prow) * rope_freq(fi, 8) * 0.15915494309189535f; const float sn = __builtin_amdgcn_sinf(rev), cs = __builtin_amdgcn_cosf(rev);
                const float qo = bf2f((bf16_t)rw[12 + i]), ko = bf2f((bf16_t)rw[24 + i]);
                qv = first ? (qv * cs - qo * sn) : (qo * sn + qv * cs);
                kv = first ? (kv * cs - ko * sn) : (ko * sn + kv * cs);
            }
            ((bf16_t*)(p->ws + WS_QA))[(size_t)r * 384 + idx] = f2bf(qv * rq * mla_scale);
            ((bf16_t*)(p->ws + WS_KA))[(size_t)r * 384 + idx] = f2bf(kv);
        }
#pragma unroll
        for (int i = 0; i < 4; ++i) ((bf16_t*)(p->ws + WS_VA))[(size_t)r * 256 + lane + 64 * i] = f2bf(bf2f((bf16_t)rw[30 + i]) * rkv);
        const int blk = lane >> 5, w = lane & 31, fi = w & 15; const bool first = w < 16;
        float sn = 0.f, cs = 1.f;
        if (lat) { const float rev = (blk ? pcol : prow) * rope_freq(fi, 16) * 0.15915494309189535f; sn = __builtin_amdgcn_sinf(rev); cs = __builtin_amdgcn_cosf(rev); }
        const float nwq = p->gqa_qn[l * 64 + lane], nwk = p->gqa_kn[l * 64 + lane];
#pragma unroll
        for (int hh = 0; hh < 6; ++hh) {
            const bool isq = hh < 4;
            const float v = bf2f((bf16_t)rw[34 + hh]);
            const float ss = wave_sum(v * v);
            const float n = v * rsqrtf(ss * (1.f / 64.f) + EPSF) * (isq ? nwq : nwk);
            const float other = xor_swz<16>(n);
            float val = n;
            if (lat) val = first ? (n * cs - other * sn) : (other * sn + n * cs);
            if (isq) ((bf16_t*)(p->ws + WS_GQ))[(size_t)r * 256 + hh * 64 + lane] = f2bf(val * (0.125f * 1.4426950408889634f));
            else ((bf16_t*)(p->ws + WS_GK))[(size_t)r * 128 + (hh - 4) * 64 + lane] = f2bf(val);
        }
    };
    const int rstep = nblk * 8;
    int r = bid * 8 + wid;
    if (r < TG) {
        unsigned ra[40], rb[40];
        load_row(ra, r);
        for (;;) {
            const bool m1 = r + rstep < TG;
            if (m1) load_row(rb, r + rstep);
            proc_row(ra, r);
            if (!m1) break;
            r += rstep;
            const bool m2 = r + rstep < TG;
            if (m2) load_row(ra, r + rstep);
            proc_row(rb, r);
            if (!m2) break;
            r += rstep;
        }
    }
}

template <int DQ>
__device__ __forceinline__ void attn_unit(const bf16_t* __restrict__ Qb, int qld, const bf16_t* __restrict__ Kb, int kld, const bf16_t* __restrict__ Vb, int vld,
                                          int nq, int nk, bf16_t* __restrict__ Ob, int old_, char* lds)
{
    constexpr int NS = DQ / 16, CPR = DQ / 8, KP = DQ * 2 + 16, VP = 144, KB = 64 * KP, VB = 64 * VP, STG = KB + VB, KCH = 64 * CPR;
    const int tid = get_tid(), lane = tid & 63, wid = tid >> 6, r = lane & 31, h = lane >> 5;
    int qrow[2]; bool qvalid[2];
    bf16x8 qf[2][NS];
#pragma unroll
    for (int qb = 0; qb < 2; ++qb) {
        qrow[qb] = wid * 64 + qb * 32 + r; qvalid[qb] = qrow[qb] < nq; if (!qvalid[qb]) qrow[qb] = 0;
#pragma unroll
        for (int s2 = 0; s2 < NS; ++s2) qf[qb][s2] = *(const bf16x8*)(Qb + (size_t)qrow[qb] * qld + 16 * s2 + 8 * h);
    }
    f32x16 o0[2], o1[2];
    float m[2] = {0.f, 0.f}, l[2] = {0.f, 0.f};
#pragma unroll
    for (int qb = 0; qb < 2; ++qb)
#pragma unroll
        for (int i = 0; i < 16; ++i) { o0[qb][i] = 0.f; o1[qb][i] = 0.f; }
    const int kr0 = tid / CPR, kc0 = tid % CPR, kr1 = (tid + 512) / CPR, kc1 = (tid + 512) % CPR; const bool k1 = (tid + 512) < KCH;
    const int vr = tid >> 3, vc = tid & 7;
    const bf16_t* kg0 = Kb + (size_t)kr0 * kld + kc0 * 8; const bf16_t* kg1 = Kb + (size_t)kr1 * kld + kc1 * 8; const bf16_t* vg = Vb + (size_t)vr * vld + vc * 8;
    const int kl0 = kr0 * KP + kc0 * 16, kl1 = kr1 * KP + kc1 * 16, vl = KB + vr * VP + vc * 16;
    u32x4 rk0, rk1 = (u32x4){0u, 0u, 0u, 0u}, rv;
    rk0 = *(const u32x4*)kg0; if (k1) rk1 = *(const u32x4*)kg1; rv = *(const u32x4*)vg;
    __syncthreads();
    *(u32x4*)(lds + kl0) = rk0; if (k1) *(u32x4*)(lds + kl1) = rk1; *(u32x4*)(lds + vl) = rv;
    __syncthreads();
    const int i16 = lane & 15, blk = (lane >> 4) & 1, q4 = i16 >> 2, p4 = i16 & 3;
    const int koff = r * KP + 16 * h, voff = KB + (4 * h + q4) * VP + 32 * blk + 8 * p4;
    const int nt = nk >> 6;
    for (int kt = 0; kt < nt; ++kt) {
        const int cur = (kt & 1) * STG, nxt = ((kt + 1) & 1) * STG;
        const bool more = kt + 1 < nt;
        if (more) {
            const size_t adv = (size_t)(kt + 1) * 64;
            rk0 = *(const u32x4*)(kg0 + adv * kld); if (k1) rk1 = *(const u32x4*)(kg1 + adv * kld); rv = *(const u32x4*)(vg + adv * vld);
        }
#pragma unroll
        for (int sub = 0; sub < 2; ++sub) {
            f32x16 sq[2];
#pragma unroll
            for (int i = 0; i < 16; ++i) { sq[0][i] = 0.f; sq[1][i] = 0.f; }
#pragma unroll
            for (int g0 = 0; g0 < NS; g0 += 4) {
                bf16x8 kfr[4];
#pragma unroll
                for (int s2 = 0; s2 < 4; ++s2) if (g0 + s2 < NS) kfr[s2] = *(const bf16x8*)(lds + cur + koff + sub * 32 * KP + (g0 + s2) * 32);
#pragma unroll
                for (int s2 = 0; s2 < 4; ++s2) if (g0 + s2 < NS) {
                    sq[0] = __builtin_amdgcn_mfma_f32_32x32x16_bf16(kfr[s2], qf[0][g0 + s2], sq[0], 0, 0, 0);
                    sq[1] = __builtin_amdgcn_mfma_f32_32x32x16_bf16(kfr[s2], qf[1][g0 + s2], sq[1], 0, 0, 0);
                }
            }
            bf16x8 vfr[2][2];
#pragma unroll
            for (int s2 = 0; s2 < 1; ++s2) {
                const int vb = cur + voff + (sub * 32 + 16 * s2) * VP;
                const s16x4 lo0 = __builtin_amdgcn_ds_read_tr16_b64_v4i16((LAS s16x4*)(lds + vb));
                const s16x4 hi0 = __builtin_amdgcn_ds_read_tr16_b64_v4i16((LAS s16x4*)(lds + vb + 8 * VP));
                const s16x4 lo1 = __builtin_amdgcn_ds_read_tr16_b64_v4i16((LAS s16x4*)(lds + vb + 64));
                const s16x4 hi1 = __builtin_amdgcn_ds_read_tr16_b64_v4i16((LAS s16x4*)(lds + vb + 8 * VP + 64));
                vfr[s2][0] = __builtin_shufflevector(lo0, hi0, 0, 1, 2, 3, 4, 5, 6, 7); vfr[s2][1] = __builtin_shufflevector(lo1, hi1, 0, 1, 2, 3, 4, 5, 6, 7);
            }
            bf16x8 pf[2][2];
#pragma unroll
            for (int qb = 0; qb < 2; ++qb) {
                f32x16& st = sq[qb];
                if (__builtin_amdgcn_ballot_w64(m[qb] != 0.f) != 0ull) {
#pragma unroll
                    for (int i = 0; i < 16; ++i) st[i] -= m[qb];
                }
                float mx = fmaxf(st[0], st[1]);
#pragma unroll
                for (int i = 2; i < 16; i += 2) mx = fmaxf(fmaxf(mx, st[i]), st[i + 1]);
                { const u32x2 sw = __builtin_amdgcn_permlane32_swap(__float_as_uint(mx), __float_as_uint(mx), false, false); mx = fmaxf(__uint_as_float(sw.x), __uint_as_float(sw.y)); }
                const bool first = (kt == 0) && (sub == 0);
                const bool mv = mx > 24.f || (first && mx < -24.f);
                if (__builtin_amdgcn_ballot_w64(mv) != 0ull) {
                    const float dlt = mv ? mx : 0.f, alpha = __builtin_amdgcn_exp2f(-dlt);
                    m[qb] += dlt; l[qb] *= alpha;
#pragma unroll
                    for (int i = 0; i < 16; ++i) { st[i] -= dlt; o0[qb][i] *= alpha; o1[qb][i] *= alpha; }
                }
                f32x2 rs2 = (f32x2){0.f, 0.f};
#pragma unroll
                for (int i = 0; i < 16; i += 2) { st[i] = __builtin_amdgcn_exp2f(st[i]); st[i + 1] = __builtin_amdgcn_exp2f(st[i + 1]); rs2 += (f32x2){st[i], st[i + 1]}; }
                l[qb] += rs2.x + rs2.y;
                u32x4 pw0, pw1;
                pw0.x = pack_bf16(st[0], st[1]); pw0.y = pack_bf16(st[2], st[3]); pw0.z = pack_bf16(st[4], st[5]); pw0.w = pack_bf16(st[6], st[7]);
                pw1.x = pack_bf16(st[8], st[9]); pw1.y = pack_bf16(st[10], st[11]); pw1.z = pack_bf16(st[12], st[13]); pw1.w = pack_bf16(st[14], st[15]);
                pf[qb][0] = __builtin_bit_cast(bf16x8, pw0); pf[qb][1] = __builtin_bit_cast(bf16x8, pw1);
            }
            {
                const int vb = cur + voff + (sub * 32 + 16) * VP;
                const s16x4 lo0 = __builtin_amdgcn_ds_read_tr16_b64_v4i16((LAS s16x4*)(lds + vb));
                const s16x4 hi0 = __builtin_amdgcn_ds_read_tr16_b64_v4i16((LAS s16x4*)(lds + vb + 8 * VP));
                const s16x4 lo1 = __builtin_amdgcn_ds_read_tr16_b64_v4i16((LAS s16x4*)(lds + vb + 64));
                const s16x4 hi1 = __builtin_amdgcn_ds_read_tr16_b64_v4i16((LAS s16x4*)(lds + vb + 8 * VP + 64));
                vfr[1][0] = __builtin_shufflevector(lo0, hi0, 0, 1, 2, 3, 4, 5, 6, 7); vfr[1][1] = __builtin_shufflevector(lo1, hi1, 0, 1, 2, 3, 4, 5, 6, 7);
            }
#pragma unroll
            for (int s2 = 0; s2 < 2; ++s2)
#pragma unroll
                for (int qb = 0; qb < 2; ++qb) {
                    o0[qb] = __builtin_amdgcn_mfma_f32_32x32x16_bf16(vfr[s2][0], pf[qb][s2], o0[qb], 0, 0, 0);
                    o1[qb] = __builtin_amdgcn_mfma_f32_32x32x16_bf16(vfr[s2][1], pf[qb][s2], o1[qb], 0, 0, 0);
                }
        }
        if (more) { *(u32x4*)(lds + nxt + kl0) = rk0; if (k1) *(u32x4*)(lds + nxt + kl1) = rk1; *(u32x4*)(lds + nxt + vl) = rv; }
        __syncthreads();
    }
#pragma unroll
    for (int qb = 0; qb < 2; ++qb) {
        float lt = sum_xor32(l[qb]);
        if (qvalid[qb]) {
            const float inv = 1.f / lt;
            bf16_t* op = Ob + (size_t)qrow[qb] * old_ + 4 * h;
#pragma unroll
            for (int g4 = 0; g4 < 4; ++g4) {
                store_bf16x4(op + 8 * g4, (f32x4){o0[qb][4 * g4] * inv, o0[qb][4 * g4 + 1] * inv, o0[qb][4 * g4 + 2] * inv, o0[qb][4 * g4 + 3] * inv});
                store_bf16x4(op + 32 + 8 * g4, (f32x4){o1[qb][4 * g4] * inv, o1[qb][4 * g4 + 1] * inv, o1[qb][4 * g4 + 2] * inv, o1[qb][4 * g4 + 3] * inv});
            }
        }
    }
}

__device__ __forceinline__ void ld8(const bf16_t* p, float (&o)[8]) {
    const u32x4 w = *(const u32x4*)p;
    o[0] = bflo(w.x); o[1] = bfhi(w.x); o[2] = bflo(w.y); o[3] = bfhi(w.y); o[4] = bflo(w.z); o[5] = bfhi(w.z); o[6] = bflo(w.w); o[7] = bfhi(w.w);
}

__device__ __forceinline__ void na_unit(KP p, int l, int bl, int h, int rg, char* lds)
{
    constexpr int KP_ = 144, VP = 144, KB = 64 * KP_, VB = 64 * VP, STG = KB + VB, LBIAS = 2 * STG;
    const int tid = get_tid(), lane = tid & 63, wid = tid >> 6, r = lane & 31, h5 = lane >> 5;
    const bf16_t* PR = (const bf16_t*)(p->ws + WS_PROJ);
    const size_t Rb = (size_t)bl * LTOK;
    const int grow = rg * 4 + (wid >> 1), c = (wid & 1) * 32 + r;
    const int rs = min(max(grow - 4, 0), 56), cs = min(max(c - 8, 0), 48);
    const int Rlo = min(max(rg * 4 - 4, 0), 56), Rhi = min(max(rg * 4 + 3 - 4, 0), 56) + 7, nrow = Rhi - Rlo + 1, nt = nrow + 4;
    const size_t qrow = Rb + CTXL + (size_t)grow * 64 + c;
    bf16x8 qf[4];
#pragma unroll
    for (int s2 = 0; s2 < 4; ++s2) qf[s2] = *(const bf16x8*)(PR + qrow * PLD + C_NQ + h * 64 + 16 * s2 + 8 * h5);
    f32x16 o0, o1;
#pragma unroll
    for (int i = 0; i < 16; ++i) { o0[i] = 0.f; o1[i] = 0.f; }
    float m = -1e30f, lsum = 0.f;
    const int kr = tid >> 3, kc = tid & 7;
    const int kl = kr * KP_ + kc * 16, vl = KB + kr * VP + kc * 16;
    auto tile_row = [&](int t) -> size_t { return t < nrow ? Rb + CTXL + (size_t)(Rlo + t) * 64 : Rb + (size_t)(t - nrow) * 64; };
    u32x4 rk, rv;
    { const size_t R = tile_row(0) + kr; rk = *(const u32x4*)(PR + R * PLD + C_NK + h * 64 + kc * 8); rv = *(const u32x4*)(PR + R * PLD + C_NV + h * 64 + kc * 8); }
    __syncthreads();
    *(u32x4*)(lds + kl) = rk; *(u32x4*)(lds + vl) = rv;
    { float* sb = (float*)(lds + LBIAS); const float* bias = p->na_bias + ((size_t)l * 4 + h) * 465; if (tid < 465) sb[tid] = bias[tid] * 1.4426950408889634f; }
    __syncthreads();
    const float* sb = (const float*)(lds + LBIAS);
    const int i16 = lane & 15, blk = (lane >> 4) & 1, q4 = i16 >> 2, p4 = i16 & 3;
    const int koff = r * KP_ + 16 * h5, voff = KB + (4 * h5 + q4) * VP + 32 * blk + 8 * p4;
    for (int t = 0; t < nt; ++t) {
        const int cur = (t & 1) * STG, nxt = ((t + 1) & 1) * STG;
        const bool more = t + 1 < nt;
        if (more) { const size_t R = tile_row(t + 1) + kr; rk = *(const u32x4*)(PR + R * PLD + C_NK + h * 64 + kc * 8); rv = *(const u32x4*)(PR + R * PLD + C_NV + h * 64 + kc * 8); }
        const bool win = t < nrow; const int R = Rlo + t;
        const bool mine = !win || (R >= rs && R <= rs + 7);
        if (mine) {
#pragma unroll
            for (int sub = 0; sub < 2; ++sub) {
                f32x16 st;
#pragma unroll
                for (int i = 0; i < 16; ++i) st[i] = 0.f;
#pragma unroll
                for (int s2 = 0; s2 < 4; ++s2) {
                    const bf16x8 kf = *(const bf16x8*)(lds + cur + koff + sub * 32 * KP_ + s2 * 32);
                    st = __builtin_amdgcn_mfma_f32_32x32x16_bf16(kf, qf[s2], st, 0, 0, 0);
                }
                if (win) {
                    const int brow = (R - grow + 7) * 31 + 15 - c;
#pragma unroll
                    for (int i = 0; i < 16; ++i) {
                        const int kcol = sub * 32 + (i & 3) + 8 * (i >> 2) + 4 * h5;
                        const bool ok = kcol >= cs && kcol < cs + 16;
                        const float bv = sb[ok ? brow + kcol : 0];
                        st[i] = ok ? st[i] + bv : -INFINITY;
                    }
                }
                float mx = fmaxf(st[0], st[1]);
#pragma unroll
                for (int i = 2; i < 16; i += 2) mx = fmaxf(fmaxf(mx, st[i]), st[i + 1]);
                mx = max_xor32(mx);
                const float mn = fmaxf(m, mx), alpha = __builtin_amdgcn_exp2f(m - mn);
                m = mn;
                f32x2 rs2 = (f32x2){0.f, 0.f};
#pragma unroll
                for (int i = 0; i < 16; i += 2) { st[i] = __builtin_amdgcn_exp2f(st[i] - mn); st[i + 1] = __builtin_amdgcn_exp2f(st[i + 1] - mn); rs2 += (f32x2){st[i], st[i + 1]}; }
                lsum = lsum * alpha + (rs2.x + rs2.y);
                if (__builtin_amdgcn_ballot_w64(alpha != 1.f) != 0ull) {
#pragma unroll
                    for (int i = 0; i < 16; ++i) { o0[i] *= alpha; o1[i] *= alpha; }
                }
                u32x4 pw0, pw1;
                pw0.x = pack_bf16(st[0], st[1]); pw0.y = pack_bf16(st[2], st[3]); pw0.z = pack_bf16(st[4], st[5]); pw0.w = pack_bf16(st[6], st[7]);
                pw1.x = pack_bf16(st[8], st[9]); pw1.y = pack_bf16(st[10], st[11]); pw1.z = pack_bf16(st[12], st[13]); pw1.w = pack_bf16(st[14], st[15]);
                const bf16x8 pf0 = __builtin_bit_cast(bf16x8, pw0), pf1 = __builtin_bit_cast(bf16x8, pw1);
#pragma unroll
                for (int s2 = 0; s2 < 2; ++s2) {
                    const int vb = cur + voff + (sub * 32 + 16 * s2) * VP;
                    const s16x4 lo0 = __builtin_amdgcn_ds_read_tr16_b64_v4i16((LAS s16x4*)(lds + vb));
                    const s16x4 hi0 = __builtin_amdgcn_ds_read_tr16_b64_v4i16((LAS s16x4*)(lds + vb + 8 * VP));
                    const s16x4 lo1 = __builtin_amdgcn_ds_read_tr16_b64_v4i16((LAS s16x4*)(lds + vb + 64));
                    const s16x4 hi1 = __builtin_amdgcn_ds_read_tr16_b64_v4i16((LAS s16x4*)(lds + vb + 8 * VP + 64));
                    const bf16x8 vf0 = __builtin_shufflevector(lo0, hi0, 0, 1, 2, 3, 4, 5, 6, 7), vf1 = __builtin_shufflevector(lo1, hi1, 0, 1, 2, 3, 4, 5, 6, 7);
                    o0 = __builtin_amdgcn_mfma_f32_32x32x16_bf16(vf0, s2 ? pf1 : pf0, o0, 0, 0, 0);
                    o1 = __builtin_amdgcn_mfma_f32_32x32x16_bf16(vf1, s2 ? pf1 : pf0, o1, 0, 0, 0);
                }
            }
        }
        if (more) { *(u32x4*)(lds + nxt + kl) = rk; *(u32x4*)(lds + nxt + vl) = rv; }
        __syncthreads();
    }
    lsum = sum_xor32(lsum);
    const float inv = 1.f / lsum;
    bf16_t* op = ((bf16_t*)(p->ws + WS_OUTS)) + ((size_t)2 * TG + qrow) * 256 + h * 64 + 4 * h5;
#pragma unroll
    for (int g4 = 0; g4 < 4; ++g4) {
        store_bf16x4(op + 8 * g4, (f32x4){o0[4 * g4] * inv, o0[4 * g4 + 1] * inv, o0[4 * g4 + 2] * inv, o0[4 * g4 + 3] * inv});
        store_bf16x4(op + 32 + 8 * g4, (f32x4){o1[4 * g4] * inv, o1[4 * g4 + 1] * inv, o1[4 * g4 + 2] * inv, o1[4 * g4 + 3] * inv});
    }
}

__device__ __forceinline__ void ret_out_unit(KP p, int l, int bl, int h, int rb, char* lds)
{
    const int tid = get_tid(), lane = tid & 63, wid = tid >> 6, r = lane & 31, h5 = lane >> 5;
    const bf16_t* PR = (const bf16_t*)(p->ws + WS_PROJ);
    const size_t R0 = (size_t)bl * LTOK + rb * 128;
    const float lgf = log_sigmoidf(p->ret_logit[(l * 2 + 0) * 4 + h]) * 1.4426950408889634f, lgb = log_sigmoidf(p->ret_logit[(l * 2 + 1) * 4 + h]) * 1.4426950408889634f;
    char* KK = lds; char* VV = lds + 128 * RT_PT; char* SS = lds + 2 * 128 * RT_PT;
    float* YB = (float*)lds;
    __syncthreads();
#pragma unroll
    for (int q = 0; q < 2; ++q) {
        const int c = tid + 512 * q, row = c >> 3, cc = c & 7;
        const u32x4 kw = *(const u32x4*)(PR + (R0 + row) * PLD + C_RK + h * 64 + cc * 8), vw = *(const u32x4*)(PR + (R0 + row) * PLD + C_RV + h * 64 + cc * 8);
        u32x4 ok;
#pragma unroll
        for (int j = 0; j < 4; ++j) ok[j] = pack_bf16(bflo(kw[j]) * 0.125f, bfhi(kw[j]) * 0.125f);
        *(u32x4*)(KK + row * RT_PT + cc * 16) = ok; *(u32x4*)(VV + row * RT_PT + cc * 16) = vw;
    }
    {
        const int jf = rb, jb = ret_jb(rb);
#pragma unroll
        for (int q = 0; q < 2; ++q) {
            const int e = tid + 512 * q, dir = e >> 9, dk = (e >> 3) & 63, e0 = (e & 7) * 8, j = dir ? jb : jf;
            const float* src = ((float*)(p->ws + WS_RKV)) + ((((size_t)bl * 4 + h) * 2 + dir) * 34 + j) * 4096 + dk * 64 + e0;
            const f32x4 s0 = *(const f32x4*)src, s1 = *(const f32x4*)(src + 4);
            u32x4 o; o.x = pack_bf16(s0[0], s0[1]); o.y = pack_bf16(s0[2], s0[3]); o.z = pack_bf16(s1[0], s1[1]); o.w = pack_bf16(s1[2], s1[3]);
            *(u32x4*)(SS + (dir * 64 + dk) * RT_PT + e0 * 2) = o;
        }
    }
    __syncthreads();
    const int dir = wid >> 2, mt = wid & 3;
    const float lg = dir ? lgb : lgf;
    const int qi = mt * 32 + r;
    bf16x8 qf[4];
#pragma unroll
    for (int s2 = 0; s2 < 4; ++s2) qf[s2] = *(const bf16x8*)(PR + (R0 + qi) * PLD + C_RQ + h * 64 + 16 * s2 + 8 * h5);
    f32x16 o0, o1;
#pragma unroll
    for (int i = 0; i < 16; ++i) { o0[i] = 0.f; o1[i] = 0.f; }
    {
        const char* Sd = SS + dir * 64 * RT_PT;
#pragma unroll
        for (int s2 = 0; s2 < 4; ++s2) {
            const bf16x8 a0 = tr_frag_nat(Sd, RT_PT, 16 * s2, 0, lane), a1 = tr_frag_nat(Sd, RT_PT, 16 * s2, 32, lane);
            o0 = __builtin_amdgcn_mfma_f32_32x32x16_bf16(a0, qf[s2], o0, 0, 0, 0);
            o1 = __builtin_amdgcn_mfma_f32_32x32x16_bf16(a1, qf[s2], o1, 0, 0, 0);
        }
        const int pos = dir ? 127 - qi : qi;
        const float qd = __builtin_amdgcn_exp2f(lg * (float)(pos + 1));
#pragma unroll
        for (int i = 0; i < 16; ++i) { o0[i] *= qd; o1[i] *= qd; }
    }
    const int kt0 = dir ? mt : 0, kt1 = dir ? 3 : mt;
    for (int kt = kt0; kt <= kt1; ++kt) {
        f32x16 st;
#pragma unroll
        for (int i = 0; i < 16; ++i) st[i] = 0.f;
#pragma unroll
        for (int s2 = 0; s2 < 4; ++s2) {
            const bf16x8 kf = *(const bf16x8*)(KK + (kt * 32 + r) * RT_PT + s2 * 32 + 16 * h5);
            st = __builtin_amdgcn_mfma_f32_32x32x16_bf16(kf, qf[s2], st, 0, 0, 0);
        }
#pragma unroll
        for (int i = 0; i < 16; ++i) {
            const int ki = kt * 32 + (i & 3) + 8 * (i >> 2) + 4 * h5;
            const int diff = dir ? ki - qi : qi - ki;
            st[i] = diff >= 0 ? st[i] * __builtin_amdgcn_exp2f(lg * (float)diff) : 0.f;
        }
        u32x4 pw0, pw1;
        pw0.x = pack_bf16(st[0], st[1]); pw0.y = pack_bf16(st[2], st[3]); pw0.z = pack_bf16(st[4], st[5]); pw0.w = pack_bf16(st[6], st[7]);
        pw1.x = pack_bf16(st[8], st[9]); pw1.y = pack_bf16(st[10], st[11]); pw1.z = pack_bf16(st[12], st[13]); pw1.w = pack_bf16(st[14], st[15]);
        const bf16x8 pf0 = __builtin_bit_cast(bf16x8, pw0), pf1 = __builtin_bit_cast(bf16x8, pw1);
#pragma unroll
        for (int s2 = 0; s2 < 2; ++s2) {
            const bf16x8 v0 = tr_frag_acc(VV, RT_PT, kt * 32 + 16 * s2, 0, lane), v1 = tr_frag_acc(VV, RT_PT, kt * 32 + 16 * s2, 32, lane);
            o0 = __builtin_amdgcn_mfma_f32_32x32x16_bf16(v0, s2 ? pf1 : pf0, o0, 0, 0, 0);
            o1 = __builtin_amdgcn_mfma_f32_32x32x16_bf16(v1, s2 ? pf1 : pf0, o1, 0, 0, 0);
        }
    }
    float sm = 0.f;
#pragma unroll
    for (int i = 0; i < 16; ++i) sm += o0[i] + o1[i];
    sm = sum_xor32(sm);
    const float mu = sm * (1.f / 64.f);
    float vs = 0.f;
#pragma unroll
    for (int i = 0; i < 16; ++i) { const float a0 = o0[i] - mu, a1 = o1[i] - mu; vs += a0 * a0 + a1 * a1; }
    vs = sum_xor32(vs);
    const float rstd = rsqrtf(vs * (1.f / 64.f) + EPSF);
    const bf16_t* gp = PR + (R0 + qi) * PLD + (dir ? C_RGB : C_RGF) + h * 64 + 4 * h5;
    const float* gw = p->ret_gnw + l * 256 + h * 64 + 4 * h5;
    __syncthreads();
#pragma unroll
    for (int t = 0; t < 2; ++t)
#pragma unroll
        for (int g4 = 0; g4 < 4; ++g4) {
            const u32x2 gg = *(const u32x2*)(gp + 32 * t + 8 * g4); const f32x4 ww = *(const f32x4*)(gw + 32 * t + 8 * g4);
            const float g0 = bflo(gg.x), g1 = bfhi(gg.x), g2 = bflo(gg.y), g3 = bfhi(gg.y);
            f32x4 y;
            y[0] = ((t ? o1[4 * g4] : o0[4 * g4]) - mu) * rstd * ww[0] * siluf(g0);
            y[1] = ((t ? o1[4 * g4 + 1] : o0[4 * g4 + 1]) - mu) * rstd * ww[1] * siluf(g1);
            y[2] = ((t ? o1[4 * g4 + 2] : o0[4 * g4 + 2]) - mu) * rstd * ww[2] * siluf(g2);
            y[3] = ((t ? o1[4 * g4 + 3] : o0[4 * g4 + 3]) - mu) * rstd * ww[3] * siluf(g3);
            *(f32x4*)(YB + (dir * 128 + qi) * 68 + 32 * t + 8 * g4 + 4 * h5) = y;
        }
    __syncthreads();
#pragma unroll
    for (int q = 0; q < 2; ++q) {
        const int e = tid + 512 * q, row = e >> 3, c8 = (e & 7) * 8;
        const f32x4 a0 = *(const f32x4*)(YB + row * 68 + c8), a1 = *(const f32x4*)(YB + row * 68 + c8 + 4), b0 = *(const f32x4*)(YB + (128 + row) * 68 + c8), b1 = *(const f32x4*)(YB + (128 + row) * 68 + c8 + 4);
        u32x4 o; o.x = pack_bf16(a0[0] + b0[0], a0[1] + b0[1]); o.y = pack_bf16(a0[2] + b0[2], a0[3] + b0[3]); o.z = pack_bf16(a1[0] + b1[0], a1[1] + b1[1]); o.w = pack_bf16(a1[2] + b1[2], a1[3] + b1[3]);
        *(u32x4*)(((bf16_t*)(p->ws + WS_OUTS)) + ((size_t)3 * TG + R0 + row) * 256 + h * 64 + c8) = o;
    }
}

#define U_MLA (NB * 32)
#define U_GQA (NB * 32)
#define U_NA (NB * 64)
#define U_RET (NB * 136)
#define U_CTX (NB * 12)
__device__ __forceinline__ int wq_next(unsigned* counter, LAS unsigned* wq) {
    __syncthreads();
    if (get_tid() == 0) *wq = atomicAdd(counter, 1u);
    __syncthreads();
    return (int)*wq;
}
__device__ __forceinline__ void phase_p4(KP p, int l, int g, char* ldsc, int bid, int nblk)
{
    float* lds = (float*)ldsc;
    LAS unsigned* wq = (LAS unsigned*)(smem + 32);
    unsigned* counter = ((unsigned*)(p->ws + WS_CNT)) + (l * NGROUP + g) * 64 * 8;
    (void)bid; (void)nblk;
    for (;;) {
        const int u = wq_next(counter, wq); if (u >= U_MLA) break;
        const int qb = u & 7, h = (u >> 3) & 3, bl = u >> 5; const size_t Rb = (size_t)bl * LTOK, Rq = Rb + CTXL + qb * 512;
        attn_unit<96>(((bf16_t*)(p->ws + WS_QA)) + Rq * 384 + h * 96, 384, ((bf16_t*)(p->ws + WS_KA)) + Rb * 384 + h * 96, 384, ((bf16_t*)(p->ws + WS_VA)) + Rb * 256 + h * 64, 256, 512, LTOK, ((bf16_t*)(p->ws + WS_OUTS)) + ((size_t)0 * TG + Rq) * 256 + h * 64, 256, ldsc);
    }
    for (;;) {
        const int u = wq_next(counter + 64, wq); if (u >= U_GQA) break;
        const int qb = u & 7, h = (u >> 3) & 3, bl = u >> 5; const size_t Rb = (size_t)bl * LTOK, Rq = Rb + CTXL + qb * 512; const int kvh = h >> 1;
        attn_unit<64>(((bf16_t*)(p->ws + WS_GQ)) + Rq * 256 + h * 64, 256, ((bf16_t*)(p->ws + WS_GK)) + Rb * 128 + kvh * 64, 128, ((bf16_t*)(p->ws + WS_PROJ)) + Rb * PLD + C_GV + kvh * 64, PLD, 512, LTOK, ((bf16_t*)(p->ws + WS_OUTS)) + ((size_t)1 * TG + Rq) * 256 + h * 64, 256, ldsc);
    }
    for (;;) {
        const int u = wq_next(counter + 128, wq); if (u >= U_NA) break;
        na_unit(p, l, u >> 6, (u >> 4) & 3, u & 15, ldsc);
    }
    for (;;) {
        const int u = wq_next(counter + 192, wq); if (u >= U_RET) break;
        const int rb = u % 34, h = (u / 34) & 3, bl = u / 136; ret_out_unit(p, l, bl, h, rb, ldsc);
    }
    if (l == 0) {
        for (;;) {
            const int u = wq_next(counter + 256, wq); if (u >= NB * 4) break;
            const int h = u & 3, bl = u >> 2; const size_t Rb = (size_t)bl * LTOK;
            attn_unit<96>(((bf16_t*)(p->ws + WS_QA)) + Rb * 384 + h * 96, 384, ((bf16_t*)(p->ws + WS_KA)) + Rb * 384 + h * 96, 384, ((bf16_t*)(p->ws + WS_VA)) + Rb * 256 + h * 64, 256, 256, CTXL, ((bf16_t*)(p->ws + WS_OUTS)) + ((size_t)0 * TG + Rb) * 256 + h * 64, 256, ldsc);
        }
        for (;;) {
            const int u = wq_next(counter + 320, wq); if (u >= NB * 8) break;
            const int ty = u & 1, h = (u >> 1) & 3, bl = u >> 3; const size_t Rb = (size_t)bl * LTOK;
            const bf16_t* Q = ty ? ((bf16_t*)(p->ws + WS_PROJ)) + Rb * PLD + C_NQ + h * 64 : ((bf16_t*)(p->ws + WS_GQ)) + Rb * 256 + h * 64;
            const bf16_t* K = ty ? ((bf16_t*)(p->ws + WS_PROJ)) + Rb * PLD + C_NK + h * 64 : ((bf16_t*)(p->ws + WS_GK)) + Rb * 128 + (h >> 1) * 64;
            const bf16_t* V = ty ? ((bf16_t*)(p->ws + WS_PROJ)) + Rb * PLD + C_NV + h * 64 : ((bf16_t*)(p->ws + WS_PROJ)) + Rb * PLD + C_GV + (h >> 1) * 64;
            attn_unit<64>(Q, ty ? PLD : 256, K, ty ? PLD : 128, V, PLD, 256, CTXL, ((bf16_t*)(p->ws + WS_OUTS)) + ((size_t)(1 + ty) * TG + Rb) * 256 + h * 64, 256, ldsc);
        }
    }
}

template <int MI>
__device__ __forceinline__ void p5_tile(KP p, int l, char* lds, int pm, int pn, int rsub)
{
    const int tid = get_tid(), lane = tid & 63, wid = tid >> 6, wm = wid >> 1, wn = wid & 1, fr = lane & 15, fq = lane >> 4;
    const int arow = tid >> 3, akc = tid & 7, a_l = arow * G_LDP + akc * 16;
    const int aoff = (wm * 16 * MI + fr) * G_LDP + fq * 16, boff = G_ABYTES + (wn * 64 + fr) * G_LDP + fq * 16;
    const bf16_t* OUTS = (const bf16_t*)(p->ws + WS_OUTS);
    const bf16_t* WB = (const bf16_t*)(p->ws + WS_WBT) + (size_t)l * 4 * DM * 256;
    const int rbase = pm * 256 + rsub;
    {
        const bf16_t* ag = OUTS + ((size_t)rbase + arow) * 256 + akc * 8;
        const bf16_t* bg = WB + ((size_t)pn * G_BN + arow) * 256 + akc * 8;
        const unsigned char* gp = (const unsigned char*)(p->ws + WS_GATE8) + (size_t)(rbase + wm * 16 * MI + fr) * 4096 + pn * G_BN + wn * 64 + fq * 16;
        f32x4 acc[MI][4]; zero_acc<MI>(acc);
        u32x2 totp[MI][4];
#pragma unroll
        for (int mi = 0; mi < MI; ++mi)
#pragma unroll
            for (int ni = 0; ni < 4; ++ni) totp[mi][ni] = (u32x2){0u, 0u};
        u32x4 sa[2][MI], sb[2][2];
        u32x4 gwv[MI];
#define P5_LOAD(SET, KT) do { const bf16_t* a2_ = ag + (size_t)((KT) >> 2) * TG * 256 + ((KT) & 3) * 64; const bf16_t* b2_ = bg + (size_t)((KT) >> 2) * DM * 256 + ((KT) & 3) * 64; \
            _Pragma("unroll") for (int i_ = 0; i_ < MI; ++i_) sa[SET][i_] = *(const u32x4*)(a2_ + (size_t)(64 * i_) * 256); \
            _Pragma("unroll") for (int i_ = 0; i_ < 2; ++i_) sb[SET][i_] = *(const u32x4*)(b2_ + (size_t)(64 * i_) * 256); } while (0)
#define P5_STORE(SET, BO) do { \
            _Pragma("unroll") for (int i_ = 0; i_ < MI; ++i_) *(u32x4*)(lds + (BO) + a_l + i_ * 64 * G_LDP) = sa[SET][i_]; \
            _Pragma("unroll") for (int i_ = 0; i_ < 2; ++i_) *(u32x4*)(lds + (BO) + G_ABYTES + a_l + i_ * 64 * G_LDP) = sb[SET][i_]; } while (0)
        P5_LOAD(0, 0);
        __syncthreads();
        P5_STORE(0, 0);
        P5_LOAD(0, 1); P5_LOAD(1, 2);
        __syncthreads();
#pragma unroll 1
        for (int sg = 0; sg < 4; ++sg) {
#pragma unroll
            for (int q4 = 0; q4 < 4; ++q4) {
                const int par = q4 & 1, kt = 4 * sg + q4, cur = par * G_STAGE, nxt = (par ^ 1) * G_STAGE;
#pragma unroll
                for (int ks = 0; ks < 2; ++ks) {
                    bf16x8 af[MI], bfr[4];
#pragma unroll
                    for (int mi = 0; mi < MI; ++mi) af[mi] = *(const bf16x8*)(lds + cur + aoff + mi * 16 * G_LDP + ks * 64);
#pragma unroll
                    for (int ni = 0; ni < 4; ++ni) bfr[ni] = *(const bf16x8*)(lds + cur + boff + ni * 16 * G_LDP + ks * 64);
#pragma unroll
                    for (int mi = 0; mi < MI; ++mi)
#pragma unroll
                        for (int ni = 0; ni < 4; ++ni) acc[mi][ni] = __builtin_amdgcn_mfma_f32_16x16x32_bf16(bfr[ni], af[mi], acc[mi][ni], 0, 0, 0);
                }
                if (q4 == 1) {
#pragma unroll
                    for (int mi = 0; mi < MI; ++mi)
                        gwv[mi] = *(const u32x4*)(gp + (size_t)(mi * 16) * 4096 + sg * DM);
                    __builtin_amdgcn_sched_barrier(0);
                }
                P5_STORE(par, nxt);
                { const int kn = (kt + 3 < 16) ? kt + 3 : 15; P5_LOAD(par, kn); }
                __syncthreads();
                if (q4 == 3) {
                    __builtin_amdgcn_sched_barrier(0);
#pragma unroll
                    for (int mi = 0; mi < MI; ++mi)
#pragma unroll
                        for (int ni = 0; ni < 4; ++ni) {
                            const unsigned gw = gwv[mi][ni];
                            const u32x2 tp = totp[mi][ni];
                            const float t0 = fmaf((float)((gw >> 0) & 255u), acc[mi][ni][0], bflo(tp.x)), t1 = fmaf((float)((gw >> 8) & 255u), acc[mi][ni][1], bfhi(tp.x));
                            const float t2 = fmaf((float)((gw >> 16) & 255u), acc[mi][ni][2], bflo(tp.y)), t3 = fmaf((float)((gw >> 24) & 255u), acc[mi][ni][3], bfhi(tp.y));
                            totp[mi][ni] = (u32x2){pack_bf16(t0, t1), pack_bf16(t2, t3)};
                            acc[mi][ni] = (f32x4){0.f, 0.f, 0.f, 0.f};
                        }
                }
            }
        }
#undef P5_LOAD
#undef P5_STORE
#pragma unroll
        for (int mi = 0; mi < MI; ++mi)
#pragma unroll
            for (int ni = 0; ni < 4; ++ni) {
                const u32x2 tp = totp[mi][ni]; const float k255 = 1.f / 255.f;
                *(u32x2*)(((bf16_t*)(p->ws + WS_ACC)) + (size_t)(rbase + wm * 16 * MI + mi * 16 + fr) * DM + pn * G_BN + wn * 64 + ni * 16 + fq * 4) =
                    (u32x2){pack_bf16(bflo(tp.x) * k255, bfhi(tp.x) * k255), pack_bf16(bflo(tp.y) * k255, bfhi(tp.y) * k255)};
            }
    }
}

__device__ __forceinline__ void phase_p5(KP p, int l, char* lds, int bid, int nblk)
{
    constexpr int tn = DM / G_BN, total = (TG / 256) * tn, NG8 = (TG / 256) / 8;
    const bool xord = (nblk == 256) && (tn == 8) && ((TG / 256) % 8 == 0);
    if (xord) {
        constexpr int NFULL = (NG8 % 4 == 1) ? NG8 / 4 : (NG8 + 3) / 4;
#pragma unroll 1
        for (int it = 0; it < NFULL; ++it) {
            const int g8 = it * 4 + (bid >> 6); if (g8 >= NG8) break;
            p5_tile<4>(p, l, lds, g8 * 8 + (bid & 7), (bid >> 3) & 7, 0);
        }
        if (NG8 % 4 == 1) p5_tile<1>(p, l, lds, (NG8 - 1) * 8 + (bid & 7), (bid >> 3) & 7, (bid >> 6) * 64);
    } else {
        for (int t = bid; t < total; t += nblk) p5_tile<4>(p, l, lds, t / tn, t % tn, 0);
    }
}

struct EpiResid {
    KP p; int l, g, goff;
    __device__ __forceinline__ void operator()(int row, int col, f32x4 v) const {
        const int bl = row / LTOK, t = row - bl * LTOK, b = g * NB + bl;
        float* dst; const float* src; int mr;
        if (t < CTXL) { if (l != 0) return; const size_t o = ((size_t)b * CTXL + t) * DM + col; dst = ((float*)(p->ws + WS_CTXS)) + o; src = p->ctx + o; mr = 16; }
        else { const size_t o = ((size_t)b * SEQ + (t - CTXL)) * DM + col; dst = p->out + o; src = (l == 0) ? p->x + o : (const float*)dst; mr = b; }
        const f32x4 gg = *(const f32x4*)(((float*)(p->ws + WS_MOD)) + ((size_t)l * 17 + mr) * 6144 + goff + col);
        f32x4 s = *(const f32x4*)src;
#pragma unroll
        for (int j = 0; j < 4; ++j) s[j] += gg[j] * v[j];
        *(f32x4*)dst = s;
    }
};

__device__ __forceinline__ void grid_barrier();
#if MK_ONE_LAUNCH
#define P9_GRID_SYNC() grid_barrier()
#else
#define P9_GRID_SYNC() __syncthreads()
#endif
typedef __bf16 bf16pair __attribute__((ext_vector_type(2)));
__device__ __forceinline__ float dot2bf(unsigned a, unsigned b, float c) { return __builtin_amdgcn_fdot2_f32_bf16(__builtin_bit_cast(bf16pair, a), __builtin_bit_cast(bf16pair, b), c, false); }
__device__ __forceinline__ unsigned f2ord(float f) { const unsigned b = __float_as_uint(f); return b ^ ((unsigned)((int)b >> 31) | 0x80000000u); }
__device__ __forceinline__ int mbcnt64(unsigned long long m) { return (int)__builtin_amdgcn_mbcnt_hi((unsigned)(m >> 32), __builtin_amdgcn_mbcnt_lo((unsigned)m, 0u)); }

__device__ __forceinline__ float ord2f(unsigned u) { return __uint_as_float((u & 0x80000000u) ? (u ^ 0x80000000u) : ~u); }

__device__ __forceinline__ void cx_desc(unsigned& a, unsigned& b) { const unsigned hi = a > b ? a : b, lo = a > b ? b : a; a = hi; b = lo; }
template <int N, int OFF, bool DESC, int M>
__device__ __forceinline__ void bitonic_sort(unsigned (&a)[M]) {
#pragma unroll
    for (int k = 2; k <= N; k <<= 1)
#pragma unroll
        for (int j = k >> 1; j > 0; j >>= 1)
#pragma unroll
            for (int i = 0; i < N; ++i) {
                const int l = i ^ j;
                if (l > i) { const bool up = ((i & k) == 0) != DESC; if (up) cx_desc(a[OFF + l], a[OFF + i]); else cx_desc(a[OFF + i], a[OFF + l]); }
            }
}
__device__ __forceinline__ void bitonic_merge16_desc(unsigned (&a)[16]) {
#pragma unroll
    for (int j = 8; j > 0; j >>= 1)
#pragma unroll
        for (int i = 0; i < 16; ++i) { const int l = i ^ j; if (l > i) cx_desc(a[i], a[l]); }
}
template <int XM>
__device__ __forceinline__ void merge_partner16(unsigned (&a)[16], bool upper) {
    unsigned b[16];
#pragma unroll
    for (int i = 0; i < 16; ++i) b[i] = (XM == 32) ? get_xor32_u(a[15 - i], upper) : xor_swz_u<XM & 31>(a[15 - i]);
#pragma unroll
    for (int i = 0; i < 16; ++i) a[i] = a[i] > b[i] ? a[i] : b[i];
    bitonic_merge16_desc(a);
}

#define P9_KEYP 144
#define P9_NTOK 136
#define P9_HG 3
#define P9_LKEY 0
#define P9_LIDX (P9_HG * 2 * 128 * P9_KEYP)
#define P9_LSTASH 0
__device__ __forceinline__ constexpr int p9_pair_i(int pi) {
    return pi < 16 ? 0 : pi < 24 ? 1 : pi < 29 ? 2 : pi < 33 ? 3 : pi < 36 ? 4 : pi < 38 ? 5 : pi < 40 ? 6 : pi < 42 ? 7 : pi < 50 ? pi - 34 : 0;
}
__device__ __forceinline__ constexpr int p9_pair_j(int pi) {
    return pi < 16 ? pi : pi < 24 ? pi - 16 : pi < 29 ? pi - 24 : pi < 33 ? pi - 29 : pi < 36 ? pi - 33 : pi < 38 ? pi - 36 : pi < 40 ? pi - 38 : pi < 42 ? pi - 40 : 0;
}
__device__ __forceinline__ void phase_p9(KP p, int l, int g, char* lds, int bid, int nblk)
{
    const int tid = get_tid(), wid = tid >> 6;
    const bf16_t* KEYB = (const bf16_t*)(p->ws + WS_KEYB) + (size_t)l * 8 * 2 * 128 * 64;
    const bf16_t* PQ = (const bf16_t*)(p->ws + WS_PQ);
    unsigned* stash = (unsigned*)(lds + P9_LSTASH);
    const int nit = (TG / P9_NTOK + nblk - 1) / nblk;
    for (int it = 0; it < nit; ++it) {
        const int blk = bid + it * nblk;
        if (blk >= TG / P9_NTOK) { P9_GRID_SYNC(); P9_GRID_SYNC(); continue; }
        const int row0 = blk * P9_NTOK;
        unsigned* gst = (unsigned*)(p->ws + WS_PROJ) + (size_t)row0 * 128;
#pragma unroll 1
        for (int h0 = 0; h0 < 8; h0 += P9_HG) {
            const int nh = (8 - h0) < P9_HG ? (8 - h0) : P9_HG;
            __syncthreads();
            for (int c = tid; c < nh * 2048; c += NTHREADS) { const int row = c >> 3, cc = c & 7;
                *(u32x4*)(lds + P9_LKEY + row * P9_KEYP + cc * 16) = *(const u32x4*)(KEYB + ((size_t)h0 * 256 + row) * 64 + cc * 8); }
            __syncthreads();
#pragma unroll 1
            for (int item = wid; item < 9 * nh; item += 8) {
                const int tile = item % 9, hh = item / 9, h = h0 + hh;
                const int LK = P9_LKEY + hh * 256 * P9_KEYP;
                const int tidh = get_tid(), tk = tidh & 15, qd = (tidh >> 4) & 3;
                const int ntile = (P9_NTOK - 16 * tile) < 16 ? (P9_NTOK - 16 * tile) : 16;
                const int trow = row0 + 16 * tile + (tk < ntile ? tk : ntile - 1);
                unsigned* idxl = (unsigned*)(lds + P9_LIDX) + (wid * 16 + tk) * 33;
                unsigned top[2][16];
#pragma unroll
                for (int pp = 0; pp < 2; ++pp) {
                    f32x4 acc[8];
#pragma unroll
                    for (int t = 0; t < 8; ++t) acc[t] = (f32x4){0.f, 0.f, 0.f, 0.f};
#pragma unroll
                    for (int ks = 0; ks < 2; ++ks) {
                        const bf16x8 qfr = *(const bf16x8*)(PQ + (size_t)trow * DM + h * 128 + pp * 64 + ks * 32 + qd * 8);
#pragma unroll
                        for (int t = 0; t < 8; ++t) {
                            const bf16x8 kfr = *(const bf16x8*)(lds + LK + (pp * 128 + t * 16 + tk) * P9_KEYP + ks * 64 + qd * 16);
                            acc[t] = __builtin_amdgcn_mfma_f32_16x16x32_bf16(kfr, qfr, acc[t], 0, 0, 0);
                        }
                    }
                    unsigned ck[32];
#pragma unroll
                    for (int t = 0; t < 8; ++t)
#pragma unroll
                        for (int jj = 0; jj < 4; ++jj) ck[t * 4 + jj] = (f2ord(acc[t][jj]) & 0xFFFFFF80u) | (unsigned)(16 * t + jj) | ((unsigned)qd << 2);
                    bitonic_sort<16, 0, true>(ck);
                    bitonic_sort<16, 16, false>(ck);
                    unsigned (&tp)[16] = top[pp];
#pragma unroll
                    for (int i = 0; i < 16; ++i) tp[i] = ck[i] > ck[16 + i] ? ck[i] : ck[16 + i];
                    bitonic_merge16_desc(tp);
                    merge_partner16<16>(tp, false); merge_partner16<32>(tp, (qd & 2) != 0);
                    if (qd == 0) {
#pragma unroll
                        for (int i = 0; i < 16; ++i) idxl[pp * 16 + i] = tp[i] & 127u;
                    }
                }
                float v1[16], v2[16];
#pragma unroll
                for (int i = 0; i < 16; ++i) { v1[i] = ord2f(top[0][i] & 0xFFFFFF80u); v2[i] = ord2f(top[1][i] & 0xFFFFFF80u); }
                unsigned cand[16];
#pragma unroll
                for (int n = 0; n < 13; ++n) {
                    const unsigned k0 = (f2ord(v1[p9_pair_i(4 * n)] + v2[p9_pair_j(4 * n)]) & 0xFFFFFF00u) | (unsigned)(p9_pair_i(4 * n) * 16 + p9_pair_j(4 * n));
                    const unsigned k1 = (f2ord(v1[p9_pair_i(4 * n + 1)] + v2[p9_pair_j(4 * n + 1)]) & 0xFFFFFF00u) | (unsigned)(p9_pair_i(4 * n + 1) * 16 + p9_pair_j(4 * n + 1));
                    const unsigned k2 = (4 * n + 2 < 50) ? ((f2ord(v1[p9_pair_i(4 * n + 2)] + v2[p9_pair_j(4 * n + 2)]) & 0xFFFFFF00u) | (unsigned)(p9_pair_i(4 * n + 2) * 16 + p9_pair_j(4 * n + 2))) : 0u;
                    const unsigned k3 = (4 * n + 3 < 50) ? ((f2ord(v1[p9_pair_i(4 * n + 3)] + v2[p9_pair_j(4 * n + 3)]) & 0xFFFFFF00u) | (unsigned)(p9_pair_i(4 * n + 3) * 16 + p9_pair_j(4 * n + 3))) : 0u;
                    cand[n] = qd == 0 ? k0 : (qd == 1 ? k1 : (qd == 2 ? k2 : k3));
                }
                cand[13] = 0u; cand[14] = 0u; cand[15] = 0u;
                bitonic_sort<16, 0, true>(cand);
                merge_partner16<16>(cand, false); merge_partner16<32>(cand, (qd & 2) != 0);
                const float mx = ord2f(cand[0] & 0xFFFFFF00u);
                float ex[16], den = 0.f;
#pragma unroll
                for (int k = 0; k < 16; ++k) { ex[k] = __expf(ord2f(cand[k] & 0xFFFFFF00u) - mx); den += ex[k]; }
                const float inv = 1.f / den;
                if (qd == 0 && tk < ntile) {
#pragma unroll
                    for (int k = 0; k < 16; ++k) {
                        const unsigned e = idxl[(cand[k] >> 4) & 15u] * 128u + idxl[16 + (cand[k] & 15u)];
                        gst[((16 * tile + tk) * 8 + h) * 16 + k] = (e << 16) | (unsigned)f2bf(ex[k] * inv);
                    }
                }
            }
        }
        P9_GRID_SYNC();
        {
            const u32x4* src = (const u32x4*)gst; u32x4* dstl = (u32x4*)(lds + P9_LSTASH);
            for (int c = get_tid(); c < P9_NTOK * 128 / 4; c += NTHREADS) dstl[c] = src[c];
            __syncthreads();
        }
        {
            const int tid2 = get_tid(), lane = tid2 & 63, wid2 = tid2 >> 6;
            KP p2 = get_kp();
            const unsigned char* UB = (const unsigned char*)(p2->ws + WS_UB) + (size_t)l * 16384 * (DM / 2);
            const float* USC = (const float*)(p2->ws + WS_USC) + (size_t)l * 16384; const float* VSC = (const float*)(p2->ws + WS_VSC) + (size_t)l * 16384;
            const bf16_t* Hh = HG(p2, g);
#pragma unroll 1
            for (int slot = wid2; slot < P9_NTOK; slot += 8) {
                const int r = row0 + slot;
                if ((r % LTOK) < CTXL && l != 0) continue;
                const u32x4 x0 = *(const u32x4*)(Hh + (size_t)r * DM + lane * 16), x1 = *(const u32x4*)(Hh + (size_t)r * DM + lane * 16 + 8);
#pragma unroll 1
                for (int h = 0; h < 8; ++h) {
                    unsigned* st = stash + (slot * 8 + h) * 16;
                    float d[16];
                    const int kk = (lane >> 2) & 15;
                    const unsigned sk = st[kk];
                    const float su = USC[sk >> 16], svs = VSC[sk >> 16];
                    {
                        u32x2 ua[16];
#pragma unroll
                        for (int k = 0; k < 16; ++k) ua[k] = *(const u32x2*)(UB + (size_t)(st[k] >> 16) * (DM / 2) + lane * 8);
#pragma unroll
                        for (int k = 0; k < 16; ++k) {
                            float a = 0.f;
#define P9_UDOT(XW, UW, B) { const unsigned xw_ = (XW); a = __builtin_amdgcn_fdot2_f32_bf16(__builtin_bit_cast(bf16pair, xw_), __builtin_amdgcn_cvt_scalef32_pk_bf16_fp4((UW), 1.0f, B), a, false); }
                            { const unsigned u0_ = ua[k].x, u1_ = ua[k].y;
                              P9_UDOT(x0.x, u0_, 0) P9_UDOT(x0.y, u0_, 1) P9_UDOT(x0.z, u0_, 2) P9_UDOT(x0.w, u0_, 3)
                              P9_UDOT(x1.x, u1_, 0) P9_UDOT(x1.y, u1_, 1) P9_UDOT(x1.z, u1_, 2) P9_UDOT(x1.w, u1_, 3) }
#undef P9_UDOT
                            d[k] = a;
                        }
                    }
                    float r8[8], r4[4], r2[2], r1;
#pragma unroll
                    for (int i = 0; i < 8; ++i) { const u32x2 sw = __builtin_amdgcn_permlane32_swap(__float_as_uint(d[i]), __float_as_uint(d[i + 8]), false, false); r8[i] = __uint_as_float(sw.x) + __uint_as_float(sw.y); }
#pragma unroll
                    for (int i = 0; i < 4; ++i) { const u32x2 sw = __builtin_amdgcn_permlane16_swap(__float_as_uint(r8[i]), __float_as_uint(r8[i + 4]), false, false); r4[i] = __uint_as_float(sw.x) + __uint_as_float(sw.y); }
                    { const bool bb = (lane & 8) != 0;
#pragma unroll
                      for (int i = 0; i < 2; ++i) { const float snd = bb ? r4[i] : r4[i + 2], keep = bb ? r4[i + 2] : r4[i]; r2[i] = keep + xor_swz<8>(snd); } }
                    { const bool bb = (lane & 4) != 0; const float snd = bb ? r2[0] : r2[1], keep = bb ? r2[1] : r2[0]; r1 = keep + xor_swz<4>(snd); }
                    r1 += xor_swz<2>(r1); r1 += xor_swz<1>(r1);
                    r1 *= su;
                    const float cf = bflo(sk) * 0.5f * r1 * (1.f + erff(r1 * 0.70710678118654752f)) * svs;
                    if ((lane & 3) == 0) st[kk] = (sk & 0xffff0000u) | (unsigned)f2bf(cf);
                }
            }
        }
        P9_GRID_SYNC();
        {
            const int tid2 = get_tid(), lane = tid2 & 63, wid2 = tid2 >> 6;
            KP p2 = get_kp();
            const unsigned char* VB = (const unsigned char*)(p2->ws + WS_VB) + (size_t)l * 16384 * (DM / 2);
#pragma unroll 1
            for (int slot = wid2; slot < P9_NTOK; slot += 8) {
                const int r = row0 + slot;
                const int bl = r / LTOK, t = r - bl * LTOK, b = g * NB + bl;
                if (t < CTXL && l != 0) continue;
                float* dst; int mr;
                if (t < CTXL) { dst = ((float*)(p2->ws + WS_CTXS)) + ((size_t)b * CTXL + t) * DM; mr = 16; } else { dst = p2->out + ((size_t)b * SEQ + (t - CTXL)) * DM; mr = b; }
                const float* g2 = ((float*)(p2->ws + WS_MOD)) + ((size_t)l * 17 + mr) * 6144 + 5120;
                f32x4 sv[4];
#pragma unroll
                for (int i = 0; i < 4; ++i) sv[i] = *(const f32x4*)(dst + lane * 16 + i * 4);
                float outv[16];
#pragma unroll
                for (int i = 0; i < 16; ++i) outv[i] = 0.f;
#pragma unroll 1
                for (int h = 0; h < 8; ++h) {
                    const unsigned* st = stash + (slot * 8 + h) * 16;
                    u32x2 va[16]; unsigned sk[16];
#pragma unroll
                    for (int k = 0; k < 16; ++k) { sk[k] = st[k]; va[k] = *(const u32x2*)(VB + (size_t)(sk[k] >> 16) * (DM / 2) + lane * 8); }
#pragma unroll
                    for (int k = 0; k < 16; ++k) {
                        const float ck = bflo(sk[k]);
#define P9_VFMA(W, B) { const f32x2 t_ = __builtin_amdgcn_cvt_scalef32_pk_f32_fp4(va[k][W], 1.0f, B); outv[8 * (W) + 2 * (B)] += ck * t_.x; outv[8 * (W) + 2 * (B) + 1] += ck * t_.y; }
                        P9_VFMA(0, 0) P9_VFMA(0, 1) P9_VFMA(0, 2) P9_VFMA(0, 3) P9_VFMA(1, 0) P9_VFMA(1, 1) P9_VFMA(1, 2) P9_VFMA(1, 3)
#undef P9_VFMA
                        if ((k & 3) == 3) __builtin_amdgcn_sched_barrier(0);
                    }
                }
                const int lane = get_tid() & 63;
                float ss = 0.f;
#pragma unroll
                for (int i = 0; i < 4; ++i) {
                    const f32x4 gg = *(const f32x4*)(g2 + lane * 16 + i * 4);
#pragma unroll
                    for (int jj = 0; jj < 4; ++jj) { sv[i][jj] += gg[jj] * outv[i * 4 + jj]; ss += sv[i][jj] * sv[i][jj]; }
                }
                if (l == 0) {
                    const float rstd0 = rsqrtf(wave_sum(ss) * (1.f / DM) + EPSF);
                    const float* md1 = ((float*)(p2->ws + WS_MOD)) + ((size_t)17 + mr) * 6144;
                    bf16_t* hrow = HG(p2, g) + (size_t)r * DM + lane * 16;
#pragma unroll
                    for (int i = 0; i < 4; ++i) {
                        const int c = lane * 16 + i * 4;
                        const f32x4 w1 = *(const f32x4*)(p2->norm1_w + DM + c), sc = *(const f32x4*)(md1 + 1024 + c), sh = *(const f32x4*)(md1 + c);
                        f32x4 y;
#pragma unroll
                        for (int jj = 0; jj < 4; ++jj) y[jj] = sv[i][jj] * rstd0 * w1[jj] * (1.f + sc[jj]) + sh[jj];
                        store_bf16x4(hrow + i * 4, y);
                    }
                }
                if (l == 1) {
                    ss = wave_sum(ss);
                    const float rstd = rsqrtf(ss * (1.f / DM) + EPSF);
#pragma unroll
                    for (int i = 0; i < 4; ++i) { const f32x4 fw = *(const f32x4*)(p2->final_w + lane * 16 + i * 4);
#pragma unroll
                        for (int jj = 0; jj < 4; ++jj) sv[i][jj] *= rstd * fw[jj]; }
                }
#pragma unroll
                for (int i = 0; i < 4; ++i) *(f32x4*)(dst + lane * 16 + i * 4) = sv[i];
            }
        }
    }
}

__device__ __forceinline__ void phase_final(KP p, int bid, int nblk)
{
    const int lane = get_tid() & 63, wid = get_tid() >> 6;
    for (int r = bid * 8 + wid; r < NBATCH * SEQ; r += nblk * 8) {
        float* src = p->out + (size_t)r * DM;
        f32x4 v[4]; float ss = 0.f;
#pragma unroll
        for (int i = 0; i < 4; ++i) { v[i] = *(const f32x4*)(src + i * 256 + lane * 4); ss += v[i][0] * v[i][0] + v[i][1] * v[i][1] + v[i][2] * v[i][2] + v[i][3] * v[i][3]; }
        ss = wave_sum(ss);
        const float rstd = rsqrtf(ss * (1.f / DM) + EPSF);
#pragma unroll
        for (int i = 0; i < 4; ++i) {
            const f32x4 w = *(const f32x4*)(p->final_w + i * 256 + lane * 4);
            f32x4 y;
#pragma unroll
            for (int j = 0; j < 4; ++j) y[j] = v[i][j] * rstd * w[j];
            *(f32x4*)(src + i * 256 + lane * 4) = y;
        }
    }
}

template <int PH>
__device__ __forceinline__ void run_phase(KP p, int l, int g, char* lds, int bid, int nblk)
{
    asm volatile("" : "+s"(l), "+s"(g), "+s"(bid), "+s"(nblk));
    if constexpr (PH == 0) phase_prologue(p, lds, bid, nblk);
    if constexpr (PH == 1) { for (int gg = 0; gg < NGROUP; ++gg) phase_norm(p, 0, gg, 0, bid, nblk); }
    if constexpr (PH == 2) big_gemm(HG(p, g), ((bf16_t*)(p->ws + WS_WINT)) + (size_t)l * NPROJ * DM, TG, NPROJ, DM, Epi8<EpiProj8>{EpiProj8{((bf16_t*)(p->ws + WS_PROJ)), (unsigned char*)(p->ws + WS_GATE8)}}, lds, bid, nblk);
    if constexpr (PH == 3) phase_p3a(p, l, bid, nblk, lds);
    if constexpr (PH == 4) phase_p3b(p, l, bid, nblk);
    if constexpr (PH == 6) phase_p4(p, l, g, lds, bid, nblk);
    if constexpr (PH == 7) phase_p5(p, l, lds, bid, nblk);
    if constexpr (PH == 8) big_gemm(((bf16_t*)(p->ws + WS_ACC)), ((bf16_t*)(p->ws + WS_WOUTT)) + (size_t)l * DM * DM, TG, DM, DM, Epi4<EpiResid>{EpiResid{p, l, g, 2048}}, lds, bid, nblk);
    if constexpr (PH == 9) phase_norm(p, l, g, 1, bid, nblk);
    if constexpr (PH == 10) big_gemm(HG(p, g), ((bf16_t*)(p->ws + WS_WQT)) + (size_t)l * DM * DM, TG, DM, DM, Epi8<EpiStore8>{EpiStore8{((bf16_t*)(p->ws + WS_PQ)), DM}}, lds, bid, nblk);
    if constexpr (PH == 11) phase_p9(p, l, g, lds, bid, nblk);
    if constexpr (PH == 12) phase_final(p, bid, nblk);
}


__device__ __forceinline__ void grid_barrier() {
    XcdBarrier b; b.bar = (unsigned*)(get_kp()->ws + WS_BAR); b.x = xb_xcc_id(); b.st = (volatile LAS unsigned*)smem;
    xcd_barrier(b);
}

template <int PH>
__global__ void __launch_bounds__(NTHREADS, 2) k_phase(Params p_unused, int l, int g)
{
    (void)p_unused;
    tid_setup();
    run_phase<PH>(get_kp(), l, g, smem + 512, blockIdx.x, gridDim.x);
}

#if MK_ONE_LAUNCH
__global__ void __launch_bounds__(NTHREADS, 2) k_mega(Params p_unused)
{
    (void)p_unused;
    tid_setup();
    if (get_tid() == 0) *(uint4*)smem = make_uint4(0u, 0u, 0u, 0u);
    __syncthreads();
    (void)xcd_barrier_post((unsigned*)(get_kp()->ws + WS_BAR), (volatile LAS unsigned*)smem);
    char* lds = smem + 512;
    const int bid = blockIdx.x, nblk = gridDim.x;
    run_phase<0>(get_kp(), 0, 0, lds, bid, nblk);
    grid_barrier();
#define MK_LG(L_, G_) do { \
        run_phase<2>(get_kp(), L_, G_, lds, bid, nblk); grid_barrier(); \
        run_phase<3>(get_kp(), L_, G_, lds, bid, nblk); grid_barrier(); \
        run_phase<4>(get_kp(), L_, G_, lds, bid, nblk); grid_barrier(); \
        run_phase<6>(get_kp(), L_, G_, lds, bid, nblk); grid_barrier(); \
        run_phase<7>(get_kp(), L_, G_, lds, bid, nblk); grid_barrier(); \
        run_phase<8>(get_kp(), L_, G_, lds, bid, nblk); grid_barrier(); \
        run_phase<9>(get_kp(), L_, G_, lds, bid, nblk); grid_barrier(); \
        run_phase<10>(get_kp(), L_, G_, lds, bid, nblk); grid_barrier(); \
        run_phase<11>(get_kp(), L_, G_, lds, bid, nblk); grid_barrier(); } while (0)
    run_phase<1>(get_kp(), 0, 0, lds, bid, nblk); grid_barrier();
    static_assert(NGROUP == 2, "phase program written out for two groups");
    MK_LG(0, 0); MK_LG(0, 1); MK_LG(1, 0); MK_LG(1, 1);
#undef MK_LG
}
#endif

static inline size_t al256(size_t x) { return (x + 255) & ~(size_t)255; }

template <int PH>
static void launch_phase(const Params& p, int l, int g, int grid, hipStream_t s)
{
    static bool attr = false;
    if (!attr) { (void)hipFuncSetAttribute((const void*)k_phase<PH>, hipFuncAttributeMaxDynamicSharedMemorySize, LDS_BYTES); attr = true; }
    hipLaunchKernelGGL(k_phase<PH>, dim3(grid), dim3(NTHREADS), LDS_BYTES, s, p, l, g);
}

extern "C" void kernel_launch(void* const* d_in, const int* in_sizes, int n_in, void* d_out, int out_size, void* d_ws, size_t ws_size, hipStream_t stream)
{
    (void)in_sizes; (void)n_in; (void)out_size;
    Params p{};
    p.x = (const float*)d_in[0]; p.c = (const float*)d_in[1]; p.ctx = (const float*)d_in[2]; p.c_ctx = (const float*)d_in[3];
    p.mod_w = (const float*)d_in[4]; p.mod_b = (const float*)d_in[5]; p.norm1_w = (const float*)d_in[6]; p.norm2_w = (const float*)d_in[7];
    p.w_in = (const float*)d_in[8]; p.mla_qn = (const float*)d_in[9]; p.mla_wuq = (const float*)d_in[10]; p.mla_kvn = (const float*)d_in[11];
    p.mla_wukv = (const float*)d_in[12]; p.gqa_qn = (const float*)d_in[13]; p.gqa_kn = (const float*)d_in[14]; p.na_bias = (const float*)d_in[15];
    p.ret_logit = (const float*)d_in[16]; p.ret_gnw = (const float*)d_in[17]; p.w_branch = (const float*)d_in[18]; p.w_out = (const float*)d_in[19];
    p.peer_wq = (const float*)d_in[20]; p.peer_keys = (const float*)d_in[21]; p.peer_u = (const float*)d_in[22]; p.peer_v = (const float*)d_in[23];
    p.final_w = (const float*)d_in[24];
    p.out = (float*)d_out;
    p.ws = (char*)d_ws;
    if (WS_TOTAL > ws_size) { fprintf(stderr, "workspace too small: need %zu have %zu\n", (size_t)WS_TOTAL, ws_size); return; }
    (void)hipMemsetAsync(d_ws, 0, WS_ZERO_END, stream);

    static int ncu = 0;
    if (!ncu) { int dev = 0; (void)hipGetDevice(&dev); (void)hipDeviceGetAttribute(&ncu, hipDeviceAttributeMultiprocessorCount, dev); if (ncu <= 0) ncu = 256; }
#if MK_ONE_LAUNCH
    static bool attr = false;
    if (!attr) { (void)hipFuncSetAttribute((const void*)k_mega, hipFuncAttributeMaxDynamicSharedMemorySize, LDS_BYTES); attr = true; }
    hipLaunchKernelGGL(k_mega, dim3(ncu), dim3(NTHREADS), LDS_BYTES, stream, p);
#else
    const int grid = ncu;
    launch_phase<0>(p, 0, 0, grid, stream);
    for (int l = 0; l < 2; ++l)
        for (int g = 0; g < NGROUP; ++g) {
            if (l == 0 && g == 0) launch_phase<1>(p, l, g, grid, stream);
            launch_phase<2>(p, l, g, grid, stream);
            launch_phase<3>(p, l, g, grid, stream);
            launch_phase<4>(p, l, g, grid, stream);
            launch_phase<6>(p, l, g, grid, stream);
            launch_phase<7>(p, l, g, grid, stream);
            launch_phase<8>(p, l, g, grid, stream);
            launch_phase<9>(p, l, g, grid, stream);
            launch_phase<10>(p, l, g, grid, stream);
            launch_phase<11>(p, l, g, grid, stream);
        }
#endif
}
```

```cpp
#include <hip/hip_runtime.h>
#include <stdint.h>
#include <stdio.h>

#ifndef MK_ONE_LAUNCH
#define MK_ONE_LAUNCH 1
#endif

#define DM 1024
#define NBATCH 16
#define SEQ 4096
#define CTXL 256
#define LTOK 4352
#define IN_COLS 7072
#define NPROJ 7168
#define PLD 3072
#define NB 8
#define NGROUP (NBATCH / NB)
#define TG (NB * LTOK)
#define NTHREADS 512
#define LDS_BYTES 131648
#define EPSF 1e-6f

#define C_CQ 0
#define C_CKV 256
#define C_KPE 384
#define C_GQ 416
#define C_GK 672
#define C_GV 800
#define C_NQ 928
#define C_NK 1184
#define C_NV 1440
#define C_RQ 1696
#define C_RK 1952
#define C_RV 2208
#define C_RGF 2464
#define C_RGB 2720
#define C_GATE 2976

#define LAS __attribute__((address_space(3)))
typedef unsigned short bf16_t;
typedef short bf16x8 __attribute__((ext_vector_type(8)));
typedef float f32x4 __attribute__((ext_vector_type(4)));
typedef float f32x2 __attribute__((ext_vector_type(2)));
typedef __bf16 bf16x2_t __attribute__((ext_vector_type(2)));
typedef unsigned u32x4 __attribute__((ext_vector_type(4)));
typedef unsigned u32x2 __attribute__((ext_vector_type(2)));
typedef float f32x16 __attribute__((ext_vector_type(16)));
typedef short s16x4 __attribute__((ext_vector_type(4)));

__device__ __forceinline__ unsigned pack_bf16(float lo, float hi) { f32x2 v = {lo, hi}; bf16x2_t b = __builtin_convertvector(v, bf16x2_t); return __builtin_bit_cast(unsigned, b); }
__device__ __forceinline__ bf16_t f2bf(float f) { return (bf16_t)(pack_bf16(f, 0.f) & 0xffffu); }
__device__ __forceinline__ float bf2f(bf16_t b) { return __uint_as_float(((unsigned)b) << 16); }
__device__ __forceinline__ float bflo(unsigned w) { return __uint_as_float(w << 16); }
__device__ __forceinline__ float bfhi(unsigned w) { return __uint_as_float(w & 0xffff0000u); }
#define PEER_USCALE 128.f
#define PEER_VSCALE 16.f
__device__ __forceinline__ float clamp448(float x) { return fminf(fmaxf(x, -448.f), 448.f); }
__device__ __forceinline__ unsigned pack_fp8x4(f32x4 v, float sc) {
    int w = 0;
    w = __builtin_amdgcn_cvt_pk_fp8_f32(clamp448(v[0] * sc), clamp448(v[1] * sc), w, false);
    w = __builtin_amdgcn_cvt_pk_fp8_f32(clamp448(v[2] * sc), clamp448(v[3] * sc), w, true);
    return (unsigned)w;
}

template <int M> __device__ __forceinline__ float xor_swz(float v) { return __int_as_float(__builtin_amdgcn_ds_swizzle(__float_as_int(v), (M << 10) | 0x1f)); }
template <int M> __device__ __forceinline__ unsigned xor_swz_u(unsigned v) { return (unsigned)__builtin_amdgcn_ds_swizzle((int)v, (M << 10) | 0x1f); }
__device__ __forceinline__ float sum_xor32(float v) { const u32x2 r = __builtin_amdgcn_permlane32_swap(__float_as_uint(v), __float_as_uint(v), false, false); return __uint_as_float(r.x) + __uint_as_float(r.y); }
__device__ __forceinline__ float max_xor32(float v) { const u32x2 r = __builtin_amdgcn_permlane32_swap(__float_as_uint(v), __float_as_uint(v), false, false); return fmaxf(__uint_as_float(r.x), __uint_as_float(r.y)); }
__device__ __forceinline__ unsigned get_xor32_u(unsigned v, bool upper) { const u32x2 r = __builtin_amdgcn_permlane32_swap(v, v, false, false); return upper ? r.x : r.y; }
__device__ __forceinline__ float wave_max(float v) {
    v = fmaxf(v, xor_swz<1>(v)); v = fmaxf(v, xor_swz<2>(v)); v = fmaxf(v, xor_swz<4>(v)); v = fmaxf(v, xor_swz<8>(v)); v = fmaxf(v, xor_swz<16>(v));
    return max_xor32(v);
}
__device__ __forceinline__ float wave_sum(float v) {
    v += xor_swz<1>(v); v += xor_swz<2>(v); v += xor_swz<4>(v); v += xor_swz<8>(v); v += xor_swz<16>(v);
    return sum_xor32(v);
}
extern __shared__ __attribute__((aligned(16))) char smem[];
#define WIDTAB_OFF 64
__device__ __forceinline__ unsigned hw_wave_slot() { return (unsigned)__builtin_amdgcn_s_getreg((5 << 11) | 4) & 63u; }
__device__ __forceinline__ void tid_setup() {
    if ((threadIdx.x & 63) == 0) ((volatile LAS int*)(smem + WIDTAB_OFF))[hw_wave_slot()] = (int)(threadIdx.x >> 6);
    __syncthreads();
}
__device__ __forceinline__ int get_tid() {
    int lane; asm volatile("v_mbcnt_lo_u32_b32 %0, -1, 0\n\tv_mbcnt_hi_u32_b32 %0, -1, %0" : "=v"(lane));
    int w = ((volatile LAS int*)(smem + WIDTAB_OFF))[hw_wave_slot()];
    w = __builtin_amdgcn_readfirstlane(w);
    int t = (w << 6) | lane; asm volatile("" : "+v"(t)); return t;
}
__device__ __forceinline__ float siluf(float x) { return x * __builtin_amdgcn_rcpf(1.f + __builtin_amdgcn_exp2f(x * -1.4426950408889634f)); }
__device__ __forceinline__ float sigmf(float x) { return __builtin_amdgcn_rcpf(1.f + __builtin_amdgcn_exp2f(x * -1.4426950408889634f)); }

#define XB_TMO      128
#define XB_XCNT(j)  (256  + 64 * (j))
#define XB_XSUB(j)  (1280 + 64 * (j))
#define XB_XGEN(j)  (2304 + 64 * (j))
#define XB_TOP      3328
#define XB_TOPGEN   3392
#define XCD_BAR_WORDS 3456
#define XB_SPIN_CAP (1u << 18)

__device__ __forceinline__ unsigned xb_ld(unsigned* p)              { return __hip_atomic_load(p, __ATOMIC_RELAXED, __HIP_MEMORY_SCOPE_AGENT); }
__device__ __forceinline__ unsigned xb_add(unsigned* p, unsigned v) { return __hip_atomic_fetch_add(p, v, __ATOMIC_RELAXED, __HIP_MEMORY_SCOPE_AGENT); }
__device__ __forceinline__ unsigned xb_xcc_id() { return (unsigned)__builtin_amdgcn_s_getreg((3 << 11) | 20) & 0xFu; }
#define XB_SPIN(cond, bar) do { unsigned _sp = 0; while (cond) { __builtin_amdgcn_s_sleep(1); \
    if ((++_sp & 255u) == 0u) { if (xb_ld(&(bar)[XB_TMO])) break; if (_sp > XB_SPIN_CAP) { atomicAdd(&(bar)[XB_TMO], 1u); break; } } } } while (0)

struct XcdBarrier { unsigned* bar; unsigned x; volatile LAS unsigned* st; };

__device__ __forceinline__ XcdBarrier xcd_barrier_post(unsigned* bar, volatile LAS unsigned* st) {
    XcdBarrier b; b.bar = bar; b.x = xb_xcc_id(); b.st = st;
    if (get_tid() == 0) (void)xb_add(&bar[XB_XCNT(b.x)], 1u);
    return b;
}
__device__ __forceinline__ void xcd_barrier_complete(unsigned* bar, unsigned x, unsigned& nloc, unsigned& nx) {
    const unsigned G = gridDim.x * gridDim.y * gridDim.z;
    unsigned sum, cnt, mine, sp = 0u;
    for (;;) {
        sum = 0u; cnt = 0u; mine = 0u;
#pragma unroll
        for (unsigned j = 0; j < 16; ++j) { const unsigned c = xb_ld(&bar[XB_XCNT(j)]); sum += c; cnt += (c > 0u) ? 1u : 0u; mine = (j == x) ? c : mine; }
        if (sum == G) break;
        __builtin_amdgcn_s_sleep(1);
        if ((++sp & 255u) == 0u) { if (xb_ld(&bar[XB_TMO])) break; if (sp > XB_SPIN_CAP) { atomicAdd(&bar[XB_TMO], 1u); break; } }
    }
    nloc = mine > 0u ? mine : 1u; nx = cnt > 0u ? cnt : 1u;
}
__device__ __forceinline__ void xcd_barrier(const XcdBarrier& b) {
    asm volatile("s_waitcnt vmcnt(0)" ::: "memory");
    __syncthreads();
    if (get_tid() == 0) {
        unsigned* bar = b.bar;
        __builtin_amdgcn_s_waitcnt(0);
        unsigned nloc = b.st[0], nx = b.st[1];
        if (nloc == 0u) { xcd_barrier_complete(bar, b.x, nloc, nx); b.st[0] = nloc; b.st[1] = nx; }
        const unsigned old = xb_add(&bar[XB_XSUB(b.x)], 1u);
        const unsigned gen = old / nloc;
        if (old + 1u == (gen + 1u) * nloc) {
            __builtin_amdgcn_fence(__ATOMIC_RELEASE, "agent");
            asm volatile("s_waitcnt vmcnt(0)" ::: "memory");
            const unsigned og = xb_add(&bar[XB_TOP], 1u);
            const unsigned tg = og / nx;
            if (og + 1u == (tg + 1u) * nx) xb_add(&bar[XB_TOPGEN], 1u);
            else XB_SPIN(xb_ld(&bar[XB_TOPGEN]) == tg, bar);
            __builtin_amdgcn_fence(__ATOMIC_ACQUIRE, "agent");
            xb_add(&bar[XB_XGEN(b.x)], 1u);
            asm volatile("s_waitcnt vmcnt(0)" ::: "memory");
        } else {
            XB_SPIN(xb_ld(&bar[XB_XGEN(b.x)]) == gen, bar);
            __builtin_amdgcn_fence(__ATOMIC_ACQUIRE, "agent");
            asm volatile("s_waitcnt vmcnt(0)" ::: "memory");
        }
    }
    __syncthreads();
}

struct Params {
    const float *x, *c, *ctx, *c_ctx, *mod_w, *mod_b, *norm1_w, *norm2_w, *w_in, *mla_qn, *mla_wuq, *mla_kvn, *mla_wukv,
                *gqa_qn, *gqa_kn, *na_bias, *ret_logit, *ret_gnw, *w_branch, *w_out, *peer_wq, *peer_keys, *peer_u, *peer_v, *final_w;
    float* out;
    char* ws;
};
typedef const __attribute__((address_space(4))) Params* KP;
__device__ __forceinline__ KP get_kp() { KP kp = (KP)__builtin_amdgcn_kernarg_segment_ptr(); asm volatile("" : "+s"(kp)); return kp; }

constexpr size_t al256c(size_t x) { return (x + 255) & ~(size_t)255; }
constexpr size_t WS_BAR = 0;
constexpr size_t WS_CNT = WS_BAR + al256c(XCD_BAR_WORDS * 4);
constexpr size_t WS_ZERO_END = WS_CNT + al256c(8 * 8 * 64 * 4);
constexpr size_t WS_MOD = WS_ZERO_END;
constexpr size_t WS_CTXS = WS_MOD + al256c((size_t)2 * 17 * 6144 * 4);
constexpr size_t WS_WINT = WS_CTXS + al256c((size_t)NBATCH * CTXL * DM * 4);
constexpr size_t WS_WUQT = WS_WINT + al256c((size_t)2 * NPROJ * DM * 2);
constexpr size_t WS_WUKVT = WS_WUQT + al256c((size_t)2 * 384 * 256 * 2);
constexpr size_t WS_WBT = WS_WUKVT + al256c((size_t)2 * 512 * 128 * 2);
constexpr size_t WS_WOUTT = WS_WBT + al256c((size_t)2 * 4 * DM * 256 * 2);
constexpr size_t WS_WQT = WS_WOUTT + al256c((size_t)2 * DM * DM * 2);
constexpr size_t WS_H = WS_WQT + al256c((size_t)2 * DM * DM * 2);
constexpr size_t WS_PROJ = WS_H + al256c((size_t)NGROUP * TG * DM * 2);
#define HG(p_, g_) (((bf16_t*)((p_)->ws + WS_H)) + (size_t)(g_) * TG * DM)
constexpr size_t WS_GATE8 = WS_PROJ + al256c((size_t)TG * PLD * 2);
constexpr size_t WS_QRAW = WS_GATE8 + al256c((size_t)TG * 4096);
constexpr size_t WS_KVRAW = WS_QRAW + al256c((size_t)TG * 384 * 2);
constexpr size_t WS_QA = WS_KVRAW + al256c((size_t)TG * 512 * 2);
constexpr size_t WS_KA = WS_QA + al256c((size_t)TG * 384 * 2);
constexpr size_t WS_VA = WS_KA + al256c((size_t)TG * 384 * 2);
constexpr size_t WS_GQ = WS_VA + al256c((size_t)TG * 256 * 2);
constexpr size_t WS_GK = WS_GQ + al256c((size_t)TG * 256 * 2);
constexpr size_t WS_OUTS = WS_GK + al256c((size_t)TG * 128 * 2);
constexpr size_t WS_ACC = WS_QRAW;
constexpr size_t WS_PQ = WS_OUTS;
constexpr size_t WS_RKV = WS_OUTS + al256c((size_t)4 * TG * 256 * 2);
constexpr size_t WS_UB = WS_RKV + al256c((size_t)NB * 4 * 2 * 34 * 4096 * 4);
constexpr size_t WS_VB = WS_UB + al256c((size_t)2 * 16384 * DM);
constexpr size_t WS_KEYB = WS_VB + al256c((size_t)2 * 16384 * DM);
constexpr size_t WS_USC = WS_UB + (size_t)2 * 16384 * (DM / 2);
constexpr size_t WS_VSC = WS_VB + (size_t)2 * 16384 * (DM / 2);
constexpr size_t WS_TOTAL = WS_KEYB + al256c((size_t)2 * 8 * 2 * 128 * 64 * 2);

#define G_BM 256
#define G_BN 128
#define G_BK 64
#define G_LDP 144
#define G_ABYTES (G_BM * G_LDP)
#define G_BBYTES (G_BN * G_LDP)
#define G_STAGE (G_ABYTES + G_BBYTES)

template <int MI>
__device__ __forceinline__ void gemm_tile(const bf16_t* __restrict__ A, int lda, const bf16_t* __restrict__ Bt, int ldb, int K,
                                          f32x4 (&acc)[MI][4], char* lds)
{
    constexpr int NA = MI;
    const int tid = get_tid(), lane = tid & 63, wid = tid >> 6, wm = wid >> 1, wn = wid & 1, fr = lane & 15, fq = lane >> 4;
    const int nk = K / G_BK;
    u32x4 ra[NA], rb[2];
    const int arow = tid >> 3, akc = tid & 7;
    const bf16_t* ag = A + (size_t)arow * lda + akc * 8;
    const bf16_t* bg = Bt + (size_t)arow * ldb + akc * 8;
    const int a_l = arow * G_LDP + akc * 16;
#pragma unroll
    for (int i = 0; i < NA; ++i) ra[i] = *(const u32x4*)(ag + (size_t)(64 * i) * lda);
#pragma unroll
    for (int i = 0; i < 2; ++i) rb[i] = *(const u32x4*)(bg + (size_t)(64 * i) * ldb);
    __syncthreads();
#pragma unroll
    for (int i = 0; i < NA; ++i) *(u32x4*)(lds + a_l + i * 64 * G_LDP) = ra[i];
#pragma unroll
    for (int i = 0; i < 2; ++i) *(u32x4*)(lds + G_ABYTES + a_l + i * 64 * G_LDP) = rb[i];
    __syncthreads();
    const int aoff = (wm * 16 * MI + fr) * G_LDP + fq * 16;
    const int boff = G_ABYTES + (wn * 64 + fr) * G_LDP + fq * 16;
    for (int kt = 0; kt < nk; ++kt) {
        const int cur = (kt & 1) * G_STAGE, nxt = ((kt + 1) & 1) * G_STAGE;
        const bool more = (kt + 1 < nk);
        if (more) {
#pragma unroll
            for (int i = 0; i < NA; ++i) ra[i] = *(const u32x4*)(ag + (size_t)(64 * i) * lda + (kt + 1) * G_BK);
#pragma unroll
            for (int i = 0; i < 2; ++i) rb[i] = *(const u32x4*)(bg + (size_t)(64 * i) * ldb + (kt + 1) * G_BK);
        }
#pragma unroll
        for (int ks = 0; ks < 2; ++ks) {
            bf16x8 af[MI], bfr[4];
#pragma unroll
            for (int mi = 0; mi < MI; ++mi) af[mi] = *(const bf16x8*)(lds + cur + aoff + mi * 16 * G_LDP + ks * 64);
#pragma unroll
            for (int ni = 0; ni < 4; ++ni) bfr[ni] = *(const bf16x8*)(lds + cur + boff + ni * 16 * G_LDP + ks * 64);
#pragma unroll
            for (int mi = 0; mi < MI; ++mi)
#pragma unroll
                for (int ni = 0; ni < 4; ++ni) acc[mi][ni] = __builtin_amdgcn_mfma_f32_16x16x32_bf16(bfr[ni], af[mi], acc[mi][ni], 0, 0, 0);
        }
        if (more) {
#pragma unroll
            for (int i = 0; i < NA; ++i) *(u32x4*)(lds + nxt + a_l + i * 64 * G_LDP) = ra[i];
#pragma unroll
            for (int i = 0; i < 2; ++i) *(u32x4*)(lds + nxt + G_ABYTES + a_l + i * 64 * G_LDP) = rb[i];
        }
        __syncthreads();
    }
}

template <int MI>
__device__ __forceinline__ void zero_acc(f32x4 (&acc)[MI][4]) {
#pragma unroll
    for (int i = 0; i < MI; ++i)
#pragma unroll
        for (int j = 0; j < 4; ++j) acc[i][j] = (f32x4){0.f, 0.f, 0.f, 0.f};
}

template <class Epi>
__device__ __forceinline__ void gemm_phase(const bf16_t* A, int lda, const bf16_t* Bt, int ldb, int M, int N, int K, const Epi& epi, char* lds, int bid, int nblk)
{
    const int tid = get_tid(), lane = tid & 63, wid = tid >> 6, wm = wid >> 1, wn = wid & 1, fr = lane & 15, fq = lane >> 4;
    const int tn = N / G_BN, total = (M / G_BM) * tn;
    for (int t = bid; t < total; t += nblk) {
        const int pm = t / tn, pn = t % tn;
        f32x4 acc[4][4]; zero_acc(acc);
        gemm_tile<4>(A + (size_t)pm * G_BM * lda, lda, Bt + (size_t)pn * G_BN * ldb, ldb, K, acc, lds);
#pragma unroll
        for (int mi = 0; mi < 4; ++mi)
#pragma unroll
            for (int ni = 0; ni < 4; ++ni) epi(pm * G_BM + wm * 64 + mi * 16 + fr, pn * G_BN + wn * 64 + ni * 16 + fq * 4, acc[mi][ni]);
    }
}

__device__ __forceinline__ void store_bf16x4(bf16_t* p, f32x4 v) { u32x2 w; w.x = pack_bf16(v[0], v[1]); w.y = pack_bf16(v[2], v[3]); *(u32x2*)p = w; }


namespace pg8 {
#define PG8_LAS __attribute__((address_space(3)))
typedef unsigned short bf16_t;
typedef short bf16x8 __attribute__((ext_vector_type(8)));
typedef float f32x4 __attribute__((ext_vector_type(4)));
typedef unsigned u32x4 __attribute__((ext_vector_type(4)));
constexpr int BM = 256, BK = 64, HALF = 128, HTB = HALF * BK * 2  , STAGE_BYTES = 8 * HTB, NXCD = 8, WGM = 8;

__host__ __device__ __forceinline__ int lds_byte(int r, int c) { const int st = (r >> 4) * 2 + (c >> 5), rr = r & 15, cc = c & 31, ob = rr * 64 + cc * 2; return st * 1024 + (ob ^ (((ob >> 9) & 1) << 5)); }
__host__ __device__ __forceinline__ void stage_rc(int b, int& R, int& C) { const int st = b / 1024, sb = b % 1024, swz = sb ^ (((sb >> 9) & 1) << 5); R = (st >> 1) * 16 + swz / 64; C = (st & 1) * 32 + (swz % 64) / 2; }
__host__ __device__ __forceinline__ int perm32(int rho) { const int n = rho >> 4, i = rho & 15; return 8 * (i >> 2) + 4 * n + (i & 3); }

struct Unit { int pm, pn; };
struct Gemm { const bf16_t* A; const bf16_t* Bt; int M, N, K; };

struct StaticOrder {
    int nM, nN, nwg, G, c;
    __host__ __device__ void init(int M, int N, int G_, int c_) { nM = M / BM; nN = N / BM; nwg = nM * nN; G = G_; c = c_; }
    __host__ __device__ bool next(int i, Unit& u) const {
        const long L = (long)i * G + c; if (L >= nwg) return false;
        int wgid = (int)L; { const int q = nwg / NXCD, r = nwg % NXCD, xcd = wgid % NXCD, off = wgid / NXCD; wgid = (xcd < r ? xcd * (q + 1) : r * (q + 1) + (xcd - r) * q) + off; }
        const int nig = WGM * nN, gid = wgid / nig, fm = gid * WGM, gsz = (nM - fm) < WGM ? (nM - fm) : WGM;
        u.pm = fm + ((wgid % nig) % gsz); u.pn = (wgid % nig) / gsz; return true;
    }
    __device__ __forceinline__ void a_ready(const Unit&) const {}
    __device__ __forceinline__ void done(const Unit&) const {}
};
template <class Epi, class Sched, bool ALIGN_EPI = false, bool SP2 = false>
__device__ __forceinline__ void gemm_phase(PG8_LAS unsigned char* lds, const Gemm g, const Sched& S, const Epi& E) {
    const int tid = get_tid(), wid = __builtin_amdgcn_readfirstlane(tid >> 6), lane = tid & 63, wr = wid >> 2, wc = wid & 3, fr = lane & 15, fq = lane >> 4;
    const int K = g.K, nt = K / BK;
    unsigned voffA[2], voffB[2];
#pragma unroll
    for (int i = 0; i < 2; ++i) { int R, C; stage_rc(tid * 16 + i * 8192, R, C); const int Rb = Epi::PERM ? ((R & ~31) + perm32(R & 31)) : R;
        voffA[i] = (unsigned)(R * K + C) * 2u; voffB[i] = (unsigned)(Rb * K + C) * 2u; }
    const size_t kstep = (size_t)(BK * 2);
    const size_t hstep = (size_t)HALF * K * 2;
    const size_t tstep = 2 * hstep;
    const unsigned ldsw = (unsigned)wid * 1024u;
    const int aoff = lds_byte(wr * 64 + fr, fq * 8), boff = lds_byte(wc * 32 + fr, fq * 8);
#define PG8_SA(b, h) (((b) * 2 + (h)) * HTB)
#define PG8_SB(b, h) ((4 + (b) * 2 + (h)) * HTB)
#define PG8_STAGE(bufoff, gbase, voff) do { _Pragma("unroll") for (int _i = 0; _i < 2; ++_i) \
        __builtin_amdgcn_global_load_lds((const unsigned*)((const char*)(gbase) + (voff)[_i]), (PG8_LAS unsigned*)(lds + (bufoff) + ldsw + _i * 8192), 16, 0, 0); } while (0)
#define PG8_LDA(dst, b, h) do { _Pragma("unroll") for (int m = 0; m < 4; ++m) _Pragma("unroll") for (int k = 0; k < 2; ++k) dst[m][k] = *(const PG8_LAS bf16x8*)(lds + PG8_SA(b, h) + aoff + m * 2048 + k * 1024); } while (0)
#define PG8_LDB(dst, b, h) do { _Pragma("unroll") for (int n = 0; n < 2; ++n) _Pragma("unroll") for (int k = 0; k < 2; ++k) dst[n][k] = *(const PG8_LAS bf16x8*)(lds + PG8_SB(b, h) + boff + n * 2048 + k * 1024); } while (0)
#define PG8_MMA(ai, bj, At, Bt) do { __builtin_amdgcn_s_setprio(1); _Pragma("unroll") for (int m = 0; m < 4; ++m) _Pragma("unroll") for (int n = 0; n < 2; ++n) _Pragma("unroll") for (int k = 0; k < 2; ++k) \
        acc[ai][bj][m][n] = __builtin_amdgcn_mfma_f32_16x16x32_bf16(Bt[n][k], At[m][k], acc[ai][bj][m][n], 0, 0, 0); __builtin_amdgcn_s_setprio(0); } while (0)
#define PG8_WAIT_V(n) asm volatile("s_waitcnt vmcnt(" #n ")" ::: "memory")
#define PG8_WAIT_L(n) asm volatile("s_waitcnt lgkmcnt(" #n ")" ::: "memory")
#define PG8_BAR __builtin_amdgcn_s_barrier()
#define PG8_SCHED __builtin_amdgcn_sched_barrier(0)
    Unit cur, nxt; int ui = 0;
    if (!S.next(0, cur)) return;
    f32x4 acc[2][2][4][2];
#pragma unroll
    for (int a = 0; a < 2; ++a)
#pragma unroll
        for (int b = 0; b < 2; ++b)
#pragma unroll
            for (int m = 0; m < 4; ++m)
#pragma unroll
                for (int n = 0; n < 2; ++n) acc[a][b][m][n] = (f32x4){0.f, 0.f, 0.f, 0.f};
    bf16x8 At[4][2], B0[2][2], B1[2][2];
    const char* cA = (const char*)g.A + (size_t)cur.pm * tstep; const char* cB = (const char*)g.Bt + (size_t)cur.pn * tstep;
    S.a_ready(cur);
    if constexpr (SP2) {
        PG8_STAGE(PG8_SB(0, 0), cB, voffB); PG8_STAGE(PG8_SB(0, 1), cB + hstep, voffB); PG8_STAGE(PG8_SA(0, 0), cA, voffA); PG8_STAGE(PG8_SA(0, 1), cA + hstep, voffA);
        if (wr == 1) PG8_BAR;
        PG8_WAIT_V(2); PG8_BAR;
        PG8_STAGE(PG8_SB(1, 0), cB + kstep, voffB); PG8_STAGE(PG8_SA(1, 0), cA + kstep, voffA); PG8_STAGE(PG8_SB(1, 1), cB + hstep + kstep, voffB);
        PG8_WAIT_V(6); PG8_BAR;
    } else {
        PG8_STAGE(PG8_SB(0, 0), cB, voffB); PG8_STAGE(PG8_SA(0, 0), cA, voffA); PG8_STAGE(PG8_SB(0, 1), cB + hstep, voffB); PG8_STAGE(PG8_SA(0, 1), cA + hstep, voffA);
        if (wr == 1) PG8_BAR;
        PG8_WAIT_V(4); PG8_BAR;
        PG8_STAGE(PG8_SB(1, 0), cB + kstep, voffB); PG8_STAGE(PG8_SA(1, 0), cA + kstep, voffA); PG8_STAGE(PG8_SB(1, 1), cB + hstep + kstep, voffB);
        PG8_WAIT_V(6); PG8_BAR;
    }
    for (;;) {
        const bool has_next = S.next(ui + 1, nxt);
        const char* nA = has_next ? (const char*)g.A + (size_t)nxt.pm * tstep : cA; const char* nB = has_next ? (const char*)g.Bt + (size_t)nxt.pn * tstep : cB;
        for (int t = 0; t < nt; t += 2) {
            const bool last = (t == nt - 2);
            const char* a1 = cA + (size_t)(t + 1) * kstep;
            const char* a2 = last ? nA : cA + (size_t)(t + 2) * kstep; const char* b2 = last ? nB : cB + (size_t)(t + 2) * kstep;
            const char* a3 = a2 + kstep; const char* b3 = b2 + kstep;
            if (last && has_next) S.a_ready(nxt);
            if constexpr (SP2) {
            PG8_LDB(B0, 0, 0); PG8_LDB(B1, 0, 1); PG8_SCHED; PG8_LDA(At, 0, 0); PG8_STAGE(PG8_SA(1, 1), a1 + hstep, voffA);
            PG8_WAIT_V(8); PG8_WAIT_L(0); PG8_BAR; PG8_MMA(0, 0, At, B0); PG8_MMA(0, 1, At, B1); PG8_BAR; PG8_SCHED;
            PG8_LDA(At, 0, 1); PG8_STAGE(PG8_SB(0, 0), b2, voffB); PG8_STAGE(PG8_SB(0, 1), b2 + hstep, voffB); PG8_STAGE(PG8_SA(0, 0), a2, voffA);
            PG8_WAIT_V(8); PG8_WAIT_L(0); PG8_BAR; PG8_MMA(1, 0, At, B0); PG8_MMA(1, 1, At, B1); PG8_BAR; PG8_SCHED;
            PG8_LDB(B0, 1, 0); PG8_LDB(B1, 1, 1); PG8_SCHED; PG8_LDA(At, 1, 0); PG8_STAGE(PG8_SA(0, 1), a2 + hstep, voffA);
            PG8_WAIT_V(8); PG8_WAIT_L(0); PG8_BAR; PG8_MMA(0, 0, At, B0); PG8_MMA(0, 1, At, B1); PG8_BAR; PG8_SCHED;
            PG8_LDA(At, 1, 1); PG8_STAGE(PG8_SB(1, 0), b3, voffB); PG8_STAGE(PG8_SB(1, 1), b3 + hstep, voffB); PG8_STAGE(PG8_SA(1, 0), a3, voffA);
            PG8_WAIT_V(8); PG8_WAIT_L(0); PG8_BAR; PG8_MMA(1, 0, At, B0); PG8_MMA(1, 1, At, B1); PG8_BAR; PG8_SCHED;
            } else {
            PG8_LDB(B0, 0, 0); PG8_SCHED; PG8_LDA(At, 0, 0); PG8_STAGE(PG8_SA(1, 1), a1 + hstep, voffA);
            PG8_WAIT_L(8); PG8_BAR; PG8_WAIT_L(0); PG8_MMA(0, 0, At, B0); PG8_BAR; PG8_SCHED;
            PG8_LDB(B1, 0, 1); PG8_STAGE(PG8_SB(0, 0), b2, voffB);
            PG8_BAR; PG8_WAIT_L(0); PG8_MMA(0, 1, At, B1); PG8_BAR;
            PG8_LDA(At, 0, 1); PG8_STAGE(PG8_SA(0, 0), a2, voffA);
            PG8_BAR; PG8_WAIT_L(0); PG8_MMA(1, 0, At, B0); PG8_BAR; PG8_SCHED;
            PG8_STAGE(PG8_SB(0, 1), b2 + hstep, voffB);
            PG8_WAIT_V(6); PG8_BAR; PG8_MMA(1, 1, At, B1); PG8_BAR;
            PG8_LDB(B0, 1, 0); PG8_SCHED; PG8_LDA(At, 1, 0); PG8_STAGE(PG8_SA(0, 1), a2 + hstep, voffA);
            PG8_WAIT_L(8); PG8_BAR; PG8_WAIT_L(0); PG8_MMA(0, 0, At, B0); PG8_BAR; PG8_SCHED;
            PG8_LDB(B1, 1, 1); PG8_STAGE(PG8_SB(1, 0), b3, voffB);
            PG8_BAR; PG8_WAIT_L(0); PG8_MMA(0, 1, At, B1); PG8_BAR;
            PG8_LDA(At, 1, 1); PG8_STAGE(PG8_SA(1, 0), a3, voffA);
            PG8_BAR; PG8_WAIT_L(0); PG8_MMA(1, 0, At, B0); PG8_BAR; PG8_SCHED;
            PG8_STAGE(PG8_SB(1, 1), b3 + hstep, voffB);
            PG8_WAIT_V(6); PG8_BAR; PG8_MMA(1, 1, At, B1); PG8_BAR;
            }
        }
        if constexpr (ALIGN_EPI) { if (wr == 0) PG8_BAR; }
        if constexpr (!Epi::AFTER_DRAIN) { E(acc, cur, wr, wc, fr, fq); S.done(cur); }
        if (!has_next) break;
#pragma unroll
        for (int a = 0; a < 2; ++a)
#pragma unroll
            for (int b = 0; b < 2; ++b)
#pragma unroll
                for (int m = 0; m < 4; ++m)
#pragma unroll
                    for (int n = 0; n < 2; ++n) acc[a][b][m][n] = (f32x4){0.f, 0.f, 0.f, 0.f};
        cur = nxt; cA = nA; cB = nB; ++ui;
        if constexpr (ALIGN_EPI) { if (wr == 1) PG8_BAR; }
    }
    PG8_WAIT_V(0);
    if constexpr (!ALIGN_EPI) { if (wr == 0) PG8_BAR; }
    PG8_BAR;
    if constexpr (Epi::AFTER_DRAIN) { E.fused(acc, cur, wr, wc, fr, fq, lds, wid, lane); S.done(cur); }
#undef PG8_SA
#undef PG8_SB
#undef PG8_STAGE
#undef PG8_LDA
#undef PG8_LDB
#undef PG8_MMA
#undef PG8_WAIT_V
#undef PG8_WAIT_L
#undef PG8_BAR
#undef PG8_SCHED
}
}

template <class F> struct Epi4 {
    static constexpr bool PERM = false, AFTER_DRAIN = false; F f;
    __device__ __forceinline__ void operator()(const f32x4 (&acc)[2][2][4][2], const pg8::Unit& u, int wr, int wc, int fr, int fq) const {
#pragma unroll
        for (int ai = 0; ai < 2; ++ai)
#pragma unroll
            for (int m = 0; m < 4; ++m)
#pragma unroll
                for (int bj = 0; bj < 2; ++bj)
#pragma unroll
                    for (int n = 0; n < 2; ++n) f(u.pm * 256 + ai * 128 + wr * 64 + m * 16 + fr, u.pn * 256 + bj * 128 + wc * 32 + n * 16 + fq * 4, acc[ai][bj][m][n]);
    }
};
template <class F> struct Epi8 {
    static constexpr bool PERM = true, AFTER_DRAIN = false; F f;
    __device__ __forceinline__ void operator()(const f32x4 (&acc)[2][2][4][2], const pg8::Unit& u, int wr, int wc, int fr, int fq) const {
#pragma unroll
        for (int ai = 0; ai < 2; ++ai)
#pragma unroll
            for (int m = 0; m < 4; ++m)
#pragma unroll
                for (int bj = 0; bj < 2; ++bj) f(u.pm * 256 + ai * 128 + wr * 64 + m * 16 + fr, u.pn * 256 + bj * 128 + wc * 32 + fq * 8, acc[ai][bj][m][0], acc[ai][bj][m][1]);
    }
};
template <class E>
__device__ __forceinline__ void big_gemm(const bf16_t* A, const bf16_t* Bt, int M, int N, int K, const E& e, char* lds, int bid, int nblk) {
    pg8::StaticOrder so; so.init(M, N, nblk, bid);
    pg8::gemm_phase<E, pg8::StaticOrder, true, true>((PG8_LAS unsigned char*)lds, pg8::Gemm{A, Bt, M, N, K}, so, e);
}

__device__ __forceinline__ void transpose_cvt(const float* __restrict__ src, int K, int N, int Npad, bf16_t* __restrict__ dst, const float* __restrict__ kscale, float* lds, int bid, int nblk)
{
    const int tid = get_tid();
    const int tk = K / 64, tn = Npad / 64, total = tk * tn;
    const int lk = tid >> 3, ln = (tid & 7) * 8;
    const int sn = tid >> 3, sk = (tid & 7) * 8;
    for (int t = bid; t < total; t += nblk) {
        const int k0 = (t / tn) * 64, n0 = (t % tn) * 64;
        f32x4 a = (f32x4){0.f, 0.f, 0.f, 0.f}, c = a;
        if (n0 + ln < N) { const float* sp = src + (size_t)(k0 + lk) * N + n0 + ln; a = *(const f32x4*)sp; c = *(const f32x4*)(sp + 4); if (kscale) { const float ks = kscale[k0 + lk]; a *= ks; c *= ks; } }
        __syncthreads();
#pragma unroll
        for (int j = 0; j < 4; ++j) { lds[lk * 65 + ln + j] = a[j]; lds[lk * 65 + ln + 4 + j] = c[j]; }
        __syncthreads();
        u32x4 w;
        w.x = pack_bf16(lds[(sk + 0) * 65 + sn], lds[(sk + 1) * 65 + sn]); w.y = pack_bf16(lds[(sk + 2) * 65 + sn], lds[(sk + 3) * 65 + sn]);
        w.z = pack_bf16(lds[(sk + 4) * 65 + sn], lds[(sk + 5) * 65 + sn]); w.w = pack_bf16(lds[(sk + 6) * 65 + sn], lds[(sk + 7) * 65 + sn]);
        *(u32x4*)(dst + (size_t)(n0 + sn) * K + k0 + sk) = w;
    }
}

__device__ __forceinline__ void phase_prologue(KP p, char* ldsc, int bid, int nblk)
{
    float* lds = (float*)ldsc;
    const int tid = get_tid();
    for (int l = 0; l < 2; ++l) {
        transpose_cvt(p->w_in + (size_t)l * DM * IN_COLS, DM, IN_COLS, NPROJ, ((bf16_t*)(p->ws + WS_WINT)) + (size_t)l * NPROJ * DM, nullptr, lds, bid, nblk);
        transpose_cvt(p->mla_wuq + (size_t)l * 256 * 384, 256, 384, 384, ((bf16_t*)(p->ws + WS_WUQT)) + (size_t)l * 384 * 256, p->mla_qn + l * 256, lds, bid, nblk);
        transpose_cvt(p->mla_wukv + (size_t)l * 128 * 512, 128, 512, 512, ((bf16_t*)(p->ws + WS_WUKVT)) + (size_t)l * 512 * 128, p->mla_kvn + l * 128, lds, bid, nblk);
        for (int i = 0; i < 4; ++i)
            transpose_cvt(p->w_branch + (size_t)(l * 4 + i) * 256 * DM, 256, DM, DM, ((bf16_t*)(p->ws + WS_WBT)) + (size_t)(l * 4 + i) * DM * 256, nullptr, lds, bid, nblk);
        transpose_cvt(p->w_out + (size_t)l * DM * DM, DM, DM, DM, ((bf16_t*)(p->ws + WS_WOUTT)) + (size_t)l * DM * DM, nullptr, lds, bid, nblk);
        transpose_cvt(p->peer_wq + (size_t)l * DM * DM, DM, DM, DM, ((bf16_t*)(p->ws + WS_WQT)) + (size_t)l * DM * DM, nullptr, lds, bid, nblk);
    }
    {
        float* sil = lds;
        float* red = lds + 17 * 1024;
        __syncthreads();
        for (int e = tid; e < 17 * 1024; e += NTHREADS) { const int r = e >> 10, k = e & 1023; const float v = (r < 16) ? p->c[r * 1024 + k] : p->c_ctx[k]; sil[e] = siluf(v); }
        __syncthreads();
        for (int u = bid; u < 2 * 96; u += nblk) {
            const int l = u / 96, j0 = (u % 96) * 64, kg = tid >> 6, j = tid & 63;
            float a[17];
#pragma unroll
            for (int r = 0; r < 17; ++r) a[r] = 0.f;
            const float* w = p->mod_w + (size_t)l * DM * 6144 + j0 + j;
#pragma unroll 1
            for (int k0 = kg * 128; k0 < kg * 128 + 128; k0 += 16) {
                float wv[16];
#pragma unroll
                for (int kk = 0; kk < 16; ++kk) wv[kk] = w[(size_t)(k0 + kk) * 6144];
#pragma unroll
                for (int kk = 0; kk < 16; ++kk)
#pragma unroll
                    for (int r = 0; r < 17; ++r) a[r] += sil[r * 1024 + k0 + kk] * wv[kk];
            }
#pragma unroll
            for (int r = 0; r < 17; ++r) red[(kg * 17 + r) * 64 + j] = a[r];
            __syncthreads();
            for (int e = tid; e < 17 * 64; e += NTHREADS) {
                const int r = e >> 6, jj = e & 63; float s = 0.f;
                for (int q = 0; q < 8; ++q) s += red[(q * 17 + r) * 64 + jj];
                ((float*)(p->ws + WS_MOD))[((size_t)l * 17 + r) * 6144 + j0 + jj] = s + p->mod_b[l * 6144 + j0 + jj];
            }
            __syncthreads();
        }
    }
    {
        const size_t n16 = (size_t)2 * 16384 * DM / 16;
        for (size_t i = (size_t)bid * NTHREADS + tid; i < n16; i += (size_t)nblk * NTHREADS) {
            f32x4 a[4], c[4];
#pragma unroll
            for (int q = 0; q < 4; ++q) { a[q] = ((const f32x4*)p->peer_u)[4 * i + q]; c[q] = ((const f32x4*)p->peer_v)[4 * i + q]; }
            float mu = 0.f, mv = 0.f;
#pragma unroll
            for (int q = 0; q < 4; ++q)
#pragma unroll
                for (int j = 0; j < 4; ++j) { mu = fmaxf(mu, fabsf(a[q][j])); mv = fmaxf(mv, fabsf(c[q][j])); }
            mu = wave_max(mu); mv = wave_max(mv);
            const float su = mu > 0.f ? mu * (1.f / 6.f) : 1.f, sv = mv > 0.f ? mv * (1.f / 6.f) : 1.f, iu = 1.f / su, iv = 1.f / sv;
            u32x2 wu = (u32x2){0u, 0u}, wv = (u32x2){0u, 0u};
#pragma unroll
            for (int q = 0; q < 4; ++q) {
                unsigned tu = wu[q >> 1], tv = wv[q >> 1];
                if ((q & 1) == 0) {
                    tu = __builtin_amdgcn_cvt_scalef32_pk_fp4_f32(tu, a[q][0] * iu, a[q][1] * iu, 1.0f, 0); tu = __builtin_amdgcn_cvt_scalef32_pk_fp4_f32(tu, a[q][2] * iu, a[q][3] * iu, 1.0f, 1);
                    tv = __builtin_amdgcn_cvt_scalef32_pk_fp4_f32(tv, c[q][0] * iv, c[q][1] * iv, 1.0f, 0); tv = __builtin_amdgcn_cvt_scalef32_pk_fp4_f32(tv, c[q][2] * iv, c[q][3] * iv, 1.0f, 1);
                } else {
                    tu = __builtin_amdgcn_cvt_scalef32_pk_fp4_f32(tu, a[q][0] * iu, a[q][1] * iu, 1.0f, 2); tu = __builtin_amdgcn_cvt_scalef32_pk_fp4_f32(tu, a[q][2] * iu, a[q][3] * iu, 1.0f, 3);
                    tv = __builtin_amdgcn_cvt_scalef32_pk_fp4_f32(tv, c[q][0] * iv, c[q][1] * iv, 1.0f, 2); tv = __builtin_amdgcn_cvt_scalef32_pk_fp4_f32(tv, c[q][2] * iv, c[q][3] * iv, 1.0f, 3);
                }
                wu[q >> 1] = tu; wv[q >> 1] = tv;
            }
            ((u32x2*)(p->ws + WS_UB))[i] = wu; ((u32x2*)(p->ws + WS_VB))[i] = wv;
            if ((tid & 63) == 0) { ((float*)(p->ws + WS_USC))[i >> 6] = su; ((float*)(p->ws + WS_VSC))[i >> 6] = sv; }
        }
        const size_t k8 = (size_t)2 * 8 * 2 * 128 * 64 / 8;
        for (size_t i = (size_t)bid * NTHREADS + tid; i < k8; i += (size_t)nblk * NTHREADS) {
            const f32x4 a = ((const f32x4*)p->peer_keys)[2 * i], b = ((const f32x4*)p->peer_keys)[2 * i + 1];
            u32x4 w; w.x = pack_bf16(a[0], a[1]); w.y = pack_bf16(a[2], a[3]); w.z = pack_bf16(b[0], b[1]); w.w = pack_bf16(b[2], b[3]);
            ((u32x4*)(p->ws + WS_KEYB))[i] = w;
        }
    }
}

__device__ __forceinline__ const float* state_row(KP p, int g, int r, int& modrow, bool from_input) {
    const int bl = r / LTOK, t = r - bl * LTOK, b = g * NB + bl;
    if (t < CTXL) { modrow = 16; return (from_input ? p->ctx : (const float*)(p->ws + WS_CTXS)) + ((size_t)b * CTXL + t) * DM; }
    modrow = b; return (from_input ? p->x : (const float*)p->out) + ((size_t)b * SEQ + (t - CTXL)) * DM;
}

__device__ __forceinline__ void phase_norm(KP p, int l, int g, int which, int bid, int nblk)
{
    const int lane = get_tid() & 63, wid = get_tid() >> 6;
    const float* nw = (which ? p->norm2_w : p->norm1_w) + l * DM;
    const int shoff = which ? 3072 : 0, scoff = which ? 4096 : 1024;
    for (int r = bid * 8 + wid; r < TG; r += nblk * 8) {
        int mr; const float* src = state_row(p, g, r, mr, l == 0 && which == 0);
        const float* md = ((float*)(p->ws + WS_MOD)) + ((size_t)l * 17 + mr) * 6144;
        f32x4 v[4]; float ss = 0.f;
#pragma unroll
        for (int i = 0; i < 4; ++i) { v[i] = *(const f32x4*)(src + i * 256 + lane * 4); ss += v[i][0] * v[i][0] + v[i][1] * v[i][1] + v[i][2] * v[i][2] + v[i][3] * v[i][3]; }
        ss = wave_sum(ss);
        const float rstd = rsqrtf(ss * (1.f / DM) + EPSF);
#pragma unroll
        for (int i = 0; i < 4; ++i) {
            const int c = i * 256 + lane * 4;
            const f32x4 w = *(const f32x4*)(nw + c), sc = *(const f32x4*)(md + scoff + c), sh = *(const f32x4*)(md + shoff + c);
            f32x4 y;
#pragma unroll
            for (int j = 0; j < 4; ++j) y[j] = v[i][j] * rstd * w[j] * (1.f + sc[j]) + sh[j];
            store_bf16x4(HG(p, g) + (size_t)r * DM + c, y);
        }
    }
}

struct EpiProj8 {
    bf16_t* O; unsigned char* G8;
    __device__ __forceinline__ void operator()(int row, int col, f32x4 a, f32x4 b) const {
        if (col >= C_GATE) {
            const int gi = col - C_GATE; if (gi >= 4096) return;
            unsigned w0 = 0u, w1 = 0u;
#pragma unroll
            for (int j = 0; j < 4; ++j) {
                w0 |= (unsigned)__builtin_amdgcn_cvt_pk_u8_f32(sigmf(a[j]) * 255.f, j, 0);
                w1 |= (unsigned)__builtin_amdgcn_cvt_pk_u8_f32(sigmf(b[j]) * 255.f, j, 0);
            }
            const int gp_ = (gi & ~63) | (((gi >> 2) & 3) << 4) | (((gi >> 4) & 3) << 2);
            *(unsigned*)(G8 + (size_t)row * 4096 + gp_) = w0; *(unsigned*)(G8 + (size_t)row * 4096 + gp_ + 16) = w1;
            return;
        }
        if (col >= C_NQ && col < C_NK) { a *= (0.125f * 1.4426950408889634f); b *= (0.125f * 1.4426950408889634f); }
        u32x4 w; w.x = pack_bf16(a[0], a[1]); w.y = pack_bf16(a[2], a[3]); w.z = pack_bf16(b[0], b[1]); w.w = pack_bf16(b[2], b[3]);
        *(u32x4*)(O + (size_t)row * PLD + col) = w;
    }
};
struct EpiStore8 { bf16_t* O; int ld;
    __device__ __forceinline__ void operator()(int row, int col, f32x4 a, f32x4 b) const {
        u32x4 w; w.x = pack_bf16(a[0], a[1]); w.y = pack_bf16(a[2], a[3]); w.z = pack_bf16(b[0], b[1]); w.w = pack_bf16(b[2], b[3]);
        *(u32x4*)(O + (size_t)row * ld + col) = w; } };
struct EpiStore { bf16_t* O; int ld; __device__ __forceinline__ void operator()(int row, int col, f32x4 v) const { store_bf16x4(O + (size_t)row * ld + col, v); } };

__device__ __forceinline__ float log_sigmoidf(float x) { return fminf(x, 0.f) - log1pf(__expf(-fabsf(x))); }

__device__ __forceinline__ int ret_jb(int rb) { return rb == 0 ? 1 : (rb == 1 ? 0 : 35 - rb); }

__device__ __forceinline__ bf16x8 tr_frag_nat(const char* img, int PT, int k0, int col0, int lane) {
    const int i16 = lane & 15, blk = (lane >> 4) & 1, h5 = lane >> 5, q4 = i16 >> 2, p4 = i16 & 3;
    const char* a = img + (k0 + 8 * h5 + q4) * PT + (col0 + 16 * blk) * 2 + 8 * p4;
    const s16x4 lo = __builtin_amdgcn_ds_read_tr16_b64_v4i16((LAS s16x4*)a), hi = __builtin_amdgcn_ds_read_tr16_b64_v4i16((LAS s16x4*)(a + 4 * PT));
    return __builtin_shufflevector(lo, hi, 0, 1, 2, 3, 4, 5, 6, 7);
}
__device__ __forceinline__ bf16x8 tr_frag_acc(const char* img, int PT, int k0, int col0, int lane) {
    const int i16 = lane & 15, blk = (lane >> 4) & 1, h5 = lane >> 5, q4 = i16 >> 2, p4 = i16 & 3;
    const char* a = img + (k0 + 4 * h5 + q4) * PT + (col0 + 16 * blk) * 2 + 8 * p4;
    const s16x4 lo = __builtin_amdgcn_ds_read_tr16_b64_v4i16((LAS s16x4*)a), hi = __builtin_amdgcn_ds_read_tr16_b64_v4i16((LAS s16x4*)(a + 8 * PT));
    return __builtin_shufflevector(lo, hi, 0, 1, 2, 3, 4, 5, 6, 7);
}
#define RT_PT 144
__device__ __forceinline__ void ret_kv_unit(KP p, int l, int bl, int h, int rb, char* lds)
{
    const int tid = get_tid(), lane = tid & 63, wid = tid >> 6, r = lane & 31, h5 = lane >> 5;
    const bf16_t* PR = (const bf16_t*)(p->ws + WS_PROJ);
    const size_t R0 = (size_t)bl * LTOK + rb * 128;
    const float lgf = log_sigmoidf(p->ret_logit[(l * 2 + 0) * 4 + h]) * 1.4426950408889634f, lgb = log_sigmoidf(p->ret_logit[(l * 2 + 1) * 4 + h]) * 1.4426950408889634f;
    char* KF = lds; char* KBk = lds + 128 * RT_PT; char* VV = lds + 2 * 128 * RT_PT;
    __syncthreads();
#pragma unroll
    for (int q = 0; q < 2; ++q) {
        const int c = tid + 512 * q, row = c >> 3, cc = c & 7;
        const u32x4 kw = *(const u32x4*)(PR + (R0 + row) * PLD + C_RK + h * 64 + cc * 8), vw = *(const u32x4*)(PR + (R0 + row) * PLD + C_RV + h * 64 + cc * 8);
        const float wf = 0.125f * __builtin_amdgcn_exp2f(lgf * (float)(127 - row)), wb = 0.125f * __builtin_amdgcn_exp2f(lgb * (float)row);
        u32x4 of, ob;
#pragma unroll
        for (int j = 0; j < 4; ++j) { const float lo = bflo(kw[j]), hi = bfhi(kw[j]); of[j] = pack_bf16(lo * wf, hi * wf); ob[j] = pack_bf16(lo * wb, hi * wb); }
        *(u32x4*)(KF + row * RT_PT + cc * 16) = of; *(u32x4*)(KBk + row * RT_PT + cc * 16) = ob; *(u32x4*)(VV + row * RT_PT + cc * 16) = vw;
    }
    __syncthreads();
    const int dir = wid >> 2, dt = (wid >> 1) & 1, et = wid & 1;
    const char* Ks = dir ? KBk : KF;
    f32x16 acc;
#pragma unroll
    for (int i = 0; i < 16; ++i) acc[i] = 0.f;
#pragma unroll
    for (int s2 = 0; s2 < 8; ++s2) {
        const bf16x8 af = tr_frag_nat(Ks, RT_PT, 16 * s2, dt * 32, lane), bfv = tr_frag_nat(VV, RT_PT, 16 * s2, et * 32, lane);
        acc = __builtin_amdgcn_mfma_f32_32x32x16_bf16(af, bfv, acc, 0, 0, 0);
    }
    const int j = dir ? ret_jb(rb) : rb;
    float* dst = ((float*)(p->ws + WS_RKV)) + ((((size_t)bl * 4 + h) * 2 + dir) * 34 + j) * 4096 + et * 32 + r;
#pragma unroll
    for (int i = 0; i < 16; ++i) dst[(dt * 32 + (i & 3) + 8 * (i >> 2) + 4 * h5) * 64] = acc[i];
}

__device__ __forceinline__ void phase_p3a(KP p, int l, int bid, int nblk, char* lds)
{
    gemm_phase(((bf16_t*)(p->ws + WS_PROJ)) + C_CQ, PLD, ((bf16_t*)(p->ws + WS_WUQT)) + (size_t)l * 384 * 256, 256, TG, 384, 256, EpiStore{((bf16_t*)(p->ws + WS_QRAW)), 384}, lds, bid, nblk);
    gemm_phase(((bf16_t*)(p->ws + WS_PROJ)) + C_CKV, PLD, ((bf16_t*)(p->ws + WS_WUKVT)) + (size_t)l * 512 * 128, 128, TG, 512, 128, EpiStore{((bf16_t*)(p->ws + WS_KVRAW)), 512}, lds, bid, nblk);
    for (int u = bid; u < NB * 4 * 34; u += nblk) { const int rb = u % 34, h = (u / 34) & 3, bl = u / 136; ret_kv_unit(p, l, bl, h, rb, lds); }
}

#define LOG2_THETA 13.287712379549449f
__device__ __forceinline__ float rope_freq(int i, int half) { return exp2f(-LOG2_THETA * (float)i / (float)half); }

__device__ __forceinline__ void phase_p3b(KP p, int l, int bid, int nblk)
{
    {
        const int gt = bid * NTHREADS + get_tid();
        for (int it = gt; it < NB * 4 * 2 * 1024; it += nblk * NTHREADS) {
            const int e4 = it & 1023, bhd = it >> 10, dir = bhd & 1, h = (bhd >> 1) & 3;
            const float dec = __builtin_amdgcn_exp2f(log_sigmoidf(p->ret_logit[(l * 2 + dir) * 4 + h]) * 1.4426950408889634f * 128.f);
            f32x4* base = (f32x4*)((float*)(p->ws + WS_RKV) + (size_t)bhd * 34 * 4096) + e4;
            f32x4 st = (f32x4){0.f, 0.f, 0.f, 0.f};
            f32x4 kv[34];
#pragma unroll
            for (int j = 0; j < 34; ++j) kv[j] = base[(size_t)j * 1024];
#pragma unroll
            for (int j = 0; j < 34; ++j) { base[(size_t)j * 1024] = st; st = st * dec + kv[j]; }
        }
    }
    const int lane = get_tid() & 63, wid = get_tid() >> 6;
    const float mla_scale = 0.10206207261596575f * 1.4426950408889634f;
    auto load_row = [&](unsigned (&rw)[40], int r) {
        const bf16_t* pr = ((bf16_t*)(p->ws + WS_PROJ)) + (size_t)r * PLD;
        const bf16_t* qraw = ((bf16_t*)(p->ws + WS_QRAW)) + (size_t)r * 384;
        const bf16_t* kvraw = ((bf16_t*)(p->ws + WS_KVRAW)) + (size_t)r * 512;
#pragma unroll
        for (int i = 0; i < 4; ++i) rw[i] = pr[C_CQ + lane + 64 * i];
#pragma unroll
        for (int i = 0; i < 2; ++i) rw[4 + i] = pr[C_CKV + lane + 64 * i];
#pragma unroll
        for (int i = 0; i < 6; ++i) {
            const int idx = lane + 64 * i, h = idx / 96, d = idx % 96, dd = d >= 64 ? d - 64 : 0;
            rw[6 + i] = qraw[idx];
            rw[12 + i] = qraw[(unsigned)(d >= 64 ? idx - dd + (dd ^ 8) : idx)];
            rw[18 + i] = d < 64 ? kvraw[h * 128 + d] : pr[C_KPE + dd];
            rw[24 + i] = pr[C_KPE + (unsigned)(dd ^ 8)];
        }
#pragma unroll
        for (int i = 0; i < 4; ++i) { const int idx = lane + 64 * i, h = idx >> 6, e = idx & 63; rw[30 + i] = kvraw[h * 128 + 64 + e]; }
#pragma unroll
        for (int hh = 0; hh < 6; ++hh) rw[34 + hh] = pr[(hh < 4 ? C_GQ + hh * 64 : C_GK + (hh - 4) * 64) + lane];
    };
    auto proc_row = [&](const unsigned (&rw)[40], int r) {
        const int t = r % LTOK;
        const bool lat = t >= CTXL;
        const float prow = lat ? (float)((t - CTXL) >> 6) : 0.f, pcol = lat ? (float)((t - CTXL) & 63) : 0.f;
        float sq = 0.f, skv = 0.f;
#pragma unroll
        for (int i = 0; i < 4; ++i) { const float v = bf2f((bf16_t)rw[i]); sq += v * v; }
#pragma unroll
        for (int i = 0; i < 2; ++i) { const float v = bf2f((bf16_t)rw[4 + i]); skv += v * v; }
        sq = wave_sum(sq); skv = wave_sum(skv);
        const float rq = rsqrtf(sq * (1.f / 256.f) + EPSF), rkv = rsqrtf(skv * (1.f / 128.f) + EPSF);
#pragma unroll
        for (int i = 0; i < 6; ++i) {
            const int idx = lane + 64 * i, d = idx % 96;
            float qv = bf2f((bf16_t)rw[6 + i]), kv = bf2f((bf16_t)rw[18 + i]);
            if (d < 64) kv *= rkv;
            else if (lat) {
                const int dd = d - 64, blk = dd >> 4, w = dd & 15, fi = w & 7; const bool first = w < 8;
                const float rev = (blk ? pcol : prow) * rope_freq(fi, 8) * 0.15915494309189535f; const float sn = __builtin_amdgcn_sinf(rev), cs = __builtin_amdgcn_cosf(rev);
                const float qo = bf2f((bf16_t)rw[12 + i]), ko = bf2f((bf16_t)rw[24 + i]);
                qv = first ? (qv * cs - qo * sn) : (qo * sn + qv * cs);
                kv = first ? (kv * cs - ko * sn) : (ko * sn + kv * cs);
            }
            ((bf16_t*)(p->ws + WS_QA))[(size_t)r * 384 + idx] = f2bf(qv * rq * mla_scale);
            ((bf16_t*)(p->ws + WS_KA))[(size_t)r * 384 + idx] = f2bf(kv);
        }
#pragma unroll
        for (int i = 0; i < 4; ++i) ((bf16_t*)(p->ws + WS_VA))[(size_t)r * 256 + lane + 64 * i] = f2bf(bf2f((bf16_t)rw[30 + i]) * rkv);
        const int blk = lane >> 5, w = lane & 31, fi = w & 15; const bool first = w < 16;
        float sn = 0.f, cs = 1.f;
        if (lat) { const float rev = (blk ? pcol : prow) * rope_freq(fi, 16) * 0.15915494309189535f; sn = __builtin_amdgcn_sinf(rev); cs = __builtin_amdgcn_cosf(rev); }
        const float nwq = p->gqa_qn[l * 64 + lane], nwk = p->gqa_kn[l * 64 + lane];
#pragma unroll
        for (int hh = 0; hh < 6; ++hh) {
            const bool isq = hh < 4;
            const float v = bf2f((bf16_t)rw[34 + hh]);
            const float ss = wave_sum(v * v);
            const float n = v * rsqrtf(ss * (1.f / 64.f) + EPSF) * (isq ? nwq : nwk);
            const float other = xor_swz<16>(n);
            float val = n;
            if (lat) val = first ? (n * cs - other * sn) : (other * sn + n * cs);
            if (isq) ((bf16_t*)(p->ws + WS_GQ))[(size_t)r * 256 + hh * 64 + lane] = f2bf(val * (0.125f * 1.4426950408889634f));
            else ((bf16_t*)(p->ws + WS_GK))[(size_t)r * 128 + (hh - 4) * 64 + lane] = f2bf(val);
        }
    };
    const int rstep = nblk * 8;
    int r = bid * 8 + wid;
    if (r < TG) {
        unsigned ra[40], rb[40];
        load_row(ra, r);
        for (;;) {
            const bool m1 = r + rstep < TG;
            if (m1) load_row(rb, r + rstep);
            proc_row(ra, r);
            if (!m1) break;
            r += rstep;
            const bool m2 = r + rstep < TG;
            if (m2) load_row(ra, r + rstep);
            proc_row(rb, r);
            if (!m2) break;
            r += rstep;
        }
    }
}

template <int DQ>
__device__ __forceinline__ void attn_unit(const bf16_t* __restrict__ Qb, int qld, const bf16_t* __restrict__ Kb, int kld, const bf16_t* __restrict__ Vb, int vld,
                                          int nq, int nk, bf16_t* __restrict__ Ob, int old_, char* lds)
{
    constexpr int NS = DQ / 16, CPR = DQ / 8, KP = DQ * 2 + 16, VP = 144, KB = 64 * KP, VB = 64 * VP, STG = KB + VB, KCH = 64 * CPR;
    const int tid = get_tid(), lane = tid & 63, wid = tid >> 6, r = lane & 31, h = lane >> 5;
    int qrow[2]; bool qvalid[2];
    bf16x8 qf[2][NS];
#pragma unroll
    for (int qb = 0; qb < 2; ++qb) {
        qrow[qb] = wid * 64 + qb * 32 + r; qvalid[qb] = qrow[qb] < nq; if (!qvalid[qb]) qrow[qb] = 0;
#pragma unroll
        for (int s2 = 0; s2 < NS; ++s2) qf[qb][s2] = *(const bf16x8*)(Qb + (size_t)qrow[qb] * qld + 16 * s2 + 8 * h);
    }
    f32x16 o0[2], o1[2];
    float m[2] = {0.f, 0.f}, l[2] = {0.f, 0.f};
#pragma unroll
    for (int qb = 0; qb < 2; ++qb)
#pragma unroll
        for (int i = 0; i < 16; ++i) { o0[qb][i] = 0.f; o1[qb][i] = 0.f; }
    const int kr0 = tid / CPR, kc0 = tid % CPR, kr1 = (tid + 512) / CPR, kc1 = (tid + 512) % CPR; const bool k1 = (tid + 512) < KCH;
    const int vr = tid >> 3, vc = tid & 7;
    const bf16_t* kg0 = Kb + (size_t)kr0 * kld + kc0 * 8; const bf16_t* kg1 = Kb + (size_t)kr1 * kld + kc1 * 8; const bf16_t* vg = Vb + (size_t)vr * vld + vc * 8;
    const int kl0 = kr0 * KP + kc0 * 16, kl1 = kr1 * KP + kc1 * 16, vl = KB + vr * VP + vc * 16;
    u32x4 rk0, rk1 = (u32x4){0u, 0u, 0u, 0u}, rv;
    rk0 = *(const u32x4*)kg0; if (k1) rk1 = *(const u32x4*)kg1; rv = *(const u32x4*)vg;
    __syncthreads();
    *(u32x4*)(lds + kl0) = rk0; if (k1) *(u32x4*)(lds + kl1) = rk1; *(u32x4*)(lds + vl) = rv;
    __syncthreads();
    const int i16 = lane & 15, blk = (lane >> 4) & 1, q4 = i16 >> 2, p4 = i16 & 3;
    const int koff = r * KP + 16 * h, voff = KB + (4 * h + q4) * VP + 32 * blk + 8 * p4;
    const int nt = nk >> 6;
    for (int kt = 0; kt < nt; ++kt) {
        const int cur = (kt & 1) * STG, nxt = ((kt + 1) & 1) * STG;
        const bool more = kt + 1 < nt;
        if (more) {
            const size_t adv = (size_t)(kt + 1) * 64;
            rk0 = *(const u32x4*)(kg0 + adv * kld); if (k1) rk1 = *(const u32x4*)(kg1 + adv * kld); rv = *(const u32x4*)(vg + adv * vld);
        }
#pragma unroll
        for (int sub = 0; sub < 2; ++sub) {
            f32x16 sq[2];
#pragma unroll
            for (int i = 0; i < 16; ++i) { sq[0][i] = 0.f; sq[1][i] = 0.f; }
#pragma unroll
            for (int g0 = 0; g0 < NS; g0 += 4) {
                bf16x8 kfr[4];
#pragma unroll
                for (int s2 = 0; s2 < 4; ++s2) if (g0 + s2 < NS) kfr[s2] = *(const bf16x8*)(lds + cur + koff + sub * 32 * KP + (g0 + s2) * 32);
                __builtin_amdgcn_sched_barrier(0);
#pragma unroll
                for (int s2 = 0; s2 < 4; ++s2) if (g0 + s2 < NS) {
                    sq[0] = __builtin_amdgcn_mfma_f32_32x32x16_bf16(kfr[s2], qf[0][g0 + s2], sq[0], 0, 0, 0);
                    sq[1] = __builtin_amdgcn_mfma_f32_32x32x16_bf16(kfr[s2], qf[1][g0 + s2], sq[1], 0, 0, 0);
                }
            }
            bf16x8 vfr[2][2];
#pragma unroll
            for (int s2 = 0; s2 < 1; ++s2) {
                const int vb = cur + voff + (sub * 32 + 16 * s2) * VP;
                const s16x4 lo0 = __builtin_amdgcn_ds_read_tr16_b64_v4i16((LAS s16x4*)(lds + vb));
                const s16x4 hi0 = __builtin_amdgcn_ds_read_tr16_b64_v4i16((LAS s16x4*)(lds + vb + 8 * VP));
                const s16x4 lo1 = __builtin_amdgcn_ds_read_tr16_b64_v4i16((LAS s16x4*)(lds + vb + 64));
                const s16x4 hi1 = __builtin_amdgcn_ds_read_tr16_b64_v4i16((LAS s16x4*)(lds + vb + 8 * VP + 64));
                vfr[s2][0] = __builtin_shufflevector(lo0, hi0, 0, 1, 2, 3, 4, 5, 6, 7); vfr[s2][1] = __builtin_shufflevector(lo1, hi1, 0, 1, 2, 3, 4, 5, 6, 7);
            }
            bf16x8 pf[2][2];
#pragma unroll
            for (int qb = 0; qb < 2; ++qb) {
                f32x16& st = sq[qb];
                if (__builtin_amdgcn_ballot_w64(m[qb] != 0.f) != 0ull) {
#pragma unroll
                    for (int i = 0; i < 16; ++i) st[i] -= m[qb];
                }
                float mx = fmaxf(st[0], st[1]);
#pragma unroll
                for (int i = 2; i < 16; i += 2) mx = fmaxf(fmaxf(mx, st[i]), st[i + 1]);
                { const u32x2 sw = __builtin_amdgcn_permlane32_swap(__float_as_uint(mx), __float_as_uint(mx), false, false); mx = fmaxf(__uint_as_float(sw.x), __uint_as_float(sw.y)); }
                const bool first = (kt == 0) && (sub == 0);
                const bool mv = mx > 24.f || (first && mx < -24.f);
                if (__builtin_amdgcn_ballot_w64(mv) != 0ull) {
                    const float dlt = mv ? mx : 0.f, alpha = __builtin_amdgcn_exp2f(-dlt);
                    m[qb] += dlt; l[qb] *= alpha;
#pragma unroll
                    for (int i = 0; i < 16; ++i) { st[i] -= dlt; o0[qb][i] *= alpha; o1[qb][i] *= alpha; }
                }
                f32x2 rs2 = (f32x2){0.f, 0.f};
#pragma unroll
                for (int i = 0; i < 16; i += 2) { st[i] = __builtin_amdgcn_exp2f(st[i]); st[i + 1] = __builtin_amdgcn_exp2f(st[i + 1]); rs2 += (f32x2){st[i], st[i + 1]}; }
                l[qb] += rs2.x + rs2.y;
                u32x4 pw0, pw1;
                pw0.x = pack_bf16(st[0], st[1]); pw0.y = pack_bf16(st[2], st[3]); pw0.z = pack_bf16(st[4], st[5]); pw0.w = pack_bf16(st[6], st[7]);
                pw1.x = pack_bf16(st[8], st[9]); pw1.y = pack_bf16(st[10], st[11]); pw1.z = pack_bf16(st[12], st[13]); pw1.w = pack_bf16(st[14], st[15]);
                pf[qb][0] = __builtin_bit_cast(bf16x8, pw0); pf[qb][1] = __builtin_bit_cast(bf16x8, pw1);
            }
            {
                const int vb = cur + voff + (sub * 32 + 16) * VP;
                const s16x4 lo0 = __builtin_amdgcn_ds_read_tr16_b64_v4i16((LAS s16x4*)(lds + vb));
                const s16x4 hi0 = __builtin_amdgcn_ds_read_tr16_b64_v4i16((LAS s16x4*)(lds + vb + 8 * VP));
                const s16x4 lo1 = __builtin_amdgcn_ds_read_tr16_b64_v4i16((LAS s16x4*)(lds + vb + 64));
                const s16x4 hi1 = __builtin_amdgcn_ds_read_tr16_b64_v4i16((LAS s16x4*)(lds + vb + 8 * VP + 64));
                vfr[1][0] = __builtin_shufflevector(lo0, hi0, 0, 1, 2, 3, 4, 5, 6, 7); vfr[1][1] = __builtin_shufflevector(lo1, hi1, 0, 1, 2, 3, 4, 5, 6, 7);
            }
#pragma unroll
            for (int s2 = 0; s2 < 2; ++s2)
#pragma unroll
                for (int qb = 0; qb < 2; ++qb) {
                    o0[qb] = __builtin_amdgcn_mfma_f32_32x32x16_bf16(vfr[s2][0], pf[qb][s2], o0[qb], 0, 0, 0);
                    o1[qb] = __builtin_amdgcn_mfma_f32_32x32x16_bf16(vfr[s2][1], pf[qb][s2], o1[qb], 0, 0, 0);
                }
        }
        if (more) { *(u32x4*)(lds + nxt + kl0) = rk0; if (k1) *(u32x4*)(lds + nxt + kl1) = rk1; *(u32x4*)(lds + nxt + vl) = rv; }
        __syncthreads();
    }
#pragma unroll
    for (int qb = 0; qb < 2; ++qb) {
        float lt = sum_xor32(l[qb]);
        if (qvalid[qb]) {
            const float inv = 1.f / lt;
            bf16_t* op = Ob + (size_t)qrow[qb] * old_ + 4 * h;
#pragma unroll
            for (int g4 = 0; g4 < 4; ++g4) {
                store_bf16x4(op + 8 * g4, (f32x4){o0[qb][4 * g4] * inv, o0[qb][4 * g4 + 1] * inv, o0[qb][4 * g4 + 2] * inv, o0[qb][4 * g4 + 3] * inv});
                store_bf16x4(op + 32 + 8 * g4, (f32x4){o1[qb][4 * g4] * inv, o1[qb][4 * g4 + 1] * inv, o1[qb][4 * g4 + 2] * inv, o1[qb][4 * g4 + 3] * inv});
            }
        }
    }
}

__device__ __forceinline__ void ld8(const bf16_t* p, float (&o)[8]) {
    const u32x4 w = *(const u32x4*)p;
    o[0] = bflo(w.x); o[1] = bfhi(w.x); o[2] = bflo(w.y); o[3] = bfhi(w.y); o[4] = bflo(w.z); o[5] = bfhi(w.z); o[6] = bflo(w.w); o[7] = bfhi(w.w);
}

__device__ __forceinline__ void na_unit(KP p, int l, int bl, int h, int rg, char* lds)
{
    constexpr int KP_ = 144, VP = 144, KB = 64 * KP_, VB = 64 * VP, STG = KB + VB, LBIAS = 2 * STG;
    const int tid = get_tid(), lane = tid & 63, wid = tid >> 6, r = lane & 31, h5 = lane >> 5;
    const bf16_t* PR = (const bf16_t*)(p->ws + WS_PROJ);
    const size_t Rb = (size_t)bl * LTOK;
    const int grow = rg * 4 + (wid >> 1), c = (wid & 1) * 32 + r;
    const int rs = min(max(grow - 4, 0), 56), cs = min(max(c - 8, 0), 48);
    const int Rlo = min(max(rg * 4 - 4, 0), 56), Rhi = min(max(rg * 4 + 3 - 4, 0), 56) + 7, nrow = Rhi - Rlo + 1, nt = nrow + 4;
    const size_t qrow = Rb + CTXL + (size_t)grow * 64 + c;
    bf16x8 qf[4];
#pragma unroll
    for (int s2 = 0; s2 < 4; ++s2) qf[s2] = *(const bf16x8*)(PR + qrow * PLD + C_NQ + h * 64 + 16 * s2 + 8 * h5);
    f32x16 o0, o1;
#pragma unroll
    for (int i = 0; i < 16; ++i) { o0[i] = 0.f; o1[i] = 0.f; }
    float m = -1e30f, lsum = 0.f;
    const int kr = tid >> 3, kc = tid & 7;
    const int kl = kr * KP_ + kc * 16, vl = KB + kr * VP + kc * 16;
    auto tile_row = [&](int t) -> size_t { return t < nrow ? Rb + CTXL + (size_t)(Rlo + t) * 64 : Rb + (size_t)(t - nrow) * 64; };
    u32x4 rk, rv;
    { const size_t R = tile_row(0) + kr; rk = *(const u32x4*)(PR + R * PLD + C_NK + h * 64 + kc * 8); rv = *(const u32x4*)(PR + R * PLD + C_NV + h * 64 + kc * 8); }
    __syncthreads();
    *(u32x4*)(lds + kl) = rk; *(u32x4*)(lds + vl) = rv;
    { float* sb = (float*)(lds + LBIAS); const float* bias = p->na_bias + ((size_t)l * 4 + h) * 465; if (tid < 465) sb[tid] = bias[tid] * 1.4426950408889634f; }
    __syncthreads();
    const float* sb = (const float*)(lds + LBIAS);
    const int i16 = lane & 15, blk = (lane >> 4) & 1, q4 = i16 >> 2, p4 = i16 & 3;
    const int koff = r * KP_ + 16 * h5, voff = KB + (4 * h5 + q4) * VP + 32 * blk + 8 * p4;
    for (int t = 0; t < nt; ++t) {
        const int cur = (t & 1) * STG, nxt = ((t + 1) & 1) * STG;
        const bool more = t + 1 < nt;
        if (more) { const size_t R = tile_row(t + 1) + kr; rk = *(const u32x4*)(PR + R * PLD + C_NK + h * 64 + kc * 8); rv = *(const u32x4*)(PR + R * PLD + C_NV + h * 64 + kc * 8); }
        const bool win = t < nrow; const int R = Rlo + t;
        const bool mine = !win || (R >= rs && R <= rs + 7);
        if (mine) {
#pragma unroll
            for (int sub = 0; sub < 2; ++sub) {
                f32x16 st;
#pragma unroll
                for (int i = 0; i < 16; ++i) st[i] = 0.f;
#pragma unroll
                for (int s2 = 0; s2 < 4; ++s2) {
                    const bf16x8 kf = *(const bf16x8*)(lds + cur + koff + sub * 32 * KP_ + s2 * 32);
                    st = __builtin_amdgcn_mfma_f32_32x32x16_bf16(kf, qf[s2], st, 0, 0, 0);
                }
                if (win) {
                    const int brow = (R - grow + 7) * 31 + 15 - c;
#pragma unroll
                    for (int i = 0; i < 16; ++i) {
                        const int kcol = sub * 32 + (i & 3) + 8 * (i >> 2) + 4 * h5;
                        const bool ok = kcol >= cs && kcol < cs + 16;
                        const float bv = sb[ok ? brow + kcol : 0];
                        st[i] = ok ? st[i] + bv : -INFINITY;
                    }
                }
                float mx = fmaxf(st[0], st[1]);
#pragma unroll
                for (int i = 2; i < 16; i += 2) mx = fmaxf(fmaxf(mx, st[i]), st[i + 1]);
                mx = max_xor32(mx);
                const float mn = fmaxf(m, mx), alpha = __builtin_amdgcn_exp2f(m - mn);
                m = mn;
                f32x2 rs2 = (f32x2){0.f, 0.f};
#pragma unroll
                for (int i = 0; i < 16; i += 2) { st[i] = __builtin_amdgcn_exp2f(st[i] - mn); st[i + 1] = __builtin_amdgcn_exp2f(st[i + 1] - mn); rs2 += (f32x2){st[i], st[i + 1]}; }
                lsum = lsum * alpha + (rs2.x + rs2.y);
                if (__builtin_amdgcn_ballot_w64(alpha != 1.f) != 0ull) {
#pragma unroll
                    for (int i = 0; i < 16; ++i) { o0[i] *= alpha; o1[i] *= alpha; }
                }
                u32x4 pw0, pw1;
                pw0.x = pack_bf16(st[0], st[1]); pw0.y = pack_bf16(st[2], st[3]); pw0.z = pack_bf16(st[4], st[5]); pw0.w = pack_bf16(st[6], st[7]);
                pw1.x = pack_bf16(st[8], st[9]); pw1.y = pack_bf16(st[10], st[11]); pw1.z = pack_bf16(st[12], st[13]); pw1.w = pack_bf16(st[14], st[15]);
                const bf16x8 pf0 = __builtin_bit_cast(bf16x8, pw0), pf1 = __builtin_bit_cast(bf16x8, pw1);
#pragma unroll
                for (int s2 = 0; s2 < 2; ++s2) {
                    const int vb = cur + voff + (sub * 32 + 16 * s2) * VP;
                    const s16x4 lo0 = __builtin_amdgcn_ds_read_tr16_b64_v4i16((LAS s16x4*)(lds + vb));
                    const s16x4 hi0 = __builtin_amdgcn_ds_read_tr16_b64_v4i16((LAS s16x4*)(lds + vb + 8 * VP));
                    const s16x4 lo1 = __builtin_amdgcn_ds_read_tr16_b64_v4i16((LAS s16x4*)(lds + vb + 64));
                    const s16x4 hi1 = __builtin_amdgcn_ds_read_tr16_b64_v4i16((LAS s16x4*)(lds + vb + 8 * VP + 64));
                    const bf16x8 vf0 = __builtin_shufflevector(lo0, hi0, 0, 1, 2, 3, 4, 5, 6, 7), vf1 = __builtin_shufflevector(lo1, hi1, 0, 1, 2, 3, 4, 5, 6, 7);
                    o0 = __builtin_amdgcn_mfma_f32_32x32x16_bf16(vf0, s2 ? pf1 : pf0, o0, 0, 0, 0);
                    o1 = __builtin_amdgcn_mfma_f32_32x32x16_bf16(vf1, s2 ? pf1 : pf0, o1, 0, 0, 0);
                }
            }
        }
        if (more) { *(u32x4*)(lds + nxt + kl) = rk; *(u32x4*)(lds + nxt + vl) = rv; }
        __syncthreads();
    }
    lsum = sum_xor32(lsum);
    const float inv = 1.f / lsum;
    bf16_t* op = ((bf16_t*)(p->ws + WS_OUTS)) + ((size_t)2 * TG + qrow) * 256 + h * 64 + 4 * h5;
#pragma unroll
    for (int g4 = 0; g4 < 4; ++g4) {
        store_bf16x4(op + 8 * g4, (f32x4){o0[4 * g4] * inv, o0[4 * g4 + 1] * inv, o0[4 * g4 + 2] * inv, o0[4 * g4 + 3] * inv});
        store_bf16x4(op + 32 + 8 * g4, (f32x4){o1[4 * g4] * inv, o1[4 * g4 + 1] * inv, o1[4 * g4 + 2] * inv, o1[4 * g4 + 3] * inv});
    }
}

__device__ __forceinline__ void ret_out_unit(KP p, int l, int bl, int h, int rb, char* lds)
{
    const int tid = get_tid(), lane = tid & 63, wid = tid >> 6, r = lane & 31, h5 = lane >> 5;
    const bf16_t* PR = (const bf16_t*)(p->ws + WS_PROJ);
    const size_t R0 = (size_t)bl * LTOK + rb * 128;
    const float lgf = log_sigmoidf(p->ret_logit[(l * 2 + 0) * 4 + h]) * 1.4426950408889634f, lgb = log_sigmoidf(p->ret_logit[(l * 2 + 1) * 4 + h]) * 1.4426950408889634f;
    char* KK = lds; char* VV = lds + 128 * RT_PT; char* SS = lds + 2 * 128 * RT_PT;
    float* YB = (float*)lds;
    __syncthreads();
#pragma unroll
    for (int q = 0; q < 2; ++q) {
        const int c = tid + 512 * q, row = c >> 3, cc = c & 7;
        const u32x4 kw = *(const u32x4*)(PR + (R0 + row) * PLD + C_RK + h * 64 + cc * 8), vw = *(const u32x4*)(PR + (R0 + row) * PLD + C_RV + h * 64 + cc * 8);
        u32x4 ok;
#pragma unroll
        for (int j = 0; j < 4; ++j) ok[j] = pack_bf16(bflo(kw[j]) * 0.125f, bfhi(kw[j]) * 0.125f);
        *(u32x4*)(KK + row * RT_PT + cc * 16) = ok; *(u32x4*)(VV + row * RT_PT + cc * 16) = vw;
    }
    {
        const int jf = rb, jb = ret_jb(rb);
#pragma unroll
        for (int q = 0; q < 2; ++q) {
            const int e = tid + 512 * q, dir = e >> 9, dk = (e >> 3) & 63, e0 = (e & 7) * 8, j = dir ? jb : jf;
            const float* src = ((float*)(p->ws + WS_RKV)) + ((((size_t)bl * 4 + h) * 2 + dir) * 34 + j) * 4096 + dk * 64 + e0;
            const f32x4 s0 = *(const f32x4*)src, s1 = *(const f32x4*)(src + 4);
            u32x4 o; o.x = pack_bf16(s0[0], s0[1]); o.y = pack_bf16(s0[2], s0[3]); o.z = pack_bf16(s1[0], s1[1]); o.w = pack_bf16(s1[2], s1[3]);
            *(u32x4*)(SS + (dir * 64 + dk) * RT_PT + e0 * 2) = o;
        }
    }
    __syncthreads();
    const int dir = wid >> 2, mt = wid & 3;
    const float lg = dir ? lgb : lgf;
    const int qi = mt * 32 + r;
    bf16x8 qf[4];
#pragma unroll
    for (int s2 = 0; s2 < 4; ++s2) qf[s2] = *(const bf16x8*)(PR + (R0 + qi) * PLD + C_RQ + h * 64 + 16 * s2 + 8 * h5);
    f32x16 o0, o1;
#pragma unroll
    for (int i = 0; i < 16; ++i) { o0[i] = 0.f; o1[i] = 0.f; }
    {
        const char* Sd = SS + dir * 64 * RT_PT;
#pragma unroll
        for (int s2 = 0; s2 < 4; ++s2) {
            const bf16x8 a0 = tr_frag_nat(Sd, RT_PT, 16 * s2, 0, lane), a1 = tr_frag_nat(Sd, RT_PT, 16 * s2, 32, lane);
            o0 = __builtin_amdgcn_mfma_f32_32x32x16_bf16(a0, qf[s2], o0, 0, 0, 0);
            o1 = __builtin_amdgcn_mfma_f32_32x32x16_bf16(a1, qf[s2], o1, 0, 0, 0);
        }
        const int pos = dir ? 127 - qi : qi;
        const float qd = __builtin_amdgcn_exp2f(lg * (float)(pos + 1));
#pragma unroll
        for (int i = 0; i < 16; ++i) { o0[i] *= qd; o1[i] *= qd; }
    }
    const int kt0 = dir ? mt : 0, kt1 = dir ? 3 : mt;
    for (int kt = kt0; kt <= kt1; ++kt) {
        f32x16 st;
#pragma unroll
        for (int i = 0; i < 16; ++i) st[i] = 0.f;
#pragma unroll
        for (int s2 = 0; s2 < 4; ++s2) {
            const bf16x8 kf = *(const bf16x8*)(KK + (kt * 32 + r) * RT_PT + s2 * 32 + 16 * h5);
            st = __builtin_amdgcn_mfma_f32_32x32x16_bf16(kf, qf[s2], st, 0, 0, 0);
        }
#pragma unroll
        for (int i = 0; i < 16; ++i) {
            const int ki = kt * 32 + (i & 3) + 8 * (i >> 2) + 4 * h5;
            const int diff = dir ? ki - qi : qi - ki;
            st[i] = diff >= 0 ? st[i] * __builtin_amdgcn_exp2f(lg * (float)diff) : 0.f;
        }
        u32x4 pw0, pw1;
        pw0.x = pack_bf16(st[0], st[1]); pw0.y = pack_bf16(st[2], st[3]); pw0.z = pack_bf16(st[4], st[5]); pw0.w = pack_bf16(st[6], st[7]);
        pw1.x = pack_bf16(st[8], st[9]); pw1.y = pack_bf16(st[10], st[11]); pw1.z = pack_bf16(st[12], st[13]); pw1.w = pack_bf16(st[14], st[15]);
        const bf16x8 pf0 = __builtin_bit_cast(bf16x8, pw0), pf1 = __builtin_bit_cast(bf16x8, pw1);
#pragma unroll
        for (int s2 = 0; s2 < 2; ++s2) {
            const bf16x8 v0 = tr_frag_acc(VV, RT_PT, kt * 32 + 16 * s2, 0, lane), v1 = tr_frag_acc(VV, RT_PT, kt * 32 + 16 * s2, 32, lane);
            o0 = __builtin_amdgcn_mfma_f32_32x32x16_bf16(v0, s2 ? pf1 : pf0, o0, 0, 0, 0);
            o1 = __builtin_amdgcn_mfma_f32_32x32x16_bf16(v1, s2 ? pf1 : pf0, o1, 0, 0, 0);
        }
    }
    float sm = 0.f;
#pragma unroll
    for (int i = 0; i < 16; ++i) sm += o0[i] + o1[i];
    sm = sum_xor32(sm);
    const float mu = sm * (1.f / 64.f);
    float vs = 0.f;
#pragma unroll
    for (int i = 0; i < 16; ++i) { const float a0 = o0[i] - mu, a1 = o1[i] - mu; vs += a0 * a0 + a1 * a1; }
    vs = sum_xor32(vs);
    const float rstd = rsqrtf(vs * (1.f / 64.f) + EPSF);
    const bf16_t* gp = PR + (R0 + qi) * PLD + (dir ? C_RGB : C_RGF) + h * 64 + 4 * h5;
    const float* gw = p->ret_gnw + l * 256 + h * 64 + 4 * h5;
    __syncthreads();
#pragma unroll
    for (int t = 0; t < 2; ++t)
#pragma unroll
        for (int g4 = 0; g4 < 4; ++g4) {
            const u32x2 gg = *(const u32x2*)(gp + 32 * t + 8 * g4); const f32x4 ww = *(const f32x4*)(gw + 32 * t + 8 * g4);
            const float g0 = bflo(gg.x), g1 = bfhi(gg.x), g2 = bflo(gg.y), g3 = bfhi(gg.y);
            f32x4 y;
            y[0] = ((t ? o1[4 * g4] : o0[4 * g4]) - mu) * rstd * ww[0] * siluf(g0);
            y[1] = ((t ? o1[4 * g4 + 1] : o0[4 * g4 + 1]) - mu) * rstd * ww[1] * siluf(g1);
            y[2] = ((t ? o1[4 * g4 + 2] : o0[4 * g4 + 2]) - mu) * rstd * ww[2] * siluf(g2);
            y[3] = ((t ? o1[4 * g4 + 3] : o0[4 * g4 + 3]) - mu) * rstd * ww[3] * siluf(g3);
            *(f32x4*)(YB + (dir * 128 + qi) * 68 + 32 * t + 8 * g4 + 4 * h5) = y;
        }
    __syncthreads();
#pragma unroll
    for (int q = 0; q < 2; ++q) {
        const int e = tid + 512 * q, row = e >> 3, c8 = (e & 7) * 8;
        const f32x4 a0 = *(const f32x4*)(YB + row * 68 + c8), a1 = *(const f32x4*)(YB + row * 68 + c8 + 4), b0 = *(const f32x4*)(YB + (128 + row) * 68 + c8), b1 = *(const f32x4*)(YB + (128 + row) * 68 + c8 + 4);
        u32x4 o; o.x = pack_bf16(a0[0] + b0[0], a0[1] + b0[1]); o.y = pack_bf16(a0[2] + b0[2], a0[3] + b0[3]); o.z = pack_bf16(a1[0] + b1[0], a1[1] + b1[1]); o.w = pack_bf16(a1[2] + b1[2], a1[3] + b1[3]);
        *(u32x4*)(((bf16_t*)(p->ws + WS_OUTS)) + ((size_t)3 * TG + R0 + row) * 256 + h * 64 + c8) = o;
    }
}

#define U_MLA (NB * 32)
#define U_GQA (NB * 32)
#define U_NA (NB * 64)
#define U_RET (NB * 136)
#define U_CTX (NB * 12)
__device__ __forceinline__ int wq_next(unsigned* counter, LAS unsigned* wq) {
    __syncthreads();
    if (get_tid() == 0) *wq = atomicAdd(counter, 1u);
    __syncthreads();
    return (int)*wq;
}
__device__ __forceinline__ void phase_p4(KP p, int l, int g, char* ldsc, int bid, int nblk)
{
    float* lds = (float*)ldsc;
    LAS unsigned* wq = (LAS unsigned*)(smem + 32);
    unsigned* counter = ((unsigned*)(p->ws + WS_CNT)) + (l * NGROUP + g) * 64 * 8;
    (void)bid; (void)nblk;
    for (;;) {
        const int u = wq_next(counter, wq); if (u >= U_MLA) break;
        const int qb = u & 7, h = (u >> 3) & 3, bl = u >> 5; const size_t Rb = (size_t)bl * LTOK, Rq = Rb + CTXL + qb * 512;
        attn_unit<96>(((bf16_t*)(p->ws + WS_QA)) + Rq * 384 + h * 96, 384, ((bf16_t*)(p->ws + WS_KA)) + Rb * 384 + h * 96, 384, ((bf16_t*)(p->ws + WS_VA)) + Rb * 256 + h * 64, 256, 512, LTOK, ((bf16_t*)(p->ws + WS_OUTS)) + ((size_t)0 * TG + Rq) * 256 + h * 64, 256, ldsc);
    }
    for (;;) {
        const int u = wq_next(counter + 64, wq); if (u >= U_GQA) break;
        const int qb = u & 7, h = (u >> 3) & 3, bl = u >> 5; const size_t Rb = (size_t)bl * LTOK, Rq = Rb + CTXL + qb * 512; const int kvh = h >> 1;
        attn_unit<64>(((bf16_t*)(p->ws + WS_GQ)) + Rq * 256 + h * 64, 256, ((bf16_t*)(p->ws + WS_GK)) + Rb * 128 + kvh * 64, 128, ((bf16_t*)(p->ws + WS_PROJ)) + Rb * PLD + C_GV + kvh * 64, PLD, 512, LTOK, ((bf16_t*)(p->ws + WS_OUTS)) + ((size_t)1 * TG + Rq) * 256 + h * 64, 256, ldsc);
    }
    for (;;) {
        const int u = wq_next(counter + 128, wq); if (u >= U_NA) break;
        na_unit(p, l, u >> 6, (u >> 4) & 3, u & 15, ldsc);
    }
    for (;;) {
        const int u = wq_next(counter + 192, wq); if (u >= U_RET) break;
        const int rb = u % 34, h = (u / 34) & 3, bl = u / 136; ret_out_unit(p, l, bl, h, rb, ldsc);
    }
    if (l == 0) {
        for (;;) {
            const int u = wq_next(counter + 256, wq); if (u >= NB * 4) break;
            const int h = u & 3, bl = u >> 2; const size_t Rb = (size_t)bl * LTOK;
            attn_unit<96>(((bf16_t*)(p->ws + WS_QA)) + Rb * 384 + h * 96, 384, ((bf16_t*)(p->ws + WS_KA)) + Rb * 384 + h * 96, 384, ((bf16_t*)(p->ws + WS_VA)) + Rb * 256 + h * 64, 256, 256, CTXL, ((bf16_t*)(p->ws + WS_OUTS)) + ((size_t)0 * TG + Rb) * 256 + h * 64, 256, ldsc);
        }
        for (;;) {
            const int u = wq_next(counter + 320, wq); if (u >= NB * 8) break;
            const int ty = u & 1, h = (u >> 1) & 3, bl = u >> 3; const size_t Rb = (size_t)bl * LTOK;
            const bf16_t* Q = ty ? ((bf16_t*)(p->ws + WS_PROJ)) + Rb * PLD + C_NQ + h * 64 : ((bf16_t*)(p->ws + WS_GQ)) + Rb * 256 + h * 64;
            const bf16_t* K = ty ? ((bf16_t*)(p->ws + WS_PROJ)) + Rb * PLD + C_NK + h * 64 : ((bf16_t*)(p->ws + WS_GK)) + Rb * 128 + (h >> 1) * 64;
            const bf16_t* V = ty ? ((bf16_t*)(p->ws + WS_PROJ)) + Rb * PLD + C_NV + h * 64 : ((bf16_t*)(p->ws + WS_PROJ)) + Rb * PLD + C_GV + (h >> 1) * 64;
            attn_unit<64>(Q, ty ? PLD : 256, K, ty ? PLD : 128, V, PLD, 256, CTXL, ((bf16_t*)(p->ws + WS_OUTS)) + ((size_t)(1 + ty) * TG + Rb) * 256 + h * 64, 256, ldsc);
        }
    }
}

template <int MI>
__device__ __forceinline__ void p5_tile(KP p, int l, char* lds, int pm, int pn, int rsub)
{
    const int tid = get_tid(), lane = tid & 63, wid = tid >> 6, wm = wid >> 1, wn = wid & 1, fr = lane & 15, fq = lane >> 4;
    const int arow = tid >> 3, akc = tid & 7, a_l = arow * G_LDP + akc * 16;
    const int aoff = (wm * 16 * MI + fr) * G_LDP + fq * 16, boff = G_ABYTES + (wn * 64 + fr) * G_LDP + fq * 16;
    const bf16_t* OUTS = (const bf16_t*)(p->ws + WS_OUTS);
    const bf16_t* WB = (const bf16_t*)(p->ws + WS_WBT) + (size_t)l * 4 * DM * 256;
    const int rbase = pm * 256 + rsub;
    {
        const bf16_t* ag = OUTS + ((size_t)rbase + arow) * 256 + akc * 8;
        const bf16_t* bg = WB + ((size_t)pn * G_BN + arow) * 256 + akc * 8;
        const unsigned char* gp = (const unsigned char*)(p->ws + WS_GATE8) + (size_t)(rbase + wm * 16 * MI + fr) * 4096 + pn * G_BN + wn * 64 + fq * 16;
        f32x4 acc[MI][4]; zero_acc<MI>(acc);
        u32x2 totp[MI][4];
#pragma unroll
        for (int mi = 0; mi < MI; ++mi)
#pragma unroll
            for (int ni = 0; ni < 4; ++ni) totp[mi][ni] = (u32x2){0u, 0u};
        u32x4 sa[2][MI], sb[2][2];
        u32x4 gwv[MI];
#define P5_LOAD(SET, KT) do { const bf16_t* a2_ = ag + (size_t)((KT) >> 2) * TG * 256 + ((KT) & 3) * 64; const bf16_t* b2_ = bg + (size_t)((KT) >> 2) * DM * 256 + ((KT) & 3) * 64; \
            _Pragma("unroll") for (int i_ = 0; i_ < MI; ++i_) sa[SET][i_] = *(const u32x4*)(a2_ + (size_t)(64 * i_) * 256); \
            _Pragma("unroll") for (int i_ = 0; i_ < 2; ++i_) sb[SET][i_] = *(const u32x4*)(b2_ + (size_t)(64 * i_) * 256); } while (0)
#define P5_STORE(SET, BO) do { \
            _Pragma("unroll") for (int i_ = 0; i_ < MI; ++i_) *(u32x4*)(lds + (BO) + a_l + i_ * 64 * G_LDP) = sa[SET][i_]; \
            _Pragma("unroll") for (int i_ = 0; i_ < 2; ++i_) *(u32x4*)(lds + (BO) + G_ABYTES + a_l + i_ * 64 * G_LDP) = sb[SET][i_]; } while (0)
        P5_LOAD(0, 0);
        __syncthreads();
        P5_STORE(0, 0);
        P5_LOAD(0, 1); P5_LOAD(1, 2);
        __syncthreads();
#pragma unroll 1
        for (int sg = 0; sg < 4; ++sg) {
#pragma unroll
            for (int q4 = 0; q4 < 4; ++q4) {
                const int par = q4 & 1, kt = 4 * sg + q4, cur = par * G_STAGE, nxt = (par ^ 1) * G_STAGE;
#pragma unroll
                for (int ks = 0; ks < 2; ++ks) {
                    bf16x8 af[MI], bfr[4];
#pragma unroll
                    for (int mi = 0; mi < MI; ++mi) af[mi] = *(const bf16x8*)(lds + cur + aoff + mi * 16 * G_LDP + ks * 64);
#pragma unroll
                    for (int ni = 0; ni < 4; ++ni) bfr[ni] = *(const bf16x8*)(lds + cur + boff + ni * 16 * G_LDP + ks * 64);
#pragma unroll
                    for (int mi = 0; mi < MI; ++mi)
#pragma unroll
                        for (int ni = 0; ni < 4; ++ni) acc[mi][ni] = __builtin_amdgcn_mfma_f32_16x16x32_bf16(bfr[ni], af[mi], acc[mi][ni], 0, 0, 0);
                }
                if (q4 == 1) {
#pragma unroll
                    for (int mi = 0; mi < MI; ++mi)
                        gwv[mi] = *(const u32x4*)(gp + (size_t)(mi * 16) * 4096 + sg * DM);
                    __builtin_amdgcn_sched_barrier(0);
                }
                P5_STORE(par, nxt);
                { const int kn = (kt + 3 < 16) ? kt + 3 : 15; P5_LOAD(par, kn); }
                __syncthreads();
                if (q4 == 3) {
                    __builtin_amdgcn_sched_barrier(0);
#pragma unroll
                    for (int mi = 0; mi < MI; ++mi)
#pragma unroll
                        for (int ni = 0; ni < 4; ++ni) {
                            const unsigned gw = gwv[mi][ni];
                            const u32x2 tp = totp[mi][ni];
                            const float t0 = fmaf((float)((gw >> 0) & 255u), acc[mi][ni][0], bflo(tp.x)), t1 = fmaf((float)((gw >> 8) & 255u), acc[mi][ni][1], bfhi(tp.x));
                            const float t2 = fmaf((float)((gw >> 16) & 255u), acc[mi][ni][2], bflo(tp.y)), t3 = fmaf((float)((gw >> 24) & 255u), acc[mi][ni][3], bfhi(tp.y));
                            totp[mi][ni] = (u32x2){pack_bf16(t0, t1), pack_bf16(t2, t3)};
                            acc[mi][ni] = (f32x4){0.f, 0.f, 0.f, 0.f};
                        }
                }
            }
        }
#undef P5_LOAD
#undef P5_STORE
#pragma unroll
        for (int mi = 0; mi < MI; ++mi)
#pragma unroll
            for (int ni = 0; ni < 4; ++ni) {
                const u32x2 tp = totp[mi][ni]; const float k255 = 1.f / 255.f;
                *(u32x2*)(((bf16_t*)(p->ws + WS_ACC)) + (size_t)(rbase + wm * 16 * MI + mi * 16 + fr) * DM + pn * G_BN + wn * 64 + ni * 16 + fq * 4) =
                    (u32x2){pack_bf16(bflo(tp.x) * k255, bfhi(tp.x) * k255), pack_bf16(bflo(tp.y) * k255, bfhi(tp.y) * k255)};
            }
    }
}

__device__ __forceinline__ void phase_p5(KP p, int l, char* lds, int bid, int nblk)
{
    constexpr int tn = DM / G_BN, total = (TG / 256) * tn, NG8 = (TG / 256) / 8;
    const bool xord = (nblk == 256) && (tn == 8) && ((TG / 256) % 8 == 0);
    if (xord) {
        constexpr int NFULL = (NG8 % 4 == 1) ? NG8 / 4 : (NG8 + 3) / 4;
#pragma unroll 1
        for (int it = 0; it < NFULL; ++it) {
            const int g8 = it * 4 + (bid >> 6); if (g8 >= NG8) break;
            p5_tile<4>(p, l, lds, g8 * 8 + (bid & 7), (bid >> 3) & 7, 0);
        }
        if (NG8 % 4 == 1) p5_tile<1>(p, l, lds, (NG8 - 1) * 8 + (bid & 7), (bid >> 3) & 7, (bid >> 6) * 64);
    } else {
        for (int t = bid; t < total; t += nblk) p5_tile<4>(p, l, lds, t / tn, t % tn, 0);
    }
}

struct EpiResid {
    KP p; int l, g, goff;
    __device__ __forceinline__ void operator()(int row, int col, f32x4 v) const {
        const int bl = row / LTOK, t = row - bl * LTOK, b = g * NB + bl;
        float* dst; const float* src; int mr;
        if (t < CTXL) { if (l != 0) return; const size_t o = ((size_t)b * CTXL + t) * DM + col; dst = ((float*)(p->ws + WS_CTXS)) + o; src = p->ctx + o; mr = 16; }
        else { const size_t o = ((size_t)b * SEQ + (t - CTXL)) * DM + col; dst = p->out + o; src = (l == 0) ? p->x + o : (const float*)dst; mr = b; }
        const f32x4 gg = *(const f32x4*)(((float*)(p->ws + WS_MOD)) + ((size_t)l * 17 + mr) * 6144 + goff + col);
        f32x4 s = *(const f32x4*)src;
#pragma unroll
        for (int j = 0; j < 4; ++j) s[j] += gg[j] * v[j];
        *(f32x4*)dst = s;
    }
};

__device__ __forceinline__ void grid_barrier();
#if MK_ONE_LAUNCH
#define P9_GRID_SYNC() grid_barrier()
#else
#define P9_GRID_SYNC() __syncthreads()
#endif
typedef __bf16 bf16pair __attribute__((ext_vector_type(2)));
__device__ __forceinline__ float dot2bf(unsigned a, unsigned b, float c) { return __builtin_amdgcn_fdot2_f32_bf16(__builtin_bit_cast(bf16pair, a), __builtin_bit_cast(bf16pair, b), c, false); }
__device__ __forceinline__ unsigned f2ord(float f) { const unsigned b = __float_as_uint(f); return b ^ ((unsigned)((int)b >> 31) | 0x80000000u); }
__device__ __forceinline__ int mbcnt64(unsigned long long m) { return (int)__builtin_amdgcn_mbcnt_hi((unsigned)(m >> 32), __builtin_amdgcn_mbcnt_lo((unsigned)m, 0u)); }

__device__ __forceinline__ float ord2f(unsigned u) { return __uint_as_float((u & 0x80000000u) ? (u ^ 0x80000000u) : ~u); }

__device__ __forceinline__ void cx_desc(unsigned& a, unsigned& b) { const unsigned hi = a > b ? a : b, lo = a > b ? b : a; a = hi; b = lo; }
template <int N, int OFF, bool DESC, int M>
__device__ __forceinline__ void bitonic_sort(unsigned (&a)[M]) {
#pragma unroll
    for (int k = 2; k <= N; k <<= 1)
#pragma unroll
        for (int j = k >> 1; j > 0; j >>= 1)
#pragma unroll
            for (int i = 0; i < N; ++i) {
                const int l = i ^ j;
                if (l > i) { const bool up = ((i & k) == 0) != DESC; if (up) cx_desc(a[OFF + l], a[OFF + i]); else cx_desc(a[OFF + i], a[OFF + l]); }
            }
}
__device__ __forceinline__ void bitonic_merge16_desc(unsigned (&a)[16]) {
#pragma unroll
    for (int j = 8; j > 0; j >>= 1)
#pragma unroll
        for (int i = 0; i < 16; ++i) { const int l = i ^ j; if (l > i) cx_desc(a[i], a[l]); }
}
template <int XM>
__device__ __forceinline__ void merge_partner16(unsigned (&a)[16], bool upper) {
    unsigned b[16];
#pragma unroll
    for (int i = 0; i < 16; ++i) b[i] = (XM == 32) ? get_xor32_u(a[15 - i], upper) : xor_swz_u<XM & 31>(a[15 - i]);
#pragma unroll
    for (int i = 0; i < 16; ++i) a[i] = a[i] > b[i] ? a[i] : b[i];
    bitonic_merge16_desc(a);
}

#define P9_KEYP 144
#define P9_NTOK 136
#define P9_HG 3
#define P9_LKEY 0
#define P9_LIDX (P9_HG * 2 * 128 * P9_KEYP)
#define P9_LSTASH 0
__device__ __forceinline__ constexpr int p9_pair_i(int pi) {
    return pi < 16 ? 0 : pi < 24 ? 1 : pi < 29 ? 2 : pi < 33 ? 3 : pi < 36 ? 4 : pi < 38 ? 5 : pi < 40 ? 6 : pi < 42 ? 7 : pi < 50 ? pi - 34 : 0;
}
__device__ __forceinline__ constexpr int p9_pair_j(int pi) {
    return pi < 16 ? pi : pi < 24 ? pi - 16 : pi < 29 ? pi - 24 : pi < 33 ? pi - 29 : pi < 36 ? pi - 33 : pi < 38 ? pi - 36 : pi < 40 ? pi - 38 : pi < 42 ? pi - 40 : 0;
}
__device__ __forceinline__ void phase_p9(KP p, int l, int g, char* lds, int bid, int nblk)
{
    const int tid = get_tid(), wid = tid >> 6;
    const bf16_t* KEYB = (const bf16_t*)(p->ws + WS_KEYB) + (size_t)l * 8 * 2 * 128 * 64;
    const bf16_t* PQ = (const bf16_t*)(p->ws + WS_PQ);
    unsigned* stash = (unsigned*)(lds + P9_LSTASH);
    const int nit = (TG / P9_NTOK + nblk - 1) / nblk;
    for (int it = 0; it < nit; ++it) {
        const int blk = bid + it * nblk;
        if (blk >= TG / P9_NTOK) { P9_GRID_SYNC(); P9_GRID_SYNC(); continue; }
        const int row0 = blk * P9_NTOK;
        unsigned* gst = (unsigned*)(p->ws + WS_PROJ) + (size_t)row0 * 128;
#pragma unroll 1
        for (int h0 = 0; h0 < 8; h0 += P9_HG) {
            const int nh = (8 - h0) < P9_HG ? (8 - h0) : P9_HG;
            __syncthreads();
            for (int c = tid; c < nh * 2048; c += NTHREADS) { const int row = c >> 3, cc = c & 7;
                *(u32x4*)(lds + P9_LKEY + row * P9_KEYP + cc * 16) = *(const u32x4*)(KEYB + ((size_t)h0 * 256 + row) * 64 + cc * 8); }
            __syncthreads();
#pragma unroll 1
            for (int item = wid; item < 9 * nh; item += 8) {
                const int tile = item % 9, hh = item / 9, h = h0 + hh;
                const int LK = P9_LKEY + hh * 256 * P9_KEYP;
                const int tidh = get_tid(), tk = tidh & 15, qd = (tidh >> 4) & 3;
                const int ntile = (P9_NTOK - 16 * tile) < 16 ? (P9_NTOK - 16 * tile) : 16;
                const int trow = row0 + 16 * tile + (tk < ntile ? tk : ntile - 1);
                unsigned* idxl = (unsigned*)(lds + P9_LIDX) + (wid * 16 + tk) * 33;
                unsigned top[2][16];
#pragma unroll
                for (int pp = 0; pp < 2; ++pp) {
                    f32x4 acc[8];
#pragma unroll
                    for (int t = 0; t < 8; ++t) acc[t] = (f32x4){0.f, 0.f, 0.f, 0.f};
#pragma unroll
                    for (int ks = 0; ks < 2; ++ks) {
                        const bf16x8 qfr = *(const bf16x8*)(PQ + (size_t)trow * DM + h * 128 + pp * 64 + ks * 32 + qd * 8);
#pragma unroll
                        for (int t = 0; t < 8; ++t) {
                            const bf16x8 kfr = *(const bf16x8*)(lds + LK + (pp * 128 + t * 16 + tk) * P9_KEYP + ks * 64 + qd * 16);
                            acc[t] = __builtin_amdgcn_mfma_f32_16x16x32_bf16(kfr, qfr, acc[t], 0, 0, 0);
                        }
                    }
                    unsigned ck[32];
#pragma unroll
                    for (int t = 0; t < 8; ++t)
#pragma unroll
                        for (int jj = 0; jj < 4; ++jj) ck[t * 4 + jj] = (f2ord(acc[t][jj]) & 0xFFFFFF80u) | (unsigned)(16 * t + jj) | ((unsigned)qd << 2);
                    bitonic_sort<16, 0, true>(ck);
                    bitonic_sort<16, 16, false>(ck);
                    unsigned (&tp)[16] = top[pp];
#pragma unroll
                    for (int i = 0; i < 16; ++i) tp[i] = ck[i] > ck[16 + i] ? ck[i] : ck[16 + i];
                    bitonic_merge16_desc(tp);
                    merge_partner16<16>(tp, false); merge_partner16<32>(tp, (qd & 2) != 0);
                    if (qd == 0) {
#pragma unroll
                        for (int i = 0; i < 16; ++i) idxl[pp * 16 + i] = tp[i] & 127u;
                    }
                }
                float v1[16], v2[16];
#pragma unroll
                for (int i = 0; i < 16; ++i) { v1[i] = ord2f(top[0][i] & 0xFFFFFF80u); v2[i] = ord2f(top[1][i] & 0xFFFFFF80u); }
                unsigned cand[16];
#pragma unroll
                for (int n = 0; n < 13; ++n) {
                    const unsigned k0 = (f2ord(v1[p9_pair_i(4 * n)] + v2[p9_pair_j(4 * n)]) & 0xFFFFFF00u) | (unsigned)(p9_pair_i(4 * n) * 16 + p9_pair_j(4 * n));
                    const unsigned k1 = (f2ord(v1[p9_pair_i(4 * n + 1)] + v2[p9_pair_j(4 * n + 1)]) & 0xFFFFFF00u) | (unsigned)(p9_pair_i(4 * n + 1) * 16 + p9_pair_j(4 * n + 1));
                    const unsigned k2 = (4 * n + 2 < 50) ? ((f2ord(v1[p9_pair_i(4 * n + 2)] + v2[p9_pair_j(4 * n + 2)]) & 0xFFFFFF00u) | (unsigned)(p9_pair_i(4 * n + 2) * 16 + p9_pair_j(4 * n + 2))) : 0u;
                    const unsigned k3 = (4 * n + 3 < 50) ? ((f2ord(v1[p9_pair_i(4 * n + 3)] + v2[p9_pair_j(4 * n + 3)]) & 0xFFFFFF00u) | (unsigned)(p9_pair_i(4 * n + 3) * 16 + p9_pair_j(4 * n + 3))) : 0u;
                    cand[n] = qd == 0 ? k0 : (qd == 1 ? k1 : (qd == 2 ? k2 : k3));
                }
                cand[13] = 0u; cand[14] = 0u; cand[15] = 0u;
                bitonic_sort<16, 0, true>(cand);
                merge_partner16<16>(cand, false); merge_partner16<32>(cand, (qd & 2) != 0);
                const float mx = ord2f(cand[0] & 0xFFFFFF00u);
                float ex[16], den = 0.f;
#pragma unroll
                for (int k = 0; k < 16; ++k) { ex[k] = __expf(ord2f(cand[k] & 0xFFFFFF00u) - mx); den += ex[k]; }
                const float inv = 1.f / den;
                if (qd == 0 && tk < ntile) {
#pragma unroll
                    for (int k = 0; k < 16; ++k) {
                        const unsigned e = idxl[(cand[k] >> 4) & 15u] * 128u + idxl[16 + (cand[k] & 15u)];
                        gst[((16 * tile + tk) * 8 + h) * 16 + k] = (e << 16) | (unsigned)f2bf(ex[k] * inv);
                    }
                }
            }
        }
        P9_GRID_SYNC();
        {
            const u32x4* src = (const u32x4*)gst; u32x4* dstl = (u32x4*)(lds + P9_LSTASH);
            for (int c = get_tid(); c < P9_NTOK * 128 / 4; c += NTHREADS) dstl[c] = src[c];
            __syncthreads();
        }
        {
            const int tid2 = get_tid(), lane = tid2 & 63, wid2 = tid2 >> 6;
            KP p2 = get_kp();
            const unsigned char* UB = (const unsigned char*)(p2->ws + WS_UB) + (size_t)l * 16384 * (DM / 2);
            const float* USC = (const float*)(p2->ws + WS_USC) + (size_t)l * 16384; const float* VSC = (const float*)(p2->ws + WS_VSC) + (size_t)l * 16384;
            const bf16_t* Hh = HG(p2, g);
#pragma unroll 1
            for (int slot = wid2; slot < P9_NTOK; slot += 8) {
                const int r = row0 + slot;
                if ((r % LTOK) < CTXL && l != 0) continue;
                const u32x4 x0 = *(const u32x4*)(Hh + (size_t)r * DM + lane * 16), x1 = *(const u32x4*)(Hh + (size_t)r * DM + lane * 16 + 8);
#pragma unroll 1
                for (int h = 0; h < 8; ++h) {
                    unsigned* st = stash + (slot * 8 + h) * 16;
                    float d[16];
                    const int kk = (lane >> 2) & 15;
                    const unsigned sk = st[kk];
                    const float su = USC[sk >> 16], svs = VSC[sk >> 16];
                    {
                        u32x2 ua[16];
#pragma unroll
                        for (int k = 0; k < 16; ++k) ua[k] = *(const u32x2*)(UB + (size_t)(st[k] >> 16) * (DM / 2) + lane * 8);
#pragma unroll
                        for (int k = 0; k < 16; ++k) {
                            float a = 0.f;
#define P9_UDOT(XW, UW, B) { const unsigned xw_ = (XW); a = __builtin_amdgcn_fdot2_f32_bf16(__builtin_bit_cast(bf16pair, xw_), __builtin_amdgcn_cvt_scalef32_pk_bf16_fp4((UW), 1.0f, B), a, false); }
                            { const unsigned u0_ = ua[k].x, u1_ = ua[k].y;
                              P9_UDOT(x0.x, u0_, 0) P9_UDOT(x0.y, u0_, 1) P9_UDOT(x0.z, u0_, 2) P9_UDOT(x0.w, u0_, 3)
                              P9_UDOT(x1.x, u1_, 0) P9_UDOT(x1.y, u1_, 1) P9_UDOT(x1.z, u1_, 2) P9_UDOT(x1.w, u1_, 3) }
#undef P9_UDOT
                            d[k] = a;
                        }
                    }
                    float r8[8], r4[4], r2[2], r1;
#pragma unroll
                    for (int i = 0; i < 8; ++i) { const u32x2 sw = __builtin_amdgcn_permlane32_swap(__float_as_uint(d[i]), __float_as_uint(d[i + 8]), false, false); r8[i] = __uint_as_float(sw.x) + __uint_as_float(sw.y); }
#pragma unroll
                    for (int i = 0; i < 4; ++i) { const u32x2 sw = __builtin_amdgcn_permlane16_swap(__float_as_uint(r8[i]), __float_as_uint(r8[i + 4]), false, false); r4[i] = __uint_as_float(sw.x) + __uint_as_float(sw.y); }
                    { const bool bb = (lane & 8) != 0;
#pragma unroll
                      for (int i = 0; i < 2; ++i) { const float snd = bb ? r4[i] : r4[i + 2], keep = bb ? r4[i + 2] : r4[i]; r2[i] = keep + xor_swz<8>(snd); } }
                    { const bool bb = (lane & 4) != 0; const float snd = bb ? r2[0] : r2[1], keep = bb ? r2[1] : r2[0]; r1 = keep + xor_swz<4>(snd); }
                    r1 += xor_swz<2>(r1); r1 += xor_swz<1>(r1);
                    r1 *= su;
                    const float cf = bflo(sk) * 0.5f * r1 * (1.f + erff(r1 * 0.70710678118654752f)) * svs;
                    if ((lane & 3) == 0) st[kk] = (sk & 0xffff0000u) | (unsigned)f2bf(cf);
                }
            }
        }
        P9_GRID_SYNC();
        {
            const int tid2 = get_tid(), lane = tid2 & 63, wid2 = tid2 >> 6;
            KP p2 = get_kp();
            const unsigned char* VB = (const unsigned char*)(p2->ws + WS_VB) + (size_t)l * 16384 * (DM / 2);
#pragma unroll 1
            for (int slot = wid2; slot < P9_NTOK; slot += 8) {
                const int r = row0 + slot;
                const int bl = r / LTOK, t = r - bl * LTOK, b = g * NB + bl;
                if (t < CTXL && l != 0) continue;
                float* dst; int mr;
                if (t < CTXL) { dst = ((float*)(p2->ws + WS_CTXS)) + ((size_t)b * CTXL + t) * DM; mr = 16; } else { dst = p2->out + ((size_t)b * SEQ + (t - CTXL)) * DM; mr = b; }
                const float* g2 = ((float*)(p2->ws + WS_MOD)) + ((size_t)l * 17 + mr) * 6144 + 5120;
                f32x4 sv[4];
#pragma unroll
                for (int i = 0; i < 4; ++i) sv[i] = *(const f32x4*)(dst + lane * 16 + i * 4);
                float outv[16];
#pragma unroll
                for (int i = 0; i < 16; ++i) outv[i] = 0.f;
#pragma unroll 1
                for (int h = 0; h < 8; ++h) {
                    const unsigned* st = stash + (slot * 8 + h) * 16;
                    u32x2 va[16]; unsigned sk[16];
#pragma unroll
                    for (int k = 0; k < 16; ++k) { sk[k] = st[k]; va[k] = *(const u32x2*)(VB + (size_t)(sk[k] >> 16) * (DM / 2) + lane * 8); }
#pragma unroll
                    for (int k = 0; k < 16; ++k) {
                        const float ck = bflo(sk[k]);
#define P9_VFMA(W, B) { const f32x2 t_ = __builtin_amdgcn_cvt_scalef32_pk_f32_fp4(va[k][W], 1.0f, B); outv[8 * (W) + 2 * (B)] += ck * t_.x; outv[8 * (W) + 2 * (B) + 1] += ck * t_.y; }
                        P9_VFMA(0, 0) P9_VFMA(0, 1) P9_VFMA(0, 2) P9_VFMA(0, 3) P9_VFMA(1, 0) P9_VFMA(1, 1) P9_VFMA(1, 2) P9_VFMA(1, 3)
#undef P9_VFMA
                        if ((k & 3) == 3) __builtin_amdgcn_sched_barrier(0);
                    }
                }
                const int lane = get_tid() & 63;
                float ss = 0.f;
#pragma unroll
                for (int i = 0; i < 4; ++i) {
                    const f32x4 gg = *(const f32x4*)(g2 + lane * 16 + i * 4);
#pragma unroll
                    for (int jj = 0; jj < 4; ++jj) { sv[i][jj] += gg[jj] * outv[i * 4 + jj]; ss += sv[i][jj] * sv[i][jj]; }
                }
                if (l == 0) {
                    const float rstd0 = rsqrtf(wave_sum(ss) * (1.f / DM) + EPSF);
                    const float* md1 = ((float*)(p2->ws + WS_MOD)) + ((size_t)17 + mr) * 6144;
                    bf16_t* hrow = HG(p2, g) + (size_t)r * DM + lane * 16;
#pragma unroll
                    for (int i = 0; i < 4; ++i) {
                        const int c = lane * 16 + i * 4;
                        const f32x4 w1 = *(const f32x4*)(p2->norm1_w + DM + c), sc = *(const f32x4*)(md1 + 1024 + c), sh = *(const f32x4*)(md1 + c);
                        f32x4 y;
#pragma unroll
                        for (int jj = 0; jj < 4; ++jj) y[jj] = sv[i][jj] * rstd0 * w1[jj] * (1.f + sc[jj]) + sh[jj];
                        store_bf16x4(hrow + i * 4, y);
                    }
                }
                if (l == 1) {
                    ss = wave_sum(ss);
                    const float rstd = rsqrtf(ss * (1.f / DM) + EPSF);
#pragma unroll
                    for (int i = 0; i < 4; ++i) { const f32x4 fw = *(const f32x4*)(p2->final_w + lane * 16 + i * 4);
#pragma unroll
                        for (int jj = 0; jj < 4; ++jj) sv[i][jj] *= rstd * fw[jj]; }
                }
#pragma unroll
                for (int i = 0; i < 4; ++i) *(f32x4*)(dst + lane * 16 + i * 4) = sv[i];
            }
        }
    }
}

__device__ __forceinline__ void phase_final(KP p, int bid, int nblk)
{
    const int lane = get_tid() & 63, wid = get_tid() >> 6;
    for (int r = bid * 8 + wid; r < NBATCH * SEQ; r += nblk * 8) {
        float* src = p->out + (size_t)r * DM;
        f32x4 v[4]; float ss = 0.f;
#pragma unroll
        for (int i = 0; i < 4; ++i) { v[i] = *(const f32x4*)(src + i * 256 + lane * 4); ss += v[i][0] * v[i][0] + v[i][1] * v[i][1] + v[i][2] * v[i][2] + v[i][3] * v[i][3]; }
        ss = wave_sum(ss);
        const float rstd = rsqrtf(ss * (1.f / DM) + EPSF);
#pragma unroll
        for (int i = 0; i < 4; ++i) {
            const f32x4 w = *(const f32x4*)(p->final_w + i * 256 + lane * 4);
            f32x4 y;
#pragma unroll
            for (int j = 0; j < 4; ++j) y[j] = v[i][j] * rstd * w[j];
            *(f32x4*)(src + i * 256 + lane * 4) = y;
        }
    }
}

template <int PH>
__device__ __forceinline__ void run_phase(KP p, int l, int g, char* lds, int bid, int nblk)
{
    asm volatile("" : "+s"(l), "+s"(g), "+s"(bid), "+s"(nblk));
    if constexpr (PH == 0) phase_prologue(p, lds, bid, nblk);
    if constexpr (PH == 1) { for (int gg = 0; gg < NGROUP; ++gg) phase_norm(p, 0, gg, 0, bid, nblk); }
    if constexpr (PH == 2) big_gemm(HG(p, g), ((bf16_t*)(p->ws + WS_WINT)) + (size_t)l * NPROJ * DM, TG, NPROJ, DM, Epi8<EpiProj8>{EpiProj8{((bf16_t*)(p->ws + WS_PROJ)), (unsigned char*)(p->ws + WS_GATE8)}}, lds, bid, nblk);
    if constexpr (PH == 3) phase_p3a(p, l, bid, nblk, lds);
    if constexpr (PH == 4) phase_p3b(p, l, bid, nblk);
    if constexpr (PH == 6) phase_p4(p, l, g, lds, bid, nblk);
    if constexpr (PH == 7) phase_p5(p, l, lds, bid, nblk);
    if constexpr (PH == 8) big_gemm(((bf16_t*)(p->ws + WS_ACC)), ((bf16_t*)(p->ws + WS_WOUTT)) + (size_t)l * DM * DM, TG, DM, DM, Epi4<EpiResid>{EpiResid{p, l, g, 2048}}, lds, bid, nblk);
    if constexpr (PH == 9) phase_norm(p, l, g, 1, bid, nblk);
    if constexpr (PH == 10) big_gemm(HG(p, g), ((bf16_t*)(p->ws + WS_WQT)) + (size_t)l * DM * DM, TG, DM, DM, Epi8<EpiStore8>{EpiStore8{((bf16_t*)(p->ws + WS_PQ)), DM}}, lds, bid, nblk);
    if constexpr (PH == 11) phase_p9(p, l, g, lds, bid, nblk);
    if constexpr (PH == 12) phase_final(p, bid, nblk);
}


__device__ __forceinline__ void grid_barrier() {
    XcdBarrier b; b.bar = (unsigned*)(get_kp()->ws + WS_BAR); b.x = xb_xcc_id(); b.st = (volatile LAS unsigned*)smem;
    xcd_barrier(b);
}

template <int PH>
__global__ void __launch_bounds__(NTHREADS, 2) k_phase(Params p_unused, int l, int g)
{
    (void)p_unused;
    tid_setup();
    run_phase<PH>(get_kp(), l, g, smem + 512, blockIdx.x, gridDim.x);
}

#if MK_ONE_LAUNCH
__global__ void __launch_bounds__(NTHREADS, 2) k_mega(Params p_unused)
{
    (void)p_unused;
    tid_setup();
    if (get_tid() == 0) *(uint4*)smem = make_uint4(0u, 0u, 0u, 0u);
    __syncthreads();
    (void)xcd_barrier_post((unsigned*)(get_kp()->ws + WS_BAR), (volatile LAS unsigned*)smem);
    char* lds = smem + 512;
    const int bid = blockIdx.x, nblk = gridDim.x;
    run_phase<0>(get_kp(), 0, 0, lds, bid, nblk);
    grid_barrier();
#define MK_LG(L_, G_) do { \
        run_phase<2>(get_kp(), L_, G_, lds, bid, nblk); grid_barrier(); \
        run_phase<3>(get_kp(), L_, G_, lds, bid, nblk); grid_barrier(); \
        run_phase<4>(get_kp(), L_, G_, lds, bid, nblk); grid_barrier(); \
        run_phase<6>(get_kp(), L_, G_, lds, bid, nblk); grid_barrier(); \
        run_phase<7>(get_kp(), L_, G_, lds, bid, nblk); grid_barrier(); \
        run_phase<8>(get_kp(), L_, G_, lds, bid, nblk); grid_barrier(); \
        run_phase<9>(get_kp(), L_, G_, lds, bid, nblk); grid_barrier(); \
        run_phase<10>(get_kp(), L_, G_, lds, bid, nblk); grid_barrier(); \
        run_phase<11>(get_kp(), L_, G_, lds, bid, nblk); grid_barrier(); } while (0)
    run_phase<1>(get_kp(), 0, 0, lds, bid, nblk); grid_barrier();
    static_assert(NGROUP == 2, "phase program written out for two groups");
    MK_LG(0, 0); MK_LG(0, 1); MK_LG(1, 0); MK_LG(1, 1);
#undef MK_LG
}
#endif

static inline size_t al256(size_t x) { return (x + 255) & ~(size_t)255; }

template <int PH>
static void launch_phase(const Params& p, int l, int g, int grid, hipStream_t s)
{
    static bool attr = false;
    if (!attr) { (void)hipFuncSetAttribute((const void*)k_phase<PH>, hipFuncAttributeMaxDynamicSharedMemorySize, LDS_BYTES); attr = true; }
    hipLaunchKernelGGL(k_phase<PH>, dim3(grid), dim3(NTHREADS), LDS_BYTES, s, p, l, g);
}

extern "C" void kernel_launch(void* const* d_in, const int* in_sizes, int n_in, void* d_out, int out_size, void* d_ws, size_t ws_size, hipStream_t stream)
{
    (void)in_sizes; (void)n_in; (void)out_size;
    Params p{};
    p.x = (const float*)d_in[0]; p.c = (const float*)d_in[1]; p.ctx = (const float*)d_in[2]; p.c_ctx = (const float*)d_in[3];
    p.mod_w = (const float*)d_in[4]; p.mod_b = (const float*)d_in[5]; p.norm1_w = (const float*)d_in[6]; p.norm2_w = (const float*)d_in[7];
    p.w_in = (const float*)d_in[8]; p.mla_qn = (const float*)d_in[9]; p.mla_wuq = (const float*)d_in[10]; p.mla_kvn = (const float*)d_in[11];
    p.mla_wukv = (const float*)d_in[12]; p.gqa_qn = (const float*)d_in[13]; p.gqa_kn = (const float*)d_in[14]; p.na_bias = (const float*)d_in[15];
    p.ret_logit = (const float*)d_in[16]; p.ret_gnw = (const float*)d_in[17]; p.w_branch = (const float*)d_in[18]; p.w_out = (const float*)d_in[19];
    p.peer_wq = (const float*)d_in[20]; p.peer_keys = (const float*)d_in[21]; p.peer_u = (const float*)d_in[22]; p.peer_v = (const float*)d_in[23];
    p.final_w = (const float*)d_in[24];
    p.out = (float*)d_out;
    p.ws = (char*)d_ws;
    if (WS_TOTAL > ws_size) { fprintf(stderr, "workspace too small: need %zu have %zu\n", (size_t)WS_TOTAL, ws_size); return; }
    (void)hipMemsetAsync(d_ws, 0, WS_ZERO_END, stream);

    static int ncu = 0;
    if (!ncu) { int dev = 0; (void)hipGetDevice(&dev); (void)hipDeviceGetAttribute(&ncu, hipDeviceAttributeMultiprocessorCount, dev); if (ncu <= 0) ncu = 256; }
#if MK_ONE_LAUNCH
    static bool attr = false;
    if (!attr) { (void)hipFuncSetAttribute((const void*)k_mega, hipFuncAttributeMaxDynamicSharedMemorySize, LDS_BYTES); attr = true; }
    hipLaunchKernelGGL(k_mega, dim3(ncu), dim3(NTHREADS), LDS_BYTES, stream, p);
#else
    const int grid = ncu;
    launch_phase<0>(p, 0, 0, grid, stream);
    for (int l = 0; l < 2; ++l)
        for (int g = 0; g < NGROUP; ++g) {
            if (l == 0 && g == 0) launch_phase<1>(p, l, g, grid, stream);
            launch_phase<2>(p, l, g, grid, stream);
            launch_phase<3>(p, l, g, grid, stream);
            launch_phase<4>(p, l, g, grid, stream);
            launch_phase<6>(p, l, g, grid, stream);
            launch_phase<7>(p, l, g, grid, stream);
            launch_phase<8>(p, l, g, grid, stream);
            launch_phase<9>(p, l, g, grid, stream);
            launch_phase<10>(p, l, g, grid, stream);
            launch_phase<11>(p, l, g, grid, stream);
        }
#endif
}
```

```cpp
#include <hip/hip_runtime.h>
#include <stdint.h>
#include <stdio.h>

#ifndef MK_ONE_LAUNCH
#define MK_ONE_LAUNCH 1
#endif

#define DM 1024
#define NBATCH 16
#define SEQ 4096
#define CTXL 256
#define LTOK 4352
#define IN_COLS 7072
#define NPROJ 7168
#define PLD 3072
#define NB 8
#define NGROUP (NBATCH / NB)
#define TG (NB * LTOK)
#define NTHREADS 512
#define LDS_BYTES 131648
#define EPSF 1e-6f

#define C_CQ 0
#define C_CKV 256
#define C_KPE 384
#define C_GQ 416
#define C_GK 672
#define C_GV 800
#define C_NQ 928
#define C_NK 1184
#define C_NV 1440
#define C_RQ 1696
#define C_RK 1952
#define C_RV 2208
#define C_RGF 2464
#define C_RGB 2720
#define C_GATE 2976

#define LAS __attribute__((address_space(3)))
typedef unsigned short bf16_t;
typedef short bf16x8 __attribute__((ext_vector_type(8)));
typedef float f32x4 __attribute__((ext_vector_type(4)));
typedef float f32x2 __attribute__((ext_vector_type(2)));
typedef __bf16 bf16x2_t __attribute__((ext_vector_type(2)));
typedef unsigned u32x4 __attribute__((ext_vector_type(4)));
typedef unsigned u32x2 __attribute__((ext_vector_type(2)));
typedef float f32x16 __attribute__((ext_vector_type(16)));
typedef short s16x4 __attribute__((ext_vector_type(4)));

__device__ __forceinline__ unsigned pack_bf16(float lo, float hi) { f32x2 v = {lo, hi}; bf16x2_t b = __builtin_convertvector(v, bf16x2_t); return __builtin_bit_cast(unsigned, b); }
__device__ __forceinline__ bf16_t f2bf(float f) { return (bf16_t)(pack_bf16(f, 0.f) & 0xffffu); }
__device__ __forceinline__ float bf2f(bf16_t b) { return __uint_as_float(((unsigned)b) << 16); }
__device__ __forceinline__ float bflo(unsigned w) { return __uint_as_float(w << 16); }
__device__ __forceinline__ float bfhi(unsigned w) { return __uint_as_float(w & 0xffff0000u); }
#define PEER_USCALE 128.f
#define PEER_VSCALE 16.f
__device__ __forceinline__ float clamp448(float x) { return fminf(fmaxf(x, -448.f), 448.f); }
__device__ __forceinline__ unsigned pack_fp8x4(f32x4 v, float sc) {
    int w = 0;
    w = __builtin_amdgcn_cvt_pk_fp8_f32(clamp448(v[0] * sc), clamp448(v[1] * sc), w, false);
    w = __builtin_amdgcn_cvt_pk_fp8_f32(clamp448(v[2] * sc), clamp448(v[3] * sc), w, true);
    return (unsigned)w;
}

template <int M> __device__ __forceinline__ float xor_swz(float v) { return __int_as_float(__builtin_amdgcn_ds_swizzle(__float_as_int(v), (M << 10) | 0x1f)); }
template <int M> __device__ __forceinline__ unsigned xor_swz_u(unsigned v) { return (unsigned)__builtin_amdgcn_ds_swizzle((int)v, (M << 10) | 0x1f); }
__device__ __forceinline__ float sum_xor32(float v) { const u32x2 r = __builtin_amdgcn_permlane32_swap(__float_as_uint(v), __float_as_uint(v), false, false); return __uint_as_float(r.x) + __uint_as_float(r.y); }
__device__ __forceinline__ float max_xor32(float v) { const u32x2 r = __builtin_amdgcn_permlane32_swap(__float_as_uint(v), __float_as_uint(v), false, false); return fmaxf(__uint_as_float(r.x), __uint_as_float(r.y)); }
__device__ __forceinline__ unsigned get_xor32_u(unsigned v, bool upper) { const u32x2 r = __builtin_amdgcn_permlane32_swap(v, v, false, false); return upper ? r.x : r.y; }
__device__ __forceinline__ float wave_max(float v) {
    v = fmaxf(v, xor_swz<1>(v)); v = fmaxf(v, xor_swz<2>(v)); v = fmaxf(v, xor_swz<4>(v)); v = fmaxf(v, xor_swz<8>(v)); v = fmaxf(v, xor_swz<16>(v));
    return max_xor32(v);
}
__device__ __forceinline__ float wave_sum(float v) {
    v += xor_swz<1>(v); v += xor_swz<2>(v); v += xor_swz<4>(v); v += xor_swz<8>(v); v += xor_swz<16>(v);
    return sum_xor32(v);
}
extern __shared__ __attribute__((aligned(16))) char smem[];
#define WIDTAB_OFF 64
__device__ __forceinline__ unsigned hw_wave_slot() { return (unsigned)__builtin_amdgcn_s_getreg((5 << 11) | 4) & 63u; }
__device__ __forceinline__ void tid_setup() {
    if ((threadIdx.x & 63) == 0) ((volatile LAS int*)(smem + WIDTAB_OFF))[hw_wave_slot()] = (int)(threadIdx.x >> 6);
    __syncthreads();
}
__device__ __forceinline__ int get_tid() {
    int lane; asm volatile("v_mbcnt_lo_u32_b32 %0, -1, 0\n\tv_mbcnt_hi_u32_b32 %0, -1, %0" : "=v"(lane));
    int w = ((volatile LAS int*)(smem + WIDTAB_OFF))[hw_wave_slot()];
    w = __builtin_amdgcn_readfirstlane(w);
    int t = (w << 6) | lane; asm volatile("" : "+v"(t)); return t;
}
__device__ __forceinline__ float siluf(float x) { return x * __builtin_amdgcn_rcpf(1.f + __builtin_amdgcn_exp2f(x * -1.4426950408889634f)); }
__device__ __forceinline__ float sigmf(float x) { return __builtin_amdgcn_rcpf(1.f + __builtin_amdgcn_exp2f(x * -1.4426950408889634f)); }

#define XB_TMO      128
#define XB_XCNT(j)  (256  + 64 * (j))
#define XB_XSUB(j)  (1280 + 64 * (j))
#define XB_XGEN(j)  (2304 + 64 * (j))
#define XB_TOP      3328
#define XB_TOPGEN   3392
#define XCD_BAR_WORDS 3456
#define XB_SPIN_CAP (1u << 18)

__device__ __forceinline__ unsigned xb_ld(unsigned* p)              { return __hip_atomic_load(p, __ATOMIC_RELAXED, __HIP_MEMORY_SCOPE_AGENT); }
__device__ __forceinline__ unsigned xb_add(unsigned* p, unsigned v) { return __hip_atomic_fetch_add(p, v, __ATOMIC_RELAXED, __HIP_MEMORY_SCOPE_AGENT); }
__device__ __forceinline__ unsigned xb_xcc_id() { return (unsigned)__builtin_amdgcn_s_getreg((3 << 11) | 20) & 0xFu; }
#define XB_SPIN(cond, bar) do { unsigned _sp = 0; while (cond) { __builtin_amdgcn_s_sleep(1); \
    if ((++_sp & 255u) == 0u) { if (xb_ld(&(bar)[XB_TMO])) break; if (_sp > XB_SPIN_CAP) { atomicAdd(&(bar)[XB_TMO], 1u); break; } } } } while (0)

struct XcdBarrier { unsigned* bar; unsigned x; volatile LAS unsigned* st; };

__device__ __forceinline__ XcdBarrier xcd_barrier_post(unsigned* bar, volatile LAS unsigned* st) {
    XcdBarrier b; b.bar = bar; b.x = xb_xcc_id(); b.st = st;
    if (get_tid() == 0) (void)xb_add(&bar[XB_XCNT(b.x)], 1u);
    return b;
}
__device__ __forceinline__ void xcd_barrier_complete(unsigned* bar, unsigned x, unsigned& nloc, unsigned& nx) {
    const unsigned G = gridDim.x * gridDim.y * gridDim.z;
    unsigned sum, cnt, mine, sp = 0u;
    for (;;) {
        sum = 0u; cnt = 0u; mine = 0u;
#pragma unroll
        for (unsigned j = 0; j < 16; ++j) { const unsigned c = xb_ld(&bar[XB_XCNT(j)]); sum += c; cnt += (c > 0u) ? 1u : 0u; mine = (j == x) ? c : mine; }
        if (sum == G) break;
        __builtin_amdgcn_s_sleep(1);
        if ((++sp & 255u) == 0u) { if (xb_ld(&bar[XB_TMO])) break; if (sp > XB_SPIN_CAP) { atomicAdd(&bar[XB_TMO], 1u); break; } }
    }
    nloc = mine > 0u ? mine : 1u; nx = cnt > 0u ? cnt : 1u;
}
__device__ __forceinline__ void xcd_barrier(const XcdBarrier& b) {
    asm volatile("s_waitcnt vmcnt(0)" ::: "memory");
    __syncthreads();
    if (get_tid() == 0) {
        unsigned* bar = b.bar;
        __builtin_amdgcn_s_waitcnt(0);
        unsigned nloc = b.st[0], nx = b.st[1];
        if (nloc == 0u) { xcd_barrier_complete(bar, b.x, nloc, nx); b.st[0] = nloc; b.st[1] = nx; }
        const unsigned old = xb_add(&bar[XB_XSUB(b.x)], 1u);
        const unsigned gen = old / nloc;
        if (old + 1u == (gen + 1u) * nloc) {
            __builtin_amdgcn_fence(__ATOMIC_RELEASE, "agent");
            asm volatile("s_waitcnt vmcnt(0)" ::: "memory");
            const unsigned og = xb_add(&bar[XB_TOP], 1u);
            const unsigned tg = og / nx;
            if (og + 1u == (tg + 1u) * nx) xb_add(&bar[XB_TOPGEN], 1u);
            else XB_SPIN(xb_ld(&bar[XB_TOPGEN]) == tg, bar);
            __builtin_amdgcn_fence(__ATOMIC_ACQUIRE, "agent");
            xb_add(&bar[XB_XGEN(b.x)], 1u);
            asm volatile("s_waitcnt vmcnt(0)" ::: "memory");
        } else {
            XB_SPIN(xb_ld(&bar[XB_XGEN(b.x)]) == gen, bar);
            __builtin_amdgcn_fence(__ATOMIC_ACQUIRE, "agent");
            asm volatile("s_waitcnt vmcnt(0)" ::: "memory");
        }
    }
    __syncthreads();
}

struct Params {
    const float *x, *c, *ctx, *c_ctx, *mod_w, *mod_b, *norm1_w, *norm2_w, *w_in, *mla_qn, *mla_wuq, *mla_kvn, *mla_wukv,
                *gqa_qn, *gqa_kn, *na_bias, *ret_logit, *ret_gnw, *w_branch, *w_out, *peer_wq, *peer_keys, *peer_u, *peer_v, *final_w;
    float* out;
    char* ws;
};
typedef const __attribute__((address_space(4))) Params* KP;
__device__ __forceinline__ KP get_kp() { KP kp = (KP)__builtin_amdgcn_kernarg_segment_ptr(); asm volatile("" : "+s"(kp)); return kp; }

constexpr size_t al256c(size_t x) { return (x + 255) & ~(size_t)255; }
constexpr size_t WS_BAR = 0;
constexpr size_t WS_CNT = WS_BAR + al256c(XCD_BAR_WORDS * 4);
constexpr size_t WS_ZERO_END = WS_CNT + al256c(8 * 8 * 64 * 4);
constexpr size_t WS_MOD = WS_ZERO_END;
constexpr size_t WS_CTXS = WS_MOD + al256c((size_t)2 * 17 * 6144 * 4);
constexpr size_t WS_WINT = WS_CTXS + al256c((size_t)NBATCH * CTXL * DM * 4);
constexpr size_t WS_WUQT = WS_WINT + al256c((size_t)2 * NPROJ * DM * 2);
constexpr size_t WS_WUKVT = WS_WUQT + al256c((size_t)2 * 384 * 256 * 2);
constexpr size_t WS_WBT = WS_WUKVT + al256c((size_t)2 * 512 * 128 * 2);
constexpr size_t WS_WOUTT = WS_WBT + al256c((size_t)2 * 4 * DM * 256 * 2);
constexpr size_t WS_WQT = WS_WOUTT + al256c((size_t)2 * DM * DM * 2);
constexpr size_t WS_H = WS_WQT + al256c((size_t)2 * DM * DM * 2);
constexpr size_t WS_PROJ = WS_H + al256c((size_t)NGROUP * TG * DM * 2);
#define HG(p_, g_) (((bf16_t*)((p_)->ws + WS_H)) + (size_t)(g_) * TG * DM)
constexpr size_t WS_GATE8 = WS_PROJ + al256c((size_t)TG * PLD * 2);
constexpr size_t WS_QRAW = WS_GATE8 + al256c((size_t)TG * 4096);
constexpr size_t WS_KVRAW = WS_QRAW + al256c((size_t)TG * 384 * 2);
constexpr size_t WS_QA = WS_KVRAW + al256c((size_t)TG * 512 * 2);
constexpr size_t WS_KA = WS_QA + al256c((size_t)TG * 384 * 2);
constexpr size_t WS_VA = WS_KA + al256c((size_t)TG * 384 * 2);
constexpr size_t WS_GQ = WS_VA + al256c((size_t)TG * 256 * 2);
constexpr size_t WS_GK = WS_GQ + al256c((size_t)TG * 256 * 2);
constexpr size_t WS_OUTS = WS_GK + al256c((size_t)TG * 128 * 2);
constexpr size_t WS_ACC = WS_QRAW;
constexpr size_t WS_PQ = WS_OUTS;
constexpr size_t WS_RKV = WS_OUTS + al256c((size_t)4 * TG * 256 * 2);
constexpr size_t WS_UB = WS_RKV + al256c((size_t)NB * 4 * 2 * 34 * 4096 * 4);
constexpr size_t WS_VB = WS_UB + al256c((size_t)2 * 16384 * DM);
constexpr size_t WS_KEYB = WS_VB + al256c((size_t)2 * 16384 * DM);
constexpr size_t WS_USC = WS_UB + (size_t)2 * 16384 * (DM / 2);
constexpr size_t WS_VSC = WS_VB + (size_t)2 * 16384 * (DM / 2);
constexpr size_t WS_URS = WS_USC + (size_t)2 * 16384 * 4;
constexpr size_t WS_TOTAL = WS_KEYB + al256c((size_t)2 * 8 * 2 * 128 * 64 * 2);

#define G_BM 256
#define G_BN 128
#define G_BK 64
#define G_LDP 144
#define G_ABYTES (G_BM * G_LDP)
#define G_BBYTES (G_BN * G_LDP)
#define G_STAGE (G_ABYTES + G_BBYTES)

template <int MI>
__device__ __forceinline__ void gemm_tile(const bf16_t* __restrict__ A, int lda, const bf16_t* __restrict__ Bt, int ldb, int K,
                                          f32x4 (&acc)[MI][4], char* lds)
{
    constexpr int NA = MI;
    const int tid = get_tid(), lane = tid & 63, wid = tid >> 6, wm = wid >> 1, wn = wid & 1, fr = lane & 15, fq = lane >> 4;
    const int nk = K / G_BK;
    u32x4 ra[NA], rb[2];
    const int arow = tid >> 3, akc = tid & 7;
    const bf16_t* ag = A + (size_t)arow * lda + akc * 8;
    const bf16_t* bg = Bt + (size_t)arow * ldb + akc * 8;
    const int a_l = arow * G_LDP + akc * 16;
#pragma unroll
    for (int i = 0; i < NA; ++i) ra[i] = *(const u32x4*)(ag + (size_t)(64 * i) * lda);
#pragma unroll
    for (int i = 0; i < 2; ++i) rb[i] = *(const u32x4*)(bg + (size_t)(64 * i) * ldb);
    __syncthreads();
#pragma unroll
    for (int i = 0; i < NA; ++i) *(u32x4*)(lds + a_l + i * 64 * G_LDP) = ra[i];
#pragma unroll
    for (int i = 0; i < 2; ++i) *(u32x4*)(lds + G_ABYTES + a_l + i * 64 * G_LDP) = rb[i];
    __syncthreads();
    const int aoff = (wm * 16 * MI + fr) * G_LDP + fq * 16;
    const int boff = G_ABYTES + (wn * 64 + fr) * G_LDP + fq * 16;
    for (int kt = 0; kt < nk; ++kt) {
        const int cur = (kt & 1) * G_STAGE, nxt = ((kt + 1) & 1) * G_STAGE;
        const bool more = (kt + 1 < nk);
        if (more) {
#pragma unroll
            for (int i = 0; i < NA; ++i) ra[i] = *(const u32x4*)(ag + (size_t)(64 * i) * lda + (kt + 1) * G_BK);
#pragma unroll
            for (int i = 0; i < 2; ++i) rb[i] = *(const u32x4*)(bg + (size_t)(64 * i) * ldb + (kt + 1) * G_BK);
        }
#pragma unroll
        for (int ks = 0; ks < 2; ++ks) {
            bf16x8 af[MI], bfr[4];
#pragma unroll
            for (int mi = 0; mi < MI; ++mi) af[mi] = *(const bf16x8*)(lds + cur + aoff + mi * 16 * G_LDP + ks * 64);
#pragma unroll
            for (int ni = 0; ni < 4; ++ni) bfr[ni] = *(const bf16x8*)(lds + cur + boff + ni * 16 * G_LDP + ks * 64);
#pragma unroll
            for (int mi = 0; mi < MI; ++mi)
#pragma unroll
                for (int ni = 0; ni < 4; ++ni) acc[mi][ni] = __builtin_amdgcn_mfma_f32_16x16x32_bf16(bfr[ni], af[mi], acc[mi][ni], 0, 0, 0);
        }
        if (more) {
#pragma unroll
            for (int i = 0; i < NA; ++i) *(u32x4*)(lds + nxt + a_l + i * 64 * G_LDP) = ra[i];
#pragma unroll
            for (int i = 0; i < 2; ++i) *(u32x4*)(lds + nxt + G_ABYTES + a_l + i * 64 * G_LDP) = rb[i];
        }
        __syncthreads();
    }
}

template <int MI>
__device__ __forceinline__ void zero_acc(f32x4 (&acc)[MI][4]) {
#pragma unroll
    for (int i = 0; i < MI; ++i)
#pragma unroll
        for (int j = 0; j < 4; ++j) acc[i][j] = (f32x4){0.f, 0.f, 0.f, 0.f};
}

template <class Epi>
__device__ __forceinline__ void gemm_phase(const bf16_t* A, int lda, const bf16_t* Bt, int ldb, int M, int N, int K, const Epi& epi, char* lds, int bid, int nblk)
{
    const int tid = get_tid(), lane = tid & 63, wid = tid >> 6, wm = wid >> 1, wn = wid & 1, fr = lane & 15, fq = lane >> 4;
    const int tn = N / G_BN, total = (M / G_BM) * tn;
    for (int t = bid; t < total; t += nblk) {
        const int pm = t / tn, pn = t % tn;
        f32x4 acc[4][4]; zero_acc(acc);
        gemm_tile<4>(A + (size_t)pm * G_BM * lda, lda, Bt + (size_t)pn * G_BN * ldb, ldb, K, acc, lds);
#pragma unroll
        for (int mi = 0; mi < 4; ++mi)
#pragma unroll
            for (int ni = 0; ni < 4; ++ni) epi(pm * G_BM + wm * 64 + mi * 16 + fr, pn * G_BN + wn * 64 + ni * 16 + fq * 4, acc[mi][ni]);
    }
}

__device__ __forceinline__ void store_bf16x4(bf16_t* p, f32x4 v) { u32x2 w; w.x = pack_bf16(v[0], v[1]); w.y = pack_bf16(v[2], v[3]); *(u32x2*)p = w; }


namespace pg8 {
#define PG8_LAS __attribute__((address_space(3)))
typedef unsigned short bf16_t;
typedef short bf16x8 __attribute__((ext_vector_type(8)));
typedef float f32x4 __attribute__((ext_vector_type(4)));
typedef unsigned u32x4 __attribute__((ext_vector_type(4)));
constexpr int BM = 256, BK = 64, HALF = 128, HTB = HALF * BK * 2  , STAGE_BYTES = 8 * HTB, NXCD = 8, WGM = 8;

__host__ __device__ __forceinline__ int lds_byte(int r, int c) { const int st = (r >> 4) * 2 + (c >> 5), rr = r & 15, cc = c & 31, ob = rr * 64 + cc * 2; return st * 1024 + (ob ^ (((ob >> 9) & 1) << 5)); }
__host__ __device__ __forceinline__ void stage_rc(int b, int& R, int& C) { const int st = b / 1024, sb = b % 1024, swz = sb ^ (((sb >> 9) & 1) << 5); R = (st >> 1) * 16 + swz / 64; C = (st & 1) * 32 + (swz % 64) / 2; }
__host__ __device__ __forceinline__ int perm32(int rho) { const int n = rho >> 4, i = rho & 15; return 8 * (i >> 2) + 4 * n + (i & 3); }

struct Unit { int pm, pn; };
struct Gemm { const bf16_t* A; const bf16_t* Bt; int M, N, K; };

struct StaticOrder {
    int nM, nN, nwg, G, c;
    __host__ __device__ void init(int M, int N, int G_, int c_) { nM = M / BM; nN = N / BM; nwg = nM * nN; G = G_; c = c_; }
    __host__ __device__ bool next(int i, Unit& u) const {
        const long L = (long)i * G + c; if (L >= nwg) return false;
        int wgid = (int)L; { const int q = nwg / NXCD, r = nwg % NXCD, xcd = wgid % NXCD, off = wgid / NXCD; wgid = (xcd < r ? xcd * (q + 1) : r * (q + 1) + (xcd - r) * q) + off; }
        const int nig = WGM * nN, gid = wgid / nig, fm = gid * WGM, gsz = (nM - fm) < WGM ? (nM - fm) : WGM;
        u.pm = fm + ((wgid % nig) % gsz); u.pn = (wgid % nig) / gsz; return true;
    }
    __device__ __forceinline__ void a_ready(const Unit&) const {}
    __device__ __forceinline__ void done(const Unit&) const {}
};
template <class Epi, class Sched, bool ALIGN_EPI = false, bool SP2 = false>
__device__ __forceinline__ void gemm_phase(PG8_LAS unsigned char* lds, const Gemm g, const Sched& S, const Epi& E) {
    const int tid = get_tid(), wid = __builtin_amdgcn_readfirstlane(tid >> 6), lane = tid & 63, wr = wid >> 2, wc = wid & 3, fr = lane & 15, fq = lane >> 4;
    const int K = g.K, nt = K / BK;
    unsigned voffA[2], voffB[2];
#pragma unroll
    for (int i = 0; i < 2; ++i) { int R, C; stage_rc(tid * 16 + i * 8192, R, C); const int Rb = Epi::PERM ? ((R & ~31) + perm32(R & 31)) : R;
        voffA[i] = (unsigned)(R * K + C) * 2u; voffB[i] = (unsigned)(Rb * K + C) * 2u; }
    const size_t kstep = (size_t)(BK * 2);
    const size_t hstep = (size_t)HALF * K * 2;
    const size_t tstep = 2 * hstep;
    const unsigned ldsw = (unsigned)wid * 1024u;
    const int aoff = lds_byte(wr * 64 + fr, fq * 8), boff = lds_byte(wc * 32 + fr, fq * 8);
#define PG8_SA(b, h) (((b) * 2 + (h)) * HTB)
#define PG8_SB(b, h) ((4 + (b) * 2 + (h)) * HTB)
#define PG8_STAGE(bufoff, gbase, voff) do { _Pragma("unroll") for (int _i = 0; _i < 2; ++_i) \
        __builtin_amdgcn_global_load_lds((const unsigned*)((const char*)(gbase) + (voff)[_i]), (PG8_LAS unsigned*)(lds + (bufoff) + ldsw + _i * 8192), 16, 0, 0); } while (0)
#define PG8_LDA(dst, b, h) do { _Pragma("unroll") for (int m = 0; m < 4; ++m) _Pragma("unroll") for (int k = 0; k < 2; ++k) dst[m][k] = *(const PG8_LAS bf16x8*)(lds + PG8_SA(b, h) + aoff + m * 2048 + k * 1024); } while (0)
#define PG8_LDB(dst, b, h) do { _Pragma("unroll") for (int n = 0; n < 2; ++n) _Pragma("unroll") for (int k = 0; k < 2; ++k) dst[n][k] = *(const PG8_LAS bf16x8*)(lds + PG8_SB(b, h) + boff + n * 2048 + k * 1024); } while (0)
#define PG8_MMA(ai, bj, At, Bt) do { __builtin_amdgcn_s_setprio(1); _Pragma("unroll") for (int m = 0; m < 4; ++m) _Pragma("unroll") for (int n = 0; n < 2; ++n) _Pragma("unroll") for (int k = 0; k < 2; ++k) \
        acc[ai][bj][m][n] = __builtin_amdgcn_mfma_f32_16x16x32_bf16(Bt[n][k], At[m][k], acc[ai][bj][m][n], 0, 0, 0); __builtin_amdgcn_s_setprio(0); } while (0)
#define PG8_WAIT_V(n) asm volatile("s_waitcnt vmcnt(" #n ")" ::: "memory")
#define PG8_WAIT_L(n) asm volatile("s_waitcnt lgkmcnt(" #n ")" ::: "memory")
#define PG8_BAR __builtin_amdgcn_s_barrier()
#define PG8_SCHED __builtin_amdgcn_sched_barrier(0)
    Unit cur, nxt; int ui = 0;
    if (!S.next(0, cur)) return;
    f32x4 acc[2][2][4][2];
#pragma unroll
    for (int a = 0; a < 2; ++a)
#pragma unroll
        for (int b = 0; b < 2; ++b)
#pragma unroll
            for (int m = 0; m < 4; ++m)
#pragma unroll
                for (int n = 0; n < 2; ++n) acc[a][b][m][n] = (f32x4){0.f, 0.f, 0.f, 0.f};
    bf16x8 At[4][2], B0[2][2], B1[2][2];
    const char* cA = (const char*)g.A + (size_t)cur.pm * tstep; const char* cB = (const char*)g.Bt + (size_t)cur.pn * tstep;
    S.a_ready(cur);
    if constexpr (SP2) {
        PG8_STAGE(PG8_SB(0, 0), cB, voffB); PG8_STAGE(PG8_SB(0, 1), cB + hstep, voffB); PG8_STAGE(PG8_SA(0, 0), cA, voffA); PG8_STAGE(PG8_SA(0, 1), cA + hstep, voffA);
        if (wr == 1) PG8_BAR;
        PG8_WAIT_V(2); PG8_BAR;
        PG8_STAGE(PG8_SB(1, 0), cB + kstep, voffB); PG8_STAGE(PG8_SA(1, 0), cA + kstep, voffA); PG8_STAGE(PG8_SB(1, 1), cB + hstep + kstep, voffB);
        PG8_WAIT_V(6); PG8_BAR;
    } else {
        PG8_STAGE(PG8_SB(0, 0), cB, voffB); PG8_STAGE(PG8_SA(0, 0), cA, voffA); PG8_STAGE(PG8_SB(0, 1), cB + hstep, voffB); PG8_STAGE(PG8_SA(0, 1), cA + hstep, voffA);
        if (wr == 1) PG8_BAR;
        PG8_WAIT_V(4); PG8_BAR;
        PG8_STAGE(PG8_SB(1, 0), cB + kstep, voffB); PG8_STAGE(PG8_SA(1, 0), cA + kstep, voffA); PG8_STAGE(PG8_SB(1, 1), cB + hstep + kstep, voffB);
        PG8_WAIT_V(6); PG8_BAR;
    }
    for (;;) {
        const bool has_next = S.next(ui + 1, nxt);
        const char* nA = has_next ? (const char*)g.A + (size_t)nxt.pm * tstep : cA; const char* nB = has_next ? (const char*)g.Bt + (size_t)nxt.pn * tstep : cB;
        for (int t = 0; t < nt; t += 2) {
            const bool last = (t == nt - 2);
            const char* a1 = cA + (size_t)(t + 1) * kstep;
            const char* a2 = last ? nA : cA + (size_t)(t + 2) * kstep; const char* b2 = last ? nB : cB + (size_t)(t + 2) * kstep;
            const char* a3 = a2 + kstep; const char* b3 = b2 + kstep;
            if (last && has_next) S.a_ready(nxt);
            if constexpr (SP2) {
            PG8_LDB(B0, 0, 0); PG8_LDB(B1, 0, 1); PG8_SCHED; PG8_LDA(At, 0, 0); PG8_STAGE(PG8_SA(1, 1), a1 + hstep, voffA);
            PG8_WAIT_V(8); PG8_WAIT_L(0); PG8_BAR; PG8_MMA(0, 0, At, B0); PG8_MMA(0, 1, At, B1); PG8_BAR; PG8_SCHED;
            PG8_LDA(At, 0, 1); PG8_STAGE(PG8_SB(0, 0), b2, voffB); PG8_STAGE(PG8_SB(0, 1), b2 + hstep, voffB); PG8_STAGE(PG8_SA(0, 0), a2, voffA);
            PG8_WAIT_V(8); PG8_WAIT_L(0); PG8_BAR; PG8_MMA(1, 0, At, B0); PG8_MMA(1, 1, At, B1); PG8_BAR; PG8_SCHED;
            PG8_LDB(B0, 1, 0); PG8_LDB(B1, 1, 1); PG8_SCHED; PG8_LDA(At, 1, 0); PG8_STAGE(PG8_SA(0, 1), a2 + hstep, voffA);
            PG8_WAIT_V(8); PG8_WAIT_L(0); PG8_BAR; PG8_MMA(0, 0, At, B0); PG8_MMA(0, 1, At, B1); PG8_BAR; PG8_SCHED;
            PG8_LDA(At, 1, 1); PG8_STAGE(PG8_SB(1, 0), b3, voffB); PG8_STAGE(PG8_SB(1, 1), b3 + hstep, voffB); PG8_STAGE(PG8_SA(1, 0), a3, voffA);
            PG8_WAIT_V(8); PG8_WAIT_L(0); PG8_BAR; PG8_MMA(1, 0, At, B0); PG8_MMA(1, 1, At, B1); PG8_BAR; PG8_SCHED;
            } else {
            PG8_LDB(B0, 0, 0); PG8_SCHED; PG8_LDA(At, 0, 0); PG8_STAGE(PG8_SA(1, 1), a1 + hstep, voffA);
            PG8_WAIT_L(8); PG8_BAR; PG8_WAIT_L(0); PG8_MMA(0, 0, At, B0); PG8_BAR; PG8_SCHED;
            PG8_LDB(B1, 0, 1); PG8_STAGE(PG8_SB(0, 0), b2, voffB);
            PG8_BAR; PG8_WAIT_L(0); PG8_MMA(0, 1, At, B1); PG8_BAR;
            PG8_LDA(At, 0, 1); PG8_STAGE(PG8_SA(0, 0), a2, voffA);
            PG8_BAR; PG8_WAIT_L(0); PG8_MMA(1, 0, At, B0); PG8_BAR; PG8_SCHED;
            PG8_STAGE(PG8_SB(0, 1), b2 + hstep, voffB);
            PG8_WAIT_V(6); PG8_BAR; PG8_MMA(1, 1, At, B1); PG8_BAR;
            PG8_LDB(B0, 1, 0); PG8_SCHED; PG8_LDA(At, 1, 0); PG8_STAGE(PG8_SA(0, 1), a2 + hstep, voffA);
            PG8_WAIT_L(8); PG8_BAR; PG8_WAIT_L(0); PG8_MMA(0, 0, At, B0); PG8_BAR; PG8_SCHED;
            PG8_LDB(B1, 1, 1); PG8_STAGE(PG8_SB(1, 0), b3, voffB);
            PG8_BAR; PG8_WAIT_L(0); PG8_MMA(0, 1, At, B1); PG8_BAR;
            PG8_LDA(At, 1, 1); PG8_STAGE(PG8_SA(1, 0), a3, voffA);
            PG8_BAR; PG8_WAIT_L(0); PG8_MMA(1, 0, At, B0); PG8_BAR; PG8_SCHED;
            PG8_STAGE(PG8_SB(1, 1), b3 + hstep, voffB);
            PG8_WAIT_V(6); PG8_BAR; PG8_MMA(1, 1, At, B1); PG8_BAR;
            }
        }
        if constexpr (ALIGN_EPI) { if (wr == 0) PG8_BAR; }
        if constexpr (!Epi::AFTER_DRAIN) { E(acc, cur, wr, wc, fr, fq); S.done(cur); }
        if (!has_next) break;
#pragma unroll
        for (int a = 0; a < 2; ++a)
#pragma unroll
            for (int b = 0; b < 2; ++b)
#pragma unroll
                for (int m = 0; m < 4; ++m)
#pragma unroll
                    for (int n = 0; n < 2; ++n) acc[a][b][m][n] = (f32x4){0.f, 0.f, 0.f, 0.f};
        cur = nxt; cA = nA; cB = nB; ++ui;
        if constexpr (ALIGN_EPI) { if (wr == 1) PG8_BAR; }
    }
    PG8_WAIT_V(0);
    if constexpr (!ALIGN_EPI) { if (wr == 0) PG8_BAR; }
    PG8_BAR;
    if constexpr (Epi::AFTER_DRAIN) { E.fused(acc, cur, wr, wc, fr, fq, lds, wid, lane); S.done(cur); }
#undef PG8_SA
#undef PG8_SB
#undef PG8_STAGE
#undef PG8_LDA
#undef PG8_LDB
#undef PG8_MMA
#undef PG8_WAIT_V
#undef PG8_WAIT_L
#undef PG8_BAR
#undef PG8_SCHED
}
}

template <class F> struct Epi4 {
    static constexpr bool PERM = false, AFTER_DRAIN = false; F f;
    __device__ __forceinline__ void operator()(const f32x4 (&acc)[2][2][4][2], const pg8::Unit& u, int wr, int wc, int fr, int fq) const {
#pragma unroll
        for (int ai = 0; ai < 2; ++ai)
#pragma unroll
            for (int m = 0; m < 4; ++m)
#pragma unroll
                for (int bj = 0; bj < 2; ++bj)
#pragma unroll
                    for (int n = 0; n < 2; ++n) f(u.pm * 256 + ai * 128 + wr * 64 + m * 16 + fr, u.pn * 256 + bj * 128 + wc * 32 + n * 16 + fq * 4, acc[ai][bj][m][n]);
    }
};
template <class F> struct Epi8 {
    static constexpr bool PERM = true, AFTER_DRAIN = false; F f;
    __device__ __forceinline__ void operator()(const f32x4 (&acc)[2][2][4][2], const pg8::Unit& u, int wr, int wc, int fr, int fq) const {
#pragma unroll
        for (int ai = 0; ai < 2; ++ai)
#pragma unroll
            for (int m = 0; m < 4; ++m)
#pragma unroll
                for (int bj = 0; bj < 2; ++bj) f(u.pm * 256 + ai * 128 + wr * 64 + m * 16 + fr, u.pn * 256 + bj * 128 + wc * 32 + fq * 8, acc[ai][bj][m][0], acc[ai][bj][m][1]);
    }
};
template <class E>
__device__ __forceinline__ void big_gemm(const bf16_t* A, const bf16_t* Bt, int M, int N, int K, const E& e, char* lds, int bid, int nblk) {
    pg8::StaticOrder so; so.init(M, N, nblk, bid);
    pg8::gemm_phase<E, pg8::StaticOrder, true, true>((PG8_LAS unsigned char*)lds, pg8::Gemm{A, Bt, M, N, K}, so, e);
}

__device__ __forceinline__ void transpose_cvt(const float* __restrict__ src, int K, int N, int Npad, bf16_t* __restrict__ dst, const float* __restrict__ kscale, float* lds, int bid, int nblk)
{
    const int tid = get_tid();
    const int tk = K / 64, tn = Npad / 64, total = tk * tn;
    const int lk = tid >> 3, ln = (tid & 7) * 8;
    const int sn = tid >> 3, sk = (tid & 7) * 8;
    for (int t = bid; t < total; t += nblk) {
        const int k0 = (t / tn) * 64, n0 = (t % tn) * 64;
        f32x4 a = (f32x4){0.f, 0.f, 0.f, 0.f}, c = a;
        if (n0 + ln < N) { const float* sp = src + (size_t)(k0 + lk) * N + n0 + ln; a = *(const f32x4*)sp; c = *(const f32x4*)(sp + 4); if (kscale) { const float ks = kscale[k0 + lk]; a *= ks; c *= ks; } }
        __syncthreads();
#pragma unroll
        for (int j = 0; j < 4; ++j) { lds[lk * 65 + ln + j] = a[j]; lds[lk * 65 + ln + 4 + j] = c[j]; }
        __syncthreads();
        u32x4 w;
        w.x = pack_bf16(lds[(sk + 0) * 65 + sn], lds[(sk + 1) * 65 + sn]); w.y = pack_bf16(lds[(sk + 2) * 65 + sn], lds[(sk + 3) * 65 + sn]);
        w.z = pack_bf16(lds[(sk + 4) * 65 + sn], lds[(sk + 5) * 65 + sn]); w.w = pack_bf16(lds[(sk + 6) * 65 + sn], lds[(sk + 7) * 65 + sn]);
        *(u32x4*)(dst + (size_t)(n0 + sn) * K + k0 + sk) = w;
    }
}

__device__ __forceinline__ void phase_prologue(KP p, char* ldsc, int bid, int nblk)
{
    float* lds = (float*)ldsc;
    const int tid = get_tid();
    for (int l = 0; l < 2; ++l) {
        transpose_cvt(p->w_in + (size_t)l * DM * IN_COLS, DM, IN_COLS, NPROJ, ((bf16_t*)(p->ws + WS_WINT)) + (size_t)l * NPROJ * DM, nullptr, lds, bid, nblk);
        transpose_cvt(p->mla_wuq + (size_t)l * 256 * 384, 256, 384, 384, ((bf16_t*)(p->ws + WS_WUQT)) + (size_t)l * 384 * 256, p->mla_qn + l * 256, lds, bid, nblk);
        transpose_cvt(p->mla_wukv + (size_t)l * 128 * 512, 128, 512, 512, ((bf16_t*)(p->ws + WS_WUKVT)) + (size_t)l * 512 * 128, p->mla_kvn + l * 128, lds, bid, nblk);
        for (int i = 0; i < 4; ++i)
            transpose_cvt(p->w_branch + (size_t)(l * 4 + i) * 256 * DM, 256, DM, DM, ((bf16_t*)(p->ws + WS_WBT)) + (size_t)(l * 4 + i) * DM * 256, nullptr, lds, bid, nblk);
        transpose_cvt(p->w_out + (size_t)l * DM * DM, DM, DM, DM, ((bf16_t*)(p->ws + WS_WOUTT)) + (size_t)l * DM * DM, nullptr, lds, bid, nblk);
        transpose_cvt(p->peer_wq + (size_t)l * DM * DM, DM, DM, DM, ((bf16_t*)(p->ws + WS_WQT)) + (size_t)l * DM * DM, nullptr, lds, bid, nblk);
    }
    {
        float* sil = lds;
        float* red = lds + 17 * 1024;
        __syncthreads();
        for (int e = tid; e < 17 * 1024; e += NTHREADS) { const int r = e >> 10, k = e & 1023; const float v = (r < 16) ? p->c[r * 1024 + k] : p->c_ctx[k]; sil[e] = siluf(v); }
        __syncthreads();
        for (int u = bid; u < 2 * 96; u += nblk) {
            const int l = u / 96, j0 = (u % 96) * 64, kg = tid >> 6, j = tid & 63;
            float a[17];
#pragma unroll
            for (int r = 0; r < 17; ++r) a[r] = 0.f;
            const float* w = p->mod_w + (size_t)l * DM * 6144 + j0 + j;
#pragma unroll 1
            for (int k0 = kg * 128; k0 < kg * 128 + 128; k0 += 16) {
                float wv[16];
#pragma unroll
                for (int kk = 0; kk < 16; ++kk) wv[kk] = w[(size_t)(k0 + kk) * 6144];
#pragma unroll
                for (int kk = 0; kk < 16; ++kk)
#pragma unroll
                    for (int r = 0; r < 17; ++r) a[r] += sil[r * 1024 + k0 + kk] * wv[kk];
            }
#pragma unroll
            for (int r = 0; r < 17; ++r) red[(kg * 17 + r) * 64 + j] = a[r];
            __syncthreads();
            for (int e = tid; e < 17 * 64; e += NTHREADS) {
                const int r = e >> 6, jj = e & 63; float s = 0.f;
                for (int q = 0; q < 8; ++q) s += red[(q * 17 + r) * 64 + jj];
                ((float*)(p->ws + WS_MOD))[((size_t)l * 17 + r) * 6144 + j0 + jj] = s + p->mod_b[l * 6144 + j0 + jj];
            }
            __syncthreads();
        }
    }
    {
        const size_t n16 = (size_t)2 * 16384 * DM / 16;
        for (size_t i = (size_t)bid * NTHREADS + tid; i < n16; i += (size_t)nblk * NTHREADS) {
            f32x4 a[4], c[4];
#pragma unroll
            for (int q = 0; q < 4; ++q) { a[q] = ((const f32x4*)p->peer_u)[4 * i + q]; c[q] = ((const f32x4*)p->peer_v)[4 * i + q]; }
            float mu = 0.f, mv = 0.f;
#pragma unroll
            for (int q = 0; q < 4; ++q)
#pragma unroll
                for (int j = 0; j < 4; ++j) { mu = fmaxf(mu, fabsf(a[q][j])); mv = fmaxf(mv, fabsf(c[q][j])); }
            mu = wave_max(mu); mv = wave_max(mv);
            const float su = mu > 0.f ? mu * (0.8f / 7.f) : 1.f, sv = mv > 0.f ? mv * (1.f / 6.f) : 1.f, iu = 1.f / su, iv = 1.f / sv;
            u32x2 wu = (u32x2){0u, 0u}, wv = (u32x2){0u, 0u};
            float rsum = 0.f;
#pragma unroll
            for (int q = 0; q < 4; ++q) {
                unsigned tu = wu[q >> 1], tv = wv[q >> 1];
#pragma unroll
                for (int j = 0; j < 4; ++j) { const float qv = fminf(fmaxf(__builtin_rintf(a[q][j] * iu), -8.f), 7.f); rsum += qv; tu |= ((unsigned)(int)qv & 15u) << (4 * ((4 * q + j) & 7)); }
                if ((q & 1) == 0) {
                    tv = __builtin_amdgcn_cvt_scalef32_pk_fp4_f32(tv, c[q][0] * iv, c[q][1] * iv, 1.0f, 0); tv = __builtin_amdgcn_cvt_scalef32_pk_fp4_f32(tv, c[q][2] * iv, c[q][3] * iv, 1.0f, 1);
                } else {
                    tv = __builtin_amdgcn_cvt_scalef32_pk_fp4_f32(tv, c[q][0] * iv, c[q][1] * iv, 1.0f, 2); tv = __builtin_amdgcn_cvt_scalef32_pk_fp4_f32(tv, c[q][2] * iv, c[q][3] * iv, 1.0f, 3);
                }
                wu[q >> 1] = tu; wv[q >> 1] = tv;
            }
            rsum = wave_sum(rsum);
            ((u32x2*)(p->ws + WS_UB))[i] = wu; ((u32x2*)(p->ws + WS_VB))[i] = wv;
            if ((tid & 63) == 0) { ((float*)(p->ws + WS_USC))[i >> 6] = su; ((float*)(p->ws + WS_VSC))[i >> 6] = sv; ((float*)(p->ws + WS_URS))[i >> 6] = 8.f * rsum; }
        }
        const size_t k8 = (size_t)2 * 8 * 2 * 128 * 64 / 8;
        for (size_t i = (size_t)bid * NTHREADS + tid; i < k8; i += (size_t)nblk * NTHREADS) {
            const f32x4 a = ((const f32x4*)p->peer_keys)[2 * i], b = ((const f32x4*)p->peer_keys)[2 * i + 1];
            u32x4 w; w.x = pack_bf16(a[0], a[1]); w.y = pack_bf16(a[2], a[3]); w.z = pack_bf16(b[0], b[1]); w.w = pack_bf16(b[2], b[3]);
            ((u32x4*)(p->ws + WS_KEYB))[i] = w;
        }
    }
}

__device__ __forceinline__ const float* state_row(KP p, int g, int r, int& modrow, bool from_input) {
    const int bl = r / LTOK, t = r - bl * LTOK, b = g * NB + bl;
    if (t < CTXL) { modrow = 16; return (from_input ? p->ctx : (const float*)(p->ws + WS_CTXS)) + ((size_t)b * CTXL + t) * DM; }
    modrow = b; return (from_input ? p->x : (const float*)p->out) + ((size_t)b * SEQ + (t - CTXL)) * DM;
}

__device__ __forceinline__ void phase_norm(KP p, int l, int g, int which, int bid, int nblk)
{
    const int lane = get_tid() & 63, wid = get_tid() >> 6;
    const float* nw = (which ? p->norm2_w : p->norm1_w) + l * DM;
    const int shoff = which ? 3072 : 0, scoff = which ? 4096 : 1024;
    for (int r = bid * 8 + wid; r < TG; r += nblk * 8) {
        int mr; const float* src = state_row(p, g, r, mr, l == 0 && which == 0);
        const float* md = ((float*)(p->ws + WS_MOD)) + ((size_t)l * 17 + mr) * 6144;
        f32x4 v[4]; float ss = 0.f;
#pragma unroll
        for (int i = 0; i < 4; ++i) { v[i] = *(const f32x4*)(src + i * 256 + lane * 4); ss += v[i][0] * v[i][0] + v[i][1] * v[i][1] + v[i][2] * v[i][2] + v[i][3] * v[i][3]; }
        ss = wave_sum(ss);
        const float rstd = rsqrtf(ss * (1.f / DM) + EPSF);
#pragma unroll
        for (int i = 0; i < 4; ++i) {
            const int c = i * 256 + lane * 4;
            const f32x4 w = *(const f32x4*)(nw + c), sc = *(const f32x4*)(md + scoff + c), sh = *(const f32x4*)(md + shoff + c);
            f32x4 y;
#pragma unroll
            for (int j = 0; j < 4; ++j) y[j] = v[i][j] * rstd * w[j] * (1.f + sc[j]) + sh[j];
            store_bf16x4(HG(p, g) + (size_t)r * DM + c, y);
        }
    }
}

struct EpiProj8 {
    bf16_t* O; unsigned char* G8;
    __device__ __forceinline__ void operator()(int row, int col, f32x4 a, f32x4 b) const {
        if (col >= C_GATE) {
            const int gi = col - C_GATE; if (gi >= 4096) return;
            unsigned w0 = 0u, w1 = 0u;
#pragma unroll
            for (int j = 0; j < 4; ++j) {
                w0 |= (unsigned)__builtin_amdgcn_cvt_pk_u8_f32(sigmf(a[j]) * 255.f, j, 0);
                w1 |= (unsigned)__builtin_amdgcn_cvt_pk_u8_f32(sigmf(b[j]) * 255.f, j, 0);
            }
            const int gp_ = (gi & ~63) | (((gi >> 2) & 3) << 4) | (((gi >> 4) & 3) << 2);
            *(unsigned*)(G8 + (size_t)row * 4096 + gp_) = w0; *(unsigned*)(G8 + (size_t)row * 4096 + gp_ + 16) = w1;
            return;
        }
        if (col >= C_NQ && col < C_NK) { a *= (0.125f * 1.4426950408889634f); b *= (0.125f * 1.4426950408889634f); }
        u32x4 w; w.x = pack_bf16(a[0], a[1]); w.y = pack_bf16(a[2], a[3]); w.z = pack_bf16(b[0], b[1]); w.w = pack_bf16(b[2], b[3]);
        *(u32x4*)(O + (size_t)row * PLD + col) = w;
    }
};
struct EpiStore8 { bf16_t* O; int ld;
    __device__ __forceinline__ void operator()(int row, int col, f32x4 a, f32x4 b) const {
        u32x4 w; w.x = pack_bf16(a[0], a[1]); w.y = pack_bf16(a[2], a[3]); w.z = pack_bf16(b[0], b[1]); w.w = pack_bf16(b[2], b[3]);
        *(u32x4*)(O + (size_t)row * ld + col) = w; } };
struct EpiStore { bf16_t* O; int ld; __device__ __forceinline__ void operator()(int row, int col, f32x4 v) const { store_bf16x4(O + (size_t)row * ld + col, v); } };

__device__ __forceinline__ float log_sigmoidf(float x) { return fminf(x, 0.f) - log1pf(__expf(-fabsf(x))); }

__device__ __forceinline__ int ret_jb(int rb) { return rb == 0 ? 1 : (rb == 1 ? 0 : 35 - rb); }

__device__ __forceinline__ bf16x8 tr_frag_nat(const char* img, int PT, int k0, int col0, int lane) {
    const int i16 = lane & 15, blk = (lane >> 4) & 1, h5 = lane >> 5, q4 = i16 >> 2, p4 = i16 & 3;
    const char* a = img + (k0 + 8 * h5 + q4) * PT + (col0 + 16 * blk) * 2 + 8 * p4;
    const s16x4 lo = __builtin_amdgcn_ds_read_tr16_b64_v4i16((LAS s16x4*)a), hi = __builtin_amdgcn_ds_read_tr16_b64_v4i16((LAS s16x4*)(a + 4 * PT));
    return __builtin_shufflevector(lo, hi, 0, 1, 2, 3, 4, 5, 6, 7);
}
__device__ __forceinline__ bf16x8 tr_frag_acc(const char* img, int PT, int k0, int col0, int lane) {
    const int i16 = lane & 15, blk = (lane >> 4) & 1, h5 = lane >> 5, q4 = i16 >> 2, p4 = i16 & 3;
    const char* a = img + (k0 + 4 * h5 + q4) * PT + (col0 + 16 * blk) * 2 + 8 * p4;
    const s16x4 lo = __builtin_amdgcn_ds_read_tr16_b64_v4i16((LAS s16x4*)a), hi = __builtin_amdgcn_ds_read_tr16_b64_v4i16((LAS s16x4*)(a + 8 * PT));
    return __builtin_shufflevector(lo, hi, 0, 1, 2, 3, 4, 5, 6, 7);
}
#define RT_PT 144
__device__ __forceinline__ void ret_kv_unit(KP p, int l, int bl, int h, int rb, char* lds)
{
    const int tid = get_tid(), lane = tid & 63, wid = tid >> 6, r = lane & 31, h5 = lane >> 5;
    const bf16_t* PR = (const bf16_t*)(p->ws + WS_PROJ);
    const size_t R0 = (size_t)bl * LTOK + rb * 128;
    const float lgf = log_sigmoidf(p->ret_logit[(l * 2 + 0) * 4 + h]) * 1.4426950408889634f, lgb = log_sigmoidf(p->ret_logit[(l * 2 + 1) * 4 + h]) * 1.4426950408889634f;
    char* KF = lds; char* KBk = lds + 128 * RT_PT; char* VV = lds + 2 * 128 * RT_PT;
    __syncthreads();
#pragma unroll
    for (int q = 0; q < 2; ++q) {
        const int c = tid + 512 * q, row = c >> 3, cc = c & 7;
        const u32x4 kw = *(const u32x4*)(PR + (R0 + row) * PLD + C_RK + h * 64 + cc * 8), vw = *(const u32x4*)(PR + (R0 + row) * PLD + C_RV + h * 64 + cc * 8);
        const float wf = 0.125f * __builtin_amdgcn_exp2f(lgf * (float)(127 - row)), wb = 0.125f * __builtin_amdgcn_exp2f(lgb * (float)row);
        u32x4 of, ob;
#pragma unroll
        for (int j = 0; j < 4; ++j) { const float lo = bflo(kw[j]), hi = bfhi(kw[j]); of[j] = pack_bf16(lo * wf, hi * wf); ob[j] = pack_bf16(lo * wb, hi * wb); }
        *(u32x4*)(KF + row * RT_PT + cc * 16) = of; *(u32x4*)(KBk + row * RT_PT + cc * 16) = ob; *(u32x4*)(VV + row * RT_PT + cc * 16) = vw;
    }
    __syncthreads();
    const int dir = wid >> 2, dt = (wid >> 1) & 1, et = wid & 1;
    const char* Ks = dir ? KBk : KF;
    f32x16 acc;
#pragma unroll
    for (int i = 0; i < 16; ++i) acc[i] = 0.f;
#pragma unroll
    for (int s2 = 0; s2 < 8; ++s2) {
        const bf16x8 af = tr_frag_nat(Ks, RT_PT, 16 * s2, dt * 32, lane), bfv = tr_frag_nat(VV, RT_PT, 16 * s2, et * 32, lane);
        acc = __builtin_amdgcn_mfma_f32_32x32x16_bf16(af, bfv, acc, 0, 0, 0);
    }
    const int j = dir ? ret_jb(rb) : rb;
    float* dst = ((float*)(p->ws + WS_RKV)) + ((((size_t)bl * 4 + h) * 2 + dir) * 34 + j) * 4096 + et * 32 + r;
#pragma unroll
    for (int i = 0; i < 16; ++i) dst[(dt * 32 + (i & 3) + 8 * (i >> 2) + 4 * h5) * 64] = acc[i];
}

__device__ __forceinline__ void phase_p3a(KP p, int l, int bid, int nblk, char* lds)
{
    gemm_phase(((bf16_t*)(p->ws + WS_PROJ)) + C_CQ, PLD, ((bf16_t*)(p->ws + WS_WUQT)) + (size_t)l * 384 * 256, 256, TG, 384, 256, EpiStore{((bf16_t*)(p->ws + WS_QRAW)), 384}, lds, bid, nblk);
    gemm_phase(((bf16_t*)(p->ws + WS_PROJ)) + C_CKV, PLD, ((bf16_t*)(p->ws + WS_WUKVT)) + (size_t)l * 512 * 128, 128, TG, 512, 128, EpiStore{((bf16_t*)(p->ws + WS_KVRAW)), 512}, lds, bid, nblk);
    for (int u = bid; u < NB * 4 * 34; u += nblk) { const int rb = u % 34, h = (u / 34) & 3, bl = u / 136; ret_kv_unit(p, l, bl, h, rb, lds); }
}

#define LOG2_THETA 13.287712379549449f
__device__ __forceinline__ float rope_freq(int i, int half) { return exp2f(-LOG2_THETA * (float)i / (float)half); }

__device__ __forceinline__ void phase_p3b(KP p, int l, int bid, int nblk)
{
    {
        const int gt = bid * NTHREADS + get_tid();
        for (int it = gt; it < NB * 4 * 2 * 1024; it += nblk * NTHREADS) {
            const int e4 = it & 1023, bhd = it >> 10, dir = bhd & 1, h = (bhd >> 1) & 3;
            const float dec = __builtin_amdgcn_exp2f(log_sigmoidf(p->ret_logit[(l * 2 + dir) * 4 + h]) * 1.4426950408889634f * 128.f);
            f32x4* base = (f32x4*)((float*)(p->ws + WS_RKV) + (size_t)bhd * 34 * 4096) + e4;
            f32x4 st = (f32x4){0.f, 0.f, 0.f, 0.f};
            f32x4 kv[34];
#pragma unroll
            for (int j = 0; j < 34; ++j) kv[j] = base[(size_t)j * 1024];
#pragma unroll
            for (int j = 0; j < 34; ++j) { base[(size_t)j * 1024] = st; st = st * dec + kv[j]; }
        }
    }
    const int lane = get_tid() & 63, wid = get_tid() >> 6;
    const float mla_scale = 0.10206207261596575f * 1.4426950408889634f;
    auto load_row = [&](unsigned (&rw)[40], int r) {
        const bf16_t* pr = ((bf16_t*)(p->ws + WS_PROJ)) + (size_t)r * PLD;
        const bf16_t* qraw = ((bf16_t*)(p->ws + WS_QRAW)) + (size_t)r * 384;
        const bf16_t* kvraw = ((bf16_t*)(p->ws + WS_KVRAW)) + (size_t)r * 512;
#pragma unroll
        for (int i = 0; i < 4; ++i) rw[i] = pr[C_CQ + lane + 64 * i];
#pragma unroll
        for (int i = 0; i < 2; ++i) rw[4 + i] = pr[C_CKV + lane + 64 * i];
#pragma unroll
        for (int i = 0; i < 6; ++i) {
            const int idx = lane + 64 * i, h = idx / 96, d = idx % 96, dd = d >= 64 ? d - 64 : 0;
            rw[6 + i] = qraw[idx];
            rw[12 + i] = qraw[(unsigned)(d >= 64 ? idx - dd + (dd ^ 8) : idx)];
            rw[18 + i] = d < 64 ? kvraw[h * 128 + d] : pr[C_KPE + dd];
            rw[24 + i] = pr[C_KPE + (unsigned)(dd ^ 8)];
        }
#pragma unroll
        for (int i = 0; i < 4; ++i) { const int idx = lane + 64 * i, h = idx >> 6, e = idx & 63; rw[30 + i] = kvraw[h * 128 + 64 + e]; }
#pragma unroll
        for (int hh = 0; hh < 6; ++hh) rw[34 + hh] = pr[(hh < 4 ? C_GQ + hh * 64 : C_GK + (hh - 4) * 64) + lane];
    };
    auto proc_row = [&](const unsigned (&rw)[40], int r) {
        const int t = r % LTOK;
        const bool lat = t >= CTXL;
        const float prow = lat ? (float)((t - CTXL) >> 6) : 0.f, pcol = lat ? (float)((t - CTXL) & 63) : 0.f;
        float sq = 0.f, skv = 0.f;
#pragma unroll
        for (int i = 0; i < 4; ++i) { const float v = bf2f((bf16_t)rw[i]); sq += v * v; }
#pragma unroll
        for (int i = 0; i < 2; ++i) { const float v = bf2f((bf16_t)rw[4 + i]); skv += v * v; }
        sq = wave_sum(sq); skv = wave_sum(skv);
        const float rq = rsqrtf(sq * (1.f / 256.f) + EPSF), rkv = rsqrtf(skv * (1.f / 128.f) + EPSF);
#pragma unroll
        for (int i = 0; i < 6; ++i) {
            const int idx = lane + 64 * i, d = idx % 96;
            float qv = bf2f((bf16_t)rw[6 + i]), kv = bf2f((bf16_t)rw[18 + i]);
            if (d < 64) kv *= rkv;
            else if (lat) {
                const int dd = d - 64, blk = dd >> 4, w = dd & 15, fi = w & 7; const bool first = w < 8;
                const float rev = (blk ? pcol : prow) * rope_freq(fi, 8) * 0.15915494309189535f; const float sn = __builtin_amdgcn_sinf(rev), cs = __builtin_amdgcn_cosf(rev);
                const float qo = bf2f((bf16_t)rw[12 + i]), ko = bf2f((bf16_t)rw[24 + i]);
                qv = first ? (qv * cs - qo * sn) : (qo * sn + qv * cs);
                kv = first ? (kv * cs - ko * sn) : (ko * sn + kv * cs);
            }
            ((bf16_t*)(p->ws + WS_QA))[(size_t)r * 384 + idx] = f2bf(qv * rq * mla_scale);
            ((bf16_t*)(p->ws + WS_KA))[(size_t)r * 384 + idx] = f2bf(kv);
        }
#pragma unroll
        for (int i = 0; i < 4; ++i) ((bf16_t*)(p->ws + WS_VA))[(size_t)r * 256 + lane + 64 * i] = f2bf(bf2f((bf16_t)rw[30 + i]) * rkv);
        const int blk = lane >> 5, w = lane & 31, fi = w & 15; const bool first = w < 16;
        float sn = 0.f, cs = 1.f;
        if (lat) { const float rev = (blk ? pcol : prow) * rope_freq(fi, 16) * 0.15915494309189535f; sn = __builtin_amdgcn_sinf(rev); cs = __builtin_amdgcn_cosf(rev); }
        const float nwq = p->gqa_qn[l * 64 + lane], nwk = p->gqa_kn[l * 64 + lane];
#pragma unroll
        for (int hh = 0; hh < 6; ++hh) {
            const bool isq = hh < 4;
            const float v = bf2f((bf16_t)rw[34 + hh]);
            const float ss = wave_sum(v * v);
            const float n = v * rsqrtf(ss * (1.f / 64.f) + EPSF) * (isq ? nwq : nwk);
            const float other = xor_swz<16>(n);
            float val = n;
            if (lat) val = first ? (n * cs - other * sn) : (other * sn + n * cs);
            if (isq) ((bf16_t*)(p->ws + WS_GQ))[(size_t)r * 256 + hh * 64 + lane] = f2bf(val * (0.125f * 1.4426950408889634f));
            else ((bf16_t*)(p->ws + WS_GK))[(size_t)r * 128 + (hh - 4) * 64 + lane] = f2bf(val);
        }
    };
    const int rstep = nblk * 8;
    int r = bid * 8 + wid;
    if (r < TG) {
        unsigned ra[40], rb[40];
        load_row(ra, r);
        for (;;) {
            const bool m1 = r + rstep < TG;
            if (m1) load_row(rb, r + rstep);
            proc_row(ra, r);
            if (!m1) break;
            r += rstep;
            const bool m2 = r + rstep < TG;
            if (m2) load_row(ra, r + rstep);
            proc_row(rb, r);
            if (!m2) break;
            r += rstep;
        }
    }
}

template <int DQ>
__device__ __forceinline__ void attn_unit(const bf16_t* __restrict__ Qb, int qld, const bf16_t* __restrict__ Kb, int kld, const bf16_t* __restrict__ Vb, int vld,
                                          int nq, int nk, bf16_t* __restrict__ Ob, int old_, char* lds)
{
    constexpr int NS = DQ / 16, CPR = DQ / 8, KP = DQ * 2 + 16, VP = 144, KB = 64 * KP, VB = 64 * VP, STG = KB + VB, KCH = 64 * CPR;
    const int tid = get_tid(), lane = tid & 63, wid = tid >> 6, r = lane & 31, h = lane >> 5;
    int qrow[2]; bool qvalid[2];
    bf16x8 qf[2][NS];
#pragma unroll
    for (int qb = 0; qb < 2; ++qb) {
        qrow[qb] = wid * 64 + qb * 32 + r; qvalid[qb] = qrow[qb] < nq; if (!qvalid[qb]) qrow[qb] = 0;
#pragma unroll
        for (int s2 = 0; s2 < NS; ++s2) qf[qb][s2] = *(const bf16x8*)(Qb + (size_t)qrow[qb] * qld + 16 * s2 + 8 * h);
    }
    f32x16 o0[2], o1[2];
    float m[2] = {0.f, 0.f}, l[2] = {0.f, 0.f};
#pragma unroll
    for (int qb = 0; qb < 2; ++qb)
#pragma unroll
        for (int i = 0; i < 16; ++i) { o0[qb][i] = 0.f; o1[qb][i] = 0.f; }
    const int kr0 = tid / CPR, kc0 = tid % CPR, kr1 = (tid + 512) / CPR, kc1 = (tid + 512) % CPR; const bool k1 = (tid + 512) < KCH;
    const int vr = tid >> 3, vc = tid & 7;
    const bf16_t* kg0 = Kb + (size_t)kr0 * kld + kc0 * 8; const bf16_t* kg1 = Kb + (size_t)kr1 * kld + kc1 * 8; const bf16_t* vg = Vb + (size_t)vr * vld + vc * 8;
    const int kl0 = kr0 * KP + kc0 * 16, kl1 = kr1 * KP + kc1 * 16, vl = KB + vr * VP + vc * 16;
    u32x4 rk0, rk1 = (u32x4){0u, 0u, 0u, 0u}, rv;
    rk0 = *(const u32x4*)kg0; if (k1) rk1 = *(const u32x4*)kg1; rv = *(const u32x4*)vg;
    __syncthreads();
    *(u32x4*)(lds + kl0) = rk0; if (k1) *(u32x4*)(lds + kl1) = rk1; *(u32x4*)(lds + vl) = rv;
    __syncthreads();
    const int i16 = lane & 15, blk = (lane >> 4) & 1, q4 = i16 >> 2, p4 = i16 & 3;
    const int koff = r * KP + 16 * h, voff = KB + (4 * h + q4) * VP + 32 * blk + 8 * p4;
    const int nt = nk >> 6;
    for (int kt = 0; kt < nt; ++kt) {
        const int cur = (kt & 1) * STG, nxt = ((kt + 1) & 1) * STG;
        const bool more = kt + 1 < nt;
        if (more) {
            const size_t adv = (size_t)(kt + 1) * 64;
            rk0 = *(const u32x4*)(kg0 + adv * kld); if (k1) rk1 = *(const u32x4*)(kg1 + adv * kld); rv = *(const u32x4*)(vg + adv * vld);
        }
#pragma unroll
        for (int sub = 0; sub < 2; ++sub) {
            f32x16 sq[2];
#pragma unroll
            for (int i = 0; i < 16; ++i) { sq[0][i] = 0.f; sq[1][i] = 0.f; }
#pragma unroll
            for (int g0 = 0; g0 < NS; g0 += 4) {
                bf16x8 kfr[4];
#pragma unroll
                for (int s2 = 0; s2 < 4; ++s2) if (g0 + s2 < NS) kfr[s2] = *(const bf16x8*)(lds + cur + koff + sub * 32 * KP + (g0 + s2) * 32);
                __builtin_amdgcn_sched_barrier(0);
#pragma unroll
                for (int s2 = 0; s2 < 4; ++s2) if (g0 + s2 < NS) {
                    sq[0] = __builtin_amdgcn_mfma_f32_32x32x16_bf16(kfr[s2], qf[0][g0 + s2], sq[0], 0, 0, 0);
                    sq[1] = __builtin_amdgcn_mfma_f32_32x32x16_bf16(kfr[s2], qf[1][g0 + s2], sq[1], 0, 0, 0);
                }
            }
            bf16x8 vfr[2][2];
#pragma unroll
            for (int s2 = 0; s2 < 1; ++s2) {
                const int vb = cur + voff + (sub * 32 + 16 * s2) * VP;
                const s16x4 lo0 = __builtin_amdgcn_ds_read_tr16_b64_v4i16((LAS s16x4*)(lds + vb));
                const s16x4 hi0 = __builtin_amdgcn_ds_read_tr16_b64_v4i16((LAS s16x4*)(lds + vb + 8 * VP));
                const s16x4 lo1 = __builtin_amdgcn_ds_read_tr16_b64_v4i16((LAS s16x4*)(lds + vb + 64));
                const s16x4 hi1 = __builtin_amdgcn_ds_read_tr16_b64_v4i16((LAS s16x4*)(lds + vb + 8 * VP + 64));
                vfr[s2][0] = __builtin_shufflevector(lo0, hi0, 0, 1, 2, 3, 4, 5, 6, 7); vfr[s2][1] = __builtin_shufflevector(lo1, hi1, 0, 1, 2, 3, 4, 5, 6, 7);
            }
            bf16x8 pf[2][2];
#pragma unroll
            for (int qb = 0; qb < 2; ++qb) {
                f32x16& st = sq[qb];
                if (__builtin_amdgcn_ballot_w64(m[qb] != 0.f) != 0ull) {
#pragma unroll
                    for (int i = 0; i < 16; ++i) st[i] -= m[qb];
                }
                float mx = fmaxf(st[0], st[1]);
#pragma unroll
                for (int i = 2; i < 16; i += 2) mx = fmaxf(fmaxf(mx, st[i]), st[i + 1]);
                { const u32x2 sw = __builtin_amdgcn_permlane32_swap(__float_as_uint(mx), __float_as_uint(mx), false, false); mx = fmaxf(__uint_as_float(sw.x), __uint_as_float(sw.y)); }
                const bool first = (kt == 0) && (sub == 0);
                const bool mv = mx > 24.f || (first && mx < -24.f);
                if (__builtin_amdgcn_ballot_w64(mv) != 0ull) {
                    const float dlt = mv ? mx : 0.f, alpha = __builtin_amdgcn_exp2f(-dlt);
                    m[qb] += dlt; l[qb] *= alpha;
#pragma unroll
                    for (int i = 0; i < 16; ++i) { st[i] -= dlt; o0[qb][i] *= alpha; o1[qb][i] *= alpha; }
                }
                f32x2 rs2 = (f32x2){0.f, 0.f};
#pragma unroll
                for (int i = 0; i < 16; i += 2) { st[i] = __builtin_amdgcn_exp2f(st[i]); st[i + 1] = __builtin_amdgcn_exp2f(st[i + 1]); rs2 += (f32x2){st[i], st[i + 1]}; }
                l[qb] += rs2.x + rs2.y;
                u32x4 pw0, pw1;
                pw0.x = pack_bf16(st[0], st[1]); pw0.y = pack_bf16(st[2], st[3]); pw0.z = pack_bf16(st[4], st[5]); pw0.w = pack_bf16(st[6], st[7]);
                pw1.x = pack_bf16(st[8], st[9]); pw1.y = pack_bf16(st[10], st[11]); pw1.z = pack_bf16(st[12], st[13]); pw1.w = pack_bf16(st[14], st[15]);
                pf[qb][0] = __builtin_bit_cast(bf16x8, pw0); pf[qb][1] = __builtin_bit_cast(bf16x8, pw1);
            }
            {
                const int vb = cur + voff + (sub * 32 + 16) * VP;
                const s16x4 lo0 = __builtin_amdgcn_ds_read_tr16_b64_v4i16((LAS s16x4*)(lds + vb));
                const s16x4 hi0 = __builtin_amdgcn_ds_read_tr16_b64_v4i16((LAS s16x4*)(lds + vb + 8 * VP));
                const s16x4 lo1 = __builtin_amdgcn_ds_read_tr16_b64_v4i16((LAS s16x4*)(lds + vb + 64));
                const s16x4 hi1 = __builtin_amdgcn_ds_read_tr16_b64_v4i16((LAS s16x4*)(lds + vb + 8 * VP + 64));
                vfr[1][0] = __builtin_shufflevector(lo0, hi0, 0, 1, 2, 3, 4, 5, 6, 7); vfr[1][1] = __builtin_shufflevector(lo1, hi1, 0, 1, 2, 3, 4, 5, 6, 7);
            }
#pragma unroll
            for (int s2 = 0; s2 < 2; ++s2)
#pragma unroll
                for (int qb = 0; qb < 2; ++qb) {
                    o0[qb] = __builtin_amdgcn_mfma_f32_32x32x16_bf16(vfr[s2][0], pf[qb][s2], o0[qb], 0, 0, 0);
                    o1[qb] = __builtin_amdgcn_mfma_f32_32x32x16_bf16(vfr[s2][1], pf[qb][s2], o1[qb], 0, 0, 0);
                }
        }
        if (more) { *(u32x4*)(lds + nxt + kl0) = rk0; if (k1) *(u32x4*)(lds + nxt + kl1) = rk1; *(u32x4*)(lds + nxt + vl) = rv; }
        __syncthreads();
    }
#pragma unroll
    for (int qb = 0; qb < 2; ++qb) {
        float lt = sum_xor32(l[qb]);
        if (qvalid[qb]) {
            const float inv = 1.f / lt;
            bf16_t* op = Ob + (size_t)qrow[qb] * old_ + 4 * h;
#pragma unroll
            for (int g4 = 0; g4 < 4; ++g4) {
                store_bf16x4(op + 8 * g4, (f32x4){o0[qb][4 * g4] * inv, o0[qb][4 * g4 + 1] * inv, o0[qb][4 * g4 + 2] * inv, o0[qb][4 * g4 + 3] * inv});
                store_bf16x4(op + 32 + 8 * g4, (f32x4){o1[qb][4 * g4] * inv, o1[qb][4 * g4 + 1] * inv, o1[qb][4 * g4 + 2] * inv, o1[qb][4 * g4 + 3] * inv});
            }
        }
    }
}

__device__ __forceinline__ void ld8(const bf16_t* p, float (&o)[8]) {
    const u32x4 w = *(const u32x4*)p;
    o[0] = bflo(w.x); o[1] = bfhi(w.x); o[2] = bflo(w.y); o[3] = bfhi(w.y); o[4] = bflo(w.z); o[5] = bfhi(w.z); o[6] = bflo(w.w); o[7] = bfhi(w.w);
}

__device__ __forceinline__ void na_unit(KP p, int l, int bl, int h, int rg, char* lds)
{
    constexpr int KP_ = 144, VP = 144, KB = 64 * KP_, VB = 64 * VP, STG = KB + VB, LBIAS = 2 * STG;
    const int tid = get_tid(), lane = tid & 63, wid = tid >> 6, r = lane & 31, h5 = lane >> 5;
    const bf16_t* PR = (const bf16_t*)(p->ws + WS_PROJ);
    const size_t Rb = (size_t)bl * LTOK;
    const int grow = rg * 4 + (wid >> 1), c = (wid & 1) * 32 + r;
    const int rs = min(max(grow - 4, 0), 56), cs = min(max(c - 8, 0), 48);
    const int Rlo = min(max(rg * 4 - 4, 0), 56), Rhi = min(max(rg * 4 + 3 - 4, 0), 56) + 7, nrow = Rhi - Rlo + 1, nt = nrow + 4;
    const size_t qrow = Rb + CTXL + (size_t)grow * 64 + c;
    bf16x8 qf[4];
#pragma unroll
    for (int s2 = 0; s2 < 4; ++s2) qf[s2] = *(const bf16x8*)(PR + qrow * PLD + C_NQ + h * 64 + 16 * s2 + 8 * h5);
    f32x16 o0, o1;
#pragma unroll
    for (int i = 0; i < 16; ++i) { o0[i] = 0.f; o1[i] = 0.f; }
    float m = -1e30f, lsum = 0.f;
    const int kr = tid >> 3, kc = tid & 7;
    const int kl = kr * KP_ + kc * 16, vl = KB + kr * VP + kc * 16;
    auto tile_row = [&](int t) -> size_t { return t < nrow ? Rb + CTXL + (size_t)(Rlo + t) * 64 : Rb + (size_t)(t - nrow) * 64; };
    u32x4 rk, rv;
    { const size_t R = tile_row(0) + kr; rk = *(const u32x4*)(PR + R * PLD + C_NK + h * 64 + kc * 8); rv = *(const u32x4*)(PR + R * PLD + C_NV + h * 64 + kc * 8); }
    __syncthreads();
    *(u32x4*)(lds + kl) = rk; *(u32x4*)(lds + vl) = rv;
    { float* sb = (float*)(lds + LBIAS); const float* bias = p->na_bias + ((size_t)l * 4 + h) * 465; if (tid < 465) sb[tid] = bias[tid] * 1.4426950408889634f; }
    __syncthreads();
    const float* sb = (const float*)(lds + LBIAS);
    const int i16 = lane & 15, blk = (lane >> 4) & 1, q4 = i16 >> 2, p4 = i16 & 3;
    const int koff = r * KP_ + 16 * h5, voff = KB + (4 * h5 + q4) * VP + 32 * blk + 8 * p4;
    for (int t = 0; t < nt; ++t) {
        const int cur = (t & 1) * STG, nxt = ((t + 1) & 1) * STG;
        const bool more = t + 1 < nt;
        if (more) { const size_t R = tile_row(t + 1) + kr; rk = *(const u32x4*)(PR + R * PLD + C_NK + h * 64 + kc * 8); rv = *(const u32x4*)(PR + R * PLD + C_NV + h * 64 + kc * 8); }
        const bool win = t < nrow; const int R = Rlo + t;
        const bool mine = !win || (R >= rs && R <= rs + 7);
        if (mine) {
#pragma unroll
            for (int sub = 0; sub < 2; ++sub) {
                f32x16 st;
#pragma unroll
                for (int i = 0; i < 16; ++i) st[i] = 0.f;
#pragma unroll
                for (int s2 = 0; s2 < 4; ++s2) {
                    const bf16x8 kf = *(const bf16x8*)(lds + cur + koff + sub * 32 * KP_ + s2 * 32);
                    st = __builtin_amdgcn_mfma_f32_32x32x16_bf16(kf, qf[s2], st, 0, 0, 0);
                }
                if (win) {
                    const int brow = (R - grow + 7) * 31 + 15 - c;
#pragma unroll
                    for (int i = 0; i < 16; ++i) {
                        const int kcol = sub * 32 + (i & 3) + 8 * (i >> 2) + 4 * h5;
                        const bool ok = kcol >= cs && kcol < cs + 16;
                        const float bv = sb[ok ? brow + kcol : 0];
                        st[i] = ok ? st[i] + bv : -INFINITY;
                    }
                }
                float mx = fmaxf(st[0], st[1]);
#pragma unroll
                for (int i = 2; i < 16; i += 2) mx = fmaxf(fmaxf(mx, st[i]), st[i + 1]);
                mx = max_xor32(mx);
                const float mn = fmaxf(m, mx), alpha = __builtin_amdgcn_exp2f(m - mn);
                m = mn;
                f32x2 rs2 = (f32x2){0.f, 0.f};
#pragma unroll
                for (int i = 0; i < 16; i += 2) { st[i] = __builtin_amdgcn_exp2f(st[i] - mn); st[i + 1] = __builtin_amdgcn_exp2f(st[i + 1] - mn); rs2 += (f32x2){st[i], st[i + 1]}; }
                lsum = lsum * alpha + (rs2.x + rs2.y);
                if (__builtin_amdgcn_ballot_w64(alpha != 1.f) != 0ull) {
#pragma unroll
                    for (int i = 0; i < 16; ++i) { o0[i] *= alpha; o1[i] *= alpha; }
                }
                u32x4 pw0, pw1;
                pw0.x = pack_bf16(st[0], st[1]); pw0.y = pack_bf16(st[2], st[3]); pw0.z = pack_bf16(st[4], st[5]); pw0.w = pack_bf16(st[6], st[7]);
                pw1.x = pack_bf16(st[8], st[9]); pw1.y = pack_bf16(st[10], st[11]); pw1.z = pack_bf16(st[12], st[13]); pw1.w = pack_bf16(st[14], st[15]);
                const bf16x8 pf0 = __builtin_bit_cast(bf16x8, pw0), pf1 = __builtin_bit_cast(bf16x8, pw1);
#pragma unroll
                for (int s2 = 0; s2 < 2; ++s2) {
                    const int vb = cur + voff + (sub * 32 + 16 * s2) * VP;
                    const s16x4 lo0 = __builtin_amdgcn_ds_read_tr16_b64_v4i16((LAS s16x4*)(lds + vb));
                    const s16x4 hi0 = __builtin_amdgcn_ds_read_tr16_b64_v4i16((LAS s16x4*)(lds + vb + 8 * VP));
                    const s16x4 lo1 = __builtin_amdgcn_ds_read_tr16_b64_v4i16((LAS s16x4*)(lds + vb + 64));
                    const s16x4 hi1 = __builtin_amdgcn_ds_read_tr16_b64_v4i16((LAS s16x4*)(lds + vb + 8 * VP + 64));
                    const bf16x8 vf0 = __builtin_shufflevector(lo0, hi0, 0, 1, 2, 3, 4, 5, 6, 7), vf1 = __builtin_shufflevector(lo1, hi1, 0, 1, 2, 3, 4, 5, 6, 7);
                    o0 = __builtin_amdgcn_mfma_f32_32x32x16_bf16(vf0, s2 ? pf1 : pf0, o0, 0, 0, 0);
                    o1 = __builtin_amdgcn_mfma_f32_32x32x16_bf16(vf1, s2 ? pf1 : pf0, o1, 0, 0, 0);
                }
            }
        }
        if (more) { *(u32x4*)(lds + nxt + kl) = rk; *(u32x4*)(lds + nxt + vl) = rv; }
        __syncthreads();
    }
    lsum = sum_xor32(lsum);
    const float inv = 1.f / lsum;
    bf16_t* op = ((bf16_t*)(p->ws + WS_OUTS)) + ((size_t)2 * TG + qrow) * 256 + h * 64 + 4 * h5;
#pragma unroll
    for (int g4 = 0; g4 < 4; ++g4) {
        store_bf16x4(op + 8 * g4, (f32x4){o0[4 * g4] * inv, o0[4 * g4 + 1] * inv, o0[4 * g4 + 2] * inv, o0[4 * g4 + 3] * inv});
        store_bf16x4(op + 32 + 8 * g4, (f32x4){o1[4 * g4] * inv, o1[4 * g4 + 1] * inv, o1[4 * g4 + 2] * inv, o1[4 * g4 + 3] * inv});
    }
}

__device__ __forceinline__ void ret_out_unit(KP p, int l, int bl, int h, int rb, char* lds)
{
    const int tid = get_tid(), lane = tid & 63, wid = tid >> 6, r = lane & 31, h5 = lane >> 5;
    const bf16_t* PR = (const bf16_t*)(p->ws + WS_PROJ);
    const size_t R0 = (size_t)bl * LTOK + rb * 128;
    const float lgf = log_sigmoidf(p->ret_logit[(l * 2 + 0) * 4 + h]) * 1.4426950408889634f, lgb = log_sigmoidf(p->ret_logit[(l * 2 + 1) * 4 + h]) * 1.4426950408889634f;
    char* KK = lds; char* VV = lds + 128 * RT_PT; char* SS = lds + 2 * 128 * RT_PT;
    float* YB = (float*)lds;
    __syncthreads();
#pragma unroll
    for (int q = 0; q < 2; ++q) {
        const int c = tid + 512 * q, row = c >> 3, cc = c & 7;
        const u32x4 kw = *(const u32x4*)(PR + (R0 + row) * PLD + C_RK + h * 64 + cc * 8), vw = *(const u32x4*)(PR + (R0 + row) * PLD + C_RV + h * 64 + cc * 8);
        u32x4 ok;
#pragma unroll
        for (int j = 0; j < 4; ++j) ok[j] = pack_bf16(bflo(kw[j]) * 0.125f, bfhi(kw[j]) * 0.125f);
        *(u32x4*)(KK + row * RT_PT + cc * 16) = ok; *(u32x4*)(VV + row * RT_PT + cc * 16) = vw;
    }
    {
        const int jf = rb, jb = ret_jb(rb);
#pragma unroll
        for (int q = 0; q < 2; ++q) {
            const int e = tid + 512 * q, dir = e >> 9, dk = (e >> 3) & 63, e0 = (e & 7) * 8, j = dir ? jb : jf;
            const float* src = ((float*)(p->ws + WS_RKV)) + ((((size_t)bl * 4 + h) * 2 + dir) * 34 + j) * 4096 + dk * 64 + e0;
            const f32x4 s0 = *(const f32x4*)src, s1 = *(const f32x4*)(src + 4);
            u32x4 o; o.x = pack_bf16(s0[0], s0[1]); o.y = pack_bf16(s0[2], s0[3]); o.z = pack_bf16(s1[0], s1[1]); o.w = pack_bf16(s1[2], s1[3]);
            *(u32x4*)(SS + (dir * 64 + dk) * RT_PT + e0 * 2) = o;
        }
    }
    __syncthreads();
    const int dir = wid >> 2, mt = wid & 3;
    const float lg = dir ? lgb : lgf;
    const int qi = mt * 32 + r;
    bf16x8 qf[4];
#pragma unroll
    for (int s2 = 0; s2 < 4; ++s2) qf[s2] = *(const bf16x8*)(PR + (R0 + qi) * PLD + C_RQ + h * 64 + 16 * s2 + 8 * h5);
    f32x16 o0, o1;
#pragma unroll
    for (int i = 0; i < 16; ++i) { o0[i] = 0.f; o1[i] = 0.f; }
    {
        const char* Sd = SS + dir * 64 * RT_PT;
#pragma unroll
        for (int s2 = 0; s2 < 4; ++s2) {
            const bf16x8 a0 = tr_frag_nat(Sd, RT_PT, 16 * s2, 0, lane), a1 = tr_frag_nat(Sd, RT_PT, 16 * s2, 32, lane);
            o0 = __builtin_amdgcn_mfma_f32_32x32x16_bf16(a0, qf[s2], o0, 0, 0, 0);
            o1 = __builtin_amdgcn_mfma_f32_32x32x16_bf16(a1, qf[s2], o1, 0, 0, 0);
        }
        const int pos = dir ? 127 - qi : qi;
        const float qd = __builtin_amdgcn_exp2f(lg * (float)(pos + 1));
#pragma unroll
        for (int i = 0; i < 16; ++i) { o0[i] *= qd; o1[i] *= qd; }
    }
    const int kt0 = dir ? mt : 0, kt1 = dir ? 3 : mt;
    for (int kt = kt0; kt <= kt1; ++kt) {
        f32x16 st;
#pragma unroll
        for (int i = 0; i < 16; ++i) st[i] = 0.f;
#pragma unroll
        for (int s2 = 0; s2 < 4; ++s2) {
            const bf16x8 kf = *(const bf16x8*)(KK + (kt * 32 + r) * RT_PT + s2 * 32 + 16 * h5);
            st = __builtin_amdgcn_mfma_f32_32x32x16_bf16(kf, qf[s2], st, 0, 0, 0);
        }
#pragma unroll
        for (int i = 0; i < 16; ++i) {
            const int ki = kt * 32 + (i & 3) + 8 * (i >> 2) + 4 * h5;
            const int diff = dir ? ki - qi : qi - ki;
            st[i] = diff >= 0 ? st[i] * __builtin_amdgcn_exp2f(lg * (float)diff) : 0.f;
        }
        u32x4 pw0, pw1;
        pw0.x = pack_bf16(st[0], st[1]); pw0.y = pack_bf16(st[2], st[3]); pw0.z = pack_bf16(st[4], st[5]); pw0.w = pack_bf16(st[6], st[7]);
        pw1.x = pack_bf16(st[8], st[9]); pw1.y = pack_bf16(st[10], st[11]); pw1.z = pack_bf16(st[12], st[13]); pw1.w = pack_bf16(st[14], st[15]);
        const bf16x8 pf0 = __builtin_bit_cast(bf16x8, pw0), pf1 = __builtin_bit_cast(bf16x8, pw1);
#pragma unroll
        for (int s2 = 0; s2 < 2; ++s2) {
            const bf16x8 v0 = tr_frag_acc(VV, RT_PT, kt * 32 + 16 * s2, 0, lane), v1 = tr_frag_acc(VV, RT_PT, kt * 32 + 16 * s2, 32, lane);
            o0 = __builtin_amdgcn_mfma_f32_32x32x16_bf16(v0, s2 ? pf1 : pf0, o0, 0, 0, 0);
            o1 = __builtin_amdgcn_mfma_f32_32x32x16_bf16(v1, s2 ? pf1 : pf0, o1, 0, 0, 0);
        }
    }
    float sm = 0.f;
#pragma unroll
    for (int i = 0; i < 16; ++i) sm += o0[i] + o1[i];
    sm = sum_xor32(sm);
    const float mu = sm * (1.f / 64.f);
    float vs = 0.f;
#pragma unroll
    for (int i = 0; i < 16; ++i) { const float a0 = o0[i] - mu, a1 = o1[i] - mu; vs += a0 * a0 + a1 * a1; }
    vs = sum_xor32(vs);
    const float rstd = rsqrtf(vs * (1.f / 64.f) + EPSF);
    const bf16_t* gp = PR + (R0 + qi) * PLD + (dir ? C_RGB : C_RGF) + h * 64 + 4 * h5;
    const float* gw = p->ret_gnw + l * 256 + h * 64 + 4 * h5;
    __syncthreads();
#pragma unroll
    for (int t = 0; t < 2; ++t)
#pragma unroll
        for (int g4 = 0; g4 < 4; ++g4) {
            const u32x2 gg = *(const u32x2*)(gp + 32 * t + 8 * g4); const f32x4 ww = *(const f32x4*)(gw + 32 * t + 8 * g4);
            const float g0 = bflo(gg.x), g1 = bfhi(gg.x), g2 = bflo(gg.y), g3 = bfhi(gg.y);
            f32x4 y;
            y[0] = ((t ? o1[4 * g4] : o0[4 * g4]) - mu) * rstd * ww[0] * siluf(g0);
            y[1] = ((t ? o1[4 * g4 + 1] : o0[4 * g4 + 1]) - mu) * rstd * ww[1] * siluf(g1);
            y[2] = ((t ? o1[4 * g4 + 2] : o0[4 * g4 + 2]) - mu) * rstd * ww[2] * siluf(g2);
            y[3] = ((t ? o1[4 * g4 + 3] : o0[4 * g4 + 3]) - mu) * rstd * ww[3] * siluf(g3);
            *(f32x4*)(YB + (dir * 128 + qi) * 68 + 32 * t + 8 * g4 + 4 * h5) = y;
        }
    __syncthreads();
#pragma unroll
    for (int q = 0; q < 2; ++q) {
        const int e = tid + 512 * q, row = e >> 3, c8 = (e & 7) * 8;
        const f32x4 a0 = *(const f32x4*)(YB + row * 68 + c8), a1 = *(const f32x4*)(YB + row * 68 + c8 + 4), b0 = *(const f32x4*)(YB + (128 + row) * 68 + c8), b1 = *(const f32x4*)(YB + (128 + row) * 68 + c8 + 4);
        u32x4 o; o.x = pack_bf16(a0[0] + b0[0], a0[1] + b0[1]); o.y = pack_bf16(a0[2] + b0[2], a0[3] + b0[3]); o.z = pack_bf16(a1[0] + b1[0], a1[1] + b1[1]); o.w = pack_bf16(a1[2] + b1[2], a1[3] + b1[3]);
        *(u32x4*)(((bf16_t*)(p->ws + WS_OUTS)) + ((size_t)3 * TG + R0 + row) * 256 + h * 64 + c8) = o;
    }
}

#define U_MLA (NB * 32)
#define U_GQA (NB * 32)
#define U_NA (NB * 64)
#define U_RET (NB * 136)
#define U_CTX (NB * 12)
__device__ __forceinline__ int wq_next(unsigned* counter, LAS unsigned* wq) {
    __syncthreads();
    if (get_tid() == 0) *wq = atomicAdd(counter, 1u);
    __syncthreads();
    return (int)*wq;
}
__device__ __forceinline__ void phase_p4(KP p, int l, int g, char* ldsc, int bid, int nblk)
{
    float* lds = (float*)ldsc;
    LAS unsigned* wq = (LAS unsigned*)(smem + 32);
    unsigned* counter = ((unsigned*)(p->ws + WS_CNT)) + (l * NGROUP + g) * 64 * 8;
    (void)bid; (void)nblk;
    for (;;) {
        const int u = wq_next(counter, wq); if (u >= U_MLA) break;
        const int qb = u & 7, h = (u >> 3) & 3, bl = u >> 5; const size_t Rb = (size_t)bl * LTOK, Rq = Rb + CTXL + qb * 512;
        attn_unit<96>(((bf16_t*)(p->ws + WS_QA)) + Rq * 384 + h * 96, 384, ((bf16_t*)(p->ws + WS_KA)) + Rb * 384 + h * 96, 384, ((bf16_t*)(p->ws + WS_VA)) + Rb * 256 + h * 64, 256, 512, LTOK, ((bf16_t*)(p->ws + WS_OUTS)) + ((size_t)0 * TG + Rq) * 256 + h * 64, 256, ldsc);
    }
    for (;;) {
        const int u = wq_next(counter + 64, wq); if (u >= U_GQA) break;
        const int qb = u & 7, h = (u >> 3) & 3, bl = u >> 5; const size_t Rb = (size_t)bl * LTOK, Rq = Rb + CTXL + qb * 512; const int kvh = h >> 1;
        attn_unit<64>(((bf16_t*)(p->ws + WS_GQ)) + Rq * 256 + h * 64, 256, ((bf16_t*)(p->ws + WS_GK)) + Rb * 128 + kvh * 64, 128, ((bf16_t*)(p->ws + WS_PROJ)) + Rb * PLD + C_GV + kvh * 64, PLD, 512, LTOK, ((bf16_t*)(p->ws + WS_OUTS)) + ((size_t)1 * TG + Rq) * 256 + h * 64, 256, ldsc);
    }
    for (;;) {
        const int u = wq_next(counter + 128, wq); if (u >= U_NA) break;
        na_unit(p, l, u >> 6, (u >> 4) & 3, u & 15, ldsc);
    }
    for (;;) {
        const int u = wq_next(counter + 192, wq); if (u >= U_RET) break;
        const int rb = u % 34, h = (u / 34) & 3, bl = u / 136; ret_out_unit(p, l, bl, h, rb, ldsc);
    }
    if (l == 0) {
        for (;;) {
            const int u = wq_next(counter + 256, wq); if (u >= NB * 4) break;
            const int h = u & 3, bl = u >> 2; const size_t Rb = (size_t)bl * LTOK;
            attn_unit<96>(((bf16_t*)(p->ws + WS_QA)) + Rb * 384 + h * 96, 384, ((bf16_t*)(p->ws + WS_KA)) + Rb * 384 + h * 96, 384, ((bf16_t*)(p->ws + WS_VA)) + Rb * 256 + h * 64, 256, 256, CTXL, ((bf16_t*)(p->ws + WS_OUTS)) + ((size_t)0 * TG + Rb) * 256 + h * 64, 256, ldsc);
        }
        for (;;) {
            const int u = wq_next(counter + 320, wq); if (u >= NB * 8) break;
            const int ty = u & 1, h = (u >> 1) & 3, bl = u >> 3; const size_t Rb = (size_t)bl * LTOK;
            const bf16_t* Q = ty ? ((bf16_t*)(p->ws + WS_PROJ)) + Rb * PLD + C_NQ + h * 64 : ((bf16_t*)(p->ws + WS_GQ)) + Rb * 256 + h * 64;
            const bf16_t* K = ty ? ((bf16_t*)(p->ws + WS_PROJ)) + Rb * PLD + C_NK + h * 64 : ((bf16_t*)(p->ws + WS_GK)) + Rb * 128 + (h >> 1) * 64;
            const bf16_t* V = ty ? ((bf16_t*)(p->ws + WS_PROJ)) + Rb * PLD + C_NV + h * 64 : ((bf16_t*)(p->ws + WS_PROJ)) + Rb * PLD + C_GV + (h >> 1) * 64;
            attn_unit<64>(Q, ty ? PLD : 256, K, ty ? PLD : 128, V, PLD, 256, CTXL, ((bf16_t*)(p->ws + WS_OUTS)) + ((size_t)(1 + ty) * TG + Rb) * 256 + h * 64, 256, ldsc);
        }
    }
}

template <int MI>
__device__ __forceinline__ void p5_tile(KP p, int l, char* lds, int pm, int pn, int rsub)
{
    const int tid = get_tid(), lane = tid & 63, wid = tid >> 6, wm = wid >> 1, wn = wid & 1, fr = lane & 15, fq = lane >> 4;
    const int arow = tid >> 3, akc = tid & 7, a_l = arow * G_LDP + akc * 16;
    const int aoff = (wm * 16 * MI + fr) * G_LDP + fq * 16, boff = G_ABYTES + (wn * 64 + fr) * G_LDP + fq * 16;
    const bf16_t* OUTS = (const bf16_t*)(p->ws + WS_OUTS);
    const bf16_t* WB = (const bf16_t*)(p->ws + WS_WBT) + (size_t)l * 4 * DM * 256;
    const int rbase = pm * 256 + rsub;
    {
        const bf16_t* ag = OUTS + ((size_t)rbase + arow) * 256 + akc * 8;
        const bf16_t* bg = WB + ((size_t)pn * G_BN + arow) * 256 + akc * 8;
        const unsigned char* gp = (const unsigned char*)(p->ws + WS_GATE8) + (size_t)(rbase + wm * 16 * MI + fr) * 4096 + pn * G_BN + wn * 64 + fq * 16;
        f32x4 acc[MI][4]; zero_acc<MI>(acc);
        u32x2 totp[MI][4];
#pragma unroll
        for (int mi = 0; mi < MI; ++mi)
#pragma unroll
            for (int ni = 0; ni < 4; ++ni) totp[mi][ni] = (u32x2){0u, 0u};
        u32x4 sa[2][MI], sb[2][2];
        u32x4 gwv[MI];
#define P5_LOAD(SET, KT) do { const bf16_t* a2_ = ag + (size_t)((KT) >> 2) * TG * 256 + ((KT) & 3) * 64; const bf16_t* b2_ = bg + (size_t)((KT) >> 2) * DM * 256 + ((KT) & 3) * 64; \
            _Pragma("unroll") for (int i_ = 0; i_ < MI; ++i_) sa[SET][i_] = *(const u32x4*)(a2_ + (size_t)(64 * i_) * 256); \
            _Pragma("unroll") for (int i_ = 0; i_ < 2; ++i_) sb[SET][i_] = *(const u32x4*)(b2_ + (size_t)(64 * i_) * 256); } while (0)
#define P5_STORE(SET, BO) do { \
            _Pragma("unroll") for (int i_ = 0; i_ < MI; ++i_) *(u32x4*)(lds + (BO) + a_l + i_ * 64 * G_LDP) = sa[SET][i_]; \
            _Pragma("unroll") for (int i_ = 0; i_ < 2; ++i_) *(u32x4*)(lds + (BO) + G_ABYTES + a_l + i_ * 64 * G_LDP) = sb[SET][i_]; } while (0)
        P5_LOAD(0, 0);
        __syncthreads();
        P5_STORE(0, 0);
        P5_LOAD(0, 1); P5_LOAD(1, 2);
        __syncthreads();
#pragma unroll 1
        for (int sg = 0; sg < 4; ++sg) {
#pragma unroll
            for (int q4 = 0; q4 < 4; ++q4) {
                const int par = q4 & 1, kt = 4 * sg + q4, cur = par * G_STAGE, nxt = (par ^ 1) * G_STAGE;
#pragma unroll
                for (int ks = 0; ks < 2; ++ks) {
                    bf16x8 af[MI], bfr[4];
#pragma unroll
                    for (int mi = 0; mi < MI; ++mi) af[mi] = *(const bf16x8*)(lds + cur + aoff + mi * 16 * G_LDP + ks * 64);
#pragma unroll
                    for (int ni = 0; ni < 4; ++ni) bfr[ni] = *(const bf16x8*)(lds + cur + boff + ni * 16 * G_LDP + ks * 64);
#pragma unroll
                    for (int mi = 0; mi < MI; ++mi)
#pragma unroll
                        for (int ni = 0; ni < 4; ++ni) acc[mi][ni] = __builtin_amdgcn_mfma_f32_16x16x32_bf16(bfr[ni], af[mi], acc[mi][ni], 0, 0, 0);
                }
                if (q4 == 1) {
#pragma unroll
                    for (int mi = 0; mi < MI; ++mi)
                        gwv[mi] = *(const u32x4*)(gp + (size_t)(mi * 16) * 4096 + sg * DM);
                    __builtin_amdgcn_sched_barrier(0);
                }
                P5_STORE(par, nxt);
                { const int kn = (kt + 3 < 16) ? kt + 3 : 15; P5_LOAD(par, kn); }
                __syncthreads();
                if (q4 == 3) {
                    __builtin_amdgcn_sched_barrier(0);
#pragma unroll
                    for (int mi = 0; mi < MI; ++mi)
#pragma unroll
                        for (int ni = 0; ni < 4; ++ni) {
                            const unsigned gw = gwv[mi][ni];
                            const u32x2 tp = totp[mi][ni];
                            const float t0 = fmaf((float)((gw >> 0) & 255u), acc[mi][ni][0], bflo(tp.x)), t1 = fmaf((float)((gw >> 8) & 255u), acc[mi][ni][1], bfhi(tp.x));
                            const float t2 = fmaf((float)((gw >> 16) & 255u), acc[mi][ni][2], bflo(tp.y)), t3 = fmaf((float)((gw >> 24) & 255u), acc[mi][ni][3], bfhi(tp.y));
                            totp[mi][ni] = (u32x2){pack_bf16(t0, t1), pack_bf16(t2, t3)};
                            acc[mi][ni] = (f32x4){0.f, 0.f, 0.f, 0.f};
                        }
                }
            }
        }
#undef P5_LOAD
#undef P5_STORE
#pragma unroll
        for (int mi = 0; mi < MI; ++mi)
#pragma unroll
            for (int ni = 0; ni < 4; ++ni) {
                const u32x2 tp = totp[mi][ni]; const float k255 = 1.f / 255.f;
                *(u32x2*)(((bf16_t*)(p->ws + WS_ACC)) + (size_t)(rbase + wm * 16 * MI + mi * 16 + fr) * DM + pn * G_BN + wn * 64 + ni * 16 + fq * 4) =
                    (u32x2){pack_bf16(bflo(tp.x) * k255, bfhi(tp.x) * k255), pack_bf16(bflo(tp.y) * k255, bfhi(tp.y) * k255)};
            }
    }
}

__device__ __forceinline__ void phase_p5(KP p, int l, char* lds, int bid, int nblk)
{
    constexpr int tn = DM / G_BN, total = (TG / 256) * tn, NG8 = (TG / 256) / 8;
    const bool xord = (nblk == 256) && (tn == 8) && ((TG / 256) % 8 == 0);
    if (xord) {
        constexpr int NFULL = (NG8 % 4 == 1) ? NG8 / 4 : (NG8 + 3) / 4;
#pragma unroll 1
        for (int it = 0; it < NFULL; ++it) {
            const int g8 = it * 4 + (bid >> 6); if (g8 >= NG8) break;
            p5_tile<4>(p, l, lds, g8 * 8 + (bid & 7), (bid >> 3) & 7, 0);
        }
        if (NG8 % 4 == 1) p5_tile<1>(p, l, lds, (NG8 - 1) * 8 + (bid & 7), (bid >> 3) & 7, (bid >> 6) * 64);
    } else {
        for (int t = bid; t < total; t += nblk) p5_tile<4>(p, l, lds, t / tn, t % tn, 0);
    }
}

struct EpiResid {
    KP p; int l, g, goff;
    __device__ __forceinline__ void operator()(int row, int col, f32x4 v) const {
        const int bl = row / LTOK, t = row - bl * LTOK, b = g * NB + bl;
        float* dst; const float* src; int mr;
        if (t < CTXL) { if (l != 0) return; const size_t o = ((size_t)b * CTXL + t) * DM + col; dst = ((float*)(p->ws + WS_CTXS)) + o; src = p->ctx + o; mr = 16; }
        else { const size_t o = ((size_t)b * SEQ + (t - CTXL)) * DM + col; dst = p->out + o; src = (l == 0) ? p->x + o : (const float*)dst; mr = b; }
        const f32x4 gg = *(const f32x4*)(((float*)(p->ws + WS_MOD)) + ((size_t)l * 17 + mr) * 6144 + goff + col);
        f32x4 s = *(const f32x4*)src;
#pragma unroll
        for (int j = 0; j < 4; ++j) s[j] += gg[j] * v[j];
        *(f32x4*)dst = s;
    }
};

__device__ __forceinline__ void grid_barrier();
#if MK_ONE_LAUNCH
#define P9_GRID_SYNC() grid_barrier()
#else
#define P9_GRID_SYNC() __syncthreads()
#endif
typedef __bf16 bf16pair __attribute__((ext_vector_type(2)));
__device__ __forceinline__ float dot2bf(unsigned a, unsigned b, float c) { return __builtin_amdgcn_fdot2_f32_bf16(__builtin_bit_cast(bf16pair, a), __builtin_bit_cast(bf16pair, b), c, false); }
__device__ __forceinline__ unsigned f2ord(float f) { const unsigned b = __float_as_uint(f); return b ^ ((unsigned)((int)b >> 31) | 0x80000000u); }
__device__ __forceinline__ int mbcnt64(unsigned long long m) { return (int)__builtin_amdgcn_mbcnt_hi((unsigned)(m >> 32), __builtin_amdgcn_mbcnt_lo((unsigned)m, 0u)); }

__device__ __forceinline__ float ord2f(unsigned u) { return __uint_as_float((u & 0x80000000u) ? (u ^ 0x80000000u) : ~u); }

__device__ __forceinline__ void cx_desc(unsigned& a, unsigned& b) { const unsigned hi = a > b ? a : b, lo = a > b ? b : a; a = hi; b = lo; }
template <int N, int OFF, bool DESC, int M>
__device__ __forceinline__ void bitonic_sort(unsigned (&a)[M]) {
#pragma unroll
    for (int k = 2; k <= N; k <<= 1)
#pragma unroll
        for (int j = k >> 1; j > 0; j >>= 1)
#pragma unroll
            for (int i = 0; i < N; ++i) {
                const int l = i ^ j;
                if (l > i) { const bool up = ((i & k) == 0) != DESC; if (up) cx_desc(a[OFF + l], a[OFF + i]); else cx_desc(a[OFF + i], a[OFF + l]); }
            }
}
__device__ __forceinline__ void bitonic_merge16_desc(unsigned (&a)[16]) {
#pragma unroll
    for (int j = 8; j > 0; j >>= 1)
#pragma unroll
        for (int i = 0; i < 16; ++i) { const int l = i ^ j; if (l > i) cx_desc(a[i], a[l]); }
}
template <int XM>
__device__ __forceinline__ void merge_partner16(unsigned (&a)[16], bool upper) {
    unsigned b[16];
#pragma unroll
    for (int i = 0; i < 16; ++i) b[i] = (XM == 32) ? get_xor32_u(a[15 - i], upper) : xor_swz_u<XM & 31>(a[15 - i]);
#pragma unroll
    for (int i = 0; i < 16; ++i) a[i] = a[i] > b[i] ? a[i] : b[i];
    bitonic_merge16_desc(a);
}

#define P9_KEYP 144
#define P9_NTOK 136
#define P9_HG 3
#define P9_LKEY 0
#define P9_LIDX (P9_HG * 2 * 128 * P9_KEYP)
#define P9_LSTASH 0
__device__ __forceinline__ constexpr int p9_pair_i(int pi) {
    return pi < 16 ? 0 : pi < 24 ? 1 : pi < 29 ? 2 : pi < 33 ? 3 : pi < 36 ? 4 : pi < 38 ? 5 : pi < 40 ? 6 : pi < 42 ? 7 : pi < 50 ? pi - 34 : 0;
}
__device__ __forceinline__ constexpr int p9_pair_j(int pi) {
    return pi < 16 ? pi : pi < 24 ? pi - 16 : pi < 29 ? pi - 24 : pi < 33 ? pi - 29 : pi < 36 ? pi - 33 : pi < 38 ? pi - 36 : pi < 40 ? pi - 38 : pi < 42 ? pi - 40 : 0;
}
__device__ __forceinline__ void phase_p9(KP p, int l, int g, char* lds, int bid, int nblk)
{
    const int tid = get_tid(), wid = tid >> 6;
    const bf16_t* KEYB = (const bf16_t*)(p->ws + WS_KEYB) + (size_t)l * 8 * 2 * 128 * 64;
    const bf16_t* PQ = (const bf16_t*)(p->ws + WS_PQ);
    unsigned* stash = (unsigned*)(lds + P9_LSTASH);
    const int nit = (TG / P9_NTOK + nblk - 1) / nblk;
    for (int it = 0; it < nit; ++it) {
        const int blk = bid + it * nblk;
        if (blk >= TG / P9_NTOK) { P9_GRID_SYNC(); P9_GRID_SYNC(); continue; }
        const int row0 = blk * P9_NTOK;
        unsigned* gst = (unsigned*)(p->ws + WS_PROJ) + (size_t)row0 * 128;
#pragma unroll 1
        for (int h0 = 0; h0 < 8; h0 += P9_HG) {
            const int nh = (8 - h0) < P9_HG ? (8 - h0) : P9_HG;
            __syncthreads();
            for (int c = tid; c < nh * 2048; c += NTHREADS) { const int row = c >> 3, cc = c & 7;
                *(u32x4*)(lds + P9_LKEY + row * P9_KEYP + cc * 16) = *(const u32x4*)(KEYB + ((size_t)h0 * 256 + row) * 64 + cc * 8); }
            __syncthreads();
#pragma unroll 1
            for (int item = wid; item < 9 * nh; item += 8) {
                const int tile = item % 9, hh = item / 9, h = h0 + hh;
                const int LK = P9_LKEY + hh * 256 * P9_KEYP;
                const int tidh = get_tid(), tk = tidh & 15, qd = (tidh >> 4) & 3;
                const int ntile = (P9_NTOK - 16 * tile) < 16 ? (P9_NTOK - 16 * tile) : 16;
                const int trow = row0 + 16 * tile + (tk < ntile ? tk : ntile - 1);
                unsigned* idxl = (unsigned*)(lds + P9_LIDX) + (wid * 16 + tk) * 33;
                unsigned top[2][16];
#pragma unroll
                for (int pp = 0; pp < 2; ++pp) {
                    f32x4 acc[8];
#pragma unroll
                    for (int t = 0; t < 8; ++t) acc[t] = (f32x4){0.f, 0.f, 0.f, 0.f};
#pragma unroll
                    for (int ks = 0; ks < 2; ++ks) {
                        const bf16x8 qfr = *(const bf16x8*)(PQ + (size_t)trow * DM + h * 128 + pp * 64 + ks * 32 + qd * 8);
#pragma unroll
                        for (int t = 0; t < 8; ++t) {
                            const bf16x8 kfr = *(const bf16x8*)(lds + LK + (pp * 128 + t * 16 + tk) * P9_KEYP + ks * 64 + qd * 16);
                            acc[t] = __builtin_amdgcn_mfma_f32_16x16x32_bf16(kfr, qfr, acc[t], 0, 0, 0);
                        }
                    }
                    unsigned ck[32];
#pragma unroll
                    for (int t = 0; t < 8; ++t)
#pragma unroll
                        for (int jj = 0; jj < 4; ++jj) ck[t * 4 + jj] = (f2ord(acc[t][jj]) & 0xFFFFFF80u) | (unsigned)(16 * t + jj) | ((unsigned)qd << 2);
                    bitonic_sort<16, 0, true>(ck);
                    bitonic_sort<16, 16, false>(ck);
                    unsigned (&tp)[16] = top[pp];
#pragma unroll
                    for (int i = 0; i < 16; ++i) tp[i] = ck[i] > ck[16 + i] ? ck[i] : ck[16 + i];
                    bitonic_merge16_desc(tp);
                    merge_partner16<16>(tp, false); merge_partner16<32>(tp, (qd & 2) != 0);
                    if (qd == 0) {
#pragma unroll
                        for (int i = 0; i < 16; ++i) idxl[pp * 16 + i] = tp[i] & 127u;
                    }
                }
                float v1[16], v2[16];
#pragma unroll
                for (int i = 0; i < 16; ++i) { v1[i] = ord2f(top[0][i] & 0xFFFFFF80u); v2[i] = ord2f(top[1][i] & 0xFFFFFF80u); }
                unsigned cand[16];
#pragma unroll
                for (int n = 0; n < 13; ++n) {
                    const unsigned k0 = (f2ord(v1[p9_pair_i(4 * n)] + v2[p9_pair_j(4 * n)]) & 0xFFFFFF00u) | (unsigned)(p9_pair_i(4 * n) * 16 + p9_pair_j(4 * n));
                    const unsigned k1 = (f2ord(v1[p9_pair_i(4 * n + 1)] + v2[p9_pair_j(4 * n + 1)]) & 0xFFFFFF00u) | (unsigned)(p9_pair_i(4 * n + 1) * 16 + p9_pair_j(4 * n + 1));
                    const unsigned k2 = (4 * n + 2 < 50) ? ((f2ord(v1[p9_pair_i(4 * n + 2)] + v2[p9_pair_j(4 * n + 2)]) & 0xFFFFFF00u) | (unsigned)(p9_pair_i(4 * n + 2) * 16 + p9_pair_j(4 * n + 2))) : 0u;
                    const unsigned k3 = (4 * n + 3 < 50) ? ((f2ord(v1[p9_pair_i(4 * n + 3)] + v2[p9_pair_j(4 * n + 3)]) & 0xFFFFFF00u) | (unsigned)(p9_pair_i(4 * n + 3) * 16 + p9_pair_j(4 * n + 3))) : 0u;
                    cand[n] = qd == 0 ? k0 : (qd == 1 ? k1 : (qd == 2 ? k2 : k3));
                }
                cand[13] = 0u; cand[14] = 0u; cand[15] = 0u;
                bitonic_sort<16, 0, true>(cand);
                merge_partner16<16>(cand, false); merge_partner16<32>(cand, (qd & 2) != 0);
                const float mx = ord2f(cand[0] & 0xFFFFFF00u);
                float ex[16], den = 0.f;
#pragma unroll
                for (int k = 0; k < 16; ++k) { ex[k] = __expf(ord2f(cand[k] & 0xFFFFFF00u) - mx); den += ex[k]; }
                const float inv = 1.f / den;
                if (qd == 0 && tk < ntile) {
#pragma unroll
                    for (int k = 0; k < 16; ++k) {
                        const unsigned e = idxl[(cand[k] >> 4) & 15u] * 128u + idxl[16 + (cand[k] & 15u)];
                        gst[((16 * tile + tk) * 8 + h) * 16 + k] = (e << 16) | (unsigned)f2bf(ex[k] * inv);
                    }
                }
            }
        }
        P9_GRID_SYNC();
        {
            const u32x4* src = (const u32x4*)gst; u32x4* dstl = (u32x4*)(lds + P9_LSTASH);
            for (int c = get_tid(); c < P9_NTOK * 128 / 4; c += NTHREADS) dstl[c] = src[c];
            __syncthreads();
        }
        {
            const int tid2 = get_tid(), lane = tid2 & 63, wid2 = tid2 >> 6;
            KP p2 = get_kp();
            const unsigned char* UB = (const unsigned char*)(p2->ws + WS_UB) + (size_t)l * 16384 * (DM / 2);
            const float* USC = (const float*)(p2->ws + WS_USC) + (size_t)l * 16384; const float* VSC = (const float*)(p2->ws + WS_VSC) + (size_t)l * 16384;
            const float* URS = (const float*)(p2->ws + WS_URS) + (size_t)l * 16384;
            const bf16_t* Hh = HG(p2, g);
#pragma unroll 1
            for (int slot = wid2; slot < P9_NTOK; slot += 8) {
                const int r = row0 + slot;
                if ((r % LTOK) < CTXL && l != 0) continue;
                const u32x4 x0 = *(const u32x4*)(Hh + (size_t)r * DM + lane * 16), x1 = *(const u32x4*)(Hh + (size_t)r * DM + lane * 16 + 8);
                unsigned HW0 = 0u, HW1 = 0u, LW0 = 0u, LW1 = 0u; float sx;
                {
                    float xf[16];
                    xf[0] = bflo(x0.x); xf[1] = bfhi(x0.x); xf[2] = bflo(x0.y); xf[3] = bfhi(x0.y); xf[4] = bflo(x0.z); xf[5] = bfhi(x0.z); xf[6] = bflo(x0.w); xf[7] = bfhi(x0.w);
                    xf[8] = bflo(x1.x); xf[9] = bfhi(x1.x); xf[10] = bflo(x1.y); xf[11] = bfhi(x1.y); xf[12] = bflo(x1.z); xf[13] = bfhi(x1.z); xf[14] = bflo(x1.w); xf[15] = bfhi(x1.w);
                    float am = 0.f;
#pragma unroll
                    for (int i = 0; i < 16; ++i) am = fmaxf(am, fabsf(xf[i]));
                    am = wave_max(am);
                    sx = am > 0.f ? am * (1.f / 127.f) : 1.f;
                    const float ix = 1.f / sx;
#pragma unroll
                    for (int i = 0; i < 16; ++i) {
                        const int v_ = (int)fminf(fmaxf(__builtin_rintf(xf[i] * ix), -128.f), 127.f) + 128;
                        const unsigned hs = (unsigned)((v_ >> 4) - 8) & 15u, ls = (unsigned)((v_ & 15) - 8) & 15u;
                        if (i < 8) { HW0 |= hs << (4 * i); LW0 |= ls << (4 * i); } else { HW1 |= hs << (4 * (i - 8)); LW1 |= ls << (4 * (i - 8)); }
                    }
                }
#pragma unroll 1
                for (int h = 0; h < 8; ++h) {
                    unsigned* st = stash + (slot * 8 + h) * 16;
                    float d[16];
                    const int kk = (lane >> 2) & 15;
                    const unsigned sk = st[kk];
                    const float su = USC[sk >> 16], svs = VSC[sk >> 16], urs = URS[sk >> 16];
                    {
                        u32x2 ua[16];
#pragma unroll
                        for (int k = 0; k < 16; ++k) ua[k] = *(const u32x2*)(UB + (size_t)(st[k] >> 16) * (DM / 2) + lane * 8);
#pragma unroll
                        for (int k = 0; k < 16; ++k) {
                            int dh = __builtin_amdgcn_sdot8((int)ua[k].x, (int)HW0, 0, false); dh = __builtin_amdgcn_sdot8((int)ua[k].y, (int)HW1, dh, false);
                            int dl = __builtin_amdgcn_sdot8((int)ua[k].x, (int)LW0, 0, false); dl = __builtin_amdgcn_sdot8((int)ua[k].y, (int)LW1, dl, false);
                            d[k] = (float)(16 * dh + dl);
                        }
                    }
                    float r8[8], r4[4], r2[2], r1;
#pragma unroll
                    for (int i = 0; i < 8; ++i) { const u32x2 sw = __builtin_amdgcn_permlane32_swap(__float_as_uint(d[i]), __float_as_uint(d[i + 8]), false, false); r8[i] = __uint_as_float(sw.x) + __uint_as_float(sw.y); }
#pragma unroll
                    for (int i = 0; i < 4; ++i) { const u32x2 sw = __builtin_amdgcn_permlane16_swap(__float_as_uint(r8[i]), __float_as_uint(r8[i + 4]), false, false); r4[i] = __uint_as_float(sw.x) + __uint_as_float(sw.y); }
                    { const bool bb = (lane & 8) != 0;
#pragma unroll
                      for (int i = 0; i < 2; ++i) { const float snd = bb ? r4[i] : r4[i + 2], keep = bb ? r4[i + 2] : r4[i]; r2[i] = keep + xor_swz<8>(snd); } }
                    { const bool bb = (lane & 4) != 0; const float snd = bb ? r2[0] : r2[1], keep = bb ? r2[1] : r2[0]; r1 = keep + xor_swz<4>(snd); }
                    r1 += xor_swz<2>(r1); r1 += xor_swz<1>(r1);
                    r1 = (r1 + urs) * (su * sx);
                    const float cf = bflo(sk) * 0.5f * r1 * (1.f + erff(r1 * 0.70710678118654752f)) * svs;
                    if ((lane & 3) == 0) st[kk] = (sk & 0xffff0000u) | (unsigned)f2bf(cf);
                }
            }
        }
        P9_GRID_SYNC();
        {
            const int tid2 = get_tid(), lane = tid2 & 63, wid2 = tid2 >> 6;
            KP p2 = get_kp();
            const unsigned char* VB = (const unsigned char*)(p2->ws + WS_VB) + (size_t)l * 16384 * (DM / 2);
#pragma unroll 1
            for (int slot = wid2; slot < P9_NTOK; slot += 8) {
                const int r = row0 + slot;
                const int bl = r / LTOK, t = r - bl * LTOK, b = g * NB + bl;
                if (t < CTXL && l != 0) continue;
                float* dst; int mr;
                if (t < CTXL) { dst = ((float*)(p2->ws + WS_CTXS)) + ((size_t)b * CTXL + t) * DM; mr = 16; } else { dst = p2->out + ((size_t)b * SEQ + (t - CTXL)) * DM; mr = b; }
                const float* g2 = ((float*)(p2->ws + WS_MOD)) + ((size_t)l * 17 + mr) * 6144 + 5120;
                f32x4 sv[4];
#pragma unroll
                for (int i = 0; i < 4; ++i) sv[i] = *(const f32x4*)(dst + lane * 16 + i * 4);
                float outv[16];
#pragma unroll
                for (int i = 0; i < 16; ++i) outv[i] = 0.f;
#pragma unroll 1
                for (int h = 0; h < 8; ++h) {
                    const unsigned* st = stash + (slot * 8 + h) * 16;
                    u32x2 va[16]; unsigned sk[16];
#pragma unroll
                    for (int k = 0; k < 16; ++k) { sk[k] = st[k]; va[k] = *(const u32x2*)(VB + (size_t)(sk[k] >> 16) * (DM / 2) + lane * 8); }
#pragma unroll
                    for (int k = 0; k < 16; ++k) {
                        const float ck = bflo(sk[k]);
#define P9_VFMA(W, B) { const f32x2 t_ = __builtin_amdgcn_cvt_scalef32_pk_f32_fp4(va[k][W], 1.0f, B); outv[8 * (W) + 2 * (B)] += ck * t_.x; outv[8 * (W) + 2 * (B) + 1] += ck * t_.y; }
                        P9_VFMA(0, 0) P9_VFMA(0, 1) P9_VFMA(0, 2) P9_VFMA(0, 3) P9_VFMA(1, 0) P9_VFMA(1, 1) P9_VFMA(1, 2) P9_VFMA(1, 3)
#undef P9_VFMA
                        if ((k & 3) == 3) __builtin_amdgcn_sched_barrier(0);
                    }
                }
                const int lane = get_tid() & 63;
                float ss = 0.f;
#pragma unroll
                for (int i = 0; i < 4; ++i) {
                    const f32x4 gg = *(const f32x4*)(g2 + lane * 16 + i * 4);
#pragma unroll
                    for (int jj = 0; jj < 4; ++jj) { sv[i][jj] += gg[jj] * outv[i * 4 + jj]; ss += sv[i][jj] * sv[i][jj]; }
                }
                if (l == 0) {
                    const float rstd0 = rsqrtf(wave_sum(ss) * (1.f / DM) + EPSF);
                    const float* md1 = ((float*)(p2->ws + WS_MOD)) + ((size_t)17 + mr) * 6144;
                    bf16_t* hrow = HG(p2, g) + (size_t)r * DM + lane * 16;
#pragma unroll
                    for (int i = 0; i < 4; ++i) {
                        const int c = lane * 16 + i * 4;
                        const f32x4 w1 = *(const f32x4*)(p2->norm1_w + DM + c), sc = *(const f32x4*)(md1 + 1024 + c), sh = *(const f32x4*)(md1 + c);
                        f32x4 y;
#pragma unroll
                        for (int jj = 0; jj < 4; ++jj) y[jj] = sv[i][jj] * rstd0 * w1[jj] * (1.f + sc[jj]) + sh[jj];
                        store_bf16x4(hrow + i * 4, y);
                    }
                }
                if (l == 1) {
                    ss = wave_sum(ss);
                    const float rstd = rsqrtf(ss * (1.f / DM) + EPSF);
#pragma unroll
                    for (int i = 0; i < 4; ++i) { const f32x4 fw = *(const f32x4*)(p2->final_w + lane * 16 + i * 4);
#pragma unroll
                        for (int jj = 0; jj < 4; ++jj) sv[i][jj] *= rstd * fw[jj]; }
                }
#pragma unroll
                for (int i = 0; i < 4; ++i) *(f32x4*)(dst + lane * 16 + i * 4) = sv[i];
            }
        }
    }
}

__device__ __forceinline__ void phase_final(KP p, int bid, int nblk)
{
    const int lane = get_tid() & 63, wid = get_tid() >> 6;
    for (int r = bid * 8 + wid; r < NBATCH * SEQ; r += nblk * 8) {
        float* src = p->out + (size_t)r * DM;
        f32x4 v[4]; float ss = 0.f;
#pragma unroll
        for (int i = 0; i < 4; ++i) { v[i] = *(const f32x4*)(src + i * 256 + lane * 4); ss += v[i][0] * v[i][0] + v[i][1] * v[i][1] + v[i][2] * v[i][2] + v[i][3] * v[i][3]; }
        ss = wave_sum(ss);
        const float rstd = rsqrtf(ss * (1.f / DM) + EPSF);
#pragma unroll
        for (int i = 0; i < 4; ++i) {
            const f32x4 w = *(const f32x4*)(p->final_w + i * 256 + lane * 4);
            f32x4 y;
#pragma unroll
            for (int j = 0; j < 4; ++j) y[j] = v[i][j] * rstd * w[j];
            *(f32x4*)(src + i * 256 + lane * 4) = y;
        }
    }
}

template <int PH>
__device__ __forceinline__ void run_phase(KP p, int l, int g, char* lds, int bid, int nblk)
{
    asm volatile("" : "+s"(l), "+s"(g), "+s"(bid), "+s"(nblk));
    if constexpr (PH == 0) phase_prologue(p, lds, bid, nblk);
    if constexpr (PH == 1) { for (int gg = 0; gg < NGROUP; ++gg) phase_norm(p, 0, gg, 0, bid, nblk); }
    if constexpr (PH == 2) big_gemm(HG(p, g), ((bf16_t*)(p->ws + WS_WINT)) + (size_t)l * NPROJ * DM, TG, NPROJ, DM, Epi8<EpiProj8>{EpiProj8{((bf16_t*)(p->ws + WS_PROJ)), (unsigned char*)(p->ws + WS_GATE8)}}, lds, bid, nblk);
    if constexpr (PH == 3) phase_p3a(p, l, bid, nblk, lds);
    if constexpr (PH == 4) phase_p3b(p, l, bid, nblk);
    if constexpr (PH == 6) phase_p4(p, l, g, lds, bid, nblk);
    if constexpr (PH == 7) phase_p5(p, l, lds, bid, nblk);
    if constexpr (PH == 8) big_gemm(((bf16_t*)(p->ws + WS_ACC)), ((bf16_t*)(p->ws + WS_WOUTT)) + (size_t)l * DM * DM, TG, DM, DM, Epi4<EpiResid>{EpiResid{p, l, g, 2048}}, lds, bid, nblk);
    if constexpr (PH == 9) phase_norm(p, l, g, 1, bid, nblk);
    if constexpr (PH == 10) big_gemm(HG(p, g), ((bf16_t*)(p->ws + WS_WQT)) + (size_t)l * DM * DM, TG, DM, DM, Epi8<EpiStore8>{EpiStore8{((bf16_t*)(p->ws + WS_PQ)), DM}}, lds, bid, nblk);
    if constexpr (PH == 11) phase_p9(p, l, g, lds, bid, nblk);
    if constexpr (PH == 12) phase_final(p, bid, nblk);
}


__device__ __forceinline__ void grid_barrier() {
    XcdBarrier b; b.bar = (unsigned*)(get_kp()->ws + WS_BAR); b.x = xb_xcc_id(); b.st = (volatile LAS unsigned*)smem;
    xcd_barrier(b);
}

template <int PH>
__global__ void __launch_bounds__(NTHREADS, 2) k_phase(Params p_unused, int l, int g)
{
    (void)p_unused;
    tid_setup();
    run_phase<PH>(get_kp(), l, g, smem + 512, blockIdx.x, gridDim.x);
}

#if MK_ONE_LAUNCH
__global__ void __launch_bounds__(NTHREADS, 2) k_mega(Params p_unused)
{
    (void)p_unused;
    tid_setup();
    if (get_tid() == 0) *(uint4*)smem = make_uint4(0u, 0u, 0u, 0u);
    __syncthreads();
    (void)xcd_barrier_post((unsigned*)(get_kp()->ws + WS_BAR), (volatile LAS unsigned*)smem);
    char* lds = smem + 512;
    const int bid = blockIdx.x, nblk = gridDim.x;
    run_phase<0>(get_kp(), 0, 0, lds, bid, nblk);
    grid_barrier();
#define MK_LG(L_, G_) do { \
        run_phase<2>(get_kp(), L_, G_, lds, bid, nblk); grid_barrier(); \
        run_phase<3>(get_kp(), L_, G_, lds, bid, nblk); grid_barrier(); \
        run_phase<4>(get_kp(), L_, G_, lds, bid, nblk); grid_barrier(); \
        run_phase<6>(get_kp(), L_, G_, lds, bid, nblk); grid_barrier(); \
        run_phase<7>(get_kp(), L_, G_, lds, bid, nblk); grid_barrier(); \
        run_phase<8>(get_kp(), L_, G_, lds, bid, nblk); grid_barrier(); \
        run_phase<9>(get_kp(), L_, G_, lds, bid, nblk); grid_barrier(); \
        run_phase<10>(get_kp(), L_, G_, lds, bid, nblk); grid_barrier(); \
        run_phase<11>(get_kp(), L_, G_, lds, bid, nblk); grid_barrier(); } while (0)
    run_phase<1>(get_kp(), 0, 0, lds, bid, nblk); grid_barrier();
    static_assert(NGROUP == 2, "phase program written out for two groups");
    MK_LG(0, 0); MK_LG(0, 1); MK_LG(1, 0); MK_LG(1, 1);
#undef MK_LG
}
#endif

static inline size_t al256(size_t x) { return (x + 255) & ~(size_t)255; }

template <int PH>
static void launch_phase(const Params& p, int l, int g, int grid, hipStream_t s)
{
    static bool attr = false;
    if (!attr) { (void)hipFuncSetAttribute((const void*)k_phase<PH>, hipFuncAttributeMaxDynamicSharedMemorySize, LDS_BYTES); attr = true; }
    hipLaunchKernelGGL(k_phase<PH>, dim3(grid), dim3(NTHREADS), LDS_BYTES, s, p, l, g);
}

extern "C" void kernel_launch(void* const* d_in, const int* in_sizes, int n_in, void* d_out, int out_size, void* d_ws, size_t ws_size, hipStream_t stream)
{
    (void)in_sizes; (void)n_in; (void)out_size;
    Params p{};
    p.x = (const float*)d_in[0]; p.c = (const float*)d_in[1]; p.ctx = (const float*)d_in[2]; p.c_ctx = (const float*)d_in[3];
    p.mod_w = (const float*)d_in[4]; p.mod_b = (const float*)d_in[5]; p.norm1_w = (const float*)d_in[6]; p.norm2_w = (const float*)d_in[7];
    p.w_in = (const float*)d_in[8]; p.mla_qn = (const float*)d_in[9]; p.mla_wuq = (const float*)d_in[10]; p.mla_kvn = (const float*)d_in[11];
    p.mla_wukv = (const float*)d_in[12]; p.gqa_qn = (const float*)d_in[13]; p.gqa_kn = (const float*)d_in[14]; p.na_bias = (const float*)d_in[15];
    p.ret_logit = (const float*)d_in[16]; p.ret_gnw = (const float*)d_in[17]; p.w_branch = (const float*)d_in[18]; p.w_out = (const float*)d_in[19];
    p.peer_wq = (const float*)d_in[20]; p.peer_keys = (const float*)d_in[21]; p.peer_u = (const float*)d_in[22]; p.peer_v = (const float*)d_in[23];
    p.final_w = (const float*)d_in[24];
    p.out = (float*)d_out;
    p.ws = (char*)d_ws;
    if (WS_TOTAL > ws_size) { fprintf(stderr, "workspace too small: need %zu have %zu\n", (size_t)WS_TOTAL, ws_size); return; }
    (void)hipMemsetAsync(d_ws, 0, WS_ZERO_END, stream);

    static int ncu = 0;
    if (!ncu) { int dev = 0; (void)hipGetDevice(&dev); (void)hipDeviceGetAttribute(&ncu, hipDeviceAttributeMultiprocessorCount, dev); if (ncu <= 0) ncu = 256; }
#if MK_ONE_LAUNCH
    static bool attr = false;
    if (!attr) { (void)hipFuncSetAttribute((const void*)k_mega, hipFuncAttributeMaxDynamicSharedMemorySize, LDS_BYTES); attr = true; }
    hipLaunchKernelGGL(k_mega, dim3(ncu), dim3(NTHREADS), LDS_BYTES, stream, p);
#else
    const int grid = ncu;
    launch_phase<0>(p, 0, 0, grid, stream);
    for (int l = 0; l < 2; ++l)
        for (int g = 0; g < NGROUP; ++g) {
            if (l == 0 && g == 0) launch_phase<1>(p, l, g, grid, stream);
            launch_phase<2>(p, l, g, grid, stream);
            launch_phase<3>(p, l, g, grid, stream);
            launch_phase<4>(p, l, g, grid, stream);
            launch_phase<6>(p, l, g, grid, stream);
            launch_phase<7>(p, l, g, grid, stream);
            launch_phase<8>(p, l, g, grid, stream);
            launch_phase<9>(p, l, g, grid, stream);
            launch_phase<10>(p, l, g, grid, stream);
            launch_phase<11>(p, l, g, grid, stream);
        }
#endif
}
```

```cpp
#include <hip/hip_runtime.h>
#include <stdint.h>
#include <stdio.h>

#ifndef MK_ONE_LAUNCH
#define MK_ONE_LAUNCH 1
#endif

#define DM 1024
#define NBATCH 16
#define SEQ 4096
#define CTXL 256
#define LTOK 4352
#define IN_COLS 7072
#define NPROJ 7168
#define PLD 3072
#define NB 8
#define NGROUP (NBATCH / NB)
#define TG (NB * LTOK)
#define NTHREADS 512
#define LDS_BYTES 131648
#define EPSF 1e-6f

#define C_CQ 0
#define C_CKV 256
#define C_KPE 384
#define C_GQ 416
#define C_GK 672
#define C_GV 800
#define C_NQ 928
#define C_NK 1184
#define C_NV 1440
#define C_RQ 1696
#define C_RK 1952
#define C_RV 2208
#define C_RGF 2464
#define C_RGB 2720
#define C_GATE 2976

#define LAS __attribute__((address_space(3)))
typedef unsigned short bf16_t;
typedef short bf16x8 __attribute__((ext_vector_type(8)));
typedef float f32x4 __attribute__((ext_vector_type(4)));
typedef float f32x2 __attribute__((ext_vector_type(2)));
typedef __bf16 bf16x2_t __attribute__((ext_vector_type(2)));
typedef unsigned u32x4 __attribute__((ext_vector_type(4)));
typedef unsigned u32x2 __attribute__((ext_vector_type(2)));
typedef float f32x16 __attribute__((ext_vector_type(16)));
typedef short s16x4 __attribute__((ext_vector_type(4)));

__device__ __forceinline__ unsigned pack_bf16(float lo, float hi) { f32x2 v = {lo, hi}; bf16x2_t b = __builtin_convertvector(v, bf16x2_t); return __builtin_bit_cast(unsigned, b); }
__device__ __forceinline__ bf16_t f2bf(float f) { return (bf16_t)(pack_bf16(f, 0.f) & 0xffffu); }
__device__ __forceinline__ float bf2f(bf16_t b) { return __uint_as_float(((unsigned)b) << 16); }
__device__ __forceinline__ float bflo(unsigned w) { return __uint_as_float(w << 16); }
__device__ __forceinline__ float bfhi(unsigned w) { return __uint_as_float(w & 0xffff0000u); }
#define PEER_USCALE 128.f
#define PEER_VSCALE 16.f
__device__ __forceinline__ float clamp448(float x) { return fminf(fmaxf(x, -448.f), 448.f); }
__device__ __forceinline__ unsigned pack_fp8x4(f32x4 v, float sc) {
    int w = 0;
    w = __builtin_amdgcn_cvt_pk_fp8_f32(clamp448(v[0] * sc), clamp448(v[1] * sc), w, false);
    w = __builtin_amdgcn_cvt_pk_fp8_f32(clamp448(v[2] * sc), clamp448(v[3] * sc), w, true);
    return (unsigned)w;
}

template <int M> __device__ __forceinline__ float xor_swz(float v) { return __int_as_float(__builtin_amdgcn_ds_swizzle(__float_as_int(v), (M << 10) | 0x1f)); }
template <int M> __device__ __forceinline__ unsigned xor_swz_u(unsigned v) { return (unsigned)__builtin_amdgcn_ds_swizzle((int)v, (M << 10) | 0x1f); }
__device__ __forceinline__ float sum_xor32(float v) { const u32x2 r = __builtin_amdgcn_permlane32_swap(__float_as_uint(v), __float_as_uint(v), false, false); return __uint_as_float(r.x) + __uint_as_float(r.y); }
__device__ __forceinline__ float max_xor32(float v) { const u32x2 r = __builtin_amdgcn_permlane32_swap(__float_as_uint(v), __float_as_uint(v), false, false); return fmaxf(__uint_as_float(r.x), __uint_as_float(r.y)); }
__device__ __forceinline__ unsigned get_xor32_u(unsigned v, bool upper) { const u32x2 r = __builtin_amdgcn_permlane32_swap(v, v, false, false); return upper ? r.x : r.y; }
__device__ __forceinline__ float wave_max(float v) {
    v = fmaxf(v, xor_swz<1>(v)); v = fmaxf(v, xor_swz<2>(v)); v = fmaxf(v, xor_swz<4>(v)); v = fmaxf(v, xor_swz<8>(v)); v = fmaxf(v, xor_swz<16>(v));
    return max_xor32(v);
}
__device__ __forceinline__ float wave_sum(float v) {
    v += xor_swz<1>(v); v += xor_swz<2>(v); v += xor_swz<4>(v); v += xor_swz<8>(v); v += xor_swz<16>(v);
    return sum_xor32(v);
}
extern __shared__ __attribute__((aligned(16))) char smem[];
#define WIDTAB_OFF 64
__device__ __forceinline__ unsigned hw_wave_slot() { return (unsigned)__builtin_amdgcn_s_getreg((5 << 11) | 4) & 63u; }
__device__ __forceinline__ void tid_setup() {
    if ((threadIdx.x & 63) == 0) ((volatile LAS int*)(smem + WIDTAB_OFF))[hw_wave_slot()] = (int)(threadIdx.x >> 6);
    __syncthreads();
}
__device__ __forceinline__ int get_tid() {
    int lane; asm volatile("v_mbcnt_lo_u32_b32 %0, -1, 0\n\tv_mbcnt_hi_u32_b32 %0, -1, %0" : "=v"(lane));
    int w = ((volatile LAS int*)(smem + WIDTAB_OFF))[hw_wave_slot()];
    w = __builtin_amdgcn_readfirstlane(w);
    int t = (w << 6) | lane; asm volatile("" : "+v"(t)); return t;
}
__device__ __forceinline__ float siluf(float x) { return x * __builtin_amdgcn_rcpf(1.f + __builtin_amdgcn_exp2f(x * -1.4426950408889634f)); }
__device__ __forceinline__ float sigmf(float x) { return __builtin_amdgcn_rcpf(1.f + __builtin_amdgcn_exp2f(x * -1.4426950408889634f)); }

#define XB_TMO      128
#define XB_XCNT(j)  (256  + 64 * (j))
#define XB_XSUB(j)  (1280 + 64 * (j))
#define XB_XGEN(j)  (2304 + 64 * (j))
#define XB_TOP      3328
#define XB_TOPGEN   3392
#define XCD_BAR_WORDS 3456
#define XB_SPIN_CAP (1u << 18)

__device__ __forceinline__ unsigned xb_ld(unsigned* p)              { return __hip_atomic_load(p, __ATOMIC_RELAXED, __HIP_MEMORY_SCOPE_AGENT); }
__device__ __forceinline__ unsigned xb_add(unsigned* p, unsigned v) { return __hip_atomic_fetch_add(p, v, __ATOMIC_RELAXED, __HIP_MEMORY_SCOPE_AGENT); }
__device__ __forceinline__ unsigned xb_xcc_id() { return (unsigned)__builtin_amdgcn_s_getreg((3 << 11) | 20) & 0xFu; }
#define XB_SPIN(cond, bar) do { unsigned _sp = 0; while (cond) { __builtin_amdgcn_s_sleep(1); \
    if ((++_sp & 255u) == 0u) { if (xb_ld(&(bar)[XB_TMO])) break; if (_sp > XB_SPIN_CAP) { atomicAdd(&(bar)[XB_TMO], 1u); break; } } } } while (0)

struct XcdBarrier { unsigned* bar; unsigned x; volatile LAS unsigned* st; };

__device__ __forceinline__ XcdBarrier xcd_barrier_post(unsigned* bar, volatile LAS unsigned* st) {
    XcdBarrier b; b.bar = bar; b.x = xb_xcc_id(); b.st = st;
    if (get_tid() == 0) (void)xb_add(&bar[XB_XCNT(b.x)], 1u);
    return b;
}
__device__ __forceinline__ void xcd_barrier_complete(unsigned* bar, unsigned x, unsigned& nloc, unsigned& nx) {
    const unsigned G = gridDim.x * gridDim.y * gridDim.z;
    unsigned sum, cnt, mine, sp = 0u;
    for (;;) {
        sum = 0u; cnt = 0u; mine = 0u;
#pragma unroll
        for (unsigned j = 0; j < 16; ++j) { const unsigned c = xb_ld(&bar[XB_XCNT(j)]); sum += c; cnt += (c > 0u) ? 1u : 0u; mine = (j == x) ? c : mine; }
        if (sum == G) break;
        __builtin_amdgcn_s_sleep(1);
        if ((++sp & 255u) == 0u) { if (xb_ld(&bar[XB_TMO])) break; if (sp > XB_SPIN_CAP) { atomicAdd(&bar[XB_TMO], 1u); break; } }
    }
    nloc = mine > 0u ? mine : 1u; nx = cnt > 0u ? cnt : 1u;
}
__device__ __forceinline__ void xcd_barrier(const XcdBarrier& b) {
    asm volatile("s_waitcnt vmcnt(0)" ::: "memory");
    __syncthreads();
    if (get_tid() == 0) {
        unsigned* bar = b.bar;
        __builtin_amdgcn_s_waitcnt(0);
        unsigned nloc = b.st[0], nx = b.st[1];
        if (nloc == 0u) { xcd_barrier_complete(bar, b.x, nloc, nx); b.st[0] = nloc; b.st[1] = nx; }
        const unsigned old = xb_add(&bar[XB_XSUB(b.x)], 1u);
        const unsigned gen = old / nloc;
        if (old + 1u == (gen + 1u) * nloc) {
            __builtin_amdgcn_fence(__ATOMIC_RELEASE, "agent");
            asm volatile("s_waitcnt vmcnt(0)" ::: "memory");
            const unsigned og = xb_add(&bar[XB_TOP], 1u);
            const unsigned tg = og / nx;
            if (og + 1u == (tg + 1u) * nx) xb_add(&bar[XB_TOPGEN], 1u);
            else XB_SPIN(xb_ld(&bar[XB_TOPGEN]) == tg, bar);
            __builtin_amdgcn_fence(__ATOMIC_ACQUIRE, "agent");
            xb_add(&bar[XB_XGEN(b.x)], 1u);
            asm volatile("s_waitcnt vmcnt(0)" ::: "memory");
        } else {
            XB_SPIN(xb_ld(&bar[XB_XGEN(b.x)]) == gen, bar);
            __builtin_amdgcn_fence(__ATOMIC_ACQUIRE, "agent");
            asm volatile("s_waitcnt vmcnt(0)" ::: "memory");
        }
    }
    __syncthreads();
}

struct Params {
    const float *x, *c, *ctx, *c_ctx, *mod_w, *mod_b, *norm1_w, *norm2_w, *w_in, *mla_qn, *mla_wuq, *mla_kvn, *mla_wukv,
                *gqa_qn, *gqa_kn, *na_bias, *ret_logit, *ret_gnw, *w_branch, *w_out, *peer_wq, *peer_keys, *peer_u, *peer_v, *final_w;
    float* out;
    char* ws;
};
typedef const __attribute__((address_space(4))) Params* KP;
__device__ __forceinline__ KP get_kp() { KP kp = (KP)__builtin_amdgcn_kernarg_segment_ptr(); asm volatile("" : "+s"(kp)); return kp; }

constexpr size_t al256c(size_t x) { return (x + 255) & ~(size_t)255; }
constexpr size_t WS_BAR = 0;
constexpr size_t WS_CNT = WS_BAR + al256c(XCD_BAR_WORDS * 4);
constexpr size_t WS_ZERO_END = WS_CNT + al256c(8 * 8 * 64 * 4);
constexpr size_t WS_MOD = WS_ZERO_END;
constexpr size_t WS_CTXS = WS_MOD + al256c((size_t)2 * 17 * 6144 * 4);
constexpr size_t WS_WINT = WS_CTXS + al256c((size_t)NBATCH * CTXL * DM * 4);
constexpr size_t WS_WUQT = WS_WINT + al256c((size_t)2 * NPROJ * DM * 2);
constexpr size_t WS_WUKVT = WS_WUQT + al256c((size_t)2 * 384 * 256 * 2);
constexpr size_t WS_WBT = WS_WUKVT + al256c((size_t)2 * 512 * 128 * 2);
constexpr size_t WS_WOUTT = WS_WBT + al256c((size_t)2 * 4 * DM * 256 * 2);
constexpr size_t WS_WQT = WS_WOUTT + al256c((size_t)2 * DM * DM * 2);
constexpr size_t WS_H = WS_WQT + al256c((size_t)2 * DM * DM * 2);
constexpr size_t WS_PROJ = WS_H + al256c((size_t)NGROUP * TG * DM * 2);
#define HG(p_, g_) (((bf16_t*)((p_)->ws + WS_H)) + (size_t)(g_) * TG * DM)
constexpr size_t WS_GATE8 = WS_PROJ + al256c((size_t)TG * PLD * 2);
constexpr size_t WS_QRAW = WS_GATE8 + al256c((size_t)TG * 4096);
constexpr size_t WS_KVRAW = WS_QRAW + al256c((size_t)TG * 384 * 2);
constexpr size_t WS_QA = WS_KVRAW + al256c((size_t)TG * 512 * 2);
constexpr size_t WS_KA = WS_QA + al256c((size_t)TG * 384 * 2);
constexpr size_t WS_VA = WS_KA + al256c((size_t)TG * 384 * 2);
constexpr size_t WS_GQ = WS_VA + al256c((size_t)TG * 256 * 2);
constexpr size_t WS_GK = WS_GQ + al256c((size_t)TG * 256 * 2);
constexpr size_t WS_OUTS = WS_GK + al256c((size_t)TG * 128 * 2);
constexpr size_t WS_ACC = WS_QRAW;
constexpr size_t WS_PQ = WS_OUTS;
constexpr size_t WS_RKV = WS_OUTS + al256c((size_t)4 * TG * 256 * 2);
constexpr size_t WS_UB = WS_RKV + al256c((size_t)NB * 4 * 2 * 34 * 4096 * 4);
constexpr size_t WS_VB = WS_UB + al256c((size_t)2 * 16384 * DM);
constexpr size_t WS_KEYB = WS_VB + al256c((size_t)2 * 16384 * DM);
constexpr size_t WS_USC = WS_UB + (size_t)2 * 16384 * (DM / 2);
constexpr size_t WS_VSC = WS_VB + (size_t)2 * 16384 * (DM / 2);
constexpr size_t WS_URS = WS_USC + (size_t)2 * 16384 * 4;
constexpr size_t WS_TOTAL = WS_KEYB + al256c((size_t)2 * 8 * 2 * 128 * 64 * 2);

#define G_BM 256
#define G_BN 128
#define G_BK 64
#define G_LDP 144
#define G_ABYTES (G_BM * G_LDP)
#define G_BBYTES (G_BN * G_LDP)
#define G_STAGE (G_ABYTES + G_BBYTES)

template <int MI>
__device__ __forceinline__ void gemm_tile(const bf16_t* __restrict__ A, int lda, const bf16_t* __restrict__ Bt, int ldb, int K,
                                          f32x4 (&acc)[MI][4], char* lds)
{
    constexpr int NA = MI;
    const int tid = get_tid(), lane = tid & 63, wid = tid >> 6, wm = wid >> 1, wn = wid & 1, fr = lane & 15, fq = lane >> 4;
    const int nk = K / G_BK;
    u32x4 ra[NA], rb[2];
    const int arow = tid >> 3, akc = tid & 7;
    const bf16_t* ag = A + (size_t)arow * lda + akc * 8;
    const bf16_t* bg = Bt + (size_t)arow * ldb + akc * 8;
    const int a_l = arow * G_LDP + akc * 16;
#pragma unroll
    for (int i = 0; i < NA; ++i) ra[i] = *(const u32x4*)(ag + (size_t)(64 * i) * lda);
#pragma unroll
    for (int i = 0; i < 2; ++i) rb[i] = *(const u32x4*)(bg + (size_t)(64 * i) * ldb);
    __syncthreads();
#pragma unroll
    for (int i = 0; i < NA; ++i) *(u32x4*)(lds + a_l + i * 64 * G_LDP) = ra[i];
#pragma unroll
    for (int i = 0; i < 2; ++i) *(u32x4*)(lds + G_ABYTES + a_l + i * 64 * G_LDP) = rb[i];
    __syncthreads();
    const int aoff = (wm * 16 * MI + fr) * G_LDP + fq * 16;
    const int boff = G_ABYTES + (wn * 64 + fr) * G_LDP + fq * 16;
    for (int kt = 0; kt < nk; ++kt) {
        const int cur = (kt & 1) * G_STAGE, nxt = ((kt + 1) & 1) * G_STAGE;
        const bool more = (kt + 1 < nk);
        if (more) {
#pragma unroll
            for (int i = 0; i < NA; ++i) ra[i] = *(const u32x4*)(ag + (size_t)(64 * i) * lda + (kt + 1) * G_BK);
#pragma unroll
            for (int i = 0; i < 2; ++i) rb[i] = *(const u32x4*)(bg + (size_t)(64 * i) * ldb + (kt + 1) * G_BK);
        }
#pragma unroll
        for (int ks = 0; ks < 2; ++ks) {
            bf16x8 af[MI], bfr[4];
#pragma unroll
            for (int mi = 0; mi < MI; ++mi) af[mi] = *(const bf16x8*)(lds + cur + aoff + mi * 16 * G_LDP + ks * 64);
#pragma unroll
            for (int ni = 0; ni < 4; ++ni) bfr[ni] = *(const bf16x8*)(lds + cur + boff + ni * 16 * G_LDP + ks * 64);
#pragma unroll
            for (int mi = 0; mi < MI; ++mi)
#pragma unroll
                for (int ni = 0; ni < 4; ++ni) acc[mi][ni] = __builtin_amdgcn_mfma_f32_16x16x32_bf16(bfr[ni], af[mi], acc[mi][ni], 0, 0, 0);
        }
        if (more) {
#pragma unroll
            for (int i = 0; i < NA; ++i) *(u32x4*)(lds + nxt + a_l + i * 64 * G_LDP) = ra[i];
#pragma unroll
            for (int i = 0; i < 2; ++i) *(u32x4*)(lds + nxt + G_ABYTES + a_l + i * 64 * G_LDP) = rb[i];
        }
        __syncthreads();
    }
}

template <int MI>
__device__ __forceinline__ void zero_acc(f32x4 (&acc)[MI][4]) {
#pragma unroll
    for (int i = 0; i < MI; ++i)
#pragma unroll
        for (int j = 0; j < 4; ++j) acc[i][j] = (f32x4){0.f, 0.f, 0.f, 0.f};
}

template <class Epi>
__device__ __forceinline__ void gemm_phase(const bf16_t* A, int lda, const bf16_t* Bt, int ldb, int M, int N, int K, const Epi& epi, char* lds, int bid, int nblk)
{
    const int tid = get_tid(), lane = tid & 63, wid = tid >> 6, wm = wid >> 1, wn = wid & 1, fr = lane & 15, fq = lane >> 4;
    const int tn = N / G_BN, total = (M / G_BM) * tn;
    for (int t = bid; t < total; t += nblk) {
        const int pm = t / tn, pn = t % tn;
        f32x4 acc[4][4]; zero_acc(acc);
        gemm_tile<4>(A + (size_t)pm * G_BM * lda, lda, Bt + (size_t)pn * G_BN * ldb, ldb, K, acc, lds);
#pragma unroll
        for (int mi = 0; mi < 4; ++mi)
#pragma unroll
            for (int ni = 0; ni < 4; ++ni) epi(pm * G_BM + wm * 64 + mi * 16 + fr, pn * G_BN + wn * 64 + ni * 16 + fq * 4, acc[mi][ni]);
    }
}

__device__ __forceinline__ void store_bf16x4(bf16_t* p, f32x4 v) { u32x2 w; w.x = pack_bf16(v[0], v[1]); w.y = pack_bf16(v[2], v[3]); *(u32x2*)p = w; }


namespace pg8 {
#define PG8_LAS __attribute__((address_space(3)))
typedef unsigned short bf16_t;
typedef short bf16x8 __attribute__((ext_vector_type(8)));
typedef float f32x4 __attribute__((ext_vector_type(4)));
typedef unsigned u32x4 __attribute__((ext_vector_type(4)));
constexpr int BM = 256, BK = 64, HALF = 128, HTB = HALF * BK * 2  , STAGE_BYTES = 8 * HTB, NXCD = 8, WGM = 8;

__host__ __device__ __forceinline__ int lds_byte(int r, int c) { const int st = (r >> 4) * 2 + (c >> 5), rr = r & 15, cc = c & 31, ob = rr * 64 + cc * 2; return st * 1024 + (ob ^ (((ob >> 9) & 1) << 5)); }
__host__ __device__ __forceinline__ void stage_rc(int b, int& R, int& C) { const int st = b / 1024, sb = b % 1024, swz = sb ^ (((sb >> 9) & 1) << 5); R = (st >> 1) * 16 + swz / 64; C = (st & 1) * 32 + (swz % 64) / 2; }
__host__ __device__ __forceinline__ int perm32(int rho) { const int n = rho >> 4, i = rho & 15; return 8 * (i >> 2) + 4 * n + (i & 3); }

struct Unit { int pm, pn; };
struct Gemm { const bf16_t* A; const bf16_t* Bt; int M, N, K; };

struct StaticOrder {
    int nM, nN, nwg, G, c;
    __host__ __device__ void init(int M, int N, int G_, int c_) { nM = M / BM; nN = N / BM; nwg = nM * nN; G = G_; c = c_; }
    __host__ __device__ bool next(int i, Unit& u) const {
        const long L = (long)i * G + c; if (L >= nwg) return false;
        int wgid = (int)L; { const int q = nwg / NXCD, r = nwg % NXCD, xcd = wgid % NXCD, off = wgid / NXCD; wgid = (xcd < r ? xcd * (q + 1) : r * (q + 1) + (xcd - r) * q) + off; }
        const int nig = WGM * nN, gid = wgid / nig, fm = gid * WGM, gsz = (nM - fm) < WGM ? (nM - fm) : WGM;
        u.pm = fm + ((wgid % nig) % gsz); u.pn = (wgid % nig) / gsz; return true;
    }
    __device__ __forceinline__ void a_ready(const Unit&) const {}
    __device__ __forceinline__ void done(const Unit&) const {}
};
template <class Epi, class Sched, bool ALIGN_EPI = false, bool SP2 = false>
__device__ __forceinline__ void gemm_phase(PG8_LAS unsigned char* lds, const Gemm g, const Sched& S, const Epi& E) {
    const int tid = get_tid(), wid = __builtin_amdgcn_readfirstlane(tid >> 6), lane = tid & 63, wr = wid >> 2, wc = wid & 3, fr = lane & 15, fq = lane >> 4;
    const int K = g.K, nt = K / BK;
    unsigned voffA[2], voffB[2];
#pragma unroll
    for (int i = 0; i < 2; ++i) { int R, C; stage_rc(tid * 16 + i * 8192, R, C); const int Rb = Epi::PERM ? ((R & ~31) + perm32(R & 31)) : R;
        voffA[i] = (unsigned)(R * K + C) * 2u; voffB[i] = (unsigned)(Rb * K + C) * 2u; }
    const size_t kstep = (size_t)(BK * 2);
    const size_t hstep = (size_t)HALF * K * 2;
    const size_t tstep = 2 * hstep;
    const unsigned ldsw = (unsigned)wid * 1024u;
    const int aoff = lds_byte(wr * 64 + fr, fq * 8), boff = lds_byte(wc * 32 + fr, fq * 8);
#define PG8_SA(b, h) (((b) * 2 + (h)) * HTB)
#define PG8_SB(b, h) ((4 + (b) * 2 + (h)) * HTB)
#define PG8_STAGE(bufoff, gbase, voff) do { _Pragma("unroll") for (int _i = 0; _i < 2; ++_i) \
        __builtin_amdgcn_global_load_lds((const unsigned*)((const char*)(gbase) + (voff)[_i]), (PG8_LAS unsigned*)(lds + (bufoff) + ldsw + _i * 8192), 16, 0, 0); } while (0)
#define PG8_LDA(dst, b, h) do { _Pragma("unroll") for (int m = 0; m < 4; ++m) _Pragma("unroll") for (int k = 0; k < 2; ++k) dst[m][k] = *(const PG8_LAS bf16x8*)(lds + PG8_SA(b, h) + aoff + m * 2048 + k * 1024); } while (0)
#define PG8_LDB(dst, b, h) do { _Pragma("unroll") for (int n = 0; n < 2; ++n) _Pragma("unroll") for (int k = 0; k < 2; ++k) dst[n][k] = *(const PG8_LAS bf16x8*)(lds + PG8_SB(b, h) + boff + n * 2048 + k * 1024); } while (0)
#define PG8_MMA(ai, bj, At, Bt) do { __builtin_amdgcn_s_setprio(1); _Pragma("unroll") for (int m = 0; m < 4; ++m) _Pragma("unroll") for (int n = 0; n < 2; ++n) _Pragma("unroll") for (int k = 0; k < 2; ++k) \
        acc[ai][bj][m][n] = __builtin_amdgcn_mfma_f32_16x16x32_bf16(Bt[n][k], At[m][k], acc[ai][bj][m][n], 0, 0, 0); __builtin_amdgcn_s_setprio(0); } while (0)
#define PG8_WAIT_V(n) asm volatile("s_waitcnt vmcnt(" #n ")" ::: "memory")
#define PG8_WAIT_L(n) asm volatile("s_waitcnt lgkmcnt(" #n ")" ::: "memory")
#define PG8_BAR __builtin_amdgcn_s_barrier()
#define PG8_SCHED __builtin_amdgcn_sched_barrier(0)
    Unit cur, nxt; int ui = 0;
    if (!S.next(0, cur)) return;
    f32x4 acc[2][2][4][2];
#pragma unroll
    for (int a = 0; a < 2; ++a)
#pragma unroll
        for (int b = 0; b < 2; ++b)
#pragma unroll
            for (int m = 0; m < 4; ++m)
#pragma unroll
                for (int n = 0; n < 2; ++n) acc[a][b][m][n] = (f32x4){0.f, 0.f, 0.f, 0.f};
    bf16x8 At[4][2], B0[2][2], B1[2][2];
    const char* cA = (const char*)g.A + (size_t)cur.pm * tstep; const char* cB = (const char*)g.Bt + (size_t)cur.pn * tstep;
    S.a_ready(cur);
    if constexpr (SP2) {
        PG8_STAGE(PG8_SB(0, 0), cB, voffB); PG8_STAGE(PG8_SB(0, 1), cB + hstep, voffB); PG8_STAGE(PG8_SA(0, 0), cA, voffA); PG8_STAGE(PG8_SA(0, 1), cA + hstep, voffA);
        if (wr == 1) PG8_BAR;
        PG8_WAIT_V(2); PG8_BAR;
        PG8_STAGE(PG8_SB(1, 0), cB + kstep, voffB); PG8_STAGE(PG8_SA(1, 0), cA + kstep, voffA); PG8_STAGE(PG8_SB(1, 1), cB + hstep + kstep, voffB);
        PG8_WAIT_V(6); PG8_BAR;
    } else {
        PG8_STAGE(PG8_SB(0, 0), cB, voffB); PG8_STAGE(PG8_SA(0, 0), cA, voffA); PG8_STAGE(PG8_SB(0, 1), cB + hstep, voffB); PG8_STAGE(PG8_SA(0, 1), cA + hstep, voffA);
        if (wr == 1) PG8_BAR;
        PG8_WAIT_V(4); PG8_BAR;
        PG8_STAGE(PG8_SB(1, 0), cB + kstep, voffB); PG8_STAGE(PG8_SA(1, 0), cA + kstep, voffA); PG8_STAGE(PG8_SB(1, 1), cB + hstep + kstep, voffB);
        PG8_WAIT_V(6); PG8_BAR;
    }
    for (;;) {
        const bool has_next = S.next(ui + 1, nxt);
        const char* nA = has_next ? (const char*)g.A + (size_t)nxt.pm * tstep : cA; const char* nB = has_next ? (const char*)g.Bt + (size_t)nxt.pn * tstep : cB;
        for (int t = 0; t < nt; t += 2) {
            const bool last = (t == nt - 2);
            const char* a1 = cA + (size_t)(t + 1) * kstep;
            const char* a2 = last ? nA : cA + (size_t)(t + 2) * kstep; const char* b2 = last ? nB : cB + (size_t)(t + 2) * kstep;
            const char* a3 = a2 + kstep; const char* b3 = b2 + kstep;
            if (last && has_next) S.a_ready(nxt);
            if constexpr (SP2) {
            PG8_LDB(B0, 0, 0); PG8_LDB(B1, 0, 1); PG8_SCHED; PG8_LDA(At, 0, 0); PG8_STAGE(PG8_SA(1, 1), a1 + hstep, voffA);
            PG8_WAIT_V(8); PG8_WAIT_L(0); PG8_BAR; PG8_MMA(0, 0, At, B0); PG8_MMA(0, 1, At, B1); PG8_BAR; PG8_SCHED;
            PG8_LDA(At, 0, 1); PG8_STAGE(PG8_SB(0, 0), b2, voffB); PG8_STAGE(PG8_SB(0, 1), b2 + hstep, voffB); PG8_STAGE(PG8_SA(0, 0), a2, voffA);
            PG8_WAIT_V(8); PG8_WAIT_L(0); PG8_BAR; PG8_MMA(1, 0, At, B0); PG8_MMA(1, 1, At, B1); PG8_BAR; PG8_SCHED;
            PG8_LDB(B0, 1, 0); PG8_LDB(B1, 1, 1); PG8_SCHED; PG8_LDA(At, 1, 0); PG8_STAGE(PG8_SA(0, 1), a2 + hstep, voffA);
            PG8_WAIT_V(8); PG8_WAIT_L(0); PG8_BAR; PG8_MMA(0, 0, At, B0); PG8_MMA(0, 1, At, B1); PG8_BAR; PG8_SCHED;
            PG8_LDA(At, 1, 1); PG8_STAGE(PG8_SB(1, 0), b3, voffB); PG8_STAGE(PG8_SB(1, 1), b3 + hstep, voffB); PG8_STAGE(PG8_SA(1, 0), a3, voffA);
            PG8_WAIT_V(8); PG8_WAIT_L(0); PG8_BAR; PG8_MMA(1, 0, At, B0); PG8_MMA(1, 1, At, B1); PG8_BAR; PG8_SCHED;
            } else {
            PG8_LDB(B0, 0, 0); PG8_SCHED; PG8_LDA(At, 0, 0); PG8_STAGE(PG8_SA(1, 1), a1 + hstep, voffA);
            PG8_WAIT_L(8); PG8_BAR; PG8_WAIT_L(0); PG8_MMA(0, 0, At, B0); PG8_BAR; PG8_SCHED;
            PG8_LDB(B1, 0, 1); PG8_STAGE(PG8_SB(0, 0), b2, voffB);
            PG8_BAR; PG8_WAIT_L(0); PG8_MMA(0, 1, At, B1); PG8_BAR;
            PG8_LDA(At, 0, 1); PG8_STAGE(PG8_SA(0, 0), a2, voffA);
            PG8_BAR; PG8_WAIT_L(0); PG8_MMA(1, 0, At, B0); PG8_BAR; PG8_SCHED;
            PG8_STAGE(PG8_SB(0, 1), b2 + hstep, voffB);
            PG8_WAIT_V(6); PG8_BAR; PG8_MMA(1, 1, At, B1); PG8_BAR;
            PG8_LDB(B0, 1, 0); PG8_SCHED; PG8_LDA(At, 1, 0); PG8_STAGE(PG8_SA(0, 1), a2 + hstep, voffA);
            PG8_WAIT_L(8); PG8_BAR; PG8_WAIT_L(0); PG8_MMA(0, 0, At, B0); PG8_BAR; PG8_SCHED;
            PG8_LDB(B1, 1, 1); PG8_STAGE(PG8_SB(1, 0), b3, voffB);
            PG8_BAR; PG8_WAIT_L(0); PG8_MMA(0, 1, At, B1); PG8_BAR;
            PG8_LDA(At, 1, 1); PG8_STAGE(PG8_SA(1, 0), a3, voffA);
            PG8_BAR; PG8_WAIT_L(0); PG8_MMA(1, 0, At, B0); PG8_BAR; PG8_SCHED;
            PG8_STAGE(PG8_SB(1, 1), b3 + hstep, voffB);
            PG8_WAIT_V(6); PG8_BAR; PG8_MMA(1, 1, At, B1); PG8_BAR;
            }
        }
        if constexpr (ALIGN_EPI) { if (wr == 0) PG8_BAR; }
        if constexpr (!Epi::AFTER_DRAIN) { E(acc, cur, wr, wc, fr, fq); S.done(cur); }
        if (!has_next) break;
#pragma unroll
        for (int a = 0; a < 2; ++a)
#pragma unroll
            for (int b = 0; b < 2; ++b)
#pragma unroll
                for (int m = 0; m < 4; ++m)
#pragma unroll
                    for (int n = 0; n < 2; ++n) acc[a][b][m][n] = (f32x4){0.f, 0.f, 0.f, 0.f};
        cur = nxt; cA = nA; cB = nB; ++ui;
        if constexpr (ALIGN_EPI) { if (wr == 1) PG8_BAR; }
    }
    PG8_WAIT_V(0);
    if constexpr (!ALIGN_EPI) { if (wr == 0) PG8_BAR; }
    PG8_BAR;
    if constexpr (Epi::AFTER_DRAIN) { E.fused(acc, cur, wr, wc, fr, fq, lds, wid, lane); S.done(cur); }
#undef PG8_SA
#undef PG8_SB
#undef PG8_STAGE
#undef PG8_LDA
#undef PG8_LDB
#undef PG8_MMA
#undef PG8_WAIT_V
#undef PG8_WAIT_L
#undef PG8_BAR
#undef PG8_SCHED
}
}

template <class F> struct Epi4 {
    static constexpr bool PERM = false, AFTER_DRAIN = false; F f;
    __device__ __forceinline__ void operator()(const f32x4 (&acc)[2][2][4][2], const pg8::Unit& u, int wr, int wc, int fr, int fq) const {
#pragma unroll
        for (int ai = 0; ai < 2; ++ai)
#pragma unroll
            for (int m = 0; m < 4; ++m)
#pragma unroll
                for (int bj = 0; bj < 2; ++bj)
#pragma unroll
                    for (int n = 0; n < 2; ++n) f(u.pm * 256 + ai * 128 + wr * 64 + m * 16 + fr, u.pn * 256 + bj * 128 + wc * 32 + n * 16 + fq * 4, acc[ai][bj][m][n]);
    }
};
template <class F> struct Epi8 {
    static constexpr bool PERM = true, AFTER_DRAIN = false; F f;
    __device__ __forceinline__ void operator()(const f32x4 (&acc)[2][2][4][2], const pg8::Unit& u, int wr, int wc, int fr, int fq) const {
#pragma unroll
        for (int ai = 0; ai < 2; ++ai)
#pragma unroll
            for (int m = 0; m < 4; ++m)
#pragma unroll
                for (int bj = 0; bj < 2; ++bj) f(u.pm * 256 + ai * 128 + wr * 64 + m * 16 + fr, u.pn * 256 + bj * 128 + wc * 32 + fq * 8, acc[ai][bj][m][0], acc[ai][bj][m][1]);
    }
};
template <class E>
__device__ __forceinline__ void big_gemm(const bf16_t* A, const bf16_t* Bt, int M, int N, int K, const E& e, char* lds, int bid, int nblk) {
    pg8::StaticOrder so; so.init(M, N, nblk, bid);
    pg8::gemm_phase<E, pg8::StaticOrder, true, true>((PG8_LAS unsigned char*)lds, pg8::Gemm{A, Bt, M, N, K}, so, e);
}

__device__ __forceinline__ void transpose_cvt(const float* __restrict__ src, int K, int N, int Npad, bf16_t* __restrict__ dst, const float* __restrict__ kscale, float* lds, int bid, int nblk)
{
    const int tid = get_tid();
    const int tk = K / 64, tn = Npad / 64, total = tk * tn;
    const int lk = tid >> 3, ln = (tid & 7) * 8;
    const int sn = tid >> 3, sk = (tid & 7) * 8;
    for (int t = bid; t < total; t += nblk) {
        const int k0 = (t / tn) * 64, n0 = (t % tn) * 64;
        f32x4 a = (f32x4){0.f, 0.f, 0.f, 0.f}, c = a;
        if (n0 + ln < N) { const float* sp = src + (size_t)(k0 + lk) * N + n0 + ln; a = *(const f32x4*)sp; c = *(const f32x4*)(sp + 4); if (kscale) { const float ks = kscale[k0 + lk]; a *= ks; c *= ks; } }
        __syncthreads();
#pragma unroll
        for (int j = 0; j < 4; ++j) { lds[lk * 65 + ln + j] = a[j]; lds[lk * 65 + ln + 4 + j] = c[j]; }
        __syncthreads();
        u32x4 w;
        w.x = pack_bf16(lds[(sk + 0) * 65 + sn], lds[(sk + 1) * 65 + sn]); w.y = pack_bf16(lds[(sk + 2) * 65 + sn], lds[(sk + 3) * 65 + sn]);
        w.z = pack_bf16(lds[(sk + 4) * 65 + sn], lds[(sk + 5) * 65 + sn]); w.w = pack_bf16(lds[(sk + 6) * 65 + sn], lds[(sk + 7) * 65 + sn]);
        *(u32x4*)(dst + (size_t)(n0 + sn) * K + k0 + sk) = w;
    }
}

__device__ __forceinline__ void phase_prologue(KP p, char* ldsc, int bid, int nblk)
{
    float* lds = (float*)ldsc;
    const int tid = get_tid();
    for (int l = 0; l < 2; ++l) {
        transpose_cvt(p->w_in + (size_t)l * DM * IN_COLS, DM, IN_COLS, NPROJ, ((bf16_t*)(p->ws + WS_WINT)) + (size_t)l * NPROJ * DM, nullptr, lds, bid, nblk);
        transpose_cvt(p->mla_wuq + (size_t)l * 256 * 384, 256, 384, 384, ((bf16_t*)(p->ws + WS_WUQT)) + (size_t)l * 384 * 256, p->mla_qn + l * 256, lds, bid, nblk);
        transpose_cvt(p->mla_wukv + (size_t)l * 128 * 512, 128, 512, 512, ((bf16_t*)(p->ws + WS_WUKVT)) + (size_t)l * 512 * 128, p->mla_kvn + l * 128, lds, bid, nblk);
        for (int i = 0; i < 4; ++i)
            transpose_cvt(p->w_branch + (size_t)(l * 4 + i) * 256 * DM, 256, DM, DM, ((bf16_t*)(p->ws + WS_WBT)) + (size_t)(l * 4 + i) * DM * 256, nullptr, lds, bid, nblk);
        transpose_cvt(p->w_out + (size_t)l * DM * DM, DM, DM, DM, ((bf16_t*)(p->ws + WS_WOUTT)) + (size_t)l * DM * DM, nullptr, lds, bid, nblk);
        transpose_cvt(p->peer_wq + (size_t)l * DM * DM, DM, DM, DM, ((bf16_t*)(p->ws + WS_WQT)) + (size_t)l * DM * DM, nullptr, lds, bid, nblk);
    }
    {
        float* sil = lds;
        float* red = lds + 17 * 1024;
        __syncthreads();
        for (int e = tid; e < 17 * 1024; e += NTHREADS) { const int r = e >> 10, k = e & 1023; const float v = (r < 16) ? p->c[r * 1024 + k] : p->c_ctx[k]; sil[e] = siluf(v); }
        __syncthreads();
        for (int u = bid; u < 2 * 96; u += nblk) {
            const int l = u / 96, j0 = (u % 96) * 64, kg = tid >> 6, j = tid & 63;
            float a[17];
#pragma unroll
            for (int r = 0; r < 17; ++r) a[r] = 0.f;
            const float* w = p->mod_w + (size_t)l * DM * 6144 + j0 + j;
#pragma unroll 1
            for (int k0 = kg * 128; k0 < kg * 128 + 128; k0 += 16) {
                float wv[16];
#pragma unroll
                for (int kk = 0; kk < 16; ++kk) wv[kk] = w[(size_t)(k0 + kk) * 6144];
#pragma unroll
                for (int kk = 0; kk < 16; ++kk)
#pragma unroll
                    for (int r = 0; r < 17; ++r) a[r] += sil[r * 1024 + k0 + kk] * wv[kk];
            }
#pragma unroll
            for (int r = 0; r < 17; ++r) red[(kg * 17 + r) * 64 + j] = a[r];
            __syncthreads();
            for (int e = tid; e < 17 * 64; e += NTHREADS) {
                const int r = e >> 6, jj = e & 63; float s = 0.f;
                for (int q = 0; q < 8; ++q) s += red[(q * 17 + r) * 64 + jj];
                ((float*)(p->ws + WS_MOD))[((size_t)l * 17 + r) * 6144 + j0 + jj] = s + p->mod_b[l * 6144 + j0 + jj];
            }
            __syncthreads();
        }
    }
    {
        const size_t n16 = (size_t)2 * 16384 * DM / 16;
        for (size_t i = (size_t)bid * NTHREADS + tid; i < n16; i += (size_t)nblk * NTHREADS) {
            f32x4 a[4], c[4];
#pragma unroll
            for (int q = 0; q < 4; ++q) { a[q] = ((const f32x4*)p->peer_u)[4 * i + q]; c[q] = ((const f32x4*)p->peer_v)[4 * i + q]; }
            float mu = 0.f, mv = 0.f;
#pragma unroll
            for (int q = 0; q < 4; ++q)
#pragma unroll
                for (int j = 0; j < 4; ++j) { mu = fmaxf(mu, fabsf(a[q][j])); mv = fmaxf(mv, fabsf(c[q][j])); }
            mu = wave_max(mu); mv = wave_max(mv);
            const float su = mu > 0.f ? mu * (0.8f / 7.f) : 1.f, sv = mv > 0.f ? mv * (1.f / 6.f) : 1.f, iu = 1.f / su, iv = 1.f / sv;
            u32x2 wu = (u32x2){0u, 0u}, wv = (u32x2){0u, 0u};
            float rsum = 0.f;
#pragma unroll
            for (int q = 0; q < 4; ++q) {
                unsigned tu = wu[q >> 1], tv = wv[q >> 1];
#pragma unroll
                for (int j = 0; j < 4; ++j) { const float qv = fminf(fmaxf(__builtin_rintf(a[q][j] * iu), -8.f), 7.f); rsum += qv; tu |= ((unsigned)(int)qv & 15u) << (4 * ((4 * q + j) & 7)); }
                if ((q & 1) == 0) {
                    tv = __builtin_amdgcn_cvt_scalef32_pk_fp4_f32(tv, c[q][0] * iv, c[q][1] * iv, 1.0f, 0); tv = __builtin_amdgcn_cvt_scalef32_pk_fp4_f32(tv, c[q][2] * iv, c[q][3] * iv, 1.0f, 1);
                } else {
                    tv = __builtin_amdgcn_cvt_scalef32_pk_fp4_f32(tv, c[q][0] * iv, c[q][1] * iv, 1.0f, 2); tv = __builtin_amdgcn_cvt_scalef32_pk_fp4_f32(tv, c[q][2] * iv, c[q][3] * iv, 1.0f, 3);
                }
                wu[q >> 1] = tu; wv[q >> 1] = tv;
            }
            rsum = wave_sum(rsum);
            ((u32x2*)(p->ws + WS_UB))[i] = wu; ((u32x2*)(p->ws + WS_VB))[i] = wv;
            if ((tid & 63) == 0) { ((float*)(p->ws + WS_USC))[i >> 6] = su; ((float*)(p->ws + WS_VSC))[i >> 6] = sv; ((float*)(p->ws + WS_URS))[i >> 6] = 8.f * rsum; }
        }
        const size_t k8 = (size_t)2 * 8 * 2 * 128 * 64 / 8;
        for (size_t i = (size_t)bid * NTHREADS + tid; i < k8; i += (size_t)nblk * NTHREADS) {
            const f32x4 a = ((const f32x4*)p->peer_keys)[2 * i], b = ((const f32x4*)p->peer_keys)[2 * i + 1];
            u32x4 w; w.x = pack_bf16(a[0], a[1]); w.y = pack_bf16(a[2], a[3]); w.z = pack_bf16(b[0], b[1]); w.w = pack_bf16(b[2], b[3]);
            ((u32x4*)(p->ws + WS_KEYB))[i] = w;
        }
    }
}

__device__ __forceinline__ const float* state_row(KP p, int g, int r, int& modrow, bool from_input) {
    const int bl = r / LTOK, t = r - bl * LTOK, b = g * NB + bl;
    if (t < CTXL) { modrow = 16; return (from_input ? p->ctx : (const float*)(p->ws + WS_CTXS)) + ((size_t)b * CTXL + t) * DM; }
    modrow = b; return (from_input ? p->x : (const float*)p->out) + ((size_t)b * SEQ + (t - CTXL)) * DM;
}

__device__ __forceinline__ void phase_norm(KP p, int l, int g, int which, int bid, int nblk)
{
    const int lane = get_tid() & 63, wid = get_tid() >> 6;
    const float* nw = (which ? p->norm2_w : p->norm1_w) + l * DM;
    const int shoff = which ? 3072 : 0, scoff = which ? 4096 : 1024;
    for (int r = bid * 8 + wid; r < TG; r += nblk * 8) {
        int mr; const float* src = state_row(p, g, r, mr, l == 0 && which == 0);
        const float* md = ((float*)(p->ws + WS_MOD)) + ((size_t)l * 17 + mr) * 6144;
        f32x4 v[4]; float ss = 0.f;
#pragma unroll
        for (int i = 0; i < 4; ++i) { v[i] = *(const f32x4*)(src + i * 256 + lane * 4); ss += v[i][0] * v[i][0] + v[i][1] * v[i][1] + v[i][2] * v[i][2] + v[i][3] * v[i][3]; }
        ss = wave_sum(ss);
        const float rstd = rsqrtf(ss * (1.f / DM) + EPSF);
#pragma unroll
        for (int i = 0; i < 4; ++i) {
            const int c = i * 256 + lane * 4;
            const f32x4 w = *(const f32x4*)(nw + c), sc = *(const f32x4*)(md + scoff + c), sh = *(const f32x4*)(md + shoff + c);
            f32x4 y;
#pragma unroll
            for (int j = 0; j < 4; ++j) y[j] = v[i][j] * rstd * w[j] * (1.f + sc[j]) + sh[j];
            store_bf16x4(HG(p, g) + (size_t)r * DM + c, y);
        }
    }
}

struct EpiProj8 {
    bf16_t* O; unsigned char* G8;
    __device__ __forceinline__ void operator()(int row, int col, f32x4 a, f32x4 b) const {
        if (col >= C_GATE) {
            const int gi = col - C_GATE; if (gi >= 4096) return;
            unsigned w0 = 0u, w1 = 0u;
#pragma unroll
            for (int j = 0; j < 4; ++j) {
                w0 |= (unsigned)__builtin_amdgcn_cvt_pk_u8_f32(sigmf(a[j]) * 255.f, j, 0);
                w1 |= (unsigned)__builtin_amdgcn_cvt_pk_u8_f32(sigmf(b[j]) * 255.f, j, 0);
            }
            const int gp_ = (gi & ~63) | (((gi >> 2) & 3) << 4) | (((gi >> 4) & 3) << 2);
            *(unsigned*)(G8 + (size_t)row * 4096 + gp_) = w0; *(unsigned*)(G8 + (size_t)row * 4096 + gp_ + 16) = w1;
            return;
        }
        if (col >= C_NQ && col < C_NK) { a *= (0.125f * 1.4426950408889634f); b *= (0.125f * 1.4426950408889634f); }
        u32x4 w; w.x = pack_bf16(a[0], a[1]); w.y = pack_bf16(a[2], a[3]); w.z = pack_bf16(b[0], b[1]); w.w = pack_bf16(b[2], b[3]);
        *(u32x4*)(O + (size_t)row * PLD + col) = w;
    }
};
struct EpiStore8 { bf16_t* O; int ld;
    __device__ __forceinline__ void operator()(int row, int col, f32x4 a, f32x4 b) const {
        u32x4 w; w.x = pack_bf16(a[0], a[1]); w.y = pack_bf16(a[2], a[3]); w.z = pack_bf16(b[0], b[1]); w.w = pack_bf16(b[2], b[3]);
        *(u32x4*)(O + (size_t)row * ld + col) = w; } };
struct EpiStore { bf16_t* O; int ld; __device__ __forceinline__ void operator()(int row, int col, f32x4 v) const { store_bf16x4(O + (size_t)row * ld + col, v); } };

__device__ __forceinline__ float log_sigmoidf(float x) { return fminf(x, 0.f) - log1pf(__expf(-fabsf(x))); }

__device__ __forceinline__ int ret_jb(int rb) { return rb == 0 ? 1 : (rb == 1 ? 0 : 35 - rb); }

__device__ __forceinline__ bf16x8 tr_frag_nat(const char* img, int PT, int k0, int col0, int lane) {
    const int i16 = lane & 15, blk = (lane >> 4) & 1, h5 = lane >> 5, q4 = i16 >> 2, p4 = i16 & 3;
    const char* a = img + (k0 + 8 * h5 + q4) * PT + (col0 + 16 * blk) * 2 + 8 * p4;
    const s16x4 lo = __builtin_amdgcn_ds_read_tr16_b64_v4i16((LAS s16x4*)a), hi = __builtin_amdgcn_ds_read_tr16_b64_v4i16((LAS s16x4*)(a + 4 * PT));
    return __builtin_shufflevector(lo, hi, 0, 1, 2, 3, 4, 5, 6, 7);
}
__device__ __forceinline__ bf16x8 tr_frag_acc(const char* img, int PT, int k0, int col0, int lane) {
    const int i16 = lane & 15, blk = (lane >> 4) & 1, h5 = lane >> 5, q4 = i16 >> 2, p4 = i16 & 3;
    const char* a = img + (k0 + 4 * h5 + q4) * PT + (col0 + 16 * blk) * 2 + 8 * p4;
    const s16x4 lo = __builtin_amdgcn_ds_read_tr16_b64_v4i16((LAS s16x4*)a), hi = __builtin_amdgcn_ds_read_tr16_b64_v4i16((LAS s16x4*)(a + 8 * PT));
    return __builtin_shufflevector(lo, hi, 0, 1, 2, 3, 4, 5, 6, 7);
}
#define RT_PT 144
__device__ __forceinline__ void ret_kv_unit(KP p, int l, int bl, int h, int rb, char* lds)
{
    const int tid = get_tid(), lane = tid & 63, wid = tid >> 6, r = lane & 31, h5 = lane >> 5;
    const bf16_t* PR = (const bf16_t*)(p->ws + WS_PROJ);
    const size_t R0 = (size_t)bl * LTOK + rb * 128;
    const float lgf = log_sigmoidf(p->ret_logit[(l * 2 + 0) * 4 + h]) * 1.4426950408889634f, lgb = log_sigmoidf(p->ret_logit[(l * 2 + 1) * 4 + h]) * 1.4426950408889634f;
    char* KF = lds; char* KBk = lds + 128 * RT_PT; char* VV = lds + 2 * 128 * RT_PT;
    __syncthreads();
#pragma unroll
    for (int q = 0; q < 2; ++q) {
        const int c = tid + 512 * q, row = c >> 3, cc = c & 7;
        const u32x4 kw = *(const u32x4*)(PR + (R0 + row) * PLD + C_RK + h * 64 + cc * 8), vw = *(const u32x4*)(PR + (R0 + row) * PLD + C_RV + h * 64 + cc * 8);
        const float wf = 0.125f * __builtin_amdgcn_exp2f(lgf * (float)(127 - row)), wb = 0.125f * __builtin_amdgcn_exp2f(lgb * (float)row);
        u32x4 of, ob;
#pragma unroll
        for (int j = 0; j < 4; ++j) { const float lo = bflo(kw[j]), hi = bfhi(kw[j]); of[j] = pack_bf16(lo * wf, hi * wf); ob[j] = pack_bf16(lo * wb, hi * wb); }
        *(u32x4*)(KF + row * RT_PT + cc * 16) = of; *(u32x4*)(KBk + row * RT_PT + cc * 16) = ob; *(u32x4*)(VV + row * RT_PT + cc * 16) = vw;
    }
    __syncthreads();
    const int dir = wid >> 2, dt = (wid >> 1) & 1, et = wid & 1;
    const char* Ks = dir ? KBk : KF;
    f32x16 acc;
#pragma unroll
    for (int i = 0; i < 16; ++i) acc[i] = 0.f;
#pragma unroll
    for (int s2 = 0; s2 < 8; ++s2) {
        const bf16x8 af = tr_frag_nat(Ks, RT_PT, 16 * s2, dt * 32, lane), bfv = tr_frag_nat(VV, RT_PT, 16 * s2, et * 32, lane);
        acc = __builtin_amdgcn_mfma_f32_32x32x16_bf16(af, bfv, acc, 0, 0, 0);
    }
    const int j = dir ? ret_jb(rb) : rb;
    float* dst = ((float*)(p->ws + WS_RKV)) + ((((size_t)bl * 4 + h) * 2 + dir) * 34 + j) * 4096 + et * 32 + r;
#pragma unroll
    for (int i = 0; i < 16; ++i) dst[(dt * 32 + (i & 3) + 8 * (i >> 2) + 4 * h5) * 64] = acc[i];
}

__device__ __forceinline__ void phase_p3a(KP p, int l, int bid, int nblk, char* lds)
{
    gemm_phase(((bf16_t*)(p->ws + WS_PROJ)) + C_CQ, PLD, ((bf16_t*)(p->ws + WS_WUQT)) + (size_t)l * 384 * 256, 256, TG, 384, 256, EpiStore{((bf16_t*)(p->ws + WS_QRAW)), 384}, lds, bid, nblk);
    gemm_phase(((bf16_t*)(p->ws + WS_PROJ)) + C_CKV, PLD, ((bf16_t*)(p->ws + WS_WUKVT)) + (size_t)l * 512 * 128, 128, TG, 512, 128, EpiStore{((bf16_t*)(p->ws + WS_KVRAW)), 512}, lds, bid, nblk);
    for (int u = bid; u < NB * 4 * 34; u += nblk) { const int rb = u % 34, h = (u / 34) & 3, bl = u / 136; ret_kv_unit(p, l, bl, h, rb, lds); }
}

#define LOG2_THETA 13.287712379549449f
__device__ __forceinline__ float rope_freq(int i, int half) { return exp2f(-LOG2_THETA * (float)i / (float)half); }

__device__ __forceinline__ void phase_p3b(KP p, int l, int bid, int nblk)
{
    {
        const int gt = bid * NTHREADS + get_tid();
        for (int it = gt; it < NB * 4 * 2 * 1024; it += nblk * NTHREADS) {
            const int e4 = it & 1023, bhd = it >> 10, dir = bhd & 1, h = (bhd >> 1) & 3;
            const float dec = __builtin_amdgcn_exp2f(log_sigmoidf(p->ret_logit[(l * 2 + dir) * 4 + h]) * 1.4426950408889634f * 128.f);
            f32x4* base = (f32x4*)((float*)(p->ws + WS_RKV) + (size_t)bhd * 34 * 4096) + e4;
            f32x4 st = (f32x4){0.f, 0.f, 0.f, 0.f};
            f32x4 kv[34];
#pragma unroll
            for (int j = 0; j < 34; ++j) kv[j] = base[(size_t)j * 1024];
#pragma unroll
            for (int j = 0; j < 34; ++j) { base[(size_t)j * 1024] = st; st = st * dec + kv[j]; }
        }
    }
    const int lane = get_tid() & 63, wid = get_tid() >> 6;
    const float mla_scale = 0.10206207261596575f * 1.4426950408889634f;
    auto load_row = [&](unsigned (&rw)[40], int r) {
        const bf16_t* pr = ((bf16_t*)(p->ws + WS_PROJ)) + (size_t)r * PLD;
        const bf16_t* qraw = ((bf16_t*)(p->ws + WS_QRAW)) + (size_t)r * 384;
        const bf16_t* kvraw = ((bf16_t*)(p->ws + WS_KVRAW)) + (size_t)r * 512;
#pragma unroll
        for (int i = 0; i < 4; ++i) rw[i] = pr[C_CQ + lane + 64 * i];
#pragma unroll
        for (int i = 0; i < 2; ++i) rw[4 + i] = pr[C_CKV + lane + 64 * i];
#pragma unroll
        for (int i = 0; i < 6; ++i) {
            const int idx = lane + 64 * i, h = idx / 96, d = idx % 96, dd = d >= 64 ? d - 64 : 0;
            rw[6 + i] = qraw[idx];
            rw[12 + i] = qraw[(unsigned)(d >= 64 ? idx - dd + (dd ^ 8) : idx)];
            rw[18 + i] = d < 64 ? kvraw[h * 128 + d] : pr[C_KPE + dd];
            rw[24 + i] = pr[C_KPE + (unsigned)(dd ^ 8)];
        }
#pragma unroll
        for (int i = 0; i < 4; ++i) { const int idx = lane + 64 * i, h = idx >> 6, e = idx & 63; rw[30 + i] = kvraw[h * 128 + 64 + e]; }
#pragma unroll
        for (int hh = 0; hh < 6; ++hh) rw[34 + hh] = pr[(hh < 4 ? C_GQ + hh * 64 : C_GK + (hh - 4) * 64) + lane];
    };
    auto proc_row = [&](const unsigned (&rw)[40], int r) {
        const int t = r % LTOK;
        const bool lat = t >= CTXL;
        const float prow = lat ? (float)((t - CTXL) >> 6) : 0.f, pcol = lat ? (float)((t - CTXL) & 63) : 0.f;
        float sq = 0.f, skv = 0.f;
#pragma unroll
        for (int i = 0; i < 4; ++i) { const float v = bf2f((bf16_t)rw[i]); sq += v * v; }
#pragma unroll
        for (int i = 0; i < 2; ++i) { const float v = bf2f((bf16_t)rw[4 + i]); skv += v * v; }
        sq = wave_sum(sq); skv = wave_sum(skv);
        const float rq = rsqrtf(sq * (1.f / 256.f) + EPSF), rkv = rsqrtf(skv * (1.f / 128.f) + EPSF);
#pragma unroll
        for (int i = 0; i < 6; ++i) {
            const int idx = lane + 64 * i, d = idx % 96;
            float qv = bf2f((bf16_t)rw[6 + i]), kv = bf2f((bf16_t)rw[18 + i]);
            if (d < 64) kv *= rkv;
            else if (lat) {
                const int dd = d - 64, blk = dd >> 4, w = dd & 15, fi = w & 7; const bool first = w < 8;
                const float rev = (blk ? pcol : prow) * rope_freq(fi, 8) * 0.15915494309189535f; const float sn = __builtin_amdgcn_sinf(rev), cs = __builtin_amdgcn_cosf(rev);
                const float qo = bf2f((bf16_t)rw[12 + i]), ko = bf2f((bf16_t)rw[24 + i]);
                qv = first ? (qv * cs - qo * sn) : (qo * sn + qv * cs);
                kv = first ? (kv * cs - ko * sn) : (ko * sn + kv * cs);
            }
            ((bf16_t*)(p->ws + WS_QA))[(size_t)r * 384 + idx] = f2bf(qv * rq * mla_scale);
            ((bf16_t*)(p->ws + WS_KA))[(size_t)r * 384 + idx] = f2bf(kv);
        }
#pragma unroll
        for (int i = 0; i < 4; ++i) ((bf16_t*)(p->ws + WS_VA))[(size_t)r * 256 + lane + 64 * i] = f2bf(bf2f((bf16_t)rw[30 + i]) * rkv);
        const int blk = lane >> 5, w = lane & 31, fi = w & 15; const bool first = w < 16;
        float sn = 0.f, cs = 1.f;
        if (lat) { const float rev = (blk ? pcol : prow) * rope_freq(fi, 16) * 0.15915494309189535f; sn = __builtin_amdgcn_sinf(rev); cs = __builtin_amdgcn_cosf(rev); }
        const float nwq = p->gqa_qn[l * 64 + lane], nwk = p->gqa_kn[l * 64 + lane];
#pragma unroll
        for (int hh = 0; hh < 6; ++hh) {
            const bool isq = hh < 4;
            const float v = bf2f((bf16_t)rw[34 + hh]);
            const float ss = wave_sum(v * v);
            const float n = v * rsqrtf(ss * (1.f / 64.f) + EPSF) * (isq ? nwq : nwk);
            const float other = xor_swz<16>(n);
            float val = n;
            if (lat) val = first ? (n * cs - other * sn) : (other * sn + n * cs);
            if (isq) ((bf16_t*)(p->ws + WS_GQ))[(size_t)r * 256 + hh * 64 + lane] = f2bf(val * (0.125f * 1.4426950408889634f));
            else ((bf16_t*)(p->ws + WS_GK))[(size_t)r * 128 + (hh - 4) * 64 + lane] = f2bf(val);
        }
    };
    const int rstep = nblk * 8;
    int r = bid * 8 + wid;
    if (r < TG) {
        unsigned ra[40], rb[40];
        load_row(ra, r);
        for (;;) {
            const bool m1 = r + rstep < TG;
            if (m1) load_row(rb, r + rstep);
            proc_row(ra, r);
            if (!m1) break;
            r += rstep;
            const bool m2 = r + rstep < TG;
            if (m2) load_row(ra, r + rstep);
            proc_row(rb, r);
            if (!m2) break;
            r += rstep;
        }
    }
}

template <int DQ>
__device__ __forceinline__ void attn_unit(const bf16_t* __restrict__ Qb, int qld, const bf16_t* __restrict__ Kb, int kld, const bf16_t* __restrict__ Vb, int vld,
                                          int nq, int nk, bf16_t* __restrict__ Ob, int old_, char* lds)
{
    constexpr int NS = DQ / 16, CPR = DQ / 8, KP = DQ * 2 + 16, VP = 144, KB = 64 * KP, VB = 64 * VP, STG = KB + VB, KCH = 64 * CPR;
    const int tid = get_tid(), lane = tid & 63, wid = tid >> 6, r = lane & 31, h = lane >> 5;
    int qrow[2]; bool qvalid[2];
    bf16x8 qf[2][NS];
#pragma unroll
    for (int qb = 0; qb < 2; ++qb) {
        qrow[qb] = wid * 64 + qb * 32 + r; qvalid[qb] = qrow[qb] < nq; if (!qvalid[qb]) qrow[qb] = 0;
#pragma unroll
        for (int s2 = 0; s2 < NS; ++s2) qf[qb][s2] = *(const bf16x8*)(Qb + (size_t)qrow[qb] * qld + 16 * s2 + 8 * h);
    }
    f32x16 o0[2], o1[2];
    float m[2] = {0.f, 0.f}, l[2] = {0.f, 0.f};
#pragma unroll
    for (int qb = 0; qb < 2; ++qb)
#pragma unroll
        for (int i = 0; i < 16; ++i) { o0[qb][i] = 0.f; o1[qb][i] = 0.f; }
    const int kr0 = tid / CPR, kc0 = tid % CPR, kr1 = (tid + 512) / CPR, kc1 = (tid + 512) % CPR; const bool k1 = (tid + 512) < KCH;
    const int vr = tid >> 3, vc = tid & 7;
    const bf16_t* kg0 = Kb + (size_t)kr0 * kld + kc0 * 8; const bf16_t* kg1 = Kb + (size_t)kr1 * kld + kc1 * 8; const bf16_t* vg = Vb + (size_t)vr * vld + vc * 8;
    const int kl0 = kr0 * KP + kc0 * 16, kl1 = kr1 * KP + kc1 * 16, vl = KB + vr * VP + vc * 16;
    u32x4 rk0, rk1 = (u32x4){0u, 0u, 0u, 0u}, rv;
    rk0 = *(const u32x4*)kg0; if (k1) rk1 = *(const u32x4*)kg1; rv = *(const u32x4*)vg;
    __syncthreads();
    *(u32x4*)(lds + kl0) = rk0; if (k1) *(u32x4*)(lds + kl1) = rk1; *(u32x4*)(lds + vl) = rv;
    __syncthreads();
    const int i16 = lane & 15, blk = (lane >> 4) & 1, q4 = i16 >> 2, p4 = i16 & 3;
    const int koff = r * KP + 16 * h, voff = KB + (4 * h + q4) * VP + 32 * blk + 8 * p4;
    const int nt = nk >> 6;
    for (int kt = 0; kt < nt; ++kt) {
        const int cur = (kt & 1) * STG, nxt = ((kt + 1) & 1) * STG;
        const bool more = kt + 1 < nt;
        if (more) {
            const size_t adv = (size_t)(kt + 1) * 64;
            rk0 = *(const u32x4*)(kg0 + adv * kld); if (k1) rk1 = *(const u32x4*)(kg1 + adv * kld); rv = *(const u32x4*)(vg + adv * vld);
        }
#pragma unroll
        for (int sub = 0; sub < 2; ++sub) {
            f32x16 sq[2];
#pragma unroll
            for (int i = 0; i < 16; ++i) { sq[0][i] = 0.f; sq[1][i] = 0.f; }
#pragma unroll
            for (int g0 = 0; g0 < NS; g0 += 4) {
                bf16x8 kfr[4];
#pragma unroll
                for (int s2 = 0; s2 < 4; ++s2) if (g0 + s2 < NS) kfr[s2] = *(const bf16x8*)(lds + cur + koff + sub * 32 * KP + (g0 + s2) * 32);
                __builtin_amdgcn_sched_barrier(0);
#pragma unroll
                for (int s2 = 0; s2 < 4; ++s2) if (g0 + s2 < NS) {
                    sq[0] = __builtin_amdgcn_mfma_f32_32x32x16_bf16(kfr[s2], qf[0][g0 + s2], sq[0], 0, 0, 0);
                    sq[1] = __builtin_amdgcn_mfma_f32_32x32x16_bf16(kfr[s2], qf[1][g0 + s2], sq[1], 0, 0, 0);
                }
            }
            bf16x8 vfr[2][2];
#pragma unroll
            for (int s2 = 0; s2 < 1; ++s2) {
                const int vb = cur + voff + (sub * 32 + 16 * s2) * VP;
                const s16x4 lo0 = __builtin_amdgcn_ds_read_tr16_b64_v4i16((LAS s16x4*)(lds + vb));
                const s16x4 hi0 = __builtin_amdgcn_ds_read_tr16_b64_v4i16((LAS s16x4*)(lds + vb + 8 * VP));
                const s16x4 lo1 = __builtin_amdgcn_ds_read_tr16_b64_v4i16((LAS s16x4*)(lds + vb + 64));
                const s16x4 hi1 = __builtin_amdgcn_ds_read_tr16_b64_v4i16((LAS s16x4*)(lds + vb + 8 * VP + 64));
                vfr[s2][0] = __builtin_shufflevector(lo0, hi0, 0, 1, 2, 3, 4, 5, 6, 7); vfr[s2][1] = __builtin_shufflevector(lo1, hi1, 0, 1, 2, 3, 4, 5, 6, 7);
            }
            bf16x8 pf[2][2];
#pragma unroll
            for (int qb = 0; qb < 2; ++qb) {
                f32x16& st = sq[qb];
                if (__builtin_amdgcn_ballot_w64(m[qb] != 0.f) != 0ull) {
#pragma unroll
                    for (int i = 0; i < 16; ++i) st[i] -= m[qb];
                }
                float mx = fmaxf(st[0], st[1]);
#pragma unroll
                for (int i = 2; i < 16; i += 2) mx = fmaxf(fmaxf(mx, st[i]), st[i + 1]);
                { const u32x2 sw = __builtin_amdgcn_permlane32_swap(__float_as_uint(mx), __float_as_uint(mx), false, false); mx = fmaxf(__uint_as_float(sw.x), __uint_as_float(sw.y)); }
                const bool first = (kt == 0) && (sub == 0);
                const bool mv = mx > 24.f || (first && mx < -24.f);
                if (__builtin_amdgcn_ballot_w64(mv) != 0ull) {
                    const float dlt = mv ? mx : 0.f, alpha = __builtin_amdgcn_exp2f(-dlt);
                    m[qb] += dlt; l[qb] *= alpha;
#pragma unroll
                    for (int i = 0; i < 16; ++i) { st[i] -= dlt; o0[qb][i] *= alpha; o1[qb][i] *= alpha; }
                }
                f32x2 rs2 = (f32x2){0.f, 0.f};
#pragma unroll
                for (int i = 0; i < 16; i += 2) { st[i] = __builtin_amdgcn_exp2f(st[i]); st[i + 1] = __builtin_amdgcn_exp2f(st[i + 1]); rs2 += (f32x2){st[i], st[i + 1]}; }
                l[qb] += rs2.x + rs2.y;
                u32x4 pw0, pw1;
                pw0.x = pack_bf16(st[0], st[1]); pw0.y = pack_bf16(st[2], st[3]); pw0.z = pack_bf16(st[4], st[5]); pw0.w = pack_bf16(st[6], st[7]);
                pw1.x = pack_bf16(st[8], st[9]); pw1.y = pack_bf16(st[10], st[11]); pw1.z = pack_bf16(st[12], st[13]); pw1.w = pack_bf16(st[14], st[15]);
                pf[qb][0] = __builtin_bit_cast(bf16x8, pw0); pf[qb][1] = __builtin_bit_cast(bf16x8, pw1);
            }
            {
                const int vb = cur + voff + (sub * 32 + 16) * VP;
                const s16x4 lo0 = __builtin_amdgcn_ds_read_tr16_b64_v4i16((LAS s16x4*)(lds + vb));
                const s16x4 hi0 = __builtin_amdgcn_ds_read_tr16_b64_v4i16((LAS s16x4*)(lds + vb + 8 * VP));
                const s16x4 lo1 = __builtin_amdgcn_ds_read_tr16_b64_v4i16((LAS s16x4*)(lds + vb + 64));
                const s16x4 hi1 = __builtin_amdgcn_ds_read_tr16_b64_v4i16((LAS s16x4*)(lds + vb + 8 * VP + 64));
                vfr[1][0] = __builtin_shufflevector(lo0, hi0, 0, 1, 2, 3, 4, 5, 6, 7); vfr[1][1] = __builtin_shufflevector(lo1, hi1, 0, 1, 2, 3, 4, 5, 6, 7);
            }
#pragma unroll
            for (int s2 = 0; s2 < 2; ++s2)
#pragma unroll
                for (int qb = 0; qb < 2; ++qb) {
                    o0[qb] = __builtin_amdgcn_mfma_f32_32x32x16_bf16(vfr[s2][0], pf[qb][s2], o0[qb], 0, 0, 0);
                    o1[qb] = __builtin_amdgcn_mfma_f32_32x32x16_bf16(vfr[s2][1], pf[qb][s2], o1[qb], 0, 0, 0);
                }
        }
        if (more) { *(u32x4*)(lds + nxt + kl0) = rk0; if (k1) *(u32x4*)(lds + nxt + kl1) = rk1; *(u32x4*)(lds + nxt + vl) = rv; }
        __syncthreads();
    }
#pragma unroll
    for (int qb = 0; qb < 2; ++qb) {
        float lt = sum_xor32(l[qb]);
        if (qvalid[qb]) {
            const float inv = 1.f / lt;
            bf16_t* op = Ob + (size_t)qrow[qb] * old_ + 4 * h;
#pragma unroll
            for (int g4 = 0; g4 < 4; ++g4) {
                store_bf16x4(op + 8 * g4, (f32x4){o0[qb][4 * g4] * inv, o0[qb][4 * g4 + 1] * inv, o0[qb][4 * g4 + 2] * inv, o0[qb][4 * g4 + 3] * inv});
                store_bf16x4(op + 32 + 8 * g4, (f32x4){o1[qb][4 * g4] * inv, o1[qb][4 * g4 + 1] * inv, o1[qb][4 * g4 + 2] * inv, o1[qb][4 * g4 + 3] * inv});
            }
        }
    }
}

__device__ __forceinline__ void ld8(const bf16_t* p, float (&o)[8]) {
    const u32x4 w = *(const u32x4*)p;
    o[0] = bflo(w.x); o[1] = bfhi(w.x); o[2] = bflo(w.y); o[3] = bfhi(w.y); o[4] = bflo(w.z); o[5] = bfhi(w.z); o[6] = bflo(w.w); o[7] = bfhi(w.w);
}

__device__ __forceinline__ void na_unit(KP p, int l, int bl, int h, int rg, char* lds)
{
    constexpr int KP_ = 144, VP = 144, KB = 64 * KP_, VB = 64 * VP, STG = KB + VB, LBIAS = 2 * STG;
    const int tid = get_tid(), lane = tid & 63, wid = tid >> 6, r = lane & 31, h5 = lane >> 5;
    const bf16_t* PR = (const bf16_t*)(p->ws + WS_PROJ);
    const size_t Rb = (size_t)bl * LTOK;
    const int grow = rg * 4 + (wid >> 1), c = (wid & 1) * 32 + r;
    const int rs = min(max(grow - 4, 0), 56), cs = min(max(c - 8, 0), 48);
    const int Rlo = min(max(rg * 4 - 4, 0), 56), Rhi = min(max(rg * 4 + 3 - 4, 0), 56) + 7, nrow = Rhi - Rlo + 1, nt = nrow + 4;
    const size_t qrow = Rb + CTXL + (size_t)grow * 64 + c;
    bf16x8 qf[4];
#pragma unroll
    for (int s2 = 0; s2 < 4; ++s2) qf[s2] = *(const bf16x8*)(PR + qrow * PLD + C_NQ + h * 64 + 16 * s2 + 8 * h5);
    f32x16 o0, o1;
#pragma unroll
    for (int i = 0; i < 16; ++i) { o0[i] = 0.f; o1[i] = 0.f; }
    float m = -1e30f, lsum = 0.f;
    const int kr = tid >> 3, kc = tid & 7;
    const int kl = kr * KP_ + kc * 16, vl = KB + kr * VP + kc * 16;
    auto tile_row = [&](int t) -> size_t { return t < nrow ? Rb + CTXL + (size_t)(Rlo + t) * 64 : Rb + (size_t)(t - nrow) * 64; };
    u32x4 rk, rv;
    { const size_t R = tile_row(0) + kr; rk = *(const u32x4*)(PR + R * PLD + C_NK + h * 64 + kc * 8); rv = *(const u32x4*)(PR + R * PLD + C_NV + h * 64 + kc * 8); }
    __syncthreads();
    *(u32x4*)(lds + kl) = rk; *(u32x4*)(lds + vl) = rv;
    { float* sb = (float*)(lds + LBIAS); const float* bias = p->na_bias + ((size_t)l * 4 + h) * 465; if (tid < 465) sb[tid] = bias[tid] * 1.4426950408889634f; }
    __syncthreads();
    const float* sb = (const float*)(lds + LBIAS);
    const int i16 = lane & 15, blk = (lane >> 4) & 1, q4 = i16 >> 2, p4 = i16 & 3;
    const int koff = r * KP_ + 16 * h5, voff = KB + (4 * h5 + q4) * VP + 32 * blk + 8 * p4;
    for (int t = 0; t < nt; ++t) {
        const int cur = (t & 1) * STG, nxt = ((t + 1) & 1) * STG;
        const bool more = t + 1 < nt;
        if (more) { const size_t R = tile_row(t + 1) + kr; rk = *(const u32x4*)(PR + R * PLD + C_NK + h * 64 + kc * 8); rv = *(const u32x4*)(PR + R * PLD + C_NV + h * 64 + kc * 8); }
        const bool win = t < nrow; const int R = Rlo + t;
        const bool mine = !win || (R >= rs && R <= rs + 7);
        if (mine) {
#pragma unroll
            for (int sub = 0; sub < 2; ++sub) {
                f32x16 st;
#pragma unroll
                for (int i = 0; i < 16; ++i) st[i] = 0.f;
#pragma unroll
                for (int s2 = 0; s2 < 4; ++s2) {
                    const bf16x8 kf = *(const bf16x8*)(lds + cur + koff + sub * 32 * KP_ + s2 * 32);
                    st = __builtin_amdgcn_mfma_f32_32x32x16_bf16(kf, qf[s2], st, 0, 0, 0);
                }
                if (win) {
                    const int brow = (R - grow + 7) * 31 + 15 - c;
#pragma unroll
                    for (int i = 0; i < 16; ++i) {
                        const int kcol = sub * 32 + (i & 3) + 8 * (i >> 2) + 4 * h5;
                        const bool ok = kcol >= cs && kcol < cs + 16;
                        const float bv = sb[ok ? brow + kcol : 0];
                        st[i] = ok ? st[i] + bv : -INFINITY;
                    }
                }
                float mx = fmaxf(st[0], st[1]);
#pragma unroll
                for (int i = 2; i < 16; i += 2) mx = fmaxf(fmaxf(mx, st[i]), st[i + 1]);
                mx = max_xor32(mx);
                const float mn = fmaxf(m, mx), alpha = __builtin_amdgcn_exp2f(m - mn);
                m = mn;
                f32x2 rs2 = (f32x2){0.f, 0.f};
#pragma unroll
                for (int i = 0; i < 16; i += 2) { st[i] = __builtin_amdgcn_exp2f(st[i] - mn); st[i + 1] = __builtin_amdgcn_exp2f(st[i + 1] - mn); rs2 += (f32x2){st[i], st[i + 1]}; }
                lsum = lsum * alpha + (rs2.x + rs2.y);
                if (__builtin_amdgcn_ballot_w64(alpha != 1.f) != 0ull) {
#pragma unroll
                    for (int i = 0; i < 16; ++i) { o0[i] *= alpha; o1[i] *= alpha; }
                }
                u32x4 pw0, pw1;
                pw0.x = pack_bf16(st[0], st[1]); pw0.y = pack_bf16(st[2], st[3]); pw0.z = pack_bf16(st[4], st[5]); pw0.w = pack_bf16(st[6], st[7]);
                pw1.x = pack_bf16(st[8], st[9]); pw1.y = pack_bf16(st[10], st[11]); pw1.z = pack_bf16(st[12], st[13]); pw1.w = pack_bf16(st[14], st[15]);
                const bf16x8 pf0 = __builtin_bit_cast(bf16x8, pw0), pf1 = __builtin_bit_cast(bf16x8, pw1);
#pragma unroll
                for (int s2 = 0; s2 < 2; ++s2) {
                    const int vb = cur + voff + (sub * 32 + 16 * s2) * VP;
                    const s16x4 lo0 = __builtin_amdgcn_ds_read_tr16_b64_v4i16((LAS s16x4*)(lds + vb));
                    const s16x4 hi0 = __builtin_amdgcn_ds_read_tr16_b64_v4i16((LAS s16x4*)(lds + vb + 8 * VP));
                    const s16x4 lo1 = __builtin_amdgcn_ds_read_tr16_b64_v4i16((LAS s16x4*)(lds + vb + 64));
                    const s16x4 hi1 = __builtin_amdgcn_ds_read_tr16_b64_v4i16((LAS s16x4*)(lds + vb + 8 * VP + 64));
                    const bf16x8 vf0 = __builtin_shufflevector(lo0, hi0, 0, 1, 2, 3, 4, 5, 6, 7), vf1 = __builtin_shufflevector(lo1, hi1, 0, 1, 2, 3, 4, 5, 6, 7);
                    o0 = __builtin_amdgcn_mfma_f32_32x32x16_bf16(vf0, s2 ? pf1 : pf0, o0, 0, 0, 0);
                    o1 = __builtin_amdgcn_mfma_f32_32x32x16_bf16(vf1, s2 ? pf1 : pf0, o1, 0, 0, 0);
                }
            }
        }
        if (more) { *(u32x4*)(lds + nxt + kl) = rk; *(u32x4*)(lds + nxt + vl) = rv; }
        __syncthreads();
    }
    lsum = sum_xor32(lsum);
    const float inv = 1.f / lsum;
    bf16_t* op = ((bf16_t*)(p->ws + WS_OUTS)) + ((size_t)2 * TG + qrow) * 256 + h * 64 + 4 * h5;
#pragma unroll
    for (int g4 = 0; g4 < 4; ++g4) {
        store_bf16x4(op + 8 * g4, (f32x4){o0[4 * g4] * inv, o0[4 * g4 + 1] * inv, o0[4 * g4 + 2] * inv, o0[4 * g4 + 3] * inv});
        store_bf16x4(op + 32 + 8 * g4, (f32x4){o1[4 * g4] * inv, o1[4 * g4 + 1] * inv, o1[4 * g4 + 2] * inv, o1[4 * g4 + 3] * inv});
    }
}

__device__ __forceinline__ void ret_out_unit(KP p, int l, int bl, int h, int rb, char* lds)
{
    const int tid = get_tid(), lane = tid & 63, wid = tid >> 6, r = lane & 31, h5 = lane >> 5;
    const bf16_t* PR = (const bf16_t*)(p->ws + WS_PROJ);
    const size_t R0 = (size_t)bl * LTOK + rb * 128;
    const float lgf = log_sigmoidf(p->ret_logit[(l * 2 + 0) * 4 + h]) * 1.4426950408889634f, lgb = log_sigmoidf(p->ret_logit[(l * 2 + 1) * 4 + h]) * 1.4426950408889634f;
    char* KK = lds; char* VV = lds + 128 * RT_PT; char* SS = lds + 2 * 128 * RT_PT;
    float* YB = (float*)lds;
    __syncthreads();
#pragma unroll
    for (int q = 0; q < 2; ++q) {
        const int c = tid + 512 * q, row = c >> 3, cc = c & 7;
        const u32x4 kw = *(const u32x4*)(PR + (R0 + row) * PLD + C_RK + h * 64 + cc * 8), vw = *(const u32x4*)(PR + (R0 + row) * PLD + C_RV + h * 64 + cc * 8);
        u32x4 ok;
#pragma unroll
        for (int j = 0; j < 4; ++j) ok[j] = pack_bf16(bflo(kw[j]) * 0.125f, bfhi(kw[j]) * 0.125f);
        *(u32x4*)(KK + row * RT_PT + cc * 16) = ok; *(u32x4*)(VV + row * RT_PT + cc * 16) = vw;
    }
    {
        const int jf = rb, jb = ret_jb(rb);
#pragma unroll
        for (int q = 0; q < 2; ++q) {
            const int e = tid + 512 * q, dir = e >> 9, dk = (e >> 3) & 63, e0 = (e & 7) * 8, j = dir ? jb : jf;
            const float* src = ((float*)(p->ws + WS_RKV)) + ((((size_t)bl * 4 + h) * 2 + dir) * 34 + j) * 4096 + dk * 64 + e0;
            const f32x4 s0 = *(const f32x4*)src, s1 = *(const f32x4*)(src + 4);
            u32x4 o; o.x = pack_bf16(s0[0], s0[1]); o.y = pack_bf16(s0[2], s0[3]); o.z = pack_bf16(s1[0], s1[1]); o.w = pack_bf16(s1[2], s1[3]);
            *(u32x4*)(SS + (dir * 64 + dk) * RT_PT + e0 * 2) = o;
        }
    }
    __syncthreads();
    const int dir = wid >> 2, mt = wid & 3;
    const float lg = dir ? lgb : lgf;
    const int qi = mt * 32 + r;
    bf16x8 qf[4];
#pragma unroll
    for (int s2 = 0; s2 < 4; ++s2) qf[s2] = *(const bf16x8*)(PR + (R0 + qi) * PLD + C_RQ + h * 64 + 16 * s2 + 8 * h5);
    f32x16 o0, o1;
#pragma unroll
    for (int i = 0; i < 16; ++i) { o0[i] = 0.f; o1[i] = 0.f; }
    {
        const char* Sd = SS + dir * 64 * RT_PT;
#pragma unroll
        for (int s2 = 0; s2 < 4; ++s2) {
            const bf16x8 a0 = tr_frag_nat(Sd, RT_PT, 16 * s2, 0, lane), a1 = tr_frag_nat(Sd, RT_PT, 16 * s2, 32, lane);
            o0 = __builtin_amdgcn_mfma_f32_32x32x16_bf16(a0, qf[s2], o0, 0, 0, 0);
            o1 = __builtin_amdgcn_mfma_f32_32x32x16_bf16(a1, qf[s2], o1, 0, 0, 0);
        }
        const int pos = dir ? 127 - qi : qi;
        const float qd = __builtin_amdgcn_exp2f(lg * (float)(pos + 1));
#pragma unroll
        for (int i = 0; i < 16; ++i) { o0[i] *= qd; o1[i] *= qd; }
    }
    const int kt0 = dir ? mt : 0, kt1 = dir ? 3 : mt;
    for (int kt = kt0; kt <= kt1; ++kt) {
        f32x16 st;
#pragma unroll
        for (int i = 0; i < 16; ++i) st[i] = 0.f;
#pragma unroll
        for (int s2 = 0; s2 < 4; ++s2) {
            const bf16x8 kf = *(const bf16x8*)(KK + (kt * 32 + r) * RT_PT + s2 * 32 + 16 * h5);
            st = __builtin_amdgcn_mfma_f32_32x32x16_bf16(kf, qf[s2], st, 0, 0, 0);
        }
#pragma unroll
        for (int i = 0; i < 16; ++i) {
            const int ki = kt * 32 + (i & 3) + 8 * (i >> 2) + 4 * h5;
            const int diff = dir ? ki - qi : qi - ki;
            st[i] = diff >= 0 ? st[i] * __builtin_amdgcn_exp2f(lg * (float)diff) : 0.f;
        }
        u32x4 pw0, pw1;
        pw0.x = pack_bf16(st[0], st[1]); pw0.y = pack_bf16(st[2], st[3]); pw0.z = pack_bf16(st[4], st[5]); pw0.w = pack_bf16(st[6], st[7]);
        pw1.x = pack_bf16(st[8], st[9]); pw1.y = pack_bf16(st[10], st[11]); pw1.z = pack_bf16(st[12], st[13]); pw1.w = pack_bf16(st[14], st[15]);
        const bf16x8 pf0 = __builtin_bit_cast(bf16x8, pw0), pf1 = __builtin_bit_cast(bf16x8, pw1);
#pragma unroll
        for (int s2 = 0; s2 < 2; ++s2) {
            const bf16x8 v0 = tr_frag_acc(VV, RT_PT, kt * 32 + 16 * s2, 0, lane), v1 = tr_frag_acc(VV, RT_PT, kt * 32 + 16 * s2, 32, lane);
            o0 = __builtin_amdgcn_mfma_f32_32x32x16_bf16(v0, s2 ? pf1 : pf0, o0, 0, 0, 0);
            o1 = __builtin_amdgcn_mfma_f32_32x32x16_bf16(v1, s2 ? pf1 : pf0, o1, 0, 0, 0);
        }
    }
    float sm = 0.f;
#pragma unroll
    for (int i = 0; i < 16; ++i) sm += o0[i] + o1[i];
    sm = sum_xor32(sm);
    const float mu = sm * (1.f / 64.f);
    float vs = 0.f;
#pragma unroll
    for (int i = 0; i < 16; ++i) { const float a0 = o0[i] - mu, a1 = o1[i] - mu; vs += a0 * a0 + a1 * a1; }
    vs = sum_xor32(vs);
    const float rstd = rsqrtf(vs * (1.f / 64.f) + EPSF);
    const bf16_t* gp = PR + (R0 + qi) * PLD + (dir ? C_RGB : C_RGF) + h * 64 + 4 * h5;
    const float* gw = p->ret_gnw + l * 256 + h * 64 + 4 * h5;
    __syncthreads();
#pragma unroll
    for (int t = 0; t < 2; ++t)
#pragma unroll
        for (int g4 = 0; g4 < 4; ++g4) {
            const u32x2 gg = *(const u32x2*)(gp + 32 * t + 8 * g4); const f32x4 ww = *(const f32x4*)(gw + 32 * t + 8 * g4);
            const float g0 = bflo(gg.x), g1 = bfhi(gg.x), g2 = bflo(gg.y), g3 = bfhi(gg.y);
            f32x4 y;
            y[0] = ((t ? o1[4 * g4] : o0[4 * g4]) - mu) * rstd * ww[0] * siluf(g0);
            y[1] = ((t ? o1[4 * g4 + 1] : o0[4 * g4 + 1]) - mu) * rstd * ww[1] * siluf(g1);
            y[2] = ((t ? o1[4 * g4 + 2] : o0[4 * g4 + 2]) - mu) * rstd * ww[2] * siluf(g2);
            y[3] = ((t ? o1[4 * g4 + 3] : o0[4 * g4 + 3]) - mu) * rstd * ww[3] * siluf(g3);
            *(f32x4*)(YB + (dir * 128 + qi) * 68 + 32 * t + 8 * g4 + 4 * h5) = y;
        }
    __syncthreads();
#pragma unroll
    for (int q = 0; q < 2; ++q) {
        const int e = tid + 512 * q, row = e >> 3, c8 = (e & 7) * 8;
        const f32x4 a0 = *(const f32x4*)(YB + row * 68 + c8), a1 = *(const f32x4*)(YB + row * 68 + c8 + 4), b0 = *(const f32x4*)(YB + (128 + row) * 68 + c8), b1 = *(const f32x4*)(YB + (128 + row) * 68 + c8 + 4);
        u32x4 o; o.x = pack_bf16(a0[0] + b0[0], a0[1] + b0[1]); o.y = pack_bf16(a0[2] + b0[2], a0[3] + b0[3]); o.z = pack_bf16(a1[0] + b1[0], a1[1] + b1[1]); o.w = pack_bf16(a1[2] + b1[2], a1[3] + b1[3]);
        *(u32x4*)(((bf16_t*)(p->ws + WS_OUTS)) + ((size_t)3 * TG + R0 + row) * 256 + h * 64 + c8) = o;
    }
}

#define U_MLA (NB * 32)
#define U_GQA (NB * 32)
#define U_NA (NB * 64)
#define U_RET (NB * 136)
#define U_CTX (NB * 12)
__device__ __forceinline__ int wq_next(unsigned* counter, LAS unsigned* wq) {
    __syncthreads();
    if (get_tid() == 0) *wq = atomicAdd(counter, 1u);
    __syncthreads();
    return (int)*wq;
}
__device__ __forceinline__ void phase_p4(KP p, int l, int g, char* ldsc, int bid, int nblk)
{
    float* lds = (float*)ldsc;
    LAS unsigned* wq = (LAS unsigned*)(smem + 32);
    unsigned* counter = ((unsigned*)(p->ws + WS_CNT)) + (l * NGROUP + g) * 64 * 8;
    (void)bid; (void)nblk;
    for (;;) {
        const int u = wq_next(counter, wq); if (u >= U_MLA) break;
        const int qb = u & 7, h = (u >> 3) & 3, bl = u >> 5; const size_t Rb = (size_t)bl * LTOK, Rq = Rb + CTXL + qb * 512;
        attn_unit<96>(((bf16_t*)(p->ws + WS_QA)) + Rq * 384 + h * 96, 384, ((bf16_t*)(p->ws + WS_KA)) + Rb * 384 + h * 96, 384, ((bf16_t*)(p->ws + WS_VA)) + Rb * 256 + h * 64, 256, 512, LTOK, ((bf16_t*)(p->ws + WS_OUTS)) + ((size_t)0 * TG + Rq) * 256 + h * 64, 256, ldsc);
    }
    for (;;) {
        const int u = wq_next(counter + 64, wq); if (u >= U_GQA) break;
        const int qb = u & 7, h = (u >> 3) & 3, bl = u >> 5; const size_t Rb = (size_t)bl * LTOK, Rq = Rb + CTXL + qb * 512; const int kvh = h >> 1;
        attn_unit<64>(((bf16_t*)(p->ws + WS_GQ)) + Rq * 256 + h * 64, 256, ((bf16_t*)(p->ws + WS_GK)) + Rb * 128 + kvh * 64, 128, ((bf16_t*)(p->ws + WS_PROJ)) + Rb * PLD + C_GV + kvh * 64, PLD, 512, LTOK, ((bf16_t*)(p->ws + WS_OUTS)) + ((size_t)1 * TG + Rq) * 256 + h * 64, 256, ldsc);
    }
    for (;;) {
        const int u = wq_next(counter + 128, wq); if (u >= U_NA) break;
        na_unit(p, l, u >> 6, (u >> 4) & 3, u & 15, ldsc);
    }
    for (;;) {
        const int u = wq_next(counter + 192, wq); if (u >= U_RET) break;
        const int rb = u % 34, h = (u / 34) & 3, bl = u / 136; ret_out_unit(p, l, bl, h, rb, ldsc);
    }
    if (l == 0) {
        for (;;) {
            const int u = wq_next(counter + 256, wq); if (u >= NB * 4) break;
            const int h = u & 3, bl = u >> 2; const size_t Rb = (size_t)bl * LTOK;
            attn_unit<96>(((bf16_t*)(p->ws + WS_QA)) + Rb * 384 + h * 96, 384, ((bf16_t*)(p->ws + WS_KA)) + Rb * 384 + h * 96, 384, ((bf16_t*)(p->ws + WS_VA)) + Rb * 256 + h * 64, 256, 256, CTXL, ((bf16_t*)(p->ws + WS_OUTS)) + ((size_t)0 * TG + Rb) * 256 + h * 64, 256, ldsc);
        }
        for (;;) {
            const int u = wq_next(counter + 320, wq); if (u >= NB * 8) break;
            const int ty = u & 1, h = (u >> 1) & 3, bl = u >> 3; const size_t Rb = (size_t)bl * LTOK;
            const bf16_t* Q = ty ? ((bf16_t*)(p->ws + WS_PROJ)) + Rb * PLD + C_NQ + h * 64 : ((bf16_t*)(p->ws + WS_GQ)) + Rb * 256 + h * 64;
            const bf16_t* K = ty ? ((bf16_t*)(p->ws + WS_PROJ)) + Rb * PLD + C_NK + h * 64 : ((bf16_t*)(p->ws + WS_GK)) + Rb * 128 + (h >> 1) * 64;
            const bf16_t* V = ty ? ((bf16_t*)(p->ws + WS_PROJ)) + Rb * PLD + C_NV + h * 64 : ((bf16_t*)(p->ws + WS_PROJ)) + Rb * PLD + C_GV + (h >> 1) * 64;
            attn_unit<64>(Q, ty ? PLD : 256, K, ty ? PLD : 128, V, PLD, 256, CTXL, ((bf16_t*)(p->ws + WS_OUTS)) + ((size_t)(1 + ty) * TG + Rb) * 256 + h * 64, 256, ldsc);
        }
    }
}

template <int MI>
__device__ __forceinline__ void p5_tile(KP p, int l, char* lds, int pm, int pn, int rsub)
{
    const int tid = get_tid(), lane = tid & 63, wid = tid >> 6, wm = wid >> 1, wn = wid & 1, fr = lane & 15, fq = lane >> 4;
    const int arow = tid >> 3, akc = tid & 7, a_l = arow * G_LDP + akc * 16;
    const int aoff = (wm * 16 * MI + fr) * G_LDP + fq * 16, boff = G_ABYTES + (wn * 64 + fr) * G_LDP + fq * 16;
    const bf16_t* OUTS = (const bf16_t*)(p->ws + WS_OUTS);
    const bf16_t* WB = (const bf16_t*)(p->ws + WS_WBT) + (size_t)l * 4 * DM * 256;
    const int rbase = pm * 256 + rsub;
    {
        const bf16_t* ag = OUTS + ((size_t)rbase + arow) * 256 + akc * 8;
        const bf16_t* bg = WB + ((size_t)pn * G_BN + arow) * 256 + akc * 8;
        const unsigned char* gp = (const unsigned char*)(p->ws + WS_GATE8) + (size_t)(rbase + wm * 16 * MI + fr) * 4096 + pn * G_BN + wn * 64 + fq * 16;
        f32x4 acc[MI][4]; zero_acc<MI>(acc);
        u32x2 totp[MI][4];
#pragma unroll
        for (int mi = 0; mi < MI; ++mi)
#pragma unroll
            for (int ni = 0; ni < 4; ++ni) totp[mi][ni] = (u32x2){0u, 0u};
        u32x4 sa[2][MI], sb[2][2];
        u32x4 gwv[MI];
#define P5_LOAD(SET, KT) do { const bf16_t* a2_ = ag + (size_t)((KT) >> 2) * TG * 256 + ((KT) & 3) * 64; const bf16_t* b2_ = bg + (size_t)((KT) >> 2) * DM * 256 + ((KT) & 3) * 64; \
            _Pragma("unroll") for (int i_ = 0; i_ < MI; ++i_) sa[SET][i_] = *(const u32x4*)(a2_ + (size_t)(64 * i_) * 256); \
            _Pragma("unroll") for (int i_ = 0; i_ < 2; ++i_) sb[SET][i_] = *(const u32x4*)(b2_ + (size_t)(64 * i_) * 256); } while (0)
#define P5_STORE(SET, BO) do { \
            _Pragma("unroll") for (int i_ = 0; i_ < MI; ++i_) *(u32x4*)(lds + (BO) + a_l + i_ * 64 * G_LDP) = sa[SET][i_]; \
            _Pragma("unroll") for (int i_ = 0; i_ < 2; ++i_) *(u32x4*)(lds + (BO) + G_ABYTES + a_l + i_ * 64 * G_LDP) = sb[SET][i_]; } while (0)
        P5_LOAD(0, 0);
        __syncthreads();
        P5_STORE(0, 0);
        P5_LOAD(0, 1); P5_LOAD(1, 2);
        __syncthreads();
#pragma unroll 1
        for (int sg = 0; sg < 4; ++sg) {
#pragma unroll
            for (int q4 = 0; q4 < 4; ++q4) {
                const int par = q4 & 1, kt = 4 * sg + q4, cur = par * G_STAGE, nxt = (par ^ 1) * G_STAGE;
#pragma unroll
                for (int ks = 0; ks < 2; ++ks) {
                    bf16x8 af[MI], bfr[4];
#pragma unroll
                    for (int mi = 0; mi < MI; ++mi) af[mi] = *(const bf16x8*)(lds + cur + aoff + mi * 16 * G_LDP + ks * 64);
#pragma unroll
                    for (int ni = 0; ni < 4; ++ni) bfr[ni] = *(const bf16x8*)(lds + cur + boff + ni * 16 * G_LDP + ks * 64);
#pragma unroll
                    for (int mi = 0; mi < MI; ++mi)
#pragma unroll
                        for (int ni = 0; ni < 4; ++ni) acc[mi][ni] = __builtin_amdgcn_mfma_f32_16x16x32_bf16(bfr[ni], af[mi], acc[mi][ni], 0, 0, 0);
                }
                if (q4 == 1) {
#pragma unroll
                    for (int mi = 0; mi < MI; ++mi)
                        gwv[mi] = *(const u32x4*)(gp + (size_t)(mi * 16) * 4096 + sg * DM);
                    __builtin_amdgcn_sched_barrier(0);
                }
                P5_STORE(par, nxt);
                { const int kn = (kt + 3 < 16) ? kt + 3 : 15; P5_LOAD(par, kn); }
                __syncthreads();
                if (q4 == 3) {
                    __builtin_amdgcn_sched_barrier(0);
#pragma unroll
                    for (int mi = 0; mi < MI; ++mi)
#pragma unroll
                        for (int ni = 0; ni < 4; ++ni) {
                            const unsigned gw = gwv[mi][ni];
                            const u32x2 tp = totp[mi][ni];
                            const float t0 = fmaf((float)((gw >> 0) & 255u), acc[mi][ni][0], bflo(tp.x)), t1 = fmaf((float)((gw >> 8) & 255u), acc[mi][ni][1], bfhi(tp.x));
                            const float t2 = fmaf((float)((gw >> 16) & 255u), acc[mi][ni][2], bflo(tp.y)), t3 = fmaf((float)((gw >> 24) & 255u), acc[mi][ni][3], bfhi(tp.y));
                            totp[mi][ni] = (u32x2){pack_bf16(t0, t1), pack_bf16(t2, t3)};
                            acc[mi][ni] = (f32x4){0.f, 0.f, 0.f, 0.f};
                        }
                }
            }
        }
#undef P5_LOAD
#undef P5_STORE
#pragma unroll
        for (int mi = 0; mi < MI; ++mi)
#pragma unroll
            for (int ni = 0; ni < 4; ++ni) {
                const u32x2 tp = totp[mi][ni]; const float k255 = 1.f / 255.f;
                *(u32x2*)(((bf16_t*)(p->ws + WS_ACC)) + (size_t)(rbase + wm * 16 * MI + mi * 16 + fr) * DM + pn * G_BN + wn * 64 + ni * 16 + fq * 4) =
                    (u32x2){pack_bf16(bflo(tp.x) * k255, bfhi(tp.x) * k255), pack_bf16(bflo(tp.y) * k255, bfhi(tp.y) * k255)};
            }
    }
}

__device__ __forceinline__ void phase_p5(KP p, int l, char* lds, int bid, int nblk)
{
    constexpr int tn = DM / G_BN, total = (TG / 256) * tn, NG8 = (TG / 256) / 8;
    const bool xord = (nblk == 256) && (tn == 8) && ((TG / 256) % 8 == 0);
    if (xord) {
        constexpr int NFULL = (NG8 % 4 == 1) ? NG8 / 4 : (NG8 + 3) / 4;
#pragma unroll 1
        for (int it = 0; it < NFULL; ++it) {
            const int g8 = it * 4 + (bid >> 6); if (g8 >= NG8) break;
            p5_tile<4>(p, l, lds, g8 * 8 + (bid & 7), (bid >> 3) & 7, 0);
        }
        if (NG8 % 4 == 1) p5_tile<1>(p, l, lds, (NG8 - 1) * 8 + (bid & 7), (bid >> 3) & 7, (bid >> 6) * 64);
    } else {
        for (int t = bid; t < total; t += nblk) p5_tile<4>(p, l, lds, t / tn, t % tn, 0);
    }
}

struct EpiResid {
    KP p; int l, g, goff;
    __device__ __forceinline__ void operator()(int row, int col, f32x4 v) const {
        const int bl = row / LTOK, t = row - bl * LTOK, b = g * NB + bl;
        float* dst; const float* src; int mr;
        if (t < CTXL) { if (l != 0) return; const size_t o = ((size_t)b * CTXL + t) * DM + col; dst = ((float*)(p->ws + WS_CTXS)) + o; src = p->ctx + o; mr = 16; }
        else { const size_t o = ((size_t)b * SEQ + (t - CTXL)) * DM + col; dst = p->out + o; src = (l == 0) ? p->x + o : (const float*)dst; mr = b; }
        const f32x4 gg = *(const f32x4*)(((float*)(p->ws + WS_MOD)) + ((size_t)l * 17 + mr) * 6144 + goff + col);
        f32x4 s = *(const f32x4*)src;
#pragma unroll
        for (int j = 0; j < 4; ++j) s[j] += gg[j] * v[j];
        *(f32x4*)dst = s;
    }
};

__device__ __forceinline__ void grid_barrier();
#if MK_ONE_LAUNCH
#define P9_GRID_SYNC() grid_barrier()
#else
#define P9_GRID_SYNC() __syncthreads()
#endif
typedef __bf16 bf16pair __attribute__((ext_vector_type(2)));
__device__ __forceinline__ float dot2bf(unsigned a, unsigned b, float c) { return __builtin_amdgcn_fdot2_f32_bf16(__builtin_bit_cast(bf16pair, a), __builtin_bit_cast(bf16pair, b), c, false); }
__device__ __forceinline__ unsigned f2ord(float f) { const unsigned b = __float_as_uint(f); return b ^ ((unsigned)((int)b >> 31) | 0x80000000u); }
__device__ __forceinline__ int mbcnt64(unsigned long long m) { return (int)__builtin_amdgcn_mbcnt_hi((unsigned)(m >> 32), __builtin_amdgcn_mbcnt_lo((unsigned)m, 0u)); }

__device__ __forceinline__ float ord2f(unsigned u) { return __uint_as_float((u & 0x80000000u) ? (u ^ 0x80000000u) : ~u); }

__device__ __forceinline__ void cx_desc(unsigned& a, unsigned& b) { const unsigned hi = a > b ? a : b, lo = a > b ? b : a; a = hi; b = lo; }
template <int N, int OFF, bool DESC, int M>
__device__ __forceinline__ void bitonic_sort(unsigned (&a)[M]) {
#pragma unroll
    for (int k = 2; k <= N; k <<= 1)
#pragma unroll
        for (int j = k >> 1; j > 0; j >>= 1)
#pragma unroll
            for (int i = 0; i < N; ++i) {
                const int l = i ^ j;
                if (l > i) { const bool up = ((i & k) == 0) != DESC; if (up) cx_desc(a[OFF + l], a[OFF + i]); else cx_desc(a[OFF + i], a[OFF + l]); }
            }
}
__device__ __forceinline__ void bitonic_merge16_desc(unsigned (&a)[16]) {
#pragma unroll
    for (int j = 8; j > 0; j >>= 1)
#pragma unroll
        for (int i = 0; i < 16; ++i) { const int l = i ^ j; if (l > i) cx_desc(a[i], a[l]); }
}
template <int XM>
__device__ __forceinline__ void merge_partner16(unsigned (&a)[16], bool upper) {
    unsigned b[16];
#pragma unroll
    for (int i = 0; i < 16; ++i) b[i] = (XM == 32) ? get_xor32_u(a[15 - i], upper) : xor_swz_u<XM & 31>(a[15 - i]);
#pragma unroll
    for (int i = 0; i < 16; ++i) a[i] = a[i] > b[i] ? a[i] : b[i];
    bitonic_merge16_desc(a);
}

#define P9_KEYP 144
#define P9_NTOK 136
#define P9_HG 3
#define P9_LKEY 0
#define P9_LIDX (P9_HG * 2 * 128 * P9_KEYP)
#define P9_LSTASH 0
__device__ __forceinline__ constexpr int p9_pair_i(int pi) {
    return pi < 16 ? 0 : pi < 24 ? 1 : pi < 29 ? 2 : pi < 33 ? 3 : pi < 36 ? 4 : pi < 38 ? 5 : pi < 40 ? 6 : pi < 42 ? 7 : pi < 50 ? pi - 34 : 0;
}
__device__ __forceinline__ constexpr int p9_pair_j(int pi) {
    return pi < 16 ? pi : pi < 24 ? pi - 16 : pi < 29 ? pi - 24 : pi < 33 ? pi - 29 : pi < 36 ? pi - 33 : pi < 38 ? pi - 36 : pi < 40 ? pi - 38 : pi < 42 ? pi - 40 : 0;
}
__device__ __forceinline__ void phase_p9(KP p, int l, int g, char* lds, int bid, int nblk)
{
    const int tid = get_tid(), wid = tid >> 6;
    const bf16_t* KEYB = (const bf16_t*)(p->ws + WS_KEYB) + (size_t)l * 8 * 2 * 128 * 64;
    const bf16_t* PQ = (const bf16_t*)(p->ws + WS_PQ);
    unsigned* stash = (unsigned*)(lds + P9_LSTASH);
    const int nit = (TG / P9_NTOK + nblk - 1) / nblk;
    for (int it = 0; it < nit; ++it) {
        const int blk = bid + it * nblk;
        if (blk >= TG / P9_NTOK) { P9_GRID_SYNC(); P9_GRID_SYNC(); continue; }
        const int row0 = blk * P9_NTOK;
        unsigned* gst = (unsigned*)(p->ws + WS_PROJ) + (size_t)row0 * 128;
#pragma unroll 1
        for (int h0 = 0; h0 < 8; h0 += P9_HG) {
            const int nh = (8 - h0) < P9_HG ? (8 - h0) : P9_HG;
            __syncthreads();
            for (int c = tid; c < nh * 2048; c += NTHREADS) { const int row = c >> 3, cc = c & 7;
                *(u32x4*)(lds + P9_LKEY + row * P9_KEYP + cc * 16) = *(const u32x4*)(KEYB + ((size_t)h0 * 256 + row) * 64 + cc * 8); }
            __syncthreads();
#pragma unroll 1
            for (int item = wid; item < 9 * nh; item += 8) {
                const int tile = item % 9, hh = item / 9, h = h0 + hh;
                const int LK = P9_LKEY + hh * 256 * P9_KEYP;
                const int tidh = get_tid(), tk = tidh & 15, qd = (tidh >> 4) & 3;
                const int ntile = (P9_NTOK - 16 * tile) < 16 ? (P9_NTOK - 16 * tile) : 16;
                const int trow = row0 + 16 * tile + (tk < ntile ? tk : ntile - 1);
                unsigned* idxl = (unsigned*)(lds + P9_LIDX) + (wid * 16 + tk) * 33;
                unsigned top[2][16];
#pragma unroll
                for (int pp = 0; pp < 2; ++pp) {
                    f32x4 acc[8];
#pragma unroll
                    for (int t = 0; t < 8; ++t) acc[t] = (f32x4){0.f, 0.f, 0.f, 0.f};
#pragma unroll
                    for (int ks = 0; ks < 2; ++ks) {
                        const bf16x8 qfr = *(const bf16x8*)(PQ + (size_t)trow * DM + h * 128 + pp * 64 + ks * 32 + qd * 8);
#pragma unroll
                        for (int t = 0; t < 8; ++t) {
                            const bf16x8 kfr = *(const bf16x8*)(lds + LK + (pp * 128 + t * 16 + tk) * P9_KEYP + ks * 64 + qd * 16);
                            acc[t] = __builtin_amdgcn_mfma_f32_16x16x32_bf16(kfr, qfr, acc[t], 0, 0, 0);
                        }
                    }
                    unsigned ck[32];
#pragma unroll
                    for (int t = 0; t < 8; ++t)
#pragma unroll
                        for (int jj = 0; jj < 4; ++jj) ck[t * 4 + jj] = (f2ord(acc[t][jj]) & 0xFFFFFF80u) | (unsigned)(16 * t + jj) | ((unsigned)qd << 2);
                    bitonic_sort<16, 0, true>(ck);
                    bitonic_sort<16, 16, false>(ck);
                    unsigned (&tp)[16] = top[pp];
#pragma unroll
                    for (int i = 0; i < 16; ++i) tp[i] = ck[i] > ck[16 + i] ? ck[i] : ck[16 + i];
                    bitonic_merge16_desc(tp);
                    merge_partner16<16>(tp, false); merge_partner16<32>(tp, (qd & 2) != 0);
                    if (qd == 0) {
#pragma unroll
                        for (int i = 0; i < 16; ++i) idxl[pp * 16 + i] = tp[i] & 127u;
                    }
                }
                float v1[16], v2[16];
#pragma unroll
                for (int i = 0; i < 16; ++i) { v1[i] = ord2f(top[0][i] & 0xFFFFFF80u); v2[i] = ord2f(top[1][i] & 0xFFFFFF80u); }
                unsigned cand[16];
#pragma unroll
                for (int n = 0; n < 13; ++n) {
                    const unsigned k0 = (f2ord(v1[p9_pair_i(4 * n)] + v2[p9_pair_j(4 * n)]) & 0xFFFFFF00u) | (unsigned)(p9_pair_i(4 * n) * 16 + p9_pair_j(4 * n));
                    const unsigned k1 = (f2ord(v1[p9_pair_i(4 * n + 1)] + v2[p9_pair_j(4 * n + 1)]) & 0xFFFFFF00u) | (unsigned)(p9_pair_i(4 * n + 1) * 16 + p9_pair_j(4 * n + 1));
                    const unsigned k2 = (4 * n + 2 < 50) ? ((f2ord(v1[p9_pair_i(4 * n + 2)] + v2[p9_pair_j(4 * n + 2)]) & 0xFFFFFF00u) | (unsigned)(p9_pair_i(4 * n + 2) * 16 + p9_pair_j(4 * n + 2))) : 0u;
                    const unsigned k3 = (4 * n + 3 < 50) ? ((f2ord(v1[p9_pair_i(4 * n + 3)] + v2[p9_pair_j(4 * n + 3)]) & 0xFFFFFF00u) | (unsigned)(p9_pair_i(4 * n + 3) * 16 + p9_pair_j(4 * n + 3))) : 0u;
                    cand[n] = qd == 0 ? k0 : (qd == 1 ? k1 : (qd == 2 ? k2 : k3));
                }
                cand[13] = 0u; cand[14] = 0u; cand[15] = 0u;
                bitonic_sort<16, 0, true>(cand);
                merge_partner16<16>(cand, false); merge_partner16<32>(cand, (qd & 2) != 0);
                const float mx = ord2f(cand[0] & 0xFFFFFF00u);
                float ex[16], den = 0.f;
#pragma unroll
                for (int k = 0; k < 16; ++k) { ex[k] = __expf(ord2f(cand[k] & 0xFFFFFF00u) - mx); den += ex[k]; }
                const float inv = 1.f / den;
                if (qd == 0 && tk < ntile) {
#pragma unroll
                    for (int k = 0; k < 16; ++k) {
                        const unsigned e = idxl[(cand[k] >> 4) & 15u] * 128u + idxl[16 + (cand[k] & 15u)];
                        gst[((16 * tile + tk) * 8 + h) * 16 + k] = (e << 16) | (unsigned)f2bf(ex[k] * inv);
                    }
                }
            }
        }
        P9_GRID_SYNC();
        {
            const u32x4* src = (const u32x4*)gst; u32x4* dstl = (u32x4*)(lds + P9_LSTASH);
            for (int c = get_tid(); c < P9_NTOK * 128 / 4; c += NTHREADS) dstl[c] = src[c];
            __syncthreads();
        }
        {
            const int tid2 = get_tid(), lane = tid2 & 63, wid2 = tid2 >> 6;
            KP p2 = get_kp();
            const unsigned char* UB = (const unsigned char*)(p2->ws + WS_UB) + (size_t)l * 16384 * (DM / 2);
            const float* USC = (const float*)(p2->ws + WS_USC) + (size_t)l * 16384; const float* VSC = (const float*)(p2->ws + WS_VSC) + (size_t)l * 16384;
            const float* URS = (const float*)(p2->ws + WS_URS) + (size_t)l * 16384;
            const bf16_t* Hh = HG(p2, g);
#pragma unroll 1
            for (int slot = wid2; slot < P9_NTOK; slot += 8) {
                const int r = row0 + slot;
                if ((r % LTOK) < CTXL && l != 0) continue;
                const u32x4 x0 = *(const u32x4*)(Hh + (size_t)r * DM + lane * 16), x1 = *(const u32x4*)(Hh + (size_t)r * DM + lane * 16 + 8);
                unsigned HW0 = 0u, HW1 = 0u, LW0 = 0u, LW1 = 0u; float sx;
                {
                    float xf[16];
                    xf[0] = bflo(x0.x); xf[1] = bfhi(x0.x); xf[2] = bflo(x0.y); xf[3] = bfhi(x0.y); xf[4] = bflo(x0.z); xf[5] = bfhi(x0.z); xf[6] = bflo(x0.w); xf[7] = bfhi(x0.w);
                    xf[8] = bflo(x1.x); xf[9] = bfhi(x1.x); xf[10] = bflo(x1.y); xf[11] = bfhi(x1.y); xf[12] = bflo(x1.z); xf[13] = bfhi(x1.z); xf[14] = bflo(x1.w); xf[15] = bfhi(x1.w);
                    float am = 0.f;
#pragma unroll
                    for (int i = 0; i < 16; ++i) am = fmaxf(am, fabsf(xf[i]));
                    am = wave_max(am);
                    sx = am > 0.f ? am * (1.f / 127.f) : 1.f;
                    const float ix = 1.f / sx;
#pragma unroll
                    for (int i = 0; i < 16; ++i) {
                        const int v_ = (int)fminf(fmaxf(__builtin_rintf(xf[i] * ix), -128.f), 127.f) + 128;
                        const unsigned hs = (unsigned)((v_ >> 4) - 8) & 15u, ls = (unsigned)((v_ & 15) - 8) & 15u;
                        if (i < 8) { HW0 |= hs << (4 * i); LW0 |= ls << (4 * i); } else { HW1 |= hs << (4 * (i - 8)); LW1 |= ls << (4 * (i - 8)); }
                    }
                }
#pragma unroll 1
                for (int h = 0; h < 8; ++h) {
                    unsigned* st = stash + (slot * 8 + h) * 16;
                    int d[16];
                    const int kk = (lane >> 2) & 15;
                    const unsigned sk = st[kk];
                    const float su = USC[sk >> 16], svs = VSC[sk >> 16], urs = URS[sk >> 16];
                    {
                        u32x2 ua[16];
#pragma unroll
                        for (int k = 0; k < 16; ++k) ua[k] = *(const u32x2*)(UB + (size_t)(st[k] >> 16) * (DM / 2) + lane * 8);
#pragma unroll
                        for (int k = 0; k < 16; ++k) {
                            int dh = __builtin_amdgcn_sdot8((int)ua[k].x, (int)HW0, 0, false); dh = __builtin_amdgcn_sdot8((int)ua[k].y, (int)HW1, dh, false);
                            int dl = __builtin_amdgcn_sdot8((int)ua[k].x, (int)LW0, 0, false); dl = __builtin_amdgcn_sdot8((int)ua[k].y, (int)LW1, dl, false);
                            d[k] = 16 * dh + dl;
                        }
                    }
                    int r8[8], r4[4], r2[2], ri;
#pragma unroll
                    for (int i = 0; i < 8; ++i) { const u32x2 sw = __builtin_amdgcn_permlane32_swap((unsigned)d[i], (unsigned)d[i + 8], false, false); r8[i] = (int)sw.x + (int)sw.y; }
#pragma unroll
                    for (int i = 0; i < 4; ++i) { const u32x2 sw = __builtin_amdgcn_permlane16_swap((unsigned)r8[i], (unsigned)r8[i + 4], false, false); r4[i] = (int)sw.x + (int)sw.y; }
                    { const bool bb = (lane & 8) != 0;
#pragma unroll
                      for (int i = 0; i < 2; ++i) { const int snd = bb ? r4[i] : r4[i + 2], keep = bb ? r4[i + 2] : r4[i]; r2[i] = keep + (int)xor_swz_u<8>((unsigned)snd); } }
                    { const bool bb = (lane & 4) != 0; const int snd = bb ? r2[0] : r2[1], keep = bb ? r2[1] : r2[0]; ri = keep + (int)xor_swz_u<4>((unsigned)snd); }
                    ri += (int)xor_swz_u<2>((unsigned)ri); ri += (int)xor_swz_u<1>((unsigned)ri);
                    float r1 = ((float)ri + urs) * (su * sx);
                    const float cf = bflo(sk) * 0.5f * r1 * (1.f + erff(r1 * 0.70710678118654752f)) * svs;
                    if ((lane & 3) == 0) st[kk] = (sk & 0xffff0000u) | (unsigned)f2bf(cf);
                }
            }
        }
        P9_GRID_SYNC();
        {
            const int tid2 = get_tid(), lane = tid2 & 63, wid2 = tid2 >> 6;
            KP p2 = get_kp();
            const unsigned char* VB = (const unsigned char*)(p2->ws + WS_VB) + (size_t)l * 16384 * (DM / 2);
#pragma unroll 1
            for (int slot = wid2; slot < P9_NTOK; slot += 8) {
                const int r = row0 + slot;
                const int bl = r / LTOK, t = r - bl * LTOK, b = g * NB + bl;
                if (t < CTXL && l != 0) continue;
                float* dst; int mr;
                if (t < CTXL) { dst = ((float*)(p2->ws + WS_CTXS)) + ((size_t)b * CTXL + t) * DM; mr = 16; } else { dst = p2->out + ((size_t)b * SEQ + (t - CTXL)) * DM; mr = b; }
                const float* g2 = ((float*)(p2->ws + WS_MOD)) + ((size_t)l * 17 + mr) * 6144 + 5120;
                f32x4 sv[4];
#pragma unroll
                for (int i = 0; i < 4; ++i) sv[i] = *(const f32x4*)(dst + lane * 16 + i * 4);
                float outv[16];
#pragma unroll
                for (int i = 0; i < 16; ++i) outv[i] = 0.f;
#pragma unroll 1
                for (int h = 0; h < 8; ++h) {
                    const unsigned* st = stash + (slot * 8 + h) * 16;
                    u32x2 va[16]; unsigned sk[16];
#pragma unroll
                    for (int k = 0; k < 16; ++k) { sk[k] = st[k]; va[k] = *(const u32x2*)(VB + (size_t)(sk[k] >> 16) * (DM / 2) + lane * 8); }
#pragma unroll
                    for (int k = 0; k < 16; ++k) {
                        const float ck = bflo(sk[k]);
#define P9_VFMA(W, B) { const f32x2 t_ = __builtin_amdgcn_cvt_scalef32_pk_f32_fp4(va[k][W], 1.0f, B); outv[8 * (W) + 2 * (B)] += ck * t_.x; outv[8 * (W) + 2 * (B) + 1] += ck * t_.y; }
                        P9_VFMA(0, 0) P9_VFMA(0, 1) P9_VFMA(0, 2) P9_VFMA(0, 3) P9_VFMA(1, 0) P9_VFMA(1, 1) P9_VFMA(1, 2) P9_VFMA(1, 3)
#undef P9_VFMA
                        if ((k & 3) == 3) __builtin_amdgcn_sched_barrier(0);
                    }
                }
                const int lane = get_tid() & 63;
                float ss = 0.f;
#pragma unroll
                for (int i = 0; i < 4; ++i) {
                    const f32x4 gg = *(const f32x4*)(g2 + lane * 16 + i * 4);
#pragma unroll
                    for (int jj = 0; jj < 4; ++jj) { sv[i][jj] += gg[jj] * outv[i * 4 + jj]; ss += sv[i][jj] * sv[i][jj]; }
                }
                if (l == 0) {
                    const float rstd0 = rsqrtf(wave_sum(ss) * (1.f / DM) + EPSF);
                    const float* md1 = ((float*)(p2->ws + WS_MOD)) + ((size_t)17 + mr) * 6144;
                    bf16_t* hrow = HG(p2, g) + (size_t)r * DM + lane * 16;
#pragma unroll
                    for (int i = 0; i < 4; ++i) {
                        const int c = lane * 16 + i * 4;
                        const f32x4 w1 = *(const f32x4*)(p2->norm1_w + DM + c), sc = *(const f32x4*)(md1 + 1024 + c), sh = *(const f32x4*)(md1 + c);
                        f32x4 y;
#pragma unroll
                        for (int jj = 0; jj < 4; ++jj) y[jj] = sv[i][jj] * rstd0 * w1[jj] * (1.f + sc[jj]) + sh[jj];
                        store_bf16x4(hrow + i * 4, y);
                    }
                }
                if (l == 1) {
                    ss = wave_sum(ss);
                    const float rstd = rsqrtf(ss * (1.f / DM) + EPSF);
#pragma unroll
                    for (int i = 0; i < 4; ++i) { const f32x4 fw = *(const f32x4*)(p2->final_w + lane * 16 + i * 4);
#pragma unroll
                        for (int jj = 0; jj < 4; ++jj) sv[i][jj] *= rstd * fw[jj]; }
                }
#pragma unroll
                for (int i = 0; i < 4; ++i) *(f32x4*)(dst + lane * 16 + i * 4) = sv[i];
            }
        }
    }
}

__device__ __forceinline__ void phase_final(KP p, int bid, int nblk)
{
    const int lane = get_tid() & 63, wid = get_tid() >> 6;
    for (int r = bid * 8 + wid; r < NBATCH * SEQ; r += nblk * 8) {
        float* src = p->out + (size_t)r * DM;
        f32x4 v[4]; float ss = 0.f;
#pragma unroll
        for (int i = 0; i < 4; ++i) { v[i] = *(const f32x4*)(src + i * 256 + lane * 4); ss += v[i][0] * v[i][0] + v[i][1] * v[i][1] + v[i][2] * v[i][2] + v[i][3] * v[i][3]; }
        ss = wave_sum(ss);
        const float rstd = rsqrtf(ss * (1.f / DM) + EPSF);
#pragma unroll
        for (int i = 0; i < 4; ++i) {
            const f32x4 w = *(const f32x4*)(p->final_w + i * 256 + lane * 4);
            f32x4 y;
#pragma unroll
            for (int j = 0; j < 4; ++j) y[j] = v[i][j] * rstd * w[j];
            *(f32x4*)(src + i * 256 + lane * 4) = y;
        }
    }
}

template <int PH>
__device__ __forceinline__ void run_phase(KP p, int l, int g, char* lds, int bid, int nblk)
{
    asm volatile("" : "+s"(l), "+s"(g), "+s"(bid), "+s"(nblk));
    if constexpr (PH == 0) phase_prologue(p, lds, bid, nblk);
    if constexpr (PH == 1) { for (int gg = 0; gg < NGROUP; ++gg) phase_norm(p, 0, gg, 0, bid, nblk); }
    if constexpr (PH == 2) big_gemm(HG(p, g), ((bf16_t*)(p->ws + WS_WINT)) + (size_t)l * NPROJ * DM, TG, NPROJ, DM, Epi8<EpiProj8>{EpiProj8{((bf16_t*)(p->ws + WS_PROJ)), (unsigned char*)(p->ws + WS_GATE8)}}, lds, bid, nblk);
    if constexpr (PH == 3) phase_p3a(p, l, bid, nblk, lds);
    if constexpr (PH == 4) phase_p3b(p, l, bid, nblk);
    if constexpr (PH == 6) phase_p4(p, l, g, lds, bid, nblk);
    if constexpr (PH == 7) phase_p5(p, l, lds, bid, nblk);
    if constexpr (PH == 8) big_gemm(((bf16_t*)(p->ws + WS_ACC)), ((bf16_t*)(p->ws + WS_WOUTT)) + (size_t)l * DM * DM, TG, DM, DM, Epi4<EpiResid>{EpiResid{p, l, g, 2048}}, lds, bid, nblk);
    if constexpr (PH == 9) phase_norm(p, l, g, 1, bid, nblk);
    if constexpr (PH == 10) big_gemm(HG(p, g), ((bf16_t*)(p->ws + WS_WQT)) + (size_t)l * DM * DM, TG, DM, DM, Epi8<EpiStore8>{EpiStore8{((bf16_t*)(p->ws + WS_PQ)), DM}}, lds, bid, nblk);
    if constexpr (PH == 11) phase_p9(p, l, g, lds, bid, nblk);
    if constexpr (PH == 12) phase_final(p, bid, nblk);
}


__device__ __forceinline__ void grid_barrier() {
    XcdBarrier b; b.bar = (unsigned*)(get_kp()->ws + WS_BAR); b.x = xb_xcc_id(); b.st = (volatile LAS unsigned*)smem;
    xcd_barrier(b);
}

template <int PH>
__global__ void __launch_bounds__(NTHREADS, 2) k_phase(Params p_unused, int l, int g)
{
    (void)p_unused;
    tid_setup();
    run_phase<PH>(get_kp(), l, g, smem + 512, blockIdx.x, gridDim.x);
}

#if MK_ONE_LAUNCH
__global__ void __launch_bounds__(NTHREADS, 2) k_mega(Params p_unused)
{
    (void)p_unused;
    tid_setup();
    if (get_tid() == 0) *(uint4*)smem = make_uint4(0u, 0u, 0u, 0u);
    __syncthreads();
    (void)xcd_barrier_post((unsigned*)(get_kp()->ws + WS_BAR), (volatile LAS unsigned*)smem);
    char* lds = smem + 512;
    const int bid = blockIdx.x, nblk = gridDim.x;
    run_phase<0>(get_kp(), 0, 0, lds, bid, nblk);
    grid_barrier();
#define MK_LG(L_, G_) do { \
        run_phase<2>(get_kp(), L_, G_, lds, bid, nblk); grid_barrier(); \
        run_phase<3>(get_kp(), L_, G_, lds, bid, nblk); grid_barrier(); \
        run_phase<4>(get_kp(), L_, G_, lds, bid, nblk); grid_barrier(); \
        run_phase<6>(get_kp(), L_, G_, lds, bid, nblk); grid_barrier(); \
        run_phase<7>(get_kp(), L_, G_, lds, bid, nblk); grid_barrier(); \
        run_phase<8>(get_kp(), L_, G_, lds, bid, nblk); grid_barrier(); \
        run_phase<9>(get_kp(), L_, G_, lds, bid, nblk); grid_barrier(); \
        run_phase<10>(get_kp(), L_, G_, lds, bid, nblk); grid_barrier(); \
        run_phase<11>(get_kp(), L_, G_, lds, bid, nblk); grid_barrier(); } while (0)
    run_phase<1>(get_kp(), 0, 0, lds, bid, nblk); grid_barrier();
    static_assert(NGROUP == 2, "phase program written out for two groups");
    MK_LG(0, 0); MK_LG(0, 1); MK_LG(1, 0); MK_LG(1, 1);
#undef MK_LG
}
#endif

static inline size_t al256(size_t x) { return (x + 255) & ~(size_t)255; }

template <int PH>
static void launch_phase(const Params& p, int l, int g, int grid, hipStream_t s)
{
    static bool attr = false;
    if (!attr) { (void)hipFuncSetAttribute((const void*)k_phase<PH>, hipFuncAttributeMaxDynamicSharedMemorySize, LDS_BYTES); attr = true; }
    hipLaunchKernelGGL(k_phase<PH>, dim3(grid), dim3(NTHREADS), LDS_BYTES, s, p, l, g);
}

extern "C" void kernel_launch(void* const* d_in, const int* in_sizes, int n_in, void* d_out, int out_size, void* d_ws, size_t ws_size, hipStream_t stream)
{
    (void)in_sizes; (void)n_in; (void)out_size;
    Params p{};
    p.x = (const float*)d_in[0]; p.c = (const float*)d_in[1]; p.ctx = (const float*)d_in[2]; p.c_ctx = (const float*)d_in[3];
    p.mod_w = (const float*)d_in[4]; p.mod_b = (const float*)d_in[5]; p.norm1_w = (const float*)d_in[6]; p.norm2_w = (const float*)d_in[7];
    p.w_in = (const float*)d_in[8]; p.mla_qn = (const float*)d_in[9]; p.mla_wuq = (const float*)d_in[10]; p.mla_kvn = (const float*)d_in[11];
    p.mla_wukv = (const float*)d_in[12]; p.gqa_qn = (const float*)d_in[13]; p.gqa_kn = (const float*)d_in[14]; p.na_bias = (const float*)d_in[15];
    p.ret_logit = (const float*)d_in[16]; p.ret_gnw = (const float*)d_in[17]; p.w_branch = (const float*)d_in[18]; p.w_out = (const float*)d_in[19];
    p.peer_wq = (const float*)d_in[20]; p.peer_keys = (const float*)d_in[21]; p.peer_u = (const float*)d_in[22]; p.peer_v = (const float*)d_in[23];
    p.final_w = (const float*)d_in[24];
    p.out = (float*)d_out;
    p.ws = (char*)d_ws;
    if (WS_TOTAL > ws_size) { fprintf(stderr, "workspace too small: need %zu have %zu\n", (size_t)WS_TOTAL, ws_size); return; }
    (void)hipMemsetAsync(d_ws, 0, WS_ZERO_END, stream);

    static int ncu = 0;
    if (!ncu) { int dev = 0; (void)hipGetDevice(&dev); (void)hipDeviceGetAttribute(&ncu, hipDeviceAttributeMultiprocessorCount, dev); if (ncu <= 0) ncu = 256; }
#if MK_ONE_LAUNCH
    static bool attr = false;
    if (!attr) { (void)hipFuncSetAttribute((const void*)k_mega, hipFuncAttributeMaxDynamicSharedMemorySize, LDS_BYTES); attr = true; }
    hipLaunchKernelGGL(k_mega, dim3(ncu), dim3(NTHREADS), LDS_BYTES, stream, p);
#else
    const int grid = ncu;
    launch_phase<0>(p, 0, 0, grid, stream);
    for (int l = 0; l < 2; ++l)
        for (int g = 0; g < NGROUP; ++g) {
            if (l == 0 && g == 0) launch_phase<1>(p, l, g, grid, stream);
            launch_phase<2>(p, l, g, grid, stream);
            launch_phase<3>(p, l, g, grid, stream);
            launch_phase<4>(p, l, g, grid, stream);
            launch_phase<6>(p, l, g, grid, stream);
            launch_phase<7>(p, l, g, grid, stream);
            launch_phase<8>(p, l, g, grid, stream);
            launch_phase<9>(p, l, g, grid, stream);
            launch_phase<10>(p, l, g, grid, stream);
            launch_phase<11>(p, l, g, grid, stream);
        }
#endif
}
```

```cpp
#include <hip/hip_runtime.h>
#include <stdint.h>
#include <stdio.h>

#ifndef MK_ONE_LAUNCH
#define MK_ONE_LAUNCH 1
#endif

#define DM 1024
#define NBATCH 16
#define SEQ 4096
#define CTXL 256
#define LTOK 4352
#define IN_COLS 7072
#define NPROJ 7168
#define PLD 3072
#define NB 8
#define NGROUP (NBATCH / NB)
#define TG (NB * LTOK)
#define NTHREADS 512
#define LDS_BYTES 131648
#define EPSF 1e-6f

#define C_CQ 0
#define C_CKV 256
#define C_KPE 384
#define C_GQ 416
#define C_GK 672
#define C_GV 800
#define C_NQ 928
#define C_NK 1184
#define C_NV 1440
#define C_RQ 1696
#define C_RK 1952
#define C_RV 2208
#define C_RGF 2464
#define C_RGB 2720
#define C_GATE 2976

#define LAS __attribute__((address_space(3)))
typedef unsigned short bf16_t;
typedef short bf16x8 __attribute__((ext_vector_type(8)));
typedef float f32x4 __attribute__((ext_vector_type(4)));
typedef float f32x2 __attribute__((ext_vector_type(2)));
typedef __bf16 bf16x2_t __attribute__((ext_vector_type(2)));
typedef unsigned u32x4 __attribute__((ext_vector_type(4)));
typedef unsigned u32x2 __attribute__((ext_vector_type(2)));
typedef float f32x16 __attribute__((ext_vector_type(16)));
typedef short s16x4 __attribute__((ext_vector_type(4)));

__device__ __forceinline__ unsigned pack_bf16(float lo, float hi) { f32x2 v = {lo, hi}; bf16x2_t b = __builtin_convertvector(v, bf16x2_t); return __builtin_bit_cast(unsigned, b); }
__device__ __forceinline__ bf16_t f2bf(float f) { return (bf16_t)(pack_bf16(f, 0.f) & 0xffffu); }
__device__ __forceinline__ float bf2f(bf16_t b) { return __uint_as_float(((unsigned)b) << 16); }
__device__ __forceinline__ float bflo(unsigned w) { return __uint_as_float(w << 16); }
__device__ __forceinline__ float bfhi(unsigned w) { return __uint_as_float(w & 0xffff0000u); }
#define PEER_USCALE 128.f
#define PEER_VSCALE 16.f
__device__ __forceinline__ float clamp448(float x) { return fminf(fmaxf(x, -448.f), 448.f); }
__device__ __forceinline__ unsigned pack_fp8x4(f32x4 v, float sc) {
    int w = 0;
    w = __builtin_amdgcn_cvt_pk_fp8_f32(clamp448(v[0] * sc), clamp448(v[1] * sc), w, false);
    w = __builtin_amdgcn_cvt_pk_fp8_f32(clamp448(v[2] * sc), clamp448(v[3] * sc), w, true);
    return (unsigned)w;
}

template <int M> __device__ __forceinline__ float xor_swz(float v) { return __int_as_float(__builtin_amdgcn_ds_swizzle(__float_as_int(v), (M << 10) | 0x1f)); }
template <int M> __device__ __forceinline__ unsigned xor_swz_u(unsigned v) { return (unsigned)__builtin_amdgcn_ds_swizzle((int)v, (M << 10) | 0x1f); }
__device__ __forceinline__ float sum_xor32(float v) { const u32x2 r = __builtin_amdgcn_permlane32_swap(__float_as_uint(v), __float_as_uint(v), false, false); return __uint_as_float(r.x) + __uint_as_float(r.y); }
__device__ __forceinline__ float max_xor32(float v) { const u32x2 r = __builtin_amdgcn_permlane32_swap(__float_as_uint(v), __float_as_uint(v), false, false); return fmaxf(__uint_as_float(r.x), __uint_as_float(r.y)); }
__device__ __forceinline__ unsigned get_xor32_u(unsigned v, bool upper) { const u32x2 r = __builtin_amdgcn_permlane32_swap(v, v, false, false); return upper ? r.x : r.y; }
__device__ __forceinline__ float wave_max(float v) {
    v = fmaxf(v, xor_swz<1>(v)); v = fmaxf(v, xor_swz<2>(v)); v = fmaxf(v, xor_swz<4>(v)); v = fmaxf(v, xor_swz<8>(v)); v = fmaxf(v, xor_swz<16>(v));
    return max_xor32(v);
}
__device__ __forceinline__ float wave_sum(float v) {
    v += xor_swz<1>(v); v += xor_swz<2>(v); v += xor_swz<4>(v); v += xor_swz<8>(v); v += xor_swz<16>(v);
    return sum_xor32(v);
}
extern __shared__ __attribute__((aligned(16))) char smem[];
#define WIDTAB_OFF 64
__device__ __forceinline__ unsigned hw_wave_slot() { return (unsigned)__builtin_amdgcn_s_getreg((5 << 11) | 4) & 63u; }
__device__ __forceinline__ void tid_setup() {
    if ((threadIdx.x & 63) == 0) ((volatile LAS int*)(smem + WIDTAB_OFF))[hw_wave_slot()] = (int)(threadIdx.x >> 6);
    __syncthreads();
}
__device__ __forceinline__ int get_tid() {
    int lane; asm volatile("v_mbcnt_lo_u32_b32 %0, -1, 0\n\tv_mbcnt_hi_u32_b32 %0, -1, %0" : "=v"(lane));
    int w = ((volatile LAS int*)(smem + WIDTAB_OFF))[hw_wave_slot()];
    w = __builtin_amdgcn_readfirstlane(w);
    int t = (w << 6) | lane; asm volatile("" : "+v"(t)); return t;
}
__device__ __forceinline__ float siluf(float x) { return x * __builtin_amdgcn_rcpf(1.f + __builtin_amdgcn_exp2f(x * -1.4426950408889634f)); }
__device__ __forceinline__ float sigmf(float x) { return __builtin_amdgcn_rcpf(1.f + __builtin_amdgcn_exp2f(x * -1.4426950408889634f)); }

#define XB_TMO      128
#define XB_XCNT(j)  (256  + 64 * (j))
#define XB_XSUB(j)  (1280 + 64 * (j))
#define XB_XGEN(j)  (2304 + 64 * (j))
#define XB_TOP      3328
#define XB_TOPGEN   3392
#define XCD_BAR_WORDS 3456
#define XB_SPIN_CAP (1u << 18)

__device__ __forceinline__ unsigned xb_ld(unsigned* p)              { return __hip_atomic_load(p, __ATOMIC_RELAXED, __HIP_MEMORY_SCOPE_AGENT); }
__device__ __forceinline__ unsigned xb_add(unsigned* p, unsigned v) { return __hip_atomic_fetch_add(p, v, __ATOMIC_RELAXED, __HIP_MEMORY_SCOPE_AGENT); }
__device__ __forceinline__ unsigned xb_xcc_id() { return (unsigned)__builtin_amdgcn_s_getreg((3 << 11) | 20) & 0xFu; }
#define XB_SPIN(cond, bar) do { unsigned _sp = 0; while (cond) { __builtin_amdgcn_s_sleep(1); \
    if ((++_sp & 255u) == 0u) { if (xb_ld(&(bar)[XB_TMO])) break; if (_sp > XB_SPIN_CAP) { atomicAdd(&(bar)[XB_TMO], 1u); break; } } } } while (0)

struct XcdBarrier { unsigned* bar; unsigned x; volatile LAS unsigned* st; };

__device__ __forceinline__ XcdBarrier xcd_barrier_post(unsigned* bar, volatile LAS unsigned* st) {
    XcdBarrier b; b.bar = bar; b.x = xb_xcc_id(); b.st = st;
    if (get_tid() == 0) (void)xb_add(&bar[XB_XCNT(b.x)], 1u);
    return b;
}
__device__ __forceinline__ void xcd_barrier_complete(unsigned* bar, unsigned x, unsigned& nloc, unsigned& nx) {
    const unsigned G = gridDim.x * gridDim.y * gridDim.z;
    unsigned sum, cnt, mine, sp = 0u;
    for (;;) {
        sum = 0u; cnt = 0u; mine = 0u;
#pragma unroll
        for (unsigned j = 0; j < 16; ++j) { const unsigned c = xb_ld(&bar[XB_XCNT(j)]); sum += c; cnt += (c > 0u) ? 1u : 0u; mine = (j == x) ? c : mine; }
        if (sum == G) break;
        __builtin_amdgcn_s_sleep(1);
        if ((++sp & 255u) == 0u) { if (xb_ld(&bar[XB_TMO])) break; if (sp > XB_SPIN_CAP) { atomicAdd(&bar[XB_TMO], 1u); break; } }
    }
    nloc = mine > 0u ? mine : 1u; nx = cnt > 0u ? cnt : 1u;
}
__device__ __forceinline__ void xcd_barrier(const XcdBarrier& b) {
    asm volatile("s_waitcnt vmcnt(0)" ::: "memory");
    __syncthreads();
    if (get_tid() == 0) {
        unsigned* bar = b.bar;
        __builtin_amdgcn_s_waitcnt(0);
        unsigned nloc = b.st[0], nx = b.st[1];
        if (nloc == 0u) { xcd_barrier_complete(bar, b.x, nloc, nx); b.st[0] = nloc; b.st[1] = nx; }
        const unsigned old = xb_add(&bar[XB_XSUB(b.x)], 1u);
        const unsigned gen = old / nloc;
        if (old + 1u == (gen + 1u) * nloc) {
            __builtin_amdgcn_fence(__ATOMIC_RELEASE, "agent");
            asm volatile("s_waitcnt vmcnt(0)" ::: "memory");
            const unsigned og = xb_add(&bar[XB_TOP], 1u);
            const unsigned tg = og / nx;
            if (og + 1u == (tg + 1u) * nx) xb_add(&bar[XB_TOPGEN], 1u);
            else XB_SPIN(xb_ld(&bar[XB_TOPGEN]) == tg, bar);
            __builtin_amdgcn_fence(__ATOMIC_ACQUIRE, "agent");
            xb_add(&bar[XB_XGEN(b.x)], 1u);
            asm volatile("s_waitcnt vmcnt(0)" ::: "memory");
        } else {
            XB_SPIN(xb_ld(&bar[XB_XGEN(b.x)]) == gen, bar);
            __builtin_amdgcn_fence(__ATOMIC_ACQUIRE, "agent");
            asm volatile("s_waitcnt vmcnt(0)" ::: "memory");
        }
    }
    __syncthreads();
}

struct Params {
    const float *x, *c, *ctx, *c_ctx, *mod_w, *mod_b, *norm1_w, *norm2_w, *w_in, *mla_qn, *mla_wuq, *mla_kvn, *mla_wukv,
                *gqa_qn, *gqa_kn, *na_bias, *ret_logit, *ret_gnw, *w_branch, *w_out, *peer_wq, *peer_keys, *peer_u, *peer_v, *final_w;
    float* out;
    char* ws;
};
typedef const __attribute__((address_space(4))) Params* KP;
__device__ __forceinline__ KP get_kp() { KP kp = (KP)__builtin_amdgcn_kernarg_segment_ptr(); asm volatile("" : "+s"(kp)); return kp; }

constexpr size_t al256c(size_t x) { return (x + 255) & ~(size_t)255; }
constexpr size_t WS_BAR = 0;
constexpr size_t WS_CNT = WS_BAR + al256c(XCD_BAR_WORDS * 4);
constexpr size_t WS_ZERO_END = WS_CNT + al256c(8 * 8 * 64 * 4);
constexpr size_t WS_MOD = WS_ZERO_END;
constexpr size_t WS_CTXS = WS_MOD + al256c((size_t)2 * 17 * 6144 * 4);
constexpr size_t WS_WINT = WS_CTXS + al256c((size_t)NBATCH * CTXL * DM * 4);
constexpr size_t WS_WUQT = WS_WINT + al256c((size_t)2 * NPROJ * DM * 2);
constexpr size_t WS_WUKVT = WS_WUQT + al256c((size_t)2 * 384 * 256 * 2);
constexpr size_t WS_WBT = WS_WUKVT + al256c((size_t)2 * 512 * 128 * 2);
constexpr size_t WS_WOUTT = WS_WBT + al256c((size_t)2 * 4 * DM * 256 * 2);
constexpr size_t WS_WQT = WS_WOUTT + al256c((size_t)2 * DM * DM * 2);
constexpr size_t WS_H = WS_WQT + al256c((size_t)2 * DM * DM * 2);
constexpr size_t WS_PROJ = WS_H + al256c((size_t)NGROUP * TG * DM * 2);
#define HG(p_, g_) (((bf16_t*)((p_)->ws + WS_H)) + (size_t)(g_) * TG * DM)
constexpr size_t WS_GATE8 = WS_PROJ + al256c((size_t)TG * PLD * 2);
constexpr size_t WS_QRAW = WS_GATE8 + al256c((size_t)TG * 4096);
constexpr size_t WS_KVRAW = WS_QRAW + al256c((size_t)TG * 384 * 2);
constexpr size_t WS_QA = WS_KVRAW + al256c((size_t)TG * 512 * 2);
constexpr size_t WS_KA = WS_QA + al256c((size_t)TG * 384 * 2);
constexpr size_t WS_VA = WS_KA + al256c((size_t)TG * 384 * 2);
constexpr size_t WS_GQ = WS_VA + al256c((size_t)TG * 256 * 2);
constexpr size_t WS_GK = WS_GQ + al256c((size_t)TG * 256 * 2);
constexpr size_t WS_OUTS = WS_GK + al256c((size_t)TG * 128 * 2);
constexpr size_t WS_ACC = WS_QRAW;
constexpr size_t WS_PQ = WS_OUTS;
constexpr size_t WS_RKV = WS_OUTS + al256c((size_t)4 * TG * 256 * 2);
constexpr size_t WS_UB = WS_RKV + al256c((size_t)NB * 4 * 2 * 34 * 4096 * 4);
constexpr size_t WS_VB = WS_UB + al256c((size_t)2 * 16384 * DM);
constexpr size_t WS_KEYB = WS_VB + al256c((size_t)2 * 16384 * DM);
constexpr size_t WS_USC = WS_UB + (size_t)2 * 16384 * (DM / 2);
constexpr size_t WS_VSC = WS_VB + (size_t)2 * 16384 * (DM / 2);
constexpr size_t WS_URS = WS_USC + (size_t)2 * 16384 * 4;
constexpr size_t WS_TOTAL = WS_KEYB + al256c((size_t)2 * 8 * 2 * 128 * 64 * 2);

#define G_BM 256
#define G_BN 128
#define G_BK 64
#define G_LDP 144
#define G_ABYTES (G_BM * G_LDP)
#define G_BBYTES (G_BN * G_LDP)
#define G_STAGE (G_ABYTES + G_BBYTES)

template <int MI>
__device__ __forceinline__ void gemm_tile(const bf16_t* __restrict__ A, int lda, const bf16_t* __restrict__ Bt, int ldb, int K,
                                          f32x4 (&acc)[MI][4], char* lds)
{
    constexpr int NA = MI;
    const int tid = get_tid(), lane = tid & 63, wid = tid >> 6, wm = wid >> 1, wn = wid & 1, fr = lane & 15, fq = lane >> 4;
    const int nk = K / G_BK;
    u32x4 ra[NA], rb[2];
    const int arow = tid >> 3, akc = tid & 7;
    const bf16_t* ag = A + (size_t)arow * lda + akc * 8;
    const bf16_t* bg = Bt + (size_t)arow * ldb + akc * 8;
    const int a_l = arow * G_LDP + akc * 16;
#pragma unroll
    for (int i = 0; i < NA; ++i) ra[i] = *(const u32x4*)(ag + (size_t)(64 * i) * lda);
#pragma unroll
    for (int i = 0; i < 2; ++i) rb[i] = *(const u32x4*)(bg + (size_t)(64 * i) * ldb);
    __syncthreads();
#pragma unroll
    for (int i = 0; i < NA; ++i) *(u32x4*)(lds + a_l + i * 64 * G_LDP) = ra[i];
#pragma unroll
    for (int i = 0; i < 2; ++i) *(u32x4*)(lds + G_ABYTES + a_l + i * 64 * G_LDP) = rb[i];
    __syncthreads();
    const int aoff = (wm * 16 * MI + fr) * G_LDP + fq * 16;
    const int boff = G_ABYTES + (wn * 64 + fr) * G_LDP + fq * 16;
    for (int kt = 0; kt < nk; ++kt) {
        const int cur = (kt & 1) * G_STAGE, nxt = ((kt + 1) & 1) * G_STAGE;
        const bool more = (kt + 1 < nk);
        if (more) {
#pragma unroll
            for (int i = 0; i < NA; ++i) ra[i] = *(const u32x4*)(ag + (size_t)(64 * i) * lda + (kt + 1) * G_BK);
#pragma unroll
            for (int i = 0; i < 2; ++i) rb[i] = *(const u32x4*)(bg + (size_t)(64 * i) * ldb + (kt + 1) * G_BK);
        }
#pragma unroll
        for (int ks = 0; ks < 2; ++ks) {
            bf16x8 af[MI], bfr[4];
#pragma unroll
            for (int mi = 0; mi < MI; ++mi) af[mi] = *(const bf16x8*)(lds + cur + aoff + mi * 16 * G_LDP + ks * 64);
#pragma unroll
            for (int ni = 0; ni < 4; ++ni) bfr[ni] = *(const bf16x8*)(lds + cur + boff + ni * 16 * G_LDP + ks * 64);
#pragma unroll
            for (int mi = 0; mi < MI; ++mi)
#pragma unroll
                for (int ni = 0; ni < 4; ++ni) acc[mi][ni] = __builtin_amdgcn_mfma_f32_16x16x32_bf16(bfr[ni], af[mi], acc[mi][ni], 0, 0, 0);
        }
        if (more) {
#pragma unroll
            for (int i = 0; i < NA; ++i) *(u32x4*)(lds + nxt + a_l + i * 64 * G_LDP) = ra[i];
#pragma unroll
            for (int i = 0; i < 2; ++i) *(u32x4*)(lds + nxt + G_ABYTES + a_l + i * 64 * G_LDP) = rb[i];
        }
        __syncthreads();
    }
}

template <int MI>
__device__ __forceinline__ void zero_acc(f32x4 (&acc)[MI][4]) {
#pragma unroll
    for (int i = 0; i < MI; ++i)
#pragma unroll
        for (int j = 0; j < 4; ++j) acc[i][j] = (f32x4){0.f, 0.f, 0.f, 0.f};
}

template <class Epi>
__device__ __forceinline__ void gemm_phase(const bf16_t* A, int lda, const bf16_t* Bt, int ldb, int M, int N, int K, const Epi& epi, char* lds, int bid, int nblk)
{
    const int tid = get_tid(), lane = tid & 63, wid = tid >> 6, wm = wid >> 1, wn = wid & 1, fr = lane & 15, fq = lane >> 4;
    const int tn = N / G_BN, total = (M / G_BM) * tn;
    for (int t = bid; t < total; t += nblk) {
        const int pm = t / tn, pn = t % tn;
        f32x4 acc[4][4]; zero_acc(acc);
        gemm_tile<4>(A + (size_t)pm * G_BM * lda, lda, Bt + (size_t)pn * G_BN * ldb, ldb, K, acc, lds);
#pragma unroll
        for (int mi = 0; mi < 4; ++mi)
#pragma unroll
            for (int ni = 0; ni < 4; ++ni) epi(pm * G_BM + wm * 64 + mi * 16 + fr, pn * G_BN + wn * 64 + ni * 16 + fq * 4, acc[mi][ni]);
    }
}

__device__ __forceinline__ void store_bf16x4(bf16_t* p, f32x4 v) { u32x2 w; w.x = pack_bf16(v[0], v[1]); w.y = pack_bf16(v[2], v[3]); *(u32x2*)p = w; }


namespace pg8 {
#define PG8_LAS __attribute__((address_space(3)))
typedef unsigned short bf16_t;
typedef short bf16x8 __attribute__((ext_vector_type(8)));
typedef float f32x4 __attribute__((ext_vector_type(4)));
typedef unsigned u32x4 __attribute__((ext_vector_type(4)));
constexpr int BM = 256, BK = 64, HALF = 128, HTB = HALF * BK * 2  , STAGE_BYTES = 8 * HTB, NXCD = 8, WGM = 8;

__host__ __device__ __forceinline__ int lds_byte(int r, int c) { const int st = (r >> 4) * 2 + (c >> 5), rr = r & 15, cc = c & 31, ob = rr * 64 + cc * 2; return st * 1024 + (ob ^ (((ob >> 9) & 1) << 5)); }
__host__ __device__ __forceinline__ void stage_rc(int b, int& R, int& C) { const int st = b / 1024, sb = b % 1024, swz = sb ^ (((sb >> 9) & 1) << 5); R = (st >> 1) * 16 + swz / 64; C = (st & 1) * 32 + (swz % 64) / 2; }
__host__ __device__ __forceinline__ int perm32(int rho) { const int n = rho >> 4, i = rho & 15; return 8 * (i >> 2) + 4 * n + (i & 3); }

struct Unit { int pm, pn; };
struct Gemm { const bf16_t* A; const bf16_t* Bt; int M, N, K; };

struct StaticOrder {
    int nM, nN, nwg, G, c;
    __host__ __device__ void init(int M, int N, int G_, int c_) { nM = M / BM; nN = N / BM; nwg = nM * nN; G = G_; c = c_; }
    __host__ __device__ bool next(int i, Unit& u) const {
        const long L = (long)i * G + c; if (L >= nwg) return false;
        int wgid = (int)L; { const int q = nwg / NXCD, r = nwg % NXCD, xcd = wgid % NXCD, off = wgid / NXCD; wgid = (xcd < r ? xcd * (q + 1) : r * (q + 1) + (xcd - r) * q) + off; }
        const int nig = WGM * nN, gid = wgid / nig, fm = gid * WGM, gsz = (nM - fm) < WGM ? (nM - fm) : WGM;
        u.pm = fm + ((wgid % nig) % gsz); u.pn = (wgid % nig) / gsz; return true;
    }
    __device__ __forceinline__ void a_ready(const Unit&) const {}
    __device__ __forceinline__ void done(const Unit&) const {}
};
template <class Epi, class Sched, bool ALIGN_EPI = false, bool SP2 = false>
__device__ __forceinline__ void gemm_phase(PG8_LAS unsigned char* lds, const Gemm g, const Sched& S, const Epi& E) {
    const int tid = get_tid(), wid = __builtin_amdgcn_readfirstlane(tid >> 6), lane = tid & 63, wr = wid >> 2, wc = wid & 3, fr = lane & 15, fq = lane >> 4;
    const int K = g.K, nt = K / BK;
    unsigned voffA[2], voffB[2];
#pragma unroll
    for (int i = 0; i < 2; ++i) { int R, C; stage_rc(tid * 16 + i * 8192, R, C); const int Rb = Epi::PERM ? ((R & ~31) + perm32(R & 31)) : R;
        voffA[i] = (unsigned)(R * K + C) * 2u; voffB[i] = (unsigned)(Rb * K + C) * 2u; }
    const size_t kstep = (size_t)(BK * 2);
    const size_t hstep = (size_t)HALF * K * 2;
    const size_t tstep = 2 * hstep;
    const unsigned ldsw = (unsigned)wid * 1024u;
    const int aoff = lds_byte(wr * 64 + fr, fq * 8), boff = lds_byte(wc * 32 + fr, fq * 8);
#define PG8_SA(b, h) (((b) * 2 + (h)) * HTB)
#define PG8_SB(b, h) ((4 + (b) * 2 + (h)) * HTB)
#define PG8_STAGE(bufoff, gbase, voff) do { _Pragma("unroll") for (int _i = 0; _i < 2; ++_i) \
        __builtin_amdgcn_global_load_lds((const unsigned*)((const char*)(gbase) + (voff)[_i]), (PG8_LAS unsigned*)(lds + (bufoff) + ldsw + _i * 8192), 16, 0, 0); } while (0)
#define PG8_LDA(dst, b, h) do { _Pragma("unroll") for (int m = 0; m < 4; ++m) _Pragma("unroll") for (int k = 0; k < 2; ++k) dst[m][k] = *(const PG8_LAS bf16x8*)(lds + PG8_SA(b, h) + aoff + m * 2048 + k * 1024); } while (0)
#define PG8_LDB(dst, b, h) do { _Pragma("unroll") for (int n = 0; n < 2; ++n) _Pragma("unroll") for (int k = 0; k < 2; ++k) dst[n][k] = *(const PG8_LAS bf16x8*)(lds + PG8_SB(b, h) + boff + n * 2048 + k * 1024); } while (0)
#define PG8_MMA(ai, bj, At, Bt) do { __builtin_amdgcn_s_setprio(1); _Pragma("unroll") for (int m = 0; m < 4; ++m) _Pragma("unroll") for (int n = 0; n < 2; ++n) _Pragma("unroll") for (int k = 0; k < 2; ++k) \
        acc[ai][bj][m][n] = __builtin_amdgcn_mfma_f32_16x16x32_bf16(Bt[n][k], At[m][k], acc[ai][bj][m][n], 0, 0, 0); __builtin_amdgcn_s_setprio(0); } while (0)
#define PG8_WAIT_V(n) asm volatile("s_waitcnt vmcnt(" #n ")" ::: "memory")
#define PG8_WAIT_L(n) asm volatile("s_waitcnt lgkmcnt(" #n ")" ::: "memory")
#define PG8_BAR __builtin_amdgcn_s_barrier()
#define PG8_SCHED __builtin_amdgcn_sched_barrier(0)
    Unit cur, nxt; int ui = 0;
    if (!S.next(0, cur)) return;
    f32x4 acc[2][2][4][2];
#pragma unroll
    for (int a = 0; a < 2; ++a)
#pragma unroll
        for (int b = 0; b < 2; ++b)
#pragma unroll
            for (int m = 0; m < 4; ++m)
#pragma unroll
                for (int n = 0; n < 2; ++n) acc[a][b][m][n] = (f32x4){0.f, 0.f, 0.f, 0.f};
    bf16x8 At[4][2], B0[2][2], B1[2][2];
    const char* cA = (const char*)g.A + (size_t)cur.pm * tstep; const char* cB = (const char*)g.Bt + (size_t)cur.pn * tstep;
    S.a_ready(cur);
    if constexpr (SP2) {
        PG8_STAGE(PG8_SB(0, 0), cB, voffB); PG8_STAGE(PG8_SB(0, 1), cB + hstep, voffB); PG8_STAGE(PG8_SA(0, 0), cA, voffA); PG8_STAGE(PG8_SA(0, 1), cA + hstep, voffA);
        if (wr == 1) PG8_BAR;
        PG8_WAIT_V(2); PG8_BAR;
        PG8_STAGE(PG8_SB(1, 0), cB + kstep, voffB); PG8_STAGE(PG8_SA(1, 0), cA + kstep, voffA); PG8_STAGE(PG8_SB(1, 1), cB + hstep + kstep, voffB);
        PG8_WAIT_V(6); PG8_BAR;
    } else {
        PG8_STAGE(PG8_SB(0, 0), cB, voffB); PG8_STAGE(PG8_SA(0, 0), cA, voffA); PG8_STAGE(PG8_SB(0, 1), cB + hstep, voffB); PG8_STAGE(PG8_SA(0, 1), cA + hstep, voffA);
        if (wr == 1) PG8_BAR;
        PG8_WAIT_V(4); PG8_BAR;
        PG8_STAGE(PG8_SB(1, 0), cB + kstep, voffB); PG8_STAGE(PG8_SA(1, 0), cA + kstep, voffA); PG8_STAGE(PG8_SB(1, 1), cB + hstep + kstep, voffB);
        PG8_WAIT_V(6); PG8_BAR;
    }
    for (;;) {
        const bool has_next = S.next(ui + 1, nxt);
        const char* nA = has_next ? (const char*)g.A + (size_t)nxt.pm * tstep : cA; const char* nB = has_next ? (const char*)g.Bt + (size_t)nxt.pn * tstep : cB;
        for (int t = 0; t < nt; t += 2) {
            const bool last = (t == nt - 2);
            const char* a1 = cA + (size_t)(t + 1) * kstep;
            const char* a2 = last ? nA : cA + (size_t)(t + 2) * kstep; const char* b2 = last ? nB : cB + (size_t)(t + 2) * kstep;
            const char* a3 = a2 + kstep; const char* b3 = b2 + kstep;
            if (last && has_next) S.a_ready(nxt);
            if constexpr (SP2) {
            PG8_LDB(B0, 0, 0); PG8_LDB(B1, 0, 1); PG8_SCHED; PG8_LDA(At, 0, 0); PG8_STAGE(PG8_SA(1, 1), a1 + hstep, voffA);
            PG8_WAIT_V(8); PG8_WAIT_L(0); PG8_BAR; PG8_MMA(0, 0, At, B0); PG8_MMA(0, 1, At, B1); PG8_BAR; PG8_SCHED;
            PG8_LDA(At, 0, 1); PG8_STAGE(PG8_SB(0, 0), b2, voffB); PG8_STAGE(PG8_SB(0, 1), b2 + hstep, voffB); PG8_STAGE(PG8_SA(0, 0), a2, voffA);
            PG8_WAIT_V(8); PG8_WAIT_L(0); PG8_BAR; PG8_MMA(1, 0, At, B0); PG8_MMA(1, 1, At, B1); PG8_BAR; PG8_SCHED;
            PG8_LDB(B0, 1, 0); PG8_LDB(B1, 1, 1); PG8_SCHED; PG8_LDA(At, 1, 0); PG8_STAGE(PG8_SA(0, 1), a2 + hstep, voffA);
            PG8_WAIT_V(8); PG8_WAIT_L(0); PG8_BAR; PG8_MMA(0, 0, At, B0); PG8_MMA(0, 1, At, B1); PG8_BAR; PG8_SCHED;
            PG8_LDA(At, 1, 1); PG8_STAGE(PG8_SB(1, 0), b3, voffB); PG8_STAGE(PG8_SB(1, 1), b3 + hstep, voffB); PG8_STAGE(PG8_SA(1, 0), a3, voffA);
            PG8_WAIT_V(8); PG8_WAIT_L(0); PG8_BAR; PG8_MMA(1, 0, At, B0); PG8_MMA(1, 1, At, B1); PG8_BAR; PG8_SCHED;
            } else {
            PG8_LDB(B0, 0, 0); PG8_SCHED; PG8_LDA(At, 0, 0); PG8_STAGE(PG8_SA(1, 1), a1 + hstep, voffA);
            PG8_WAIT_L(8); PG8_BAR; PG8_WAIT_L(0); PG8_MMA(0, 0, At, B0); PG8_BAR; PG8_SCHED;
            PG8_LDB(B1, 0, 1); PG8_STAGE(PG8_SB(0, 0), b2, voffB);
            PG8_BAR; PG8_WAIT_L(0); PG8_MMA(0, 1, At, B1); PG8_BAR;
            PG8_LDA(At, 0, 1); PG8_STAGE(PG8_SA(0, 0), a2, voffA);
            PG8_BAR; PG8_WAIT_L(0); PG8_MMA(1, 0, At, B0); PG8_BAR; PG8_SCHED;
            PG8_STAGE(PG8_SB(0, 1), b2 + hstep, voffB);
            PG8_WAIT_V(6); PG8_BAR; PG8_MMA(1, 1, At, B1); PG8_BAR;
            PG8_LDB(B0, 1, 0); PG8_SCHED; PG8_LDA(At, 1, 0); PG8_STAGE(PG8_SA(0, 1), a2 + hstep, voffA);
            PG8_WAIT_L(8); PG8_BAR; PG8_WAIT_L(0); PG8_MMA(0, 0, At, B0); PG8_BAR; PG8_SCHED;
            PG8_LDB(B1, 1, 1); PG8_STAGE(PG8_SB(1, 0), b3, voffB);
            PG8_BAR; PG8_WAIT_L(0); PG8_MMA(0, 1, At, B1); PG8_BAR;
            PG8_LDA(At, 1, 1); PG8_STAGE(PG8_SA(1, 0), a3, voffA);
            PG8_BAR; PG8_WAIT_L(0); PG8_MMA(1, 0, At, B0); PG8_BAR; PG8_SCHED;
            PG8_STAGE(PG8_SB(1, 1), b3 + hstep, voffB);
            PG8_WAIT_V(6); PG8_BAR; PG8_MMA(1, 1, At, B1); PG8_BAR;
            }
        }
        if constexpr (ALIGN_EPI) { if (wr == 0) PG8_BAR; }
        if constexpr (!Epi::AFTER_DRAIN) { E(acc, cur, wr, wc, fr, fq); S.done(cur); }
        if (!has_next) break;
#pragma unroll
        for (int a = 0; a < 2; ++a)
#pragma unroll
            for (int b = 0; b < 2; ++b)
#pragma unroll
                for (int m = 0; m < 4; ++m)
#pragma unroll
                    for (int n = 0; n < 2; ++n) acc[a][b][m][n] = (f32x4){0.f, 0.f, 0.f, 0.f};
        cur = nxt; cA = nA; cB = nB; ++ui;
        if constexpr (ALIGN_EPI) { if (wr == 1) PG8_BAR; }
    }
    PG8_WAIT_V(0);
    if constexpr (!ALIGN_EPI) { if (wr == 0) PG8_BAR; }
    PG8_BAR;
    if constexpr (Epi::AFTER_DRAIN) { E.fused(acc, cur, wr, wc, fr, fq, lds, wid, lane); S.done(cur); }
#undef PG8_SA
#undef PG8_SB
#undef PG8_STAGE
#undef PG8_LDA
#undef PG8_LDB
#undef PG8_MMA
#undef PG8_WAIT_V
#undef PG8_WAIT_L
#undef PG8_BAR
#undef PG8_SCHED
}
}

template <class F> struct Epi4 {
    static constexpr bool PERM = false, AFTER_DRAIN = false; F f;
    __device__ __forceinline__ void operator()(const f32x4 (&acc)[2][2][4][2], const pg8::Unit& u, int wr, int wc, int fr, int fq) const {
#pragma unroll
        for (int ai = 0; ai < 2; ++ai)
#pragma unroll
            for (int m = 0; m < 4; ++m)
#pragma unroll
                for (int bj = 0; bj < 2; ++bj)
#pragma unroll
                    for (int n = 0; n < 2; ++n) f(u.pm * 256 + ai * 128 + wr * 64 + m * 16 + fr, u.pn * 256 + bj * 128 + wc * 32 + n * 16 + fq * 4, acc[ai][bj][m][n]);
    }
};
template <class F> struct Epi8 {
    static constexpr bool PERM = true, AFTER_DRAIN = false; F f;
    __device__ __forceinline__ void operator()(const f32x4 (&acc)[2][2][4][2], const pg8::Unit& u, int wr, int wc, int fr, int fq) const {
#pragma unroll
        for (int ai = 0; ai < 2; ++ai)
#pragma unroll
            for (int m = 0; m < 4; ++m)
#pragma unroll
                for (int bj = 0; bj < 2; ++bj) f(u.pm * 256 + ai * 128 + wr * 64 + m * 16 + fr, u.pn * 256 + bj * 128 + wc * 32 + fq * 8, acc[ai][bj][m][0], acc[ai][bj][m][1]);
    }
};
template <class E>
__device__ __forceinline__ void big_gemm(const bf16_t* A, const bf16_t* Bt, int M, int N, int K, const E& e, char* lds, int bid, int nblk) {
    pg8::StaticOrder so; so.init(M, N, nblk, bid);
    pg8::gemm_phase<E, pg8::StaticOrder, true, true>((PG8_LAS unsigned char*)lds, pg8::Gemm{A, Bt, M, N, K}, so, e);
}

__device__ __forceinline__ void transpose_cvt(const float* __restrict__ src, int K, int N, int Npad, bf16_t* __restrict__ dst, const float* __restrict__ kscale, float* lds, int bid, int nblk)
{
    const int tid = get_tid();
    const int tk = K / 64, tn = Npad / 64, total = tk * tn;
    const int lk = tid >> 3, ln = (tid & 7) * 8;
    const int sn = tid >> 3, sk = (tid & 7) * 8;
    for (int t = bid; t < total; t += nblk) {
        const int k0 = (t / tn) * 64, n0 = (t % tn) * 64;
        f32x4 a = (f32x4){0.f, 0.f, 0.f, 0.f}, c = a;
        if (n0 + ln < N) { const float* sp = src + (size_t)(k0 + lk) * N + n0 + ln; a = *(const f32x4*)sp; c = *(const f32x4*)(sp + 4); if (kscale) { const float ks = kscale[k0 + lk]; a *= ks; c *= ks; } }
        __syncthreads();
#pragma unroll
        for (int j = 0; j < 4; ++j) { lds[lk * 65 + ln + j] = a[j]; lds[lk * 65 + ln + 4 + j] = c[j]; }
        __syncthreads();
        u32x4 w;
        w.x = pack_bf16(lds[(sk + 0) * 65 + sn], lds[(sk + 1) * 65 + sn]); w.y = pack_bf16(lds[(sk + 2) * 65 + sn], lds[(sk + 3) * 65 + sn]);
        w.z = pack_bf16(lds[(sk + 4) * 65 + sn], lds[(sk + 5) * 65 + sn]); w.w = pack_bf16(lds[(sk + 6) * 65 + sn], lds[(sk + 7) * 65 + sn]);
        *(u32x4*)(dst + (size_t)(n0 + sn) * K + k0 + sk) = w;
    }
}

__device__ __forceinline__ void phase_prologue(KP p, char* ldsc, int bid, int nblk)
{
    float* lds = (float*)ldsc;
    const int tid = get_tid();
    for (int l = 0; l < 2; ++l) {
        transpose_cvt(p->w_in + (size_t)l * DM * IN_COLS, DM, IN_COLS, NPROJ, ((bf16_t*)(p->ws + WS_WINT)) + (size_t)l * NPROJ * DM, nullptr, lds, bid, nblk);
        transpose_cvt(p->mla_wuq + (size_t)l * 256 * 384, 256, 384, 384, ((bf16_t*)(p->ws + WS_WUQT)) + (size_t)l * 384 * 256, p->mla_qn + l * 256, lds, bid, nblk);
        transpose_cvt(p->mla_wukv + (size_t)l * 128 * 512, 128, 512, 512, ((bf16_t*)(p->ws + WS_WUKVT)) + (size_t)l * 512 * 128, p->mla_kvn + l * 128, lds, bid, nblk);
        for (int i = 0; i < 4; ++i)
            transpose_cvt(p->w_branch + (size_t)(l * 4 + i) * 256 * DM, 256, DM, DM, ((bf16_t*)(p->ws + WS_WBT)) + (size_t)(l * 4 + i) * DM * 256, nullptr, lds, bid, nblk);
        transpose_cvt(p->w_out + (size_t)l * DM * DM, DM, DM, DM, ((bf16_t*)(p->ws + WS_WOUTT)) + (size_t)l * DM * DM, nullptr, lds, bid, nblk);
        transpose_cvt(p->peer_wq + (size_t)l * DM * DM, DM, DM, DM, ((bf16_t*)(p->ws + WS_WQT)) + (size_t)l * DM * DM, nullptr, lds, bid, nblk);
    }
    {
        float* sil = lds;
        float* red = lds + 17 * 1024;
        __syncthreads();
        for (int e = tid; e < 17 * 1024; e += NTHREADS) { const int r = e >> 10, k = e & 1023; const float v = (r < 16) ? p->c[r * 1024 + k] : p->c_ctx[k]; sil[e] = siluf(v); }
        __syncthreads();
        for (int u = bid; u < 2 * 96; u += nblk) {
            const int l = u / 96, j0 = (u % 96) * 64, kg = tid >> 6, j = tid & 63;
            float a[17];
#pragma unroll
            for (int r = 0; r < 17; ++r) a[r] = 0.f;
            const float* w = p->mod_w + (size_t)l * DM * 6144 + j0 + j;
#pragma unroll 1
            for (int k0 = kg * 128; k0 < kg * 128 + 128; k0 += 16) {
                float wv[16];
#pragma unroll
                for (int kk = 0; kk < 16; ++kk) wv[kk] = w[(size_t)(k0 + kk) * 6144];
#pragma unroll
                for (int kk = 0; kk < 16; ++kk)
#pragma unroll
                    for (int r = 0; r < 17; ++r) a[r] += sil[r * 1024 + k0 + kk] * wv[kk];
            }
#pragma unroll
            for (int r = 0; r < 17; ++r) red[(kg * 17 + r) * 64 + j] = a[r];
            __syncthreads();
            for (int e = tid; e < 17 * 64; e += NTHREADS) {
                const int r = e >> 6, jj = e & 63; float s = 0.f;
                for (int q = 0; q < 8; ++q) s += red[(q * 17 + r) * 64 + jj];
                ((float*)(p->ws + WS_MOD))[((size_t)l * 17 + r) * 6144 + j0 + jj] = s + p->mod_b[l * 6144 + j0 + jj];
            }
            __syncthreads();
        }
    }
    {
        const size_t n16 = (size_t)2 * 16384 * DM / 16;
        for (size_t i = (size_t)bid * NTHREADS + tid; i < n16; i += (size_t)nblk * NTHREADS) {
            f32x4 a[4], c[4];
#pragma unroll
            for (int q = 0; q < 4; ++q) { a[q] = ((const f32x4*)p->peer_u)[4 * i + q]; c[q] = ((const f32x4*)p->peer_v)[4 * i + q]; }
            float mu = 0.f, mv = 0.f;
#pragma unroll
            for (int q = 0; q < 4; ++q)
#pragma unroll
                for (int j = 0; j < 4; ++j) { mu = fmaxf(mu, fabsf(a[q][j])); mv = fmaxf(mv, fabsf(c[q][j])); }
            mu = wave_max(mu); mv = wave_max(mv);
            const float su = mu > 0.f ? mu * (0.8f / 7.f) : 1.f, sv = mv > 0.f ? mv * (1.f / 6.f) : 1.f, iu = 1.f / su, iv = 1.f / sv;
            u32x2 wu = (u32x2){0u, 0u}, wv = (u32x2){0u, 0u};
            float rsum = 0.f;
#pragma unroll
            for (int q = 0; q < 4; ++q) {
                unsigned tu = wu[q >> 1], tv = wv[q >> 1];
#pragma unroll
                for (int j = 0; j < 4; ++j) { const float qv = fminf(fmaxf(__builtin_rintf(a[q][j] * iu), -8.f), 7.f); rsum += qv; tu |= ((unsigned)(int)qv & 15u) << (4 * ((4 * q + j) & 7)); }
                if ((q & 1) == 0) {
                    tv = __builtin_amdgcn_cvt_scalef32_pk_fp4_f32(tv, c[q][0] * iv, c[q][1] * iv, 1.0f, 0); tv = __builtin_amdgcn_cvt_scalef32_pk_fp4_f32(tv, c[q][2] * iv, c[q][3] * iv, 1.0f, 1);
                } else {
                    tv = __builtin_amdgcn_cvt_scalef32_pk_fp4_f32(tv, c[q][0] * iv, c[q][1] * iv, 1.0f, 2); tv = __builtin_amdgcn_cvt_scalef32_pk_fp4_f32(tv, c[q][2] * iv, c[q][3] * iv, 1.0f, 3);
                }
                wu[q >> 1] = tu; wv[q >> 1] = tv;
            }
            rsum = wave_sum(rsum);
            ((u32x2*)(p->ws + WS_UB))[i] = wu; ((u32x2*)(p->ws + WS_VB))[i] = wv;
            if ((tid & 63) == 0) { ((float*)(p->ws + WS_USC))[i >> 6] = su; ((float*)(p->ws + WS_VSC))[i >> 6] = sv; ((float*)(p->ws + WS_URS))[i >> 6] = 8.f * rsum; }
        }
        const size_t k8 = (size_t)2 * 8 * 2 * 128 * 64 / 8;
        for (size_t i = (size_t)bid * NTHREADS + tid; i < k8; i += (size_t)nblk * NTHREADS) {
            const f32x4 a = ((const f32x4*)p->peer_keys)[2 * i], b = ((const f32x4*)p->peer_keys)[2 * i + 1];
            u32x4 w; w.x = pack_bf16(a[0], a[1]); w.y = pack_bf16(a[2], a[3]); w.z = pack_bf16(b[0], b[1]); w.w = pack_bf16(b[2], b[3]);
            ((u32x4*)(p->ws + WS_KEYB))[i] = w;
        }
    }
}

__device__ __forceinline__ const float* state_row(KP p, int g, int r, int& modrow, bool from_input) {
    const int bl = r / LTOK, t = r - bl * LTOK, b = g * NB + bl;
    if (t < CTXL) { modrow = 16; return (from_input ? p->ctx : (const float*)(p->ws + WS_CTXS)) + ((size_t)b * CTXL + t) * DM; }
    modrow = b; return (from_input ? p->x : (const float*)p->out) + ((size_t)b * SEQ + (t - CTXL)) * DM;
}

__device__ __forceinline__ void phase_norm(KP p, int l, int g, int which, int bid, int nblk)
{
    const int lane = get_tid() & 63, wid = get_tid() >> 6;
    const float* nw = (which ? p->norm2_w : p->norm1_w) + l * DM;
    const int shoff = which ? 3072 : 0, scoff = which ? 4096 : 1024;
    for (int r = bid * 8 + wid; r < TG; r += nblk * 8) {
        int mr; const float* src = state_row(p, g, r, mr, l == 0 && which == 0);
        const float* md = ((float*)(p->ws + WS_MOD)) + ((size_t)l * 17 + mr) * 6144;
        f32x4 v[4]; float ss = 0.f;
#pragma unroll
        for (int i = 0; i < 4; ++i) { v[i] = *(const f32x4*)(src + i * 256 + lane * 4); ss += v[i][0] * v[i][0] + v[i][1] * v[i][1] + v[i][2] * v[i][2] + v[i][3] * v[i][3]; }
        ss = wave_sum(ss);
        const float rstd = rsqrtf(ss * (1.f / DM) + EPSF);
#pragma unroll
        for (int i = 0; i < 4; ++i) {
            const int c = i * 256 + lane * 4;
            const f32x4 w = *(const f32x4*)(nw + c), sc = *(const f32x4*)(md + scoff + c), sh = *(const f32x4*)(md + shoff + c);
            f32x4 y;
#pragma unroll
            for (int j = 0; j < 4; ++j) y[j] = v[i][j] * rstd * w[j] * (1.f + sc[j]) + sh[j];
            store_bf16x4(HG(p, g) + (size_t)r * DM + c, y);
        }
    }
}

struct EpiProj8 {
    bf16_t* O; unsigned char* G8;
    __device__ __forceinline__ void operator()(int row, int col, f32x4 a, f32x4 b) const {
        if (col >= C_GATE) {
            const int gi = col - C_GATE; if (gi >= 4096) return;
            unsigned w0 = 0u, w1 = 0u;
#pragma unroll
            for (int j = 0; j < 4; ++j) {
                w0 |= (unsigned)__builtin_amdgcn_cvt_pk_u8_f32(sigmf(a[j]) * 255.f, j, 0);
                w1 |= (unsigned)__builtin_amdgcn_cvt_pk_u8_f32(sigmf(b[j]) * 255.f, j, 0);
            }
            const int gp_ = (gi & ~63) | (((gi >> 2) & 3) << 4) | (((gi >> 4) & 3) << 2);
            *(unsigned*)(G8 + (size_t)row * 4096 + gp_) = w0; *(unsigned*)(G8 + (size_t)row * 4096 + gp_ + 16) = w1;
            return;
        }
        if (col >= C_NQ && col < C_NK) { a *= (0.125f * 1.4426950408889634f); b *= (0.125f * 1.4426950408889634f); }
        u32x4 w; w.x = pack_bf16(a[0], a[1]); w.y = pack_bf16(a[2], a[3]); w.z = pack_bf16(b[0], b[1]); w.w = pack_bf16(b[2], b[3]);
        *(u32x4*)(O + (size_t)row * PLD + col) = w;
    }
};
struct EpiStore8 { bf16_t* O; int ld;
    __device__ __forceinline__ void operator()(int row, int col, f32x4 a, f32x4 b) const {
        u32x4 w; w.x = pack_bf16(a[0], a[1]); w.y = pack_bf16(a[2], a[3]); w.z = pack_bf16(b[0], b[1]); w.w = pack_bf16(b[2], b[3]);
        *(u32x4*)(O + (size_t)row * ld + col) = w; } };
struct EpiStore { bf16_t* O; int ld; __device__ __forceinline__ void operator()(int row, int col, f32x4 v) const { store_bf16x4(O + (size_t)row * ld + col, v); } };

__device__ __forceinline__ float log_sigmoidf(float x) { return fminf(x, 0.f) - log1pf(__expf(-fabsf(x))); }

__device__ __forceinline__ int ret_jb(int rb) { return rb == 0 ? 1 : (rb == 1 ? 0 : 35 - rb); }

__device__ __forceinline__ bf16x8 tr_frag_nat(const char* img, int PT, int k0, int col0, int lane) {
    const int i16 = lane & 15, blk = (lane >> 4) & 1, h5 = lane >> 5, q4 = i16 >> 2, p4 = i16 & 3;
    const char* a = img + (k0 + 8 * h5 + q4) * PT + (col0 + 16 * blk) * 2 + 8 * p4;
    const s16x4 lo = __builtin_amdgcn_ds_read_tr16_b64_v4i16((LAS s16x4*)a), hi = __builtin_amdgcn_ds_read_tr16_b64_v4i16((LAS s16x4*)(a + 4 * PT));
    return __builtin_shufflevector(lo, hi, 0, 1, 2, 3, 4, 5, 6, 7);
}
__device__ __forceinline__ bf16x8 tr_frag_acc(const char* img, int PT, int k0, int col0, int lane) {
    const int i16 = lane & 15, blk = (lane >> 4) & 1, h5 = lane >> 5, q4 = i16 >> 2, p4 = i16 & 3;
    const char* a = img + (k0 + 4 * h5 + q4) * PT + (col0 + 16 * blk) * 2 + 8 * p4;
    const s16x4 lo = __builtin_amdgcn_ds_read_tr16_b64_v4i16((LAS s16x4*)a), hi = __builtin_amdgcn_ds_read_tr16_b64_v4i16((LAS s16x4*)(a + 8 * PT));
    return __builtin_shufflevector(lo, hi, 0, 1, 2, 3, 4, 5, 6, 7);
}
#define RT_PT 144
__device__ __forceinline__ void ret_kv_unit(KP p, int l, int bl, int h, int rb, char* lds)
{
    const int tid = get_tid(), lane = tid & 63, wid = tid >> 6, r = lane & 31, h5 = lane >> 5;
    const bf16_t* PR = (const bf16_t*)(p->ws + WS_PROJ);
    const size_t R0 = (size_t)bl * LTOK + rb * 128;
    const float lgf = log_sigmoidf(p->ret_logit[(l * 2 + 0) * 4 + h]) * 1.4426950408889634f, lgb = log_sigmoidf(p->ret_logit[(l * 2 + 1) * 4 + h]) * 1.4426950408889634f;
    char* KF = lds; char* KBk = lds + 128 * RT_PT; char* VV = lds + 2 * 128 * RT_PT;
    __syncthreads();
#pragma unroll
    for (int q = 0; q < 2; ++q) {
        const int c = tid + 512 * q, row = c >> 3, cc = c & 7;
        const u32x4 kw = *(const u32x4*)(PR + (R0 + row) * PLD + C_RK + h * 64 + cc * 8), vw = *(const u32x4*)(PR + (R0 + row) * PLD + C_RV + h * 64 + cc * 8);
        const float wf = 0.125f * __builtin_amdgcn_exp2f(lgf * (float)(127 - row)), wb = 0.125f * __builtin_amdgcn_exp2f(lgb * (float)row);
        u32x4 of, ob;
#pragma unroll
        for (int j = 0; j < 4; ++j) { const float lo = bflo(kw[j]), hi = bfhi(kw[j]); of[j] = pack_bf16(lo * wf, hi * wf); ob[j] = pack_bf16(lo * wb, hi * wb); }
        *(u32x4*)(KF + row * RT_PT + cc * 16) = of; *(u32x4*)(KBk + row * RT_PT + cc * 16) = ob; *(u32x4*)(VV + row * RT_PT + cc * 16) = vw;
    }
    __syncthreads();
    const int dir = wid >> 2, dt = (wid >> 1) & 1, et = wid & 1;
    const char* Ks = dir ? KBk : KF;
    f32x16 acc;
#pragma unroll
    for (int i = 0; i < 16; ++i) acc[i] = 0.f;
#pragma unroll
    for (int s2 = 0; s2 < 8; ++s2) {
        const bf16x8 af = tr_frag_nat(Ks, RT_PT, 16 * s2, dt * 32, lane), bfv = tr_frag_nat(VV, RT_PT, 16 * s2, et * 32, lane);
        acc = __builtin_amdgcn_mfma_f32_32x32x16_bf16(af, bfv, acc, 0, 0, 0);
    }
    const int j = dir ? ret_jb(rb) : rb;
    float* dst = ((float*)(p->ws + WS_RKV)) + ((((size_t)bl * 4 + h) * 2 + dir) * 34 + j) * 4096 + et * 32 + r;
#pragma unroll
    for (int i = 0; i < 16; ++i) dst[(dt * 32 + (i & 3) + 8 * (i >> 2) + 4 * h5) * 64] = acc[i];
}

__device__ __forceinline__ void phase_p3a(KP p, int l, int bid, int nblk, char* lds)
{
    gemm_phase(((bf16_t*)(p->ws + WS_PROJ)) + C_CQ, PLD, ((bf16_t*)(p->ws + WS_WUQT)) + (size_t)l * 384 * 256, 256, TG, 384, 256, EpiStore{((bf16_t*)(p->ws + WS_QRAW)), 384}, lds, bid, nblk);
    gemm_phase(((bf16_t*)(p->ws + WS_PROJ)) + C_CKV, PLD, ((bf16_t*)(p->ws + WS_WUKVT)) + (size_t)l * 512 * 128, 128, TG, 512, 128, EpiStore{((bf16_t*)(p->ws + WS_KVRAW)), 512}, lds, bid, nblk);
    for (int u = bid; u < NB * 4 * 34; u += nblk) { const int rb = u % 34, h = (u / 34) & 3, bl = u / 136; ret_kv_unit(p, l, bl, h, rb, lds); }
}

#define LOG2_THETA 13.287712379549449f
__device__ __forceinline__ float rope_freq(int i, int half) { return exp2f(-LOG2_THETA * (float)i / (float)half); }

__device__ __forceinline__ void phase_p3b(KP p, int l, int bid, int nblk)
{
    {
        const int gt = bid * NTHREADS + get_tid();
        for (int it = gt; it < NB * 4 * 2 * 1024; it += nblk * NTHREADS) {
            const int e4 = it & 1023, bhd = it >> 10, dir = bhd & 1, h = (bhd >> 1) & 3;
            const float dec = __builtin_amdgcn_exp2f(log_sigmoidf(p->ret_logit[(l * 2 + dir) * 4 + h]) * 1.4426950408889634f * 128.f);
            f32x4* base = (f32x4*)((float*)(p->ws + WS_RKV) + (size_t)bhd * 34 * 4096) + e4;
            f32x4 st = (f32x4){0.f, 0.f, 0.f, 0.f};
            f32x4 kv[34];
#pragma unroll
            for (int j = 0; j < 34; ++j) kv[j] = base[(size_t)j * 1024];
#pragma unroll
            for (int j = 0; j < 34; ++j) { base[(size_t)j * 1024] = st; st = st * dec + kv[j]; }
        }
    }
    const int lane = get_tid() & 63, wid = get_tid() >> 6;
    const float mla_scale = 0.10206207261596575f * 1.4426950408889634f;
    auto load_row = [&](unsigned (&rw)[40], int r) {
        const bf16_t* pr = ((bf16_t*)(p->ws + WS_PROJ)) + (size_t)r * PLD;
        const bf16_t* qraw = ((bf16_t*)(p->ws + WS_QRAW)) + (size_t)r * 384;
        const bf16_t* kvraw = ((bf16_t*)(p->ws + WS_KVRAW)) + (size_t)r * 512;
#pragma unroll
        for (int i = 0; i < 4; ++i) rw[i] = pr[C_CQ + lane + 64 * i];
#pragma unroll
        for (int i = 0; i < 2; ++i) rw[4 + i] = pr[C_CKV + lane + 64 * i];
#pragma unroll
        for (int i = 0; i < 6; ++i) {
            const int idx = lane + 64 * i, h = idx / 96, d = idx % 96, dd = d >= 64 ? d - 64 : 0;
            rw[6 + i] = qraw[idx];
            rw[12 + i] = qraw[(unsigned)(d >= 64 ? idx - dd + (dd ^ 8) : idx)];
            rw[18 + i] = d < 64 ? kvraw[h * 128 + d] : pr[C_KPE + dd];
            rw[24 + i] = pr[C_KPE + (unsigned)(dd ^ 8)];
        }
#pragma unroll
        for (int i = 0; i < 4; ++i) { const int idx = lane + 64 * i, h = idx >> 6, e = idx & 63; rw[30 + i] = kvraw[h * 128 + 64 + e]; }
#pragma unroll
        for (int hh = 0; hh < 6; ++hh) rw[34 + hh] = pr[(hh < 4 ? C_GQ + hh * 64 : C_GK + (hh - 4) * 64) + lane];
    };
    auto proc_row = [&](const unsigned (&rw)[40], int r) {
        const int t = r % LTOK;
        const bool lat = t >= CTXL;
        const float prow = lat ? (float)((t - CTXL) >> 6) : 0.f, pcol = lat ? (float)((t - CTXL) & 63) : 0.f;
        float sq = 0.f, skv = 0.f;
#pragma unroll
        for (int i = 0; i < 4; ++i) { const float v = bf2f((bf16_t)rw[i]); sq += v * v; }
#pragma unroll
        for (int i = 0; i < 2; ++i) { const float v = bf2f((bf16_t)rw[4 + i]); skv += v * v; }
        sq = wave_sum(sq); skv = wave_sum(skv);
        const float rq = rsqrtf(sq * (1.f / 256.f) + EPSF), rkv = rsqrtf(skv * (1.f / 128.f) + EPSF);
#pragma unroll
        for (int i = 0; i < 6; ++i) {
            const int idx = lane + 64 * i, d = idx % 96;
            float qv = bf2f((bf16_t)rw[6 + i]), kv = bf2f((bf16_t)rw[18 + i]);
            if (d < 64) kv *= rkv;
            else if (lat) {
                const int dd = d - 64, blk = dd >> 4, w = dd & 15, fi = w & 7; const bool first = w < 8;
                const float rev = (blk ? pcol : prow) * rope_freq(fi, 8) * 0.15915494309189535f; const float sn = __builtin_amdgcn_sinf(rev), cs = __builtin_amdgcn_cosf(rev);
                const float qo = bf2f((bf16_t)rw[12 + i]), ko = bf2f((bf16_t)rw[24 + i]);
                qv = first ? (qv * cs - qo * sn) : (qo * sn + qv * cs);
                kv = first ? (kv * cs - ko * sn) : (ko * sn + kv * cs);
            }
            ((bf16_t*)(p->ws + WS_QA))[(size_t)r * 384 + idx] = f2bf(qv * rq * mla_scale);
            ((bf16_t*)(p->ws + WS_KA))[(size_t)r * 384 + idx] = f2bf(kv);
        }
#pragma unroll
        for (int i = 0; i < 4; ++i) ((bf16_t*)(p->ws + WS_VA))[(size_t)r * 256 + lane + 64 * i] = f2bf(bf2f((bf16_t)rw[30 + i]) * rkv);
        const int blk = lane >> 5, w = lane & 31, fi = w & 15; const bool first = w < 16;
        float sn = 0.f, cs = 1.f;
        if (lat) { const float rev = (blk ? pcol : prow) * rope_freq(fi, 16) * 0.15915494309189535f; sn = __builtin_amdgcn_sinf(rev); cs = __builtin_amdgcn_cosf(rev); }
        const float nwq = p->gqa_qn[l * 64 + lane], nwk = p->gqa_kn[l * 64 + lane];
#pragma unroll
        for (int hh = 0; hh < 6; ++hh) {
            const bool isq = hh < 4;
            const float v = bf2f((bf16_t)rw[34 + hh]);
            const float ss = wave_sum(v * v);
            const float n = v * rsqrtf(ss * (1.f / 64.f) + EPSF) * (isq ? nwq : nwk);
            const float other = xor_swz<16>(n);
            float val = n;
            if (lat) val = first ? (n * cs - other * sn) : (other * sn + n * cs);
            if (isq) ((bf16_t*)(p->ws + WS_GQ))[(size_t)r * 256 + hh * 64 + lane] = f2bf(val * (0.125f * 1.4426950408889634f));
            else ((bf16_t*)(p->ws + WS_GK))[(size_t)r * 128 + (hh - 4) * 64 + lane] = f2bf(val);
        }
    };
    const int rstep = nblk * 8;
    int r = bid * 8 + wid;
    if (r < TG) {
        unsigned ra[40], rb[40];
        load_row(ra, r);
        for (;;) {
            const bool m1 = r + rstep < TG;
            if (m1) load_row(rb, r + rstep);
            proc_row(ra, r);
            if (!m1) break;
            r += rstep;
            const bool m2 = r + rstep < TG;
            if (m2) load_row(ra, r + rstep);
            proc_row(rb, r);
            if (!m2) break;
            r += rstep;
        }
    }
}

template <int DQ>
__device__ __forceinline__ void attn_unit(const bf16_t* __restrict__ Qb, int qld, const bf16_t* __restrict__ Kb, int kld, const bf16_t* __restrict__ Vb, int vld,
                                          int nq, int nk, bf16_t* __restrict__ Ob, int old_, char* lds)
{
    constexpr int NS = DQ / 16, CPR = DQ / 8, KP = DQ * 2 + 16, VP = 144, KB = 64 * KP, VB = 64 * VP, STG = KB + VB, KCH = 64 * CPR;
    const int tid = get_tid(), lane = tid & 63, wid = tid >> 6, r = lane & 31, h = lane >> 5;
    int qrow[2]; bool qvalid[2];
    bf16x8 qf[2][NS];
#pragma unroll
    for (int qb = 0; qb < 2; ++qb) {
        qrow[qb] = wid * 64 + qb * 32 + r; qvalid[qb] = qrow[qb] < nq; if (!qvalid[qb]) qrow[qb] = 0;
#pragma unroll
        for (int s2 = 0; s2 < NS; ++s2) qf[qb][s2] = *(const bf16x8*)(Qb + (size_t)qrow[qb] * qld + 16 * s2 + 8 * h);
    }
    f32x16 o0[2], o1[2];
    float m[2] = {0.f, 0.f}, l[2] = {0.f, 0.f};
#pragma unroll
    for (int qb = 0; qb < 2; ++qb)
#pragma unroll
        for (int i = 0; i < 16; ++i) { o0[qb][i] = 0.f; o1[qb][i] = 0.f; }
    const int kr0 = tid / CPR, kc0 = tid % CPR, kr1 = (tid + 512) / CPR, kc1 = (tid + 512) % CPR; const bool k1 = (tid + 512) < KCH;
    const int vr = tid >> 3, vc = tid & 7;
    const bf16_t* kg0 = Kb + (size_t)kr0 * kld + kc0 * 8; const bf16_t* kg1 = Kb + (size_t)kr1 * kld + kc1 * 8; const bf16_t* vg = Vb + (size_t)vr * vld + vc * 8;
    const int kl0 = kr0 * KP + kc0 * 16, kl1 = kr1 * KP + kc1 * 16, vl = KB + vr * VP + vc * 16;
    u32x4 rk0, rk1 = (u32x4){0u, 0u, 0u, 0u}, rv;
    rk0 = *(const u32x4*)kg0; if (k1) rk1 = *(const u32x4*)kg1; rv = *(const u32x4*)vg;
    __syncthreads();
    *(u32x4*)(lds + kl0) = rk0; if (k1) *(u32x4*)(lds + kl1) = rk1; *(u32x4*)(lds + vl) = rv;
    __syncthreads();
    const int i16 = lane & 15, blk = (lane >> 4) & 1, q4 = i16 >> 2, p4 = i16 & 3;
    const int koff = r * KP + 16 * h, voff = KB + (4 * h + q4) * VP + 32 * blk + 8 * p4;
    const int nt = nk >> 6;
    for (int kt = 0; kt < nt; ++kt) {
        const int cur = (kt & 1) * STG, nxt = ((kt + 1) & 1) * STG;
        const bool more = kt + 1 < nt;
        if (more) {
            const size_t adv = (size_t)(kt + 1) * 64;
            rk0 = *(const u32x4*)(kg0 + adv * kld); if (k1) rk1 = *(const u32x4*)(kg1 + adv * kld); rv = *(const u32x4*)(vg + adv * vld);
        }
#pragma unroll
        for (int sub = 0; sub < 2; ++sub) {
            f32x16 sq[2];
#pragma unroll
            for (int i = 0; i < 16; ++i) { sq[0][i] = 0.f; sq[1][i] = 0.f; }
#pragma unroll
            for (int g0 = 0; g0 < NS; g0 += 4) {
                bf16x8 kfr[4];
#pragma unroll
                for (int s2 = 0; s2 < 4; ++s2) if (g0 + s2 < NS) kfr[s2] = *(const bf16x8*)(lds + cur + koff + sub * 32 * KP + (g0 + s2) * 32);
                __builtin_amdgcn_sched_barrier(0);
#pragma unroll
                for (int s2 = 0; s2 < 4; ++s2) if (g0 + s2 < NS) {
                    sq[0] = __builtin_amdgcn_mfma_f32_32x32x16_bf16(kfr[s2], qf[0][g0 + s2], sq[0], 0, 0, 0);
                    sq[1] = __builtin_amdgcn_mfma_f32_32x32x16_bf16(kfr[s2], qf[1][g0 + s2], sq[1], 0, 0, 0);
                }
            }
            bf16x8 vfr[2][2];
#pragma unroll
            for (int s2 = 0; s2 < 1; ++s2) {
                const int vb = cur + voff + (sub * 32 + 16 * s2) * VP;
                const s16x4 lo0 = __builtin_amdgcn_ds_read_tr16_b64_v4i16((LAS s16x4*)(lds + vb));
                const s16x4 hi0 = __builtin_amdgcn_ds_read_tr16_b64_v4i16((LAS s16x4*)(lds + vb + 8 * VP));
                const s16x4 lo1 = __builtin_amdgcn_ds_read_tr16_b64_v4i16((LAS s16x4*)(lds + vb + 64));
                const s16x4 hi1 = __builtin_amdgcn_ds_read_tr16_b64_v4i16((LAS s16x4*)(lds + vb + 8 * VP + 64));
                vfr[s2][0] = __builtin_shufflevector(lo0, hi0, 0, 1, 2, 3, 4, 5, 6, 7); vfr[s2][1] = __builtin_shufflevector(lo1, hi1, 0, 1, 2, 3, 4, 5, 6, 7);
            }
            bf16x8 pf[2][2];
#pragma unroll
            for (int qb = 0; qb < 2; ++qb) {
                f32x16& st = sq[qb];
                if (__builtin_amdgcn_ballot_w64(m[qb] != 0.f) != 0ull) {
#pragma unroll
                    for (int i = 0; i < 16; ++i) st[i] -= m[qb];
                }
                float mx = fmaxf(st[0], st[1]);
#pragma unroll
                for (int i = 2; i < 16; i += 2) mx = fmaxf(fmaxf(mx, st[i]), st[i + 1]);
                { const u32x2 sw = __builtin_amdgcn_permlane32_swap(__float_as_uint(mx), __float_as_uint(mx), false, false); mx = fmaxf(__uint_as_float(sw.x), __uint_as_float(sw.y)); }
                const bool first = (kt == 0) && (sub == 0);
                const bool mv = mx > 24.f || (first && mx < -24.f);
                if (__builtin_amdgcn_ballot_w64(mv) != 0ull) {
                    const float dlt = mv ? mx : 0.f, alpha = __builtin_amdgcn_exp2f(-dlt);
                    m[qb] += dlt; l[qb] *= alpha;
#pragma unroll
                    for (int i = 0; i < 16; ++i) { st[i] -= dlt; o0[qb][i] *= alpha; o1[qb][i] *= alpha; }
                }
                f32x2 rs2 = (f32x2){0.f, 0.f};
#pragma unroll
                for (int i = 0; i < 16; i += 2) { st[i] = __builtin_amdgcn_exp2f(st[i]); st[i + 1] = __builtin_amdgcn_exp2f(st[i + 1]); rs2 += (f32x2){st[i], st[i + 1]}; }
                l[qb] += rs2.x + rs2.y;
                u32x4 pw0, pw1;
                pw0.x = pack_bf16(st[0], st[1]); pw0.y = pack_bf16(st[2], st[3]); pw0.z = pack_bf16(st[4], st[5]); pw0.w = pack_bf16(st[6], st[7]);
                pw1.x = pack_bf16(st[8], st[9]); pw1.y = pack_bf16(st[10], st[11]); pw1.z = pack_bf16(st[12], st[13]); pw1.w = pack_bf16(st[14], st[15]);
                pf[qb][0] = __builtin_bit_cast(bf16x8, pw0); pf[qb][1] = __builtin_bit_cast(bf16x8, pw1);
            }
            {
                const int vb = cur + voff + (sub * 32 + 16) * VP;
                const s16x4 lo0 = __builtin_amdgcn_ds_read_tr16_b64_v4i16((LAS s16x4*)(lds + vb));
                const s16x4 hi0 = __builtin_amdgcn_ds_read_tr16_b64_v4i16((LAS s16x4*)(lds + vb + 8 * VP));
                const s16x4 lo1 = __builtin_amdgcn_ds_read_tr16_b64_v4i16((LAS s16x4*)(lds + vb + 64));
                const s16x4 hi1 = __builtin_amdgcn_ds_read_tr16_b64_v4i16((LAS s16x4*)(lds + vb + 8 * VP + 64));
                vfr[1][0] = __builtin_shufflevector(lo0, hi0, 0, 1, 2, 3, 4, 5, 6, 7); vfr[1][1] = __builtin_shufflevector(lo1, hi1, 0, 1, 2, 3, 4, 5, 6, 7);
            }
#pragma unroll
            for (int s2 = 0; s2 < 2; ++s2)
#pragma unroll
                for (int qb = 0; qb < 2; ++qb) {
                    o0[qb] = __builtin_amdgcn_mfma_f32_32x32x16_bf16(vfr[s2][0], pf[qb][s2], o0[qb], 0, 0, 0);
                    o1[qb] = __builtin_amdgcn_mfma_f32_32x32x16_bf16(vfr[s2][1], pf[qb][s2], o1[qb], 0, 0, 0);
                }
        }
        if (more) { *(u32x4*)(lds + nxt + kl0) = rk0; if (k1) *(u32x4*)(lds + nxt + kl1) = rk1; *(u32x4*)(lds + nxt + vl) = rv; }
        __syncthreads();
    }
#pragma unroll
    for (int qb = 0; qb < 2; ++qb) {
        float lt = sum_xor32(l[qb]);
        if (qvalid[qb]) {
            const float inv = 1.f / lt;
            bf16_t* op = Ob + (size_t)qrow[qb] * old_ + 4 * h;
#pragma unroll
            for (int g4 = 0; g4 < 4; ++g4) {
                store_bf16x4(op + 8 * g4, (f32x4){o0[qb][4 * g4] * inv, o0[qb][4 * g4 + 1] * inv, o0[qb][4 * g4 + 2] * inv, o0[qb][4 * g4 + 3] * inv});
                store_bf16x4(op + 32 + 8 * g4, (f32x4){o1[qb][4 * g4] * inv, o1[qb][4 * g4 + 1] * inv, o1[qb][4 * g4 + 2] * inv, o1[qb][4 * g4 + 3] * inv});
            }
        }
    }
}

__device__ __forceinline__ void ld8(const bf16_t* p, float (&o)[8]) {
    const u32x4 w = *(const u32x4*)p;
    o[0] = bflo(w.x); o[1] = bfhi(w.x); o[2] = bflo(w.y); o[3] = bfhi(w.y); o[4] = bflo(w.z); o[5] = bfhi(w.z); o[6] = bflo(w.w); o[7] = bfhi(w.w);
}

__device__ __forceinline__ void na_unit(KP p, int l, int bl, int h, int rg, char* lds)
{
    constexpr int KP_ = 144, VP = 144, KB = 64 * KP_, VB = 64 * VP, STG = KB + VB, LBIAS = 2 * STG;
    const int tid = get_tid(), lane = tid & 63, wid = tid >> 6, r = lane & 31, h5 = lane >> 5;
    const bf16_t* PR = (const bf16_t*)(p->ws + WS_PROJ);
    const size_t Rb = (size_t)bl * LTOK;
    const int grow = rg * 4 + (wid >> 1), c = (wid & 1) * 32 + r;
    const int rs = min(max(grow - 4, 0), 56), cs = min(max(c - 8, 0), 48);
    const int Rlo = min(max(rg * 4 - 4, 0), 56), Rhi = min(max(rg * 4 + 3 - 4, 0), 56) + 7, nrow = Rhi - Rlo + 1, nt = nrow + 4;
    const size_t qrow = Rb + CTXL + (size_t)grow * 64 + c;
    bf16x8 qf[4];
#pragma unroll
    for (int s2 = 0; s2 < 4; ++s2) qf[s2] = *(const bf16x8*)(PR + qrow * PLD + C_NQ + h * 64 + 16 * s2 + 8 * h5);
    f32x16 o0, o1;
#pragma unroll
    for (int i = 0; i < 16; ++i) { o0[i] = 0.f; o1[i] = 0.f; }
    float m = -1e30f, lsum = 0.f;
    const int kr = tid >> 3, kc = tid & 7;
    const int kl = kr * KP_ + kc * 16, vl = KB + kr * VP + kc * 16;
    auto tile_row = [&](int t) -> size_t { return t < nrow ? Rb + CTXL + (size_t)(Rlo + t) * 64 : Rb + (size_t)(t - nrow) * 64; };
    u32x4 rk, rv;
    { const size_t R = tile_row(0) + kr; rk = *(const u32x4*)(PR + R * PLD + C_NK + h * 64 + kc * 8); rv = *(const u32x4*)(PR + R * PLD + C_NV + h * 64 + kc * 8); }
    __syncthreads();
    *(u32x4*)(lds + kl) = rk; *(u32x4*)(lds + vl) = rv;
    { float* sb = (float*)(lds + LBIAS); const float* bias = p->na_bias + ((size_t)l * 4 + h) * 465; if (tid < 465) sb[tid] = bias[tid] * 1.4426950408889634f; }
    __syncthreads();
    const float* sb = (const float*)(lds + LBIAS);
    const int i16 = lane & 15, blk = (lane >> 4) & 1, q4 = i16 >> 2, p4 = i16 & 3;
    const int koff = r * KP_ + 16 * h5, voff = KB + (4 * h5 + q4) * VP + 32 * blk + 8 * p4;
    for (int t = 0; t < nt; ++t) {
        const int cur = (t & 1) * STG, nxt = ((t + 1) & 1) * STG;
        const bool more = t + 1 < nt;
        if (more) { const size_t R = tile_row(t + 1) + kr; rk = *(const u32x4*)(PR + R * PLD + C_NK + h * 64 + kc * 8); rv = *(const u32x4*)(PR + R * PLD + C_NV + h * 64 + kc * 8); }
        const bool win = t < nrow; const int R = Rlo + t;
        const bool mine = !win || (R >= rs && R <= rs + 7);
        if (mine) {
#pragma unroll
            for (int sub = 0; sub < 2; ++sub) {
                f32x16 st;
#pragma unroll
                for (int i = 0; i < 16; ++i) st[i] = 0.f;
#pragma unroll
                for (int s2 = 0; s2 < 4; ++s2) {
                    const bf16x8 kf = *(const bf16x8*)(lds + cur + koff + sub * 32 * KP_ + s2 * 32);
                    st = __builtin_amdgcn_mfma_f32_32x32x16_bf16(kf, qf[s2], st, 0, 0, 0);
                }
                if (win) {
                    const int brow = (R - grow + 7) * 31 + 15 - c;
#pragma unroll
                    for (int i = 0; i < 16; ++i) {
                        const int kcol = sub * 32 + (i & 3) + 8 * (i >> 2) + 4 * h5;
                        const bool ok = kcol >= cs && kcol < cs + 16;
                        const float bv = sb[ok ? brow + kcol : 0];
                        st[i] = ok ? st[i] + bv : -INFINITY;
                    }
                }
                float mx = fmaxf(st[0], st[1]);
#pragma unroll
                for (int i = 2; i < 16; i += 2) mx = fmaxf(fmaxf(mx, st[i]), st[i + 1]);
                mx = max_xor32(mx);
                const float mn = fmaxf(m, mx), alpha = __builtin_amdgcn_exp2f(m - mn);
                m = mn;
                f32x2 rs2 = (f32x2){0.f, 0.f};
#pragma unroll
                for (int i = 0; i < 16; i += 2) { st[i] = __builtin_amdgcn_exp2f(st[i] - mn); st[i + 1] = __builtin_amdgcn_exp2f(st[i + 1] - mn); rs2 += (f32x2){st[i], st[i + 1]}; }
                lsum = lsum * alpha + (rs2.x + rs2.y);
                if (__builtin_amdgcn_ballot_w64(alpha != 1.f) != 0ull) {
#pragma unroll
                    for (int i = 0; i < 16; ++i) { o0[i] *= alpha; o1[i] *= alpha; }
                }
                u32x4 pw0, pw1;
                pw0.x = pack_bf16(st[0], st[1]); pw0.y = pack_bf16(st[2], st[3]); pw0.z = pack_bf16(st[4], st[5]); pw0.w = pack_bf16(st[6], st[7]);
                pw1.x = pack_bf16(st[8], st[9]); pw1.y = pack_bf16(st[10], st[11]); pw1.z = pack_bf16(st[12], st[13]); pw1.w = pack_bf16(st[14], st[15]);
                const bf16x8 pf0 = __builtin_bit_cast(bf16x8, pw0), pf1 = __builtin_bit_cast(bf16x8, pw1);
#pragma unroll
                for (int s2 = 0; s2 < 2; ++s2) {
                    const int vb = cur + voff + (sub * 32 + 16 * s2) * VP;
                    const s16x4 lo0 = __builtin_amdgcn_ds_read_tr16_b64_v4i16((LAS s16x4*)(lds + vb));
                    const s16x4 hi0 = __builtin_amdgcn_ds_read_tr16_b64_v4i16((LAS s16x4*)(lds + vb + 8 * VP));
                    const s16x4 lo1 = __builtin_amdgcn_ds_read_tr16_b64_v4i16((LAS s16x4*)(lds + vb + 64));
                    const s16x4 hi1 = __builtin_amdgcn_ds_read_tr16_b64_v4i16((LAS s16x4*)(lds + vb + 8 * VP + 64));
                    const bf16x8 vf0 = __builtin_shufflevector(lo0, hi0, 0, 1, 2, 3, 4, 5, 6, 7), vf1 = __builtin_shufflevector(lo1, hi1, 0, 1, 2, 3, 4, 5, 6, 7);
                    o0 = __builtin_amdgcn_mfma_f32_32x32x16_bf16(vf0, s2 ? pf1 : pf0, o0, 0, 0, 0);
                    o1 = __builtin_amdgcn_mfma_f32_32x32x16_bf16(vf1, s2 ? pf1 : pf0, o1, 0, 0, 0);
                }
            }
        }
        if (more) { *(u32x4*)(lds + nxt + kl) = rk; *(u32x4*)(lds + nxt + vl) = rv; }
        __syncthreads();
    }
    lsum = sum_xor32(lsum);
    const float inv = 1.f / lsum;
    bf16_t* op = ((bf16_t*)(p->ws + WS_OUTS)) + ((size_t)2 * TG + qrow) * 256 + h * 64 + 4 * h5;
#pragma unroll
    for (int g4 = 0; g4 < 4; ++g4) {
        store_bf16x4(op + 8 * g4, (f32x4){o0[4 * g4] * inv, o0[4 * g4 + 1] * inv, o0[4 * g4 + 2] * inv, o0[4 * g4 + 3] * inv});
        store_bf16x4(op + 32 + 8 * g4, (f32x4){o1[4 * g4] * inv, o1[4 * g4 + 1] * inv, o1[4 * g4 + 2] * inv, o1[4 * g4 + 3] * inv});
    }
}

__device__ __forceinline__ void ret_out_unit(KP p, int l, int bl, int h, int rb, char* lds)
{
    const int tid = get_tid(), lane = tid & 63, wid = tid >> 6, r = lane & 31, h5 = lane >> 5;
    const bf16_t* PR = (const bf16_t*)(p->ws + WS_PROJ);
    const size_t R0 = (size_t)bl * LTOK + rb * 128;
    const float lgf = log_sigmoidf(p->ret_logit[(l * 2 + 0) * 4 + h]) * 1.4426950408889634f, lgb = log_sigmoidf(p->ret_logit[(l * 2 + 1) * 4 + h]) * 1.4426950408889634f;
    char* KK = lds; char* VV = lds + 128 * RT_PT; char* SS = lds + 2 * 128 * RT_PT;
    float* YB = (float*)lds;
    __syncthreads();
#pragma unroll
    for (int q = 0; q < 2; ++q) {
        const int c = tid + 512 * q, row = c >> 3, cc = c & 7;
        const u32x4 kw = *(const u32x4*)(PR + (R0 + row) * PLD + C_RK + h * 64 + cc * 8), vw = *(const u32x4*)(PR + (R0 + row) * PLD + C_RV + h * 64 + cc * 8);
        u32x4 ok;
#pragma unroll
        for (int j = 0; j < 4; ++j) ok[j] = pack_bf16(bflo(kw[j]) * 0.125f, bfhi(kw[j]) * 0.125f);
        *(u32x4*)(KK + row * RT_PT + cc * 16) = ok; *(u32x4*)(VV + row * RT_PT + cc * 16) = vw;
    }
    {
        const int jf = rb, jb = ret_jb(rb);
#pragma unroll
        for (int q = 0; q < 2; ++q) {
            const int e = tid + 512 * q, dir = e >> 9, dk = (e >> 3) & 63, e0 = (e & 7) * 8, j = dir ? jb : jf;
            const float* src = ((float*)(p->ws + WS_RKV)) + ((((size_t)bl * 4 + h) * 2 + dir) * 34 + j) * 4096 + dk * 64 + e0;
            const f32x4 s0 = *(const f32x4*)src, s1 = *(const f32x4*)(src + 4);
            u32x4 o; o.x = pack_bf16(s0[0], s0[1]); o.y = pack_bf16(s0[2], s0[3]); o.z = pack_bf16(s1[0], s1[1]); o.w = pack_bf16(s1[2], s1[3]);
            *(u32x4*)(SS + (dir * 64 + dk) * RT_PT + e0 * 2) = o;
        }
    }
    __syncthreads();
    const int dir = wid >> 2, mt = wid & 3;
    const float lg = dir ? lgb : lgf;
    const int qi = mt * 32 + r;
    bf16x8 qf[4];
#pragma unroll
    for (int s2 = 0; s2 < 4; ++s2) qf[s2] = *(const bf16x8*)(PR + (R0 + qi) * PLD + C_RQ + h * 64 + 16 * s2 + 8 * h5);
    f32x16 o0, o1;
#pragma unroll
    for (int i = 0; i < 16; ++i) { o0[i] = 0.f; o1[i] = 0.f; }
    {
        const char* Sd = SS + dir * 64 * RT_PT;
#pragma unroll
        for (int s2 = 0; s2 < 4; ++s2) {
            const bf16x8 a0 = tr_frag_nat(Sd, RT_PT, 16 * s2, 0, lane), a1 = tr_frag_nat(Sd, RT_PT, 16 * s2, 32, lane);
            o0 = __builtin_amdgcn_mfma_f32_32x32x16_bf16(a0, qf[s2], o0, 0, 0, 0);
            o1 = __builtin_amdgcn_mfma_f32_32x32x16_bf16(a1, qf[s2], o1, 0, 0, 0);
        }
        const int pos = dir ? 127 - qi : qi;
        const float qd = __builtin_amdgcn_exp2f(lg * (float)(pos + 1));
#pragma unroll
        for (int i = 0; i < 16; ++i) { o0[i] *= qd; o1[i] *= qd; }
    }
    const int kt0 = dir ? mt : 0, kt1 = dir ? 3 : mt;
    for (int kt = kt0; kt <= kt1; ++kt) {
        f32x16 st;
#pragma unroll
        for (int i = 0; i < 16; ++i) st[i] = 0.f;
#pragma unroll
        for (int s2 = 0; s2 < 4; ++s2) {
            const bf16x8 kf = *(const bf16x8*)(KK + (kt * 32 + r) * RT_PT + s2 * 32 + 16 * h5);
            st = __builtin_amdgcn_mfma_f32_32x32x16_bf16(kf, qf[s2], st, 0, 0, 0);
        }
#pragma unroll
        for (int i = 0; i < 16; ++i) {
            const int ki = kt * 32 + (i & 3) + 8 * (i >> 2) + 4 * h5;
            const int diff = dir ? ki - qi : qi - ki;
            st[i] = diff >= 0 ? st[i] * __builtin_amdgcn_exp2f(lg * (float)diff) : 0.f;
        }
        u32x4 pw0, pw1;
        pw0.x = pack_bf16(st[0], st[1]); pw0.y = pack_bf16(st[2], st[3]); pw0.z = pack_bf16(st[4], st[5]); pw0.w = pack_bf16(st[6], st[7]);
        pw1.x = pack_bf16(st[8], st[9]); pw1.y = pack_bf16(st[10], st[11]); pw1.z = pack_bf16(st[12], st[13]); pw1.w = pack_bf16(st[14], st[15]);
        const bf16x8 pf0 = __builtin_bit_cast(bf16x8, pw0), pf1 = __builtin_bit_cast(bf16x8, pw1);
#pragma unroll
        for (int s2 = 0; s2 < 2; ++s2) {
            const bf16x8 v0 = tr_frag_acc(VV, RT_PT, kt * 32 + 16 * s2, 0, lane), v1 = tr_frag_acc(VV, RT_PT, kt * 32 + 16 * s2, 32, lane);
            o0 = __builtin_amdgcn_mfma_f32_32x32x16_bf16(v0, s2 ? pf1 : pf0, o0, 0, 0, 0);
            o1 = __builtin_amdgcn_mfma_f32_32x32x16_bf16(v1, s2 ? pf1 : pf0, o1, 0, 0, 0);
        }
    }
    float sm = 0.f;
#pragma unroll
    for (int i = 0; i < 16; ++i) sm += o0[i] + o1[i];
    sm = sum_xor32(sm);
    const float mu = sm * (1.f / 64.f);
    float vs = 0.f;
#pragma unroll
    for (int i = 0; i < 16; ++i) { const float a0 = o0[i] - mu, a1 = o1[i] - mu; vs += a0 * a0 + a1 * a1; }
    vs = sum_xor32(vs);
    const float rstd = rsqrtf(vs * (1.f / 64.f) + EPSF);
    const bf16_t* gp = PR + (R0 + qi) * PLD + (dir ? C_RGB : C_RGF) + h * 64 + 4 * h5;
    const float* gw = p->ret_gnw + l * 256 + h * 64 + 4 * h5;
    __syncthreads();
#pragma unroll
    for (int t = 0; t < 2; ++t)
#pragma unroll
        for (int g4 = 0; g4 < 4; ++g4) {
            const u32x2 gg = *(const u32x2*)(gp + 32 * t + 8 * g4); const f32x4 ww = *(const f32x4*)(gw + 32 * t + 8 * g4);
            const float g0 = bflo(gg.x), g1 = bfhi(gg.x), g2 = bflo(gg.y), g3 = bfhi(gg.y);
            f32x4 y;
            y[0] = ((t ? o1[4 * g4] : o0[4 * g4]) - mu) * rstd * ww[0] * siluf(g0);
            y[1] = ((t ? o1[4 * g4 + 1] : o0[4 * g4 + 1]) - mu) * rstd * ww[1] * siluf(g1);
            y[2] = ((t ? o1[4 * g4 + 2] : o0[4 * g4 + 2]) - mu) * rstd * ww[2] * siluf(g2);
            y[3] = ((t ? o1[4 * g4 + 3] : o0[4 * g4 + 3]) - mu) * rstd * ww[3] * siluf(g3);
            *(f32x4*)(YB + (dir * 128 + qi) * 68 + 32 * t + 8 * g4 + 4 * h5) = y;
        }
    __syncthreads();
#pragma unroll
    for (int q = 0; q < 2; ++q) {
        const int e = tid + 512 * q, row = e >> 3, c8 = (e & 7) * 8;
        const f32x4 a0 = *(const f32x4*)(YB + row * 68 + c8), a1 = *(const f32x4*)(YB + row * 68 + c8 + 4), b0 = *(const f32x4*)(YB + (128 + row) * 68 + c8), b1 = *(const f32x4*)(YB + (128 + row) * 68 + c8 + 4);
        u32x4 o; o.x = pack_bf16(a0[0] + b0[0], a0[1] + b0[1]); o.y = pack_bf16(a0[2] + b0[2], a0[3] + b0[3]); o.z = pack_bf16(a1[0] + b1[0], a1[1] + b1[1]); o.w = pack_bf16(a1[2] + b1[2], a1[3] + b1[3]);
        *(u32x4*)(((bf16_t*)(p->ws + WS_OUTS)) + ((size_t)3 * TG + R0 + row) * 256 + h * 64 + c8) = o;
    }
}

#define U_MLA (NB * 32)
#define U_GQA (NB * 32)
#define U_NA (NB * 64)
#define U_RET (NB * 136)
#define U_CTX (NB * 12)
__device__ __forceinline__ int wq_next(unsigned* counter, LAS unsigned* wq) {
    __syncthreads();
    if (get_tid() == 0) *wq = atomicAdd(counter, 1u);
    __syncthreads();
    return (int)*wq;
}
__device__ __forceinline__ void phase_p4(KP p, int l, int g, char* ldsc, int bid, int nblk)
{
    float* lds = (float*)ldsc;
    LAS unsigned* wq = (LAS unsigned*)(smem + 32);
    unsigned* counter = ((unsigned*)(p->ws + WS_CNT)) + (l * NGROUP + g) * 64 * 8;
    (void)bid; (void)nblk;
    for (;;) {
        const int u = wq_next(counter, wq); if (u >= U_MLA) break;
        const int qb = u & 7, h = (u >> 3) & 3, bl = u >> 5; const size_t Rb = (size_t)bl * LTOK, Rq = Rb + CTXL + qb * 512;
        attn_unit<96>(((bf16_t*)(p->ws + WS_QA)) + Rq * 384 + h * 96, 384, ((bf16_t*)(p->ws + WS_KA)) + Rb * 384 + h * 96, 384, ((bf16_t*)(p->ws + WS_VA)) + Rb * 256 + h * 64, 256, 512, LTOK, ((bf16_t*)(p->ws + WS_OUTS)) + ((size_t)0 * TG + Rq) * 256 + h * 64, 256, ldsc);
    }
    for (;;) {
        const int u = wq_next(counter + 64, wq); if (u >= U_GQA) break;
        const int qb = u & 7, h = (u >> 3) & 3, bl = u >> 5; const size_t Rb = (size_t)bl * LTOK, Rq = Rb + CTXL + qb * 512; const int kvh = h >> 1;
        attn_unit<64>(((bf16_t*)(p->ws + WS_GQ)) + Rq * 256 + h * 64, 256, ((bf16_t*)(p->ws + WS_GK)) + Rb * 128 + kvh * 64, 128, ((bf16_t*)(p->ws + WS_PROJ)) + Rb * PLD + C_GV + kvh * 64, PLD, 512, LTOK, ((bf16_t*)(p->ws + WS_OUTS)) + ((size_t)1 * TG + Rq) * 256 + h * 64, 256, ldsc);
    }
    for (;;) {
        const int u = wq_next(counter + 128, wq); if (u >= U_NA) break;
        na_unit(p, l, u >> 6, (u >> 4) & 3, u & 15, ldsc);
    }
    for (;;) {
        const int u = wq_next(counter + 192, wq); if (u >= U_RET) break;
        const int rb = u % 34, h = (u / 34) & 3, bl = u / 136; ret_out_unit(p, l, bl, h, rb, ldsc);
    }
    if (l == 0) {
        for (;;) {
            const int u = wq_next(counter + 256, wq); if (u >= NB * 4) break;
            const int h = u & 3, bl = u >> 2; const size_t Rb = (size_t)bl * LTOK;
            attn_unit<96>(((bf16_t*)(p->ws + WS_QA)) + Rb * 384 + h * 96, 384, ((bf16_t*)(p->ws + WS_KA)) + Rb * 384 + h * 96, 384, ((bf16_t*)(p->ws + WS_VA)) + Rb * 256 + h * 64, 256, 256, CTXL, ((bf16_t*)(p->ws + WS_OUTS)) + ((size_t)0 * TG + Rb) * 256 + h * 64, 256, ldsc);
        }
        for (;;) {
            const int u = wq_next(counter + 320, wq); if (u >= NB * 8) break;
            const int ty = u & 1, h = (u >> 1) & 3, bl = u >> 3; const size_t Rb = (size_t)bl * LTOK;
            const bf16_t* Q = ty ? ((bf16_t*)(p->ws + WS_PROJ)) + Rb * PLD + C_NQ + h * 64 : ((bf16_t*)(p->ws + WS_GQ)) + Rb * 256 + h * 64;
            const bf16_t* K = ty ? ((bf16_t*)(p->ws + WS_PROJ)) + Rb * PLD + C_NK + h * 64 : ((bf16_t*)(p->ws + WS_GK)) + Rb * 128 + (h >> 1) * 64;
            const bf16_t* V = ty ? ((bf16_t*)(p->ws + WS_PROJ)) + Rb * PLD + C_NV + h * 64 : ((bf16_t*)(p->ws + WS_PROJ)) + Rb * PLD + C_GV + (h >> 1) * 64;
            attn_unit<64>(Q, ty ? PLD : 256, K, ty ? PLD : 128, V, PLD, 256, CTXL, ((bf16_t*)(p->ws + WS_OUTS)) + ((size_t)(1 + ty) * TG + Rb) * 256 + h * 64, 256, ldsc);
        }
    }
}

template <int MI>
__device__ __forceinline__ void p5_tile(KP p, int l, char* lds, int pm, int pn, int rsub)
{
    const int tid = get_tid(), lane = tid & 63, wid = tid >> 6, wm = wid >> 1, wn = wid & 1, fr = lane & 15, fq = lane >> 4;
    const int arow = tid >> 3, akc = tid & 7, a_l = arow * G_LDP + akc * 16;
    const int aoff = (wm * 16 * MI + fr) * G_LDP + fq * 16, boff = G_ABYTES + (wn * 64 + fr) * G_LDP + fq * 16;
    const bf16_t* OUTS = (const bf16_t*)(p->ws + WS_OUTS);
    const bf16_t* WB = (const bf16_t*)(p->ws + WS_WBT) + (size_t)l * 4 * DM * 256;
    const int rbase = pm * 256 + rsub;
    {
        const bf16_t* ag = OUTS + ((size_t)rbase + arow) * 256 + akc * 8;
        const bf16_t* bg = WB + ((size_t)pn * G_BN + arow) * 256 + akc * 8;
        const unsigned char* gp = (const unsigned char*)(p->ws + WS_GATE8) + (size_t)(rbase + wm * 16 * MI + fr) * 4096 + pn * G_BN + wn * 64 + fq * 16;
        f32x4 acc[MI][4]; zero_acc<MI>(acc);
        u32x2 totp[MI][4];
#pragma unroll
        for (int mi = 0; mi < MI; ++mi)
#pragma unroll
            for (int ni = 0; ni < 4; ++ni) totp[mi][ni] = (u32x2){0u, 0u};
        u32x4 sa[2][MI], sb[2][2];
        u32x4 gwv[MI];
#define P5_LOAD(SET, KT) do { const bf16_t* a2_ = ag + (size_t)((KT) >> 2) * TG * 256 + ((KT) & 3) * 64; const bf16_t* b2_ = bg + (size_t)((KT) >> 2) * DM * 256 + ((KT) & 3) * 64; \
            _Pragma("unroll") for (int i_ = 0; i_ < MI; ++i_) sa[SET][i_] = *(const u32x4*)(a2_ + (size_t)(64 * i_) * 256); \
            _Pragma("unroll") for (int i_ = 0; i_ < 2; ++i_) sb[SET][i_] = *(const u32x4*)(b2_ + (size_t)(64 * i_) * 256); } while (0)
#define P5_STORE(SET, BO) do { \
            _Pragma("unroll") for (int i_ = 0; i_ < MI; ++i_) *(u32x4*)(lds + (BO) + a_l + i_ * 64 * G_LDP) = sa[SET][i_]; \
            _Pragma("unroll") for (int i_ = 0; i_ < 2; ++i_) *(u32x4*)(lds + (BO) + G_ABYTES + a_l + i_ * 64 * G_LDP) = sb[SET][i_]; } while (0)
        P5_LOAD(0, 0);
        __syncthreads();
        P5_STORE(0, 0);
        P5_LOAD(0, 1); P5_LOAD(1, 2);
        __syncthreads();
#pragma unroll 1
        for (int sg = 0; sg < 4; ++sg) {
#pragma unroll
            for (int q4 = 0; q4 < 4; ++q4) {
                const int par = q4 & 1, kt = 4 * sg + q4, cur = par * G_STAGE, nxt = (par ^ 1) * G_STAGE;
#pragma unroll
                for (int ks = 0; ks < 2; ++ks) {
                    bf16x8 af[MI], bfr[4];
#pragma unroll
                    for (int mi = 0; mi < MI; ++mi) af[mi] = *(const bf16x8*)(lds + cur + aoff + mi * 16 * G_LDP + ks * 64);
#pragma unroll
                    for (int ni = 0; ni < 4; ++ni) bfr[ni] = *(const bf16x8*)(lds + cur + boff + ni * 16 * G_LDP + ks * 64);
#pragma unroll
                    for (int mi = 0; mi < MI; ++mi)
#pragma unroll
                        for (int ni = 0; ni < 4; ++ni) acc[mi][ni] = __builtin_amdgcn_mfma_f32_16x16x32_bf16(bfr[ni], af[mi], acc[mi][ni], 0, 0, 0);
                }
                if (q4 == 1) {
#pragma unroll
                    for (int mi = 0; mi < MI; ++mi)
                        gwv[mi] = *(const u32x4*)(gp + (size_t)(mi * 16) * 4096 + sg * DM);
                    __builtin_amdgcn_sched_barrier(0);
                }
                P5_STORE(par, nxt);
                { const int kn = (kt + 3 < 16) ? kt + 3 : 15; P5_LOAD(par, kn); }
                __syncthreads();
                if (q4 == 3) {
                    __builtin_amdgcn_sched_barrier(0);
#pragma unroll
                    for (int mi = 0; mi < MI; ++mi)
#pragma unroll
                        for (int ni = 0; ni < 4; ++ni) {
                            const unsigned gw = gwv[mi][ni];
                            const u32x2 tp = totp[mi][ni];
                            const float t0 = fmaf((float)((gw >> 0) & 255u), acc[mi][ni][0], bflo(tp.x)), t1 = fmaf((float)((gw >> 8) & 255u), acc[mi][ni][1], bfhi(tp.x));
                            const float t2 = fmaf((float)((gw >> 16) & 255u), acc[mi][ni][2], bflo(tp.y)), t3 = fmaf((float)((gw >> 24) & 255u), acc[mi][ni][3], bfhi(tp.y));
                            totp[mi][ni] = (u32x2){pack_bf16(t0, t1), pack_bf16(t2, t3)};
                            acc[mi][ni] = (f32x4){0.f, 0.f, 0.f, 0.f};
                        }
                }
            }
        }
#undef P5_LOAD
#undef P5_STORE
#pragma unroll
        for (int mi = 0; mi < MI; ++mi)
#pragma unroll
            for (int ni = 0; ni < 4; ++ni) {
                const u32x2 tp = totp[mi][ni]; const float k255 = 1.f / 255.f;
                *(u32x2*)(((bf16_t*)(p->ws + WS_ACC)) + (size_t)(rbase + wm * 16 * MI + mi * 16 + fr) * DM + pn * G_BN + wn * 64 + ni * 16 + fq * 4) =
                    (u32x2){pack_bf16(bflo(tp.x) * k255, bfhi(tp.x) * k255), pack_bf16(bflo(tp.y) * k255, bfhi(tp.y) * k255)};
            }
    }
}

__device__ __forceinline__ void phase_p5(KP p, int l, char* lds, int bid, int nblk)
{
    constexpr int tn = DM / G_BN, total = (TG / 256) * tn, NG8 = (TG / 256) / 8;
    const bool xord = (nblk == 256) && (tn == 8) && ((TG / 256) % 8 == 0);
    if (xord) {
        constexpr int NFULL = (NG8 % 4 == 1) ? NG8 / 4 : (NG8 + 3) / 4;
#pragma unroll 1
        for (int it = 0; it < NFULL; ++it) {
            const int g8 = it * 4 + (bid >> 6); if (g8 >= NG8) break;
            p5_tile<4>(p, l, lds, g8 * 8 + (bid & 7), (bid >> 3) & 7, 0);
        }
        if (NG8 % 4 == 1) p5_tile<1>(p, l, lds, (NG8 - 1) * 8 + (bid & 7), (bid >> 3) & 7, (bid >> 6) * 64);
    } else {
        for (int t = bid; t < total; t += nblk) p5_tile<4>(p, l, lds, t / tn, t % tn, 0);
    }
}

struct EpiResid {
    KP p; int l, g, goff;
    __device__ __forceinline__ void operator()(int row, int col, f32x4 v) const {
        const int bl = row / LTOK, t = row - bl * LTOK, b = g * NB + bl;
        float* dst; const float* src; int mr;
        if (t < CTXL) { if (l != 0) return; const size_t o = ((size_t)b * CTXL + t) * DM + col; dst = ((float*)(p->ws + WS_CTXS)) + o; src = p->ctx + o; mr = 16; }
        else { const size_t o = ((size_t)b * SEQ + (t - CTXL)) * DM + col; dst = p->out + o; src = (l == 0) ? p->x + o : (const float*)dst; mr = b; }
        const f32x4 gg = *(const f32x4*)(((float*)(p->ws + WS_MOD)) + ((size_t)l * 17 + mr) * 6144 + goff + col);
        f32x4 s = *(const f32x4*)src;
#pragma unroll
        for (int j = 0; j < 4; ++j) s[j] += gg[j] * v[j];
        *(f32x4*)dst = s;
    }
};

__device__ __forceinline__ void grid_barrier();
#if MK_ONE_LAUNCH
#define P9_GRID_SYNC() grid_barrier()
#else
#define P9_GRID_SYNC() __syncthreads()
#endif
typedef __bf16 bf16pair __attribute__((ext_vector_type(2)));
__device__ __forceinline__ float dot2bf(unsigned a, unsigned b, float c) { return __builtin_amdgcn_fdot2_f32_bf16(__builtin_bit_cast(bf16pair, a), __builtin_bit_cast(bf16pair, b), c, false); }
__device__ __forceinline__ unsigned f2ord(float f) { const unsigned b = __float_as_uint(f); return b ^ ((unsigned)((int)b >> 31) | 0x80000000u); }
__device__ __forceinline__ int mbcnt64(unsigned long long m) { return (int)__builtin_amdgcn_mbcnt_hi((unsigned)(m >> 32), __builtin_amdgcn_mbcnt_lo((unsigned)m, 0u)); }

__device__ __forceinline__ float ord2f(unsigned u) { return __uint_as_float((u & 0x80000000u) ? (u ^ 0x80000000u) : ~u); }

__device__ __forceinline__ void cx_desc(unsigned& a, unsigned& b) { const unsigned hi = a > b ? a : b, lo = a > b ? b : a; a = hi; b = lo; }
template <int N, int OFF, bool DESC, int M>
__device__ __forceinline__ void bitonic_sort(unsigned (&a)[M]) {
#pragma unroll
    for (int k = 2; k <= N; k <<= 1)
#pragma unroll
        for (int j = k >> 1; j > 0; j >>= 1)
#pragma unroll
            for (int i = 0; i < N; ++i) {
                const int l = i ^ j;
                if (l > i) { const bool up = ((i & k) == 0) != DESC; if (up) cx_desc(a[OFF + l], a[OFF + i]); else cx_desc(a[OFF + i], a[OFF + l]); }
            }
}
__device__ __forceinline__ void bitonic_merge16_desc(unsigned (&a)[16]) {
#pragma unroll
    for (int j = 8; j > 0; j >>= 1)
#pragma unroll
        for (int i = 0; i < 16; ++i) { const int l = i ^ j; if (l > i) cx_desc(a[i], a[l]); }
}
template <int XM>
__device__ __forceinline__ void merge_partner16(unsigned (&a)[16], bool upper) {
    unsigned b[16];
#pragma unroll
    for (int i = 0; i < 16; ++i) b[i] = (XM == 32) ? get_xor32_u(a[15 - i], upper) : xor_swz_u<XM & 31>(a[15 - i]);
#pragma unroll
    for (int i = 0; i < 16; ++i) a[i] = a[i] > b[i] ? a[i] : b[i];
    bitonic_merge16_desc(a);
}

#define P9_KEYP 144
#define P9_NTOK 136
#define P9_HG 3
#define P9_LKEY 0
#define P9_LIDX (P9_HG * 2 * 128 * P9_KEYP)
#define P9_LSTASH 0
__device__ __forceinline__ constexpr int p9_pair_i(int pi) {
    return pi < 16 ? 0 : pi < 24 ? 1 : pi < 29 ? 2 : pi < 33 ? 3 : pi < 36 ? 4 : pi < 38 ? 5 : pi < 40 ? 6 : pi < 42 ? 7 : pi < 50 ? pi - 34 : 0;
}
__device__ __forceinline__ constexpr int p9_pair_j(int pi) {
    return pi < 16 ? pi : pi < 24 ? pi - 16 : pi < 29 ? pi - 24 : pi < 33 ? pi - 29 : pi < 36 ? pi - 33 : pi < 38 ? pi - 36 : pi < 40 ? pi - 38 : pi < 42 ? pi - 40 : 0;
}
__device__ __forceinline__ void phase_p9(KP p, int l, int g, char* lds, int bid, int nblk)
{
    const int tid = get_tid(), wid = tid >> 6;
    const bf16_t* KEYB = (const bf16_t*)(p->ws + WS_KEYB) + (size_t)l * 8 * 2 * 128 * 64;
    const bf16_t* PQ = (const bf16_t*)(p->ws + WS_PQ);
    unsigned* stash = (unsigned*)(lds + P9_LSTASH);
    const int nit = (TG / P9_NTOK + nblk - 1) / nblk;
    for (int it = 0; it < nit; ++it) {
        const int blk = bid + it * nblk;
        if (blk >= TG / P9_NTOK) { P9_GRID_SYNC(); P9_GRID_SYNC(); continue; }
        const int row0 = blk * P9_NTOK;
        unsigned* gst = (unsigned*)(p->ws + WS_PROJ) + (size_t)row0 * 128;
#pragma unroll 1
        for (int h0 = 0; h0 < 8; h0 += P9_HG) {
            const int nh = (8 - h0) < P9_HG ? (8 - h0) : P9_HG;
            __syncthreads();
            for (int c = tid; c < nh * 2048; c += NTHREADS) { const int row = c >> 3, cc = c & 7;
                *(u32x4*)(lds + P9_LKEY + row * P9_KEYP + cc * 16) = *(const u32x4*)(KEYB + ((size_t)h0 * 256 + row) * 64 + cc * 8); }
            __syncthreads();
#pragma unroll 1
            for (int item = wid; item < 9 * nh; item += 8) {
                const int tile = item % 9, hh = item / 9, h = h0 + hh;
                const int LK = P9_LKEY + hh * 256 * P9_KEYP;
                const int tidh = get_tid(), tk = tidh & 15, qd = (tidh >> 4) & 3;
                const int ntile = (P9_NTOK - 16 * tile) < 16 ? (P9_NTOK - 16 * tile) : 16;
                const int trow = row0 + 16 * tile + (tk < ntile ? tk : ntile - 1);
                unsigned* idxl = (unsigned*)(lds + P9_LIDX) + (wid * 16 + tk) * 33;
                unsigned top[2][16];
#pragma unroll
                for (int pp = 0; pp < 2; ++pp) {
                    f32x4 acc[8];
#pragma unroll
                    for (int t = 0; t < 8; ++t) acc[t] = (f32x4){0.f, 0.f, 0.f, 0.f};
#pragma unroll
                    for (int ks = 0; ks < 2; ++ks) {
                        const bf16x8 qfr = *(const bf16x8*)(PQ + (size_t)trow * DM + h * 128 + pp * 64 + ks * 32 + qd * 8);
#pragma unroll
                        for (int t = 0; t < 8; ++t) {
                            const bf16x8 kfr = *(const bf16x8*)(lds + LK + (pp * 128 + t * 16 + tk) * P9_KEYP + ks * 64 + qd * 16);
                            acc[t] = __builtin_amdgcn_mfma_f32_16x16x32_bf16(kfr, qfr, acc[t], 0, 0, 0);
                        }
                    }
                    unsigned ck[32];
#pragma unroll
                    for (int t = 0; t < 8; ++t)
#pragma unroll
                        for (int jj = 0; jj < 4; ++jj) ck[t * 4 + jj] = (f2ord(acc[t][jj]) & 0xFFFFFF80u) | (unsigned)(16 * t + jj) | ((unsigned)qd << 2);
                    bitonic_sort<16, 0, true>(ck);
                    bitonic_sort<16, 16, false>(ck);
                    unsigned (&tp)[16] = top[pp];
#pragma unroll
                    for (int i = 0; i < 16; ++i) tp[i] = ck[i] > ck[16 + i] ? ck[i] : ck[16 + i];
                    bitonic_merge16_desc(tp);
                    merge_partner16<16>(tp, false); merge_partner16<32>(tp, (qd & 2) != 0);
                    if (qd == 0) {
#pragma unroll
                        for (int i = 0; i < 16; ++i) idxl[pp * 16 + i] = tp[i] & 127u;
                    }
                }
                float v1[16], v2[16];
#pragma unroll
                for (int i = 0; i < 16; ++i) { v1[i] = ord2f(top[0][i] & 0xFFFFFF80u); v2[i] = ord2f(top[1][i] & 0xFFFFFF80u); }
                unsigned cand[16];
#pragma unroll
                for (int n = 0; n < 13; ++n) {
                    const unsigned k0 = (f2ord(v1[p9_pair_i(4 * n)] + v2[p9_pair_j(4 * n)]) & 0xFFFFFF00u) | (unsigned)(p9_pair_i(4 * n) * 16 + p9_pair_j(4 * n));
                    const unsigned k1 = (f2ord(v1[p9_pair_i(4 * n + 1)] + v2[p9_pair_j(4 * n + 1)]) & 0xFFFFFF00u) | (unsigned)(p9_pair_i(4 * n + 1) * 16 + p9_pair_j(4 * n + 1));
                    const unsigned k2 = (4 * n + 2 < 50) ? ((f2ord(v1[p9_pair_i(4 * n + 2)] + v2[p9_pair_j(4 * n + 2)]) & 0xFFFFFF00u) | (unsigned)(p9_pair_i(4 * n + 2) * 16 + p9_pair_j(4 * n + 2))) : 0u;
                    const unsigned k3 = (4 * n + 3 < 50) ? ((f2ord(v1[p9_pair_i(4 * n + 3)] + v2[p9_pair_j(4 * n + 3)]) & 0xFFFFFF00u) | (unsigned)(p9_pair_i(4 * n + 3) * 16 + p9_pair_j(4 * n + 3))) : 0u;
                    cand[n] = qd == 0 ? k0 : (qd == 1 ? k1 : (qd == 2 ? k2 : k3));
                }
                cand[13] = 0u; cand[14] = 0u; cand[15] = 0u;
                bitonic_sort<16, 0, true>(cand);
                merge_partner16<16>(cand, false); merge_partner16<32>(cand, (qd & 2) != 0);
                const float mx = ord2f(cand[0] & 0xFFFFFF00u);
                float ex[16], den = 0.f;
#pragma unroll
                for (int k = 0; k < 16; ++k) { ex[k] = __expf(ord2f(cand[k] & 0xFFFFFF00u) - mx); den += ex[k]; }
                const float inv = 1.f / den;
                if (qd == 0 && tk < ntile) {
#pragma unroll
                    for (int k = 0; k < 16; ++k) {
                        const unsigned e = idxl[(cand[k] >> 4) & 15u] * 128u + idxl[16 + (cand[k] & 15u)];
                        gst[((16 * tile + tk) * 8 + h) * 16 + k] = (e << 16) | (unsigned)f2bf(ex[k] * inv);
                    }
                }
            }
        }
        P9_GRID_SYNC();
        {
            const u32x4* src = (const u32x4*)gst; u32x4* dstl = (u32x4*)(lds + P9_LSTASH);
            for (int c = get_tid(); c < P9_NTOK * 128 / 4; c += NTHREADS) dstl[c] = src[c];
            __syncthreads();
        }
        {
            const int tid2 = get_tid(), lane = tid2 & 63, wid2 = tid2 >> 6;
            KP p2 = get_kp();
            const unsigned char* UB = (const unsigned char*)(p2->ws + WS_UB) + (size_t)l * 16384 * (DM / 2);
            const float* USC = (const float*)(p2->ws + WS_USC) + (size_t)l * 16384; const float* VSC = (const float*)(p2->ws + WS_VSC) + (size_t)l * 16384;
            const float* URS = (const float*)(p2->ws + WS_URS) + (size_t)l * 16384;
            const bf16_t* Hh = HG(p2, g);
#pragma unroll 1
            for (int slot = wid2; slot < P9_NTOK; slot += 8) {
                const int r = row0 + slot;
                if ((r % LTOK) < CTXL && l != 0) continue;
                const u32x4 x0 = *(const u32x4*)(Hh + (size_t)r * DM + lane * 16), x1 = *(const u32x4*)(Hh + (size_t)r * DM + lane * 16 + 8);
                unsigned HW0 = 0u, HW1 = 0u, LW0 = 0u, LW1 = 0u; float sx;
                {
                    float xf[16];
                    xf[0] = bflo(x0.x); xf[1] = bfhi(x0.x); xf[2] = bflo(x0.y); xf[3] = bfhi(x0.y); xf[4] = bflo(x0.z); xf[5] = bfhi(x0.z); xf[6] = bflo(x0.w); xf[7] = bfhi(x0.w);
                    xf[8] = bflo(x1.x); xf[9] = bfhi(x1.x); xf[10] = bflo(x1.y); xf[11] = bfhi(x1.y); xf[12] = bflo(x1.z); xf[13] = bfhi(x1.z); xf[14] = bflo(x1.w); xf[15] = bfhi(x1.w);
                    float am = 0.f;
#pragma unroll
                    for (int i = 0; i < 16; ++i) am = fmaxf(am, fabsf(xf[i]));
                    am = wave_max(am);
                    sx = am > 0.f ? am * (1.f / 127.f) : 1.f;
                    const float ix = 1.f / sx;
#pragma unroll
                    for (int i = 0; i < 16; ++i) {
                        const int v_ = (int)fminf(fmaxf(__builtin_rintf(xf[i] * ix), -128.f), 127.f) + 128;
                        const unsigned hs = (unsigned)((v_ >> 4) - 8) & 15u, ls = (unsigned)((v_ & 15) - 8) & 15u;
                        if (i < 8) { HW0 |= hs << (4 * i); LW0 |= ls << (4 * i); } else { HW1 |= hs << (4 * (i - 8)); LW1 |= ls << (4 * (i - 8)); }
                    }
                }
#pragma unroll 1
                for (int h = 0; h < 8; ++h) {
                    unsigned* st = stash + (slot * 8 + h) * 16;
                    int d[16];
                    const int kk = (lane >> 2) & 15;
                    const unsigned sk = st[kk];
                    const float su = USC[sk >> 16], svs = VSC[sk >> 16], urs = URS[sk >> 16];
                    {
                        u32x2 ua[16];
#pragma unroll
                        for (int k = 0; k < 16; ++k) ua[k] = *(const u32x2*)(UB + (((st[k] >> 7) & 0x1FFFE00u) | (unsigned)(lane * 8)));
#pragma unroll
                        for (int k = 0; k < 16; ++k) {
                            int dh = __builtin_amdgcn_sdot8((int)ua[k].x, (int)HW0, 0, false); dh = __builtin_amdgcn_sdot8((int)ua[k].y, (int)HW1, dh, false);
                            int dl = __builtin_amdgcn_sdot8((int)ua[k].x, (int)LW0, 0, false); dl = __builtin_amdgcn_sdot8((int)ua[k].y, (int)LW1, dl, false);
                            d[k] = 16 * dh + dl;
                        }
                    }
                    int r8[8], r4[4], r2[2], ri;
#pragma unroll
                    for (int i = 0; i < 8; ++i) { const u32x2 sw = __builtin_amdgcn_permlane32_swap((unsigned)d[i], (unsigned)d[i + 8], false, false); r8[i] = (int)sw.x + (int)sw.y; }
#pragma unroll
                    for (int i = 0; i < 4; ++i) { const u32x2 sw = __builtin_amdgcn_permlane16_swap((unsigned)r8[i], (unsigned)r8[i + 4], false, false); r4[i] = (int)sw.x + (int)sw.y; }
                    { const bool bb = (lane & 8) != 0;
#pragma unroll
                      for (int i = 0; i < 2; ++i) { const int snd = bb ? r4[i] : r4[i + 2], keep = bb ? r4[i + 2] : r4[i]; r2[i] = keep + (int)xor_swz_u<8>((unsigned)snd); } }
                    { const bool bb = (lane & 4) != 0; const int snd = bb ? r2[0] : r2[1], keep = bb ? r2[1] : r2[0]; ri = keep + (int)xor_swz_u<4>((unsigned)snd); }
                    ri += (int)xor_swz_u<2>((unsigned)ri); ri += (int)xor_swz_u<1>((unsigned)ri);
                    float r1 = ((float)ri + urs) * (su * sx);
                    const float cf = bflo(sk) * 0.5f * r1 * (1.f + erff(r1 * 0.70710678118654752f)) * svs;
                    if ((lane & 3) == 0) st[kk] = (sk & 0xffff0000u) | (unsigned)f2bf(cf);
                }
            }
        }
        P9_GRID_SYNC();
        {
            const int tid2 = get_tid(), lane = tid2 & 63, wid2 = tid2 >> 6;
            KP p2 = get_kp();
            const unsigned char* VB = (const unsigned char*)(p2->ws + WS_VB) + (size_t)l * 16384 * (DM / 2);
#pragma unroll 1
            for (int slot = wid2; slot < P9_NTOK; slot += 8) {
                const int r = row0 + slot;
                const int bl = r / LTOK, t = r - bl * LTOK, b = g * NB + bl;
                if (t < CTXL && l != 0) continue;
                float* dst; int mr;
                if (t < CTXL) { dst = ((float*)(p2->ws + WS_CTXS)) + ((size_t)b * CTXL + t) * DM; mr = 16; } else { dst = p2->out + ((size_t)b * SEQ + (t - CTXL)) * DM; mr = b; }
                const float* g2 = ((float*)(p2->ws + WS_MOD)) + ((size_t)l * 17 + mr) * 6144 + 5120;
                f32x4 sv[4];
#pragma unroll
                for (int i = 0; i < 4; ++i) sv[i] = *(const f32x4*)(dst + lane * 16 + i * 4);
                float outv[16];
#pragma unroll
                for (int i = 0; i < 16; ++i) outv[i] = 0.f;
#pragma unroll 1
                for (int h = 0; h < 8; ++h) {
                    const unsigned* st = stash + (slot * 8 + h) * 16;
                    u32x2 va[16]; unsigned sk[16];
#pragma unroll
                    for (int k = 0; k < 16; ++k) { sk[k] = st[k]; va[k] = *(const u32x2*)(VB + (((sk[k] >> 7) & 0x1FFFE00u) | (unsigned)(lane * 8))); }
#pragma unroll
                    for (int k = 0; k < 16; ++k) {
                        const float ck = bflo(sk[k]);
#define P9_VFMA(W, B) { const f32x2 t_ = __builtin_amdgcn_cvt_scalef32_pk_f32_fp4(va[k][W], 1.0f, B); outv[8 * (W) + 2 * (B)] += ck * t_.x; outv[8 * (W) + 2 * (B) + 1] += ck * t_.y; }
                        P9_VFMA(0, 0) P9_VFMA(0, 1) P9_VFMA(0, 2) P9_VFMA(0, 3) P9_VFMA(1, 0) P9_VFMA(1, 1) P9_VFMA(1, 2) P9_VFMA(1, 3)
#undef P9_VFMA
                        if ((k & 3) == 3) __builtin_amdgcn_sched_barrier(0);
                    }
                }
                const int lane = get_tid() & 63;
                float ss = 0.f;
#pragma unroll
                for (int i = 0; i < 4; ++i) {
                    const f32x4 gg = *(const f32x4*)(g2 + lane * 16 + i * 4);
#pragma unroll
                    for (int jj = 0; jj < 4; ++jj) { sv[i][jj] += gg[jj] * outv[i * 4 + jj]; ss += sv[i][jj] * sv[i][jj]; }
                }
                if (l == 0) {
                    const float rstd0 = rsqrtf(wave_sum(ss) * (1.f / DM) + EPSF);
                    const float* md1 = ((float*)(p2->ws + WS_MOD)) + ((size_t)17 + mr) * 6144;
                    bf16_t* hrow = HG(p2, g) + (size_t)r * DM + lane * 16;
#pragma unroll
                    for (int i = 0; i < 4; ++i) {
                        const int c = lane * 16 + i * 4;
                        const f32x4 w1 = *(const f32x4*)(p2->norm1_w + DM + c), sc = *(const f32x4*)(md1 + 1024 + c), sh = *(const f32x4*)(md1 + c);
                        f32x4 y;
#pragma unroll
                        for (int jj = 0; jj < 4; ++jj) y[jj] = sv[i][jj] * rstd0 * w1[jj] * (1.f + sc[jj]) + sh[jj];
                        store_bf16x4(hrow + i * 4, y);
                    }
                }
                if (l == 1) {
                    ss = wave_sum(ss);
                    const float rstd = rsqrtf(ss * (1.f / DM) + EPSF);
#pragma unroll
                    for (int i = 0; i < 4; ++i) { const f32x4 fw = *(const f32x4*)(p2->final_w + lane * 16 + i * 4);
#pragma unroll
                        for (int jj = 0; jj < 4; ++jj) sv[i][jj] *= rstd * fw[jj]; }
                }
#pragma unroll
                for (int i = 0; i < 4; ++i) *(f32x4*)(dst + lane * 16 + i * 4) = sv[i];
            }
        }
    }
}

__device__ __forceinline__ void phase_final(KP p, int bid, int nblk)
{
    const int lane = get_tid() & 63, wid = get_tid() >> 6;
    for (int r = bid * 8 + wid; r < NBATCH * SEQ; r += nblk * 8) {
        float* src = p->out + (size_t)r * DM;
        f32x4 v[4]; float ss = 0.f;
#pragma unroll
        for (int i = 0; i < 4; ++i) { v[i] = *(const f32x4*)(src + i * 256 + lane * 4); ss += v[i][0] * v[i][0] + v[i][1] * v[i][1] + v[i][2] * v[i][2] + v[i][3] * v[i][3]; }
        ss = wave_sum(ss);
        const float rstd = rsqrtf(ss * (1.f / DM) + EPSF);
#pragma unroll
        for (int i = 0; i < 4; ++i) {
            const f32x4 w = *(const f32x4*)(p->final_w + i * 256 + lane * 4);
            f32x4 y;
#pragma unroll
            for (int j = 0; j < 4; ++j) y[j] = v[i][j] * rstd * w[j];
            *(f32x4*)(src + i * 256 + lane * 4) = y;
        }
    }
}

template <int PH>
__device__ __forceinline__ void run_phase(KP p, int l, int g, char* lds, int bid, int nblk)
{
    asm volatile("" : "+s"(l), "+s"(g), "+s"(bid), "+s"(nblk));
    if constexpr (PH == 0) phase_prologue(p, lds, bid, nblk);
    if constexpr (PH == 1) { for (int gg = 0; gg < NGROUP; ++gg) phase_norm(p, 0, gg, 0, bid, nblk); }
    if constexpr (PH == 2) big_gemm(HG(p, g), ((bf16_t*)(p->ws + WS_WINT)) + (size_t)l * NPROJ * DM, TG, NPROJ, DM, Epi8<EpiProj8>{EpiProj8{((bf16_t*)(p->ws + WS_PROJ)), (unsigned char*)(p->ws + WS_GATE8)}}, lds, bid, nblk);
    if constexpr (PH == 3) phase_p3a(p, l, bid, nblk, lds);
    if constexpr (PH == 4) phase_p3b(p, l, bid, nblk);
    if constexpr (PH == 6) phase_p4(p, l, g, lds, bid, nblk);
    if constexpr (PH == 7) phase_p5(p, l, lds, bid, nblk);
    if constexpr (PH == 8) big_gemm(((bf16_t*)(p->ws + WS_ACC)), ((bf16_t*)(p->ws + WS_WOUTT)) + (size_t)l * DM * DM, TG, DM, DM, Epi4<EpiResid>{EpiResid{p, l, g, 2048}}, lds, bid, nblk);
    if constexpr (PH == 9) phase_norm(p, l, g, 1, bid, nblk);
    if constexpr (PH == 10) big_gemm(HG(p, g), ((bf16_t*)(p->ws + WS_WQT)) + (size_t)l * DM * DM, TG, DM, DM, Epi8<EpiStore8>{EpiStore8{((bf16_t*)(p->ws + WS_PQ)), DM}}, lds, bid, nblk);
    if constexpr (PH == 11) phase_p9(p, l, g, lds, bid, nblk);
    if constexpr (PH == 12) phase_final(p, bid, nblk);
}


__device__ __forceinline__ void grid_barrier() {
    XcdBarrier b; b.bar = (unsigned*)(get_kp()->ws + WS_BAR); b.x = xb_xcc_id(); b.st = (volatile LAS unsigned*)smem;
    xcd_barrier(b);
}

template <int PH>
__global__ void __launch_bounds__(NTHREADS, 2) k_phase(Params p_unused, int l, int g)
{
    (void)p_unused;
    tid_setup();
    run_phase<PH>(get_kp(), l, g, smem + 512, blockIdx.x, gridDim.x);
}

#if MK_ONE_LAUNCH
__global__ void __launch_bounds__(NTHREADS, 2) k_mega(Params p_unused)
{
    (void)p_unused;
    tid_setup();
    if (get_tid() == 0) *(uint4*)smem = make_uint4(0u, 0u, 0u, 0u);
    __syncthreads();
    (void)xcd_barrier_post((unsigned*)(get_kp()->ws + WS_BAR), (volatile LAS unsigned*)smem);
    char* lds = smem + 512;
    const int bid = blockIdx.x, nblk = gridDim.x;
    run_phase<0>(get_kp(), 0, 0, lds, bid, nblk);
    grid_barrier();
#define MK_LG(L_, G_) do { \
        run_phase<2>(get_kp(), L_, G_, lds, bid, nblk); grid_barrier(); \
        run_phase<3>(get_kp(), L_, G_, lds, bid, nblk); grid_barrier(); \
        run_phase<4>(get_kp(), L_, G_, lds, bid, nblk); grid_barrier(); \
        run_phase<6>(get_kp(), L_, G_, lds, bid, nblk); grid_barrier(); \
        run_phase<7>(get_kp(), L_, G_, lds, bid, nblk); grid_barrier(); \
        run_phase<8>(get_kp(), L_, G_, lds, bid, nblk); grid_barrier(); \
        run_phase<9>(get_kp(), L_, G_, lds, bid, nblk); grid_barrier(); \
        run_phase<10>(get_kp(), L_, G_, lds, bid, nblk); grid_barrier(); \
        run_phase<11>(get_kp(), L_, G_, lds, bid, nblk); grid_barrier(); } while (0)
    run_phase<1>(get_kp(), 0, 0, lds, bid, nblk); grid_barrier();
    static_assert(NGROUP == 2, "phase program written out for two groups");
    MK_LG(0, 0); MK_LG(0, 1); MK_LG(1, 0); MK_LG(1, 1);
#undef MK_LG
}
#endif

static inline size_t al256(size_t x) { return (x + 255) & ~(size_t)255; }

template <int PH>
static void launch_phase(const Params& p, int l, int g, int grid, hipStream_t s)
{
    static bool attr = false;
    if (!attr) { (void)hipFuncSetAttribute((const void*)k_phase<PH>, hipFuncAttributeMaxDynamicSharedMemorySize, LDS_BYTES); attr = true; }
    hipLaunchKernelGGL(k_phase<PH>, dim3(grid), dim3(NTHREADS), LDS_BYTES, s, p, l, g);
}

extern "C" void kernel_launch(void* const* d_in, const int* in_sizes, int n_in, void* d_out, int out_size, void* d_ws, size_t ws_size, hipStream_t stream)
{
    (void)in_sizes; (void)n_in; (void)out_size;
    Params p{};
    p.x = (const float*)d_in[0]; p.c = (const float*)d_in[1]; p.ctx = (const float*)d_in[2]; p.c_ctx = (const float*)d_in[3];
    p.mod_w = (const float*)d_in[4]; p.mod_b = (const float*)d_in[5]; p.norm1_w = (const float*)d_in[6]; p.norm2_w = (const float*)d_in[7];
    p.w_in = (const float*)d_in[8]; p.mla_qn = (const float*)d_in[9]; p.mla_wuq = (const float*)d_in[10]; p.mla_kvn = (const float*)d_in[11];
    p.mla_wukv = (const float*)d_in[12]; p.gqa_qn = (const float*)d_in[13]; p.gqa_kn = (const float*)d_in[14]; p.na_bias = (const float*)d_in[15];
    p.ret_logit = (const float*)d_in[16]; p.ret_gnw = (const float*)d_in[17]; p.w_branch = (const float*)d_in[18]; p.w_out = (const float*)d_in[19];
    p.peer_wq = (const float*)d_in[20]; p.peer_keys = (const float*)d_in[21]; p.peer_u = (const float*)d_in[22]; p.peer_v = (const float*)d_in[23];
    p.final_w = (const float*)d_in[24];
    p.out = (float*)d_out;
    p.ws = (char*)d_ws;
    if (WS_TOTAL > ws_size) { fprintf(stderr, "workspace too small: need %zu have %zu\n", (size_t)WS_TOTAL, ws_size); return; }
    (void)hipMemsetAsync(d_ws, 0, WS_ZERO_END, stream);

    static int ncu = 0;
    if (!ncu) { int dev = 0; (void)hipGetDevice(&dev); (void)hipDeviceGetAttribute(&ncu, hipDeviceAttributeMultiprocessorCount, dev); if (ncu <= 0) ncu = 256; }
#if MK_ONE_LAUNCH
    static bool attr = false;
    if (!attr) { (void)hipFuncSetAttribute((const void*)k_mega, hipFuncAttributeMaxDynamicSharedMemorySize, LDS_BYTES); attr = true; }
    hipLaunchKernelGGL(k_mega, dim3(ncu), dim3(NTHREADS), LDS_BYTES, stream, p);
#else
    const int grid = ncu;
    launch_phase<0>(p, 0, 0, grid, stream);
    for (int l = 0; l < 2; ++l)
        for (int g = 0; g < NGROUP; ++g) {
            if (l == 0 && g == 0) launch_phase<1>(p, l, g, grid, stream);
            launch_phase<2>(p, l, g, grid, stream);
            launch_phase<3>(p, l, g, grid, stream);
            launch_phase<4>(p, l, g, grid, stream);
            launch_phase<6>(p, l, g, grid, stream);
            launch_phase<7>(p, l, g, grid, stream);
            launch_phase<8>(p, l, g, grid, stream);
            launch_phase<9>(p, l, g, grid, stream);
            launch_phase<10>(p, l, g, grid, stream);
            launch_phase<11>(p, l, g, grid, stream);
        }
#endif
}
```

```cpp
#include <hip/hip_runtime.h>
#include <stdint.h>
#include <stdio.h>

#ifndef MK_ONE_LAUNCH
#define MK_ONE_LAUNCH 1
#endif

#define DM 1024
#define NBATCH 16
#define SEQ 4096
#define CTXL 256
#define LTOK 4352
#define IN_COLS 7072
#define NPROJ 7168
#define PLD 3072
#define NB 8
#define NGROUP (NBATCH / NB)
#define TG (NB * LTOK)
#define NTHREADS 512
#define LDS_BYTES 131648
#define EPSF 1e-6f

#define C_CQ 0
#define C_CKV 256
#define C_KPE 384
#define C_GQ 416
#define C_GK 672
#define C_GV 800
#define C_NQ 928
#define C_NK 1184
#define C_NV 1440
#define C_RQ 1696
#define C_RK 1952
#define C_RV 2208
#define C_RGF 2464
#define C_RGB 2720
#define C_GATE 2976

#define LAS __attribute__((address_space(3)))
typedef unsigned short bf16_t;
typedef short bf16x8 __attribute__((ext_vector_type(8)));
typedef float f32x4 __attribute__((ext_vector_type(4)));
typedef float f32x2 __attribute__((ext_vector_type(2)));
typedef __bf16 bf16x2_t __attribute__((ext_vector_type(2)));
typedef unsigned u32x4 __attribute__((ext_vector_type(4)));
typedef unsigned u32x2 __attribute__((ext_vector_type(2)));
typedef float f32x16 __attribute__((ext_vector_type(16)));
typedef short s16x4 __attribute__((ext_vector_type(4)));

__device__ __forceinline__ unsigned pack_bf16(float lo, float hi) { f32x2 v = {lo, hi}; bf16x2_t b = __builtin_convertvector(v, bf16x2_t); return __builtin_bit_cast(unsigned, b); }
__device__ __forceinline__ bf16_t f2bf(float f) { return (bf16_t)(pack_bf16(f, 0.f) & 0xffffu); }
__device__ __forceinline__ float bf2f(bf16_t b) { return __uint_as_float(((unsigned)b) << 16); }
__device__ __forceinline__ float bflo(unsigned w) { return __uint_as_float(w << 16); }
__device__ __forceinline__ float bfhi(unsigned w) { return __uint_as_float(w & 0xffff0000u); }
#define PEER_USCALE 128.f
#define PEER_VSCALE 16.f
__device__ __forceinline__ float clamp448(float x) { return fminf(fmaxf(x, -448.f), 448.f); }
__device__ __forceinline__ unsigned pack_fp8x4(f32x4 v, float sc) {
    int w = 0;
    w = __builtin_amdgcn_cvt_pk_fp8_f32(clamp448(v[0] * sc), clamp448(v[1] * sc), w, false);
    w = __builtin_amdgcn_cvt_pk_fp8_f32(clamp448(v[2] * sc), clamp448(v[3] * sc), w, true);
    return (unsigned)w;
}

template <int M> __device__ __forceinline__ float xor_swz(float v) { return __int_as_float(__builtin_amdgcn_ds_swizzle(__float_as_int(v), (M << 10) | 0x1f)); }
template <int M> __device__ __forceinline__ unsigned xor_swz_u(unsigned v) { return (unsigned)__builtin_amdgcn_ds_swizzle((int)v, (M << 10) | 0x1f); }
__device__ __forceinline__ float sum_xor32(float v) { const u32x2 r = __builtin_amdgcn_permlane32_swap(__float_as_uint(v), __float_as_uint(v), false, false); return __uint_as_float(r.x) + __uint_as_float(r.y); }
__device__ __forceinline__ float max_xor32(float v) { const u32x2 r = __builtin_amdgcn_permlane32_swap(__float_as_uint(v), __float_as_uint(v), false, false); return fmaxf(__uint_as_float(r.x), __uint_as_float(r.y)); }
__device__ __forceinline__ unsigned get_xor32_u(unsigned v, bool upper) { const u32x2 r = __builtin_amdgcn_permlane32_swap(v, v, false, false); return upper ? r.x : r.y; }
__device__ __forceinline__ float wave_max(float v) {
    v = fmaxf(v, xor_swz<1>(v)); v = fmaxf(v, xor_swz<2>(v)); v = fmaxf(v, xor_swz<4>(v)); v = fmaxf(v, xor_swz<8>(v)); v = fmaxf(v, xor_swz<16>(v));
    return max_xor32(v);
}
__device__ __forceinline__ float wave_sum(float v) {
    v += xor_swz<1>(v); v += xor_swz<2>(v); v += xor_swz<4>(v); v += xor_swz<8>(v); v += xor_swz<16>(v);
    return sum_xor32(v);
}
extern __shared__ __attribute__((aligned(16))) char smem[];
#define WIDTAB_OFF 64
__device__ __forceinline__ unsigned hw_wave_slot() { return (unsigned)__builtin_amdgcn_s_getreg((5 << 11) | 4) & 63u; }
__device__ __forceinline__ void tid_setup() {
    if ((threadIdx.x & 63) == 0) ((volatile LAS int*)(smem + WIDTAB_OFF))[hw_wave_slot()] = (int)(threadIdx.x >> 6);
    __syncthreads();
}
__device__ __forceinline__ int get_tid() {
    int lane; asm volatile("v_mbcnt_lo_u32_b32 %0, -1, 0\n\tv_mbcnt_hi_u32_b32 %0, -1, %0" : "=v"(lane));
    int w = ((volatile LAS int*)(smem + WIDTAB_OFF))[hw_wave_slot()];
    w = __builtin_amdgcn_readfirstlane(w);
    int t = (w << 6) | lane; asm volatile("" : "+v"(t)); return t;
}
__device__ __forceinline__ float siluf(float x) { return x * __builtin_amdgcn_rcpf(1.f + __builtin_amdgcn_exp2f(x * -1.4426950408889634f)); }
__device__ __forceinline__ float sigmf(float x) { return __builtin_amdgcn_rcpf(1.f + __builtin_amdgcn_exp2f(x * -1.4426950408889634f)); }

#define XB_TMO      128
#define XB_XCNT(j)  (256  + 64 * (j))
#define XB_XSUB(j)  (1280 + 64 * (j))
#define XB_XGEN(j)  (2304 + 64 * (j))
#define XB_TOP      3328
#define XB_TOPGEN   3392
#define XCD_BAR_WORDS 3456
#define XB_SPIN_CAP (1u << 18)

__device__ __forceinline__ unsigned xb_ld(unsigned* p)              { return __hip_atomic_load(p, __ATOMIC_RELAXED, __HIP_MEMORY_SCOPE_AGENT); }
__device__ __forceinline__ unsigned xb_add(unsigned* p, unsigned v) { return __hip_atomic_fetch_add(p, v, __ATOMIC_RELAXED, __HIP_MEMORY_SCOPE_AGENT); }
__device__ __forceinline__ unsigned xb_xcc_id() { return (unsigned)__builtin_amdgcn_s_getreg((3 << 11) | 20) & 0xFu; }
#define XB_SPIN(cond, bar) do { unsigned _sp = 0; while (cond) { __builtin_amdgcn_s_sleep(1); \
    if ((++_sp & 255u) == 0u) { if (xb_ld(&(bar)[XB_TMO])) break; if (_sp > XB_SPIN_CAP) { atomicAdd(&(bar)[XB_TMO], 1u); break; } } } } while (0)

struct XcdBarrier { unsigned* bar; unsigned x; volatile LAS unsigned* st; };

__device__ __forceinline__ XcdBarrier xcd_barrier_post(unsigned* bar, volatile LAS unsigned* st) {
    XcdBarrier b; b.bar = bar; b.x = xb_xcc_id(); b.st = st;
    if (get_tid() == 0) (void)xb_add(&bar[XB_XCNT(b.x)], 1u);
    return b;
}
__device__ __forceinline__ void xcd_barrier_complete(unsigned* bar, unsigned x, unsigned& nloc, unsigned& nx) {
    const unsigned G = gridDim.x * gridDim.y * gridDim.z;
    unsigned sum, cnt, mine, sp = 0u;
    for (;;) {
        sum = 0u; cnt = 0u; mine = 0u;
#pragma unroll
        for (unsigned j = 0; j < 16; ++j) { const unsigned c = xb_ld(&bar[XB_XCNT(j)]); sum += c; cnt += (c > 0u) ? 1u : 0u; mine = (j == x) ? c : mine; }
        if (sum == G) break;
        __builtin_amdgcn_s_sleep(1);
        if ((++sp & 255u) == 0u) { if (xb_ld(&bar[XB_TMO])) break; if (sp > XB_SPIN_CAP) { atomicAdd(&bar[XB_TMO], 1u); break; } }
    }
    nloc = mine > 0u ? mine : 1u; nx = cnt > 0u ? cnt : 1u;
}
__device__ __forceinline__ void xcd_barrier(const XcdBarrier& b) {
    asm volatile("s_waitcnt vmcnt(0)" ::: "memory");
    __syncthreads();
    if (get_tid() == 0) {
        unsigned* bar = b.bar;
        __builtin_amdgcn_s_waitcnt(0);
        unsigned nloc = b.st[0], nx = b.st[1];
        if (nloc == 0u) { xcd_barrier_complete(bar, b.x, nloc, nx); b.st[0] = nloc; b.st[1] = nx; }
        const unsigned old = xb_add(&bar[XB_XSUB(b.x)], 1u);
        const unsigned gen = old / nloc;
        if (old + 1u == (gen + 1u) * nloc) {
            __builtin_amdgcn_fence(__ATOMIC_RELEASE, "agent");
            asm volatile("s_waitcnt vmcnt(0)" ::: "memory");
            const unsigned og = xb_add(&bar[XB_TOP], 1u);
            const unsigned tg = og / nx;
            if (og + 1u == (tg + 1u) * nx) xb_add(&bar[XB_TOPGEN], 1u);
            else XB_SPIN(xb_ld(&bar[XB_TOPGEN]) == tg, bar);
            __builtin_amdgcn_fence(__ATOMIC_ACQUIRE, "agent");
            xb_add(&bar[XB_XGEN(b.x)], 1u);
            asm volatile("s_waitcnt vmcnt(0)" ::: "memory");
        } else {
            XB_SPIN(xb_ld(&bar[XB_XGEN(b.x)]) == gen, bar);
            __builtin_amdgcn_fence(__ATOMIC_ACQUIRE, "agent");
            asm volatile("s_waitcnt vmcnt(0)" ::: "memory");
        }
    }
    __syncthreads();
}

struct Params {
    const float *x, *c, *ctx, *c_ctx, *mod_w, *mod_b, *norm1_w, *norm2_w, *w_in, *mla_qn, *mla_wuq, *mla_kvn, *mla_wukv,
                *gqa_qn, *gqa_kn, *na_bias, *ret_logit, *ret_gnw, *w_branch, *w_out, *peer_wq, *peer_keys, *peer_u, *peer_v, *final_w;
    float* out;
    char* ws;
};
typedef const __attribute__((address_space(4))) Params* KP;
__device__ __forceinline__ KP get_kp() { KP kp = (KP)__builtin_amdgcn_kernarg_segment_ptr(); asm volatile("" : "+s"(kp)); return kp; }

constexpr size_t al256c(size_t x) { return (x + 255) & ~(size_t)255; }
constexpr size_t WS_BAR = 0;
constexpr size_t WS_CNT = WS_BAR + al256c(XCD_BAR_WORDS * 4);
constexpr size_t WS_ZERO_END = WS_CNT + al256c(8 * 8 * 64 * 4);
constexpr size_t WS_MOD = WS_ZERO_END;
constexpr size_t WS_CTXS = WS_MOD + al256c((size_t)2 * 17 * 6144 * 4);
constexpr size_t WS_WINT = WS_CTXS + al256c((size_t)NBATCH * CTXL * DM * 4);
constexpr size_t WS_WUQT = WS_WINT + al256c((size_t)2 * NPROJ * DM * 2);
constexpr size_t WS_WUKVT = WS_WUQT + al256c((size_t)2 * 384 * 256 * 2);
constexpr size_t WS_WBT = WS_WUKVT + al256c((size_t)2 * 512 * 128 * 2);
constexpr size_t WS_WOUTT = WS_WBT + al256c((size_t)2 * 4 * DM * 256 * 2);
constexpr size_t WS_WQT = WS_WOUTT + al256c((size_t)2 * DM * DM * 2);
constexpr size_t WS_H = WS_WQT + al256c((size_t)2 * DM * DM * 2);
constexpr size_t WS_PROJ = WS_H + al256c((size_t)NGROUP * TG * DM * 2);
#define HG(p_, g_) (((bf16_t*)((p_)->ws + WS_H)) + (size_t)(g_) * TG * DM)
constexpr size_t WS_GATE8 = WS_PROJ + al256c((size_t)TG * PLD * 2);
constexpr size_t WS_QRAW = WS_GATE8 + al256c((size_t)TG * 4096);
constexpr size_t WS_KVRAW = WS_QRAW + al256c((size_t)TG * 384 * 2);
constexpr size_t WS_QA = WS_KVRAW + al256c((size_t)TG * 512 * 2);
constexpr size_t WS_KA = WS_QA + al256c((size_t)TG * 384 * 2);
constexpr size_t WS_VA = WS_KA + al256c((size_t)TG * 384 * 2);
constexpr size_t WS_GQ = WS_VA + al256c((size_t)TG * 256 * 2);
constexpr size_t WS_GK = WS_GQ + al256c((size_t)TG * 256 * 2);
constexpr size_t WS_OUTS = WS_GK + al256c((size_t)TG * 128 * 2);
constexpr size_t WS_ACC = WS_QRAW;
constexpr size_t WS_PQ = WS_OUTS;
constexpr size_t WS_RKV = WS_OUTS + al256c((size_t)4 * TG * 256 * 2);
constexpr size_t WS_UB = WS_RKV + al256c((size_t)NB * 4 * 2 * 34 * 4096 * 4);
constexpr size_t WS_VB = WS_UB + al256c((size_t)2 * 16384 * DM);
constexpr size_t WS_KEYB = WS_VB + al256c((size_t)2 * 16384 * DM);
constexpr size_t WS_USC = WS_UB + (size_t)2 * 16384 * (DM / 2);
constexpr size_t WS_VSC = WS_VB + (size_t)2 * 16384 * (DM / 2);
constexpr size_t WS_URS = WS_USC + (size_t)2 * 16384 * 4;
constexpr size_t WS_TOTAL = WS_KEYB + al256c((size_t)2 * 8 * 2 * 128 * 64 * 2);

#define G_BM 256
#define G_BN 128
#define G_BK 64
#define G_LDP 144
#define G_ABYTES (G_BM * G_LDP)
#define G_BBYTES (G_BN * G_LDP)
#define G_STAGE (G_ABYTES + G_BBYTES)

template <int MI>
__device__ __forceinline__ void gemm_tile(const bf16_t* __restrict__ A, int lda, const bf16_t* __restrict__ Bt, int ldb, int K,
                                          f32x4 (&acc)[MI][4], char* lds)
{
    constexpr int NA = MI;
    const int tid = get_tid(), lane = tid & 63, wid = tid >> 6, wm = wid >> 1, wn = wid & 1, fr = lane & 15, fq = lane >> 4;
    const int nk = K / G_BK;
    u32x4 ra[NA], rb[2];
    const int arow = tid >> 3, akc = tid & 7;
    const bf16_t* ag = A + (size_t)arow * lda + akc * 8;
    const bf16_t* bg = Bt + (size_t)arow * ldb + akc * 8;
    const int a_l = arow * G_LDP + akc * 16;
#pragma unroll
    for (int i = 0; i < NA; ++i) ra[i] = *(const u32x4*)(ag + (size_t)(64 * i) * lda);
#pragma unroll
    for (int i = 0; i < 2; ++i) rb[i] = *(const u32x4*)(bg + (size_t)(64 * i) * ldb);
    __syncthreads();
#pragma unroll
    for (int i = 0; i < NA; ++i) *(u32x4*)(lds + a_l + i * 64 * G_LDP) = ra[i];
#pragma unroll
    for (int i = 0; i < 2; ++i) *(u32x4*)(lds + G_ABYTES + a_l + i * 64 * G_LDP) = rb[i];
    __syncthreads();
    const int aoff = (wm * 16 * MI + fr) * G_LDP + fq * 16;
    const int boff = G_ABYTES + (wn * 64 + fr) * G_LDP + fq * 16;
    for (int kt = 0; kt < nk; ++kt) {
        const int cur = (kt & 1) * G_STAGE, nxt = ((kt + 1) & 1) * G_STAGE;
        const bool more = (kt + 1 < nk);
        if (more) {
#pragma unroll
            for (int i = 0; i < NA; ++i) ra[i] = *(const u32x4*)(ag + (size_t)(64 * i) * lda + (kt + 1) * G_BK);
#pragma unroll
            for (int i = 0; i < 2; ++i) rb[i] = *(const u32x4*)(bg + (size_t)(64 * i) * ldb + (kt + 1) * G_BK);
        }
#pragma unroll
        for (int ks = 0; ks < 2; ++ks) {
            bf16x8 af[MI], bfr[4];
#pragma unroll
            for (int mi = 0; mi < MI; ++mi) af[mi] = *(const bf16x8*)(lds + cur + aoff + mi * 16 * G_LDP + ks * 64);
#pragma unroll
            for (int ni = 0; ni < 4; ++ni) bfr[ni] = *(const bf16x8*)(lds + cur + boff + ni * 16 * G_LDP + ks * 64);
#pragma unroll
            for (int mi = 0; mi < MI; ++mi)
#pragma unroll
                for (int ni = 0; ni < 4; ++ni) acc[mi][ni] = __builtin_amdgcn_mfma_f32_16x16x32_bf16(bfr[ni], af[mi], acc[mi][ni], 0, 0, 0);
        }
        if (more) {
#pragma unroll
            for (int i = 0; i < NA; ++i) *(u32x4*)(lds + nxt + a_l + i * 64 * G_LDP) = ra[i];
#pragma unroll
            for (int i = 0; i < 2; ++i) *(u32x4*)(lds + nxt + G_ABYTES + a_l + i * 64 * G_LDP) = rb[i];
        }
        __syncthreads();
    }
}

template <int MI>
__device__ __forceinline__ void zero_acc(f32x4 (&acc)[MI][4]) {
#pragma unroll
    for (int i = 0; i < MI; ++i)
#pragma unroll
        for (int j = 0; j < 4; ++j) acc[i][j] = (f32x4){0.f, 0.f, 0.f, 0.f};
}

template <class Epi>
__device__ __forceinline__ void gemm_phase(const bf16_t* A, int lda, const bf16_t* Bt, int ldb, int M, int N, int K, const Epi& epi, char* lds, int bid, int nblk)
{
    const int tid = get_tid(), lane = tid & 63, wid = tid >> 6, wm = wid >> 1, wn = wid & 1, fr = lane & 15, fq = lane >> 4;
    const int tn = N / G_BN, total = (M / G_BM) * tn;
    for (int t = bid; t < total; t += nblk) {
        const int pm = t / tn, pn = t % tn;
        f32x4 acc[4][4]; zero_acc(acc);
        gemm_tile<4>(A + (size_t)pm * G_BM * lda, lda, Bt + (size_t)pn * G_BN * ldb, ldb, K, acc, lds);
#pragma unroll
        for (int mi = 0; mi < 4; ++mi)
#pragma unroll
            for (int ni = 0; ni < 4; ++ni) epi(pm * G_BM + wm * 64 + mi * 16 + fr, pn * G_BN + wn * 64 + ni * 16 + fq * 4, acc[mi][ni]);
    }
}

__device__ __forceinline__ void store_bf16x4(bf16_t* p, f32x4 v) { u32x2 w; w.x = pack_bf16(v[0], v[1]); w.y = pack_bf16(v[2], v[3]); *(u32x2*)p = w; }


namespace pg8 {
#define PG8_LAS __attribute__((address_space(3)))
typedef unsigned short bf16_t;
typedef short bf16x8 __attribute__((ext_vector_type(8)));
typedef float f32x4 __attribute__((ext_vector_type(4)));
typedef unsigned u32x4 __attribute__((ext_vector_type(4)));
constexpr int BM = 256, BK = 64, HALF = 128, HTB = HALF * BK * 2  , STAGE_BYTES = 8 * HTB, NXCD = 8, WGM = 8;

__host__ __device__ __forceinline__ int lds_byte(int r, int c) { const int st = (r >> 4) * 2 + (c >> 5), rr = r & 15, cc = c & 31, ob = rr * 64 + cc * 2; return st * 1024 + (ob ^ (((ob >> 9) & 1) << 5)); }
__host__ __device__ __forceinline__ void stage_rc(int b, int& R, int& C) { const int st = b / 1024, sb = b % 1024, swz = sb ^ (((sb >> 9) & 1) << 5); R = (st >> 1) * 16 + swz / 64; C = (st & 1) * 32 + (swz % 64) / 2; }
__host__ __device__ __forceinline__ int perm32(int rho) { const int n = rho >> 4, i = rho & 15; return 8 * (i >> 2) + 4 * n + (i & 3); }

struct Unit { int pm, pn; };
struct Gemm { const bf16_t* A; const bf16_t* Bt; int M, N, K; };

struct StaticOrder {
    int nM, nN, nwg, G, c;
    __host__ __device__ void init(int M, int N, int G_, int c_) { nM = M / BM; nN = N / BM; nwg = nM * nN; G = G_; c = c_; }
    __host__ __device__ bool next(int i, Unit& u) const {
        const long L = (long)i * G + c; if (L >= nwg) return false;
        int wgid = (int)L; { const int q = nwg / NXCD, r = nwg % NXCD, xcd = wgid % NXCD, off = wgid / NXCD; wgid = (xcd < r ? xcd * (q + 1) : r * (q + 1) + (xcd - r) * q) + off; }
        const int nig = WGM * nN, gid = wgid / nig, fm = gid * WGM, gsz = (nM - fm) < WGM ? (nM - fm) : WGM;
        u.pm = fm + ((wgid % nig) % gsz); u.pn = (wgid % nig) / gsz; return true;
    }
    __device__ __forceinline__ void a_ready(const Unit&) const {}
    __device__ __forceinline__ void done(const Unit&) const {}
};
template <class Epi, class Sched, bool ALIGN_EPI = false, bool SP2 = false>
__device__ __forceinline__ void gemm_phase(PG8_LAS unsigned char* lds, const Gemm g, const Sched& S, const Epi& E) {
    const int tid = get_tid(), wid = __builtin_amdgcn_readfirstlane(tid >> 6), lane = tid & 63, wr = wid >> 2, wc = wid & 3, fr = lane & 15, fq = lane >> 4;
    const int K = g.K, nt = K / BK;
    unsigned voffA[2], voffB[2];
#pragma unroll
    for (int i = 0; i < 2; ++i) { int R, C; stage_rc(tid * 16 + i * 8192, R, C); const int Rb = Epi::PERM ? ((R & ~31) + perm32(R & 31)) : R;
        voffA[i] = (unsigned)(R * K + C) * 2u; voffB[i] = (unsigned)(Rb * K + C) * 2u; }
    const size_t kstep = (size_t)(BK * 2);
    const size_t hstep = (size_t)HALF * K * 2;
    const size_t tstep = 2 * hstep;
    const unsigned ldsw = (unsigned)wid * 1024u;
    const int aoff = lds_byte(wr * 64 + fr, fq * 8), boff = lds_byte(wc * 32 + fr, fq * 8);
#define PG8_SA(b, h) (((b) * 2 + (h)) * HTB)
#define PG8_SB(b, h) ((4 + (b) * 2 + (h)) * HTB)
#define PG8_STAGE(bufoff, gbase, voff) do { _Pragma("unroll") for (int _i = 0; _i < 2; ++_i) \
        __builtin_amdgcn_global_load_lds((const unsigned*)((const char*)(gbase) + (voff)[_i]), (PG8_LAS unsigned*)(lds + (bufoff) + ldsw + _i * 8192), 16, 0, 0); } while (0)
#define PG8_LDA(dst, b, h) do { _Pragma("unroll") for (int m = 0; m < 4; ++m) _Pragma("unroll") for (int k = 0; k < 2; ++k) dst[m][k] = *(const PG8_LAS bf16x8*)(lds + PG8_SA(b, h) + aoff + m * 2048 + k * 1024); } while (0)
#define PG8_LDB(dst, b, h) do { _Pragma("unroll") for (int n = 0; n < 2; ++n) _Pragma("unroll") for (int k = 0; k < 2; ++k) dst[n][k] = *(const PG8_LAS bf16x8*)(lds + PG8_SB(b, h) + boff + n * 2048 + k * 1024); } while (0)
#define PG8_MMA(ai, bj, At, Bt) do { __builtin_amdgcn_s_setprio(1); _Pragma("unroll") for (int m = 0; m < 4; ++m) _Pragma("unroll") for (int n = 0; n < 2; ++n) _Pragma("unroll") for (int k = 0; k < 2; ++k) \
        acc[ai][bj][m][n] = __builtin_amdgcn_mfma_f32_16x16x32_bf16(Bt[n][k], At[m][k], acc[ai][bj][m][n], 0, 0, 0); __builtin_amdgcn_s_setprio(0); } while (0)
#define PG8_WAIT_V(n) asm volatile("s_waitcnt vmcnt(" #n ")" ::: "memory")
#define PG8_WAIT_L(n) asm volatile("s_waitcnt lgkmcnt(" #n ")" ::: "memory")
#define PG8_BAR __builtin_amdgcn_s_barrier()
#define PG8_SCHED __builtin_amdgcn_sched_barrier(0)
    Unit cur, nxt; int ui = 0;
    if (!S.next(0, cur)) return;
    f32x4 acc[2][2][4][2];
#pragma unroll
    for (int a = 0; a < 2; ++a)
#pragma unroll
        for (int b = 0; b < 2; ++b)
#pragma unroll
            for (int m = 0; m < 4; ++m)
#pragma unroll
                for (int n = 0; n < 2; ++n) acc[a][b][m][n] = (f32x4){0.f, 0.f, 0.f, 0.f};
    bf16x8 At[4][2], B0[2][2], B1[2][2];
    const char* cA = (const char*)g.A + (size_t)cur.pm * tstep; const char* cB = (const char*)g.Bt + (size_t)cur.pn * tstep;
    S.a_ready(cur);
    if constexpr (SP2) {
        PG8_STAGE(PG8_SB(0, 0), cB, voffB); PG8_STAGE(PG8_SB(0, 1), cB + hstep, voffB); PG8_STAGE(PG8_SA(0, 0), cA, voffA); PG8_STAGE(PG8_SA(0, 1), cA + hstep, voffA);
        if (wr == 1) PG8_BAR;
        PG8_WAIT_V(2); PG8_BAR;
        PG8_STAGE(PG8_SB(1, 0), cB + kstep, voffB); PG8_STAGE(PG8_SA(1, 0), cA + kstep, voffA); PG8_STAGE(PG8_SB(1, 1), cB + hstep + kstep, voffB);
        PG8_WAIT_V(6); PG8_BAR;
    } else {
        PG8_STAGE(PG8_SB(0, 0), cB, voffB); PG8_STAGE(PG8_SA(0, 0), cA, voffA); PG8_STAGE(PG8_SB(0, 1), cB + hstep, voffB); PG8_STAGE(PG8_SA(0, 1), cA + hstep, voffA);
        if (wr == 1) PG8_BAR;
        PG8_WAIT_V(4); PG8_BAR;
        PG8_STAGE(PG8_SB(1, 0), cB + kstep, voffB); PG8_STAGE(PG8_SA(1, 0), cA + kstep, voffA); PG8_STAGE(PG8_SB(1, 1), cB + hstep + kstep, voffB);
        PG8_WAIT_V(6); PG8_BAR;
    }
    for (;;) {
        const bool has_next = S.next(ui + 1, nxt);
        const char* nA = has_next ? (const char*)g.A + (size_t)nxt.pm * tstep : cA; const char* nB = has_next ? (const char*)g.Bt + (size_t)nxt.pn * tstep : cB;
        for (int t = 0; t < nt; t += 2) {
            const bool last = (t == nt - 2);
            const char* a1 = cA + (size_t)(t + 1) * kstep;
            const char* a2 = last ? nA : cA + (size_t)(t + 2) * kstep; const char* b2 = last ? nB : cB + (size_t)(t + 2) * kstep;
            const char* a3 = a2 + kstep; const char* b3 = b2 + kstep;
            if (last && has_next) S.a_ready(nxt);
            if constexpr (SP2) {
            PG8_LDB(B0, 0, 0); PG8_LDB(B1, 0, 1); PG8_SCHED; PG8_LDA(At, 0, 0); PG8_STAGE(PG8_SA(1, 1), a1 + hstep, voffA);
            PG8_WAIT_V(8); PG8_WAIT_L(0); PG8_BAR; PG8_MMA(0, 0, At, B0); PG8_MMA(0, 1, At, B1); PG8_BAR; PG8_SCHED;
            PG8_LDA(At, 0, 1); PG8_STAGE(PG8_SB(0, 0), b2, voffB); PG8_STAGE(PG8_SB(0, 1), b2 + hstep, voffB); PG8_STAGE(PG8_SA(0, 0), a2, voffA);
            PG8_WAIT_V(8); PG8_WAIT_L(0); PG8_BAR; PG8_MMA(1, 0, At, B0); PG8_MMA(1, 1, At, B1); PG8_BAR; PG8_SCHED;
            PG8_LDB(B0, 1, 0); PG8_LDB(B1, 1, 1); PG8_SCHED; PG8_LDA(At, 1, 0); PG8_STAGE(PG8_SA(0, 1), a2 + hstep, voffA);
            PG8_WAIT_V(8); PG8_WAIT_L(0); PG8_BAR; PG8_MMA(0, 0, At, B0); PG8_MMA(0, 1, At, B1); PG8_BAR; PG8_SCHED;
            PG8_LDA(At, 1, 1); PG8_STAGE(PG8_SB(1, 0), b3, voffB); PG8_STAGE(PG8_SB(1, 1), b3 + hstep, voffB); PG8_STAGE(PG8_SA(1, 0), a3, voffA);
            PG8_WAIT_V(8); PG8_WAIT_L(0); PG8_BAR; PG8_MMA(1, 0, At, B0); PG8_MMA(1, 1, At, B1); PG8_BAR; PG8_SCHED;
            } else {
            PG8_LDB(B0, 0, 0); PG8_SCHED; PG8_LDA(At, 0, 0); PG8_STAGE(PG8_SA(1, 1), a1 + hstep, voffA);
            PG8_WAIT_L(8); PG8_BAR; PG8_WAIT_L(0); PG8_MMA(0, 0, At, B0); PG8_BAR; PG8_SCHED;
            PG8_LDB(B1, 0, 1); PG8_STAGE(PG8_SB(0, 0), b2, voffB);
            PG8_BAR; PG8_WAIT_L(0); PG8_MMA(0, 1, At, B1); PG8_BAR;
            PG8_LDA(At, 0, 1); PG8_STAGE(PG8_SA(0, 0), a2, voffA);
            PG8_BAR; PG8_WAIT_L(0); PG8_MMA(1, 0, At, B0); PG8_BAR; PG8_SCHED;
            PG8_STAGE(PG8_SB(0, 1), b2 + hstep, voffB);
            PG8_WAIT_V(6); PG8_BAR; PG8_MMA(1, 1, At, B1); PG8_BAR;
            PG8_LDB(B0, 1, 0); PG8_SCHED; PG8_LDA(At, 1, 0); PG8_STAGE(PG8_SA(0, 1), a2 + hstep, voffA);
            PG8_WAIT_L(8); PG8_BAR; PG8_WAIT_L(0); PG8_MMA(0, 0, At, B0); PG8_BAR; PG8_SCHED;
            PG8_LDB(B1, 1, 1); PG8_STAGE(PG8_SB(1, 0), b3, voffB);
            PG8_BAR; PG8_WAIT_L(0); PG8_MMA(0, 1, At, B1); PG8_BAR;
            PG8_LDA(At, 1, 1); PG8_STAGE(PG8_SA(1, 0), a3, voffA);
            PG8_BAR; PG8_WAIT_L(0); PG8_MMA(1, 0, At, B0); PG8_BAR; PG8_SCHED;
            PG8_STAGE(PG8_SB(1, 1), b3 + hstep, voffB);
            PG8_WAIT_V(6); PG8_BAR; PG8_MMA(1, 1, At, B1); PG8_BAR;
            }
        }
        if constexpr (ALIGN_EPI) { if (wr == 0) PG8_BAR; }
        if constexpr (!Epi::AFTER_DRAIN) { E(acc, cur, wr, wc, fr, fq); S.done(cur); }
        if (!has_next) break;
#pragma unroll
        for (int a = 0; a < 2; ++a)
#pragma unroll
            for (int b = 0; b < 2; ++b)
#pragma unroll
                for (int m = 0; m < 4; ++m)
#pragma unroll
                    for (int n = 0; n < 2; ++n) acc[a][b][m][n] = (f32x4){0.f, 0.f, 0.f, 0.f};
        cur = nxt; cA = nA; cB = nB; ++ui;
        if constexpr (ALIGN_EPI) { if (wr == 1) PG8_BAR; }
    }
    PG8_WAIT_V(0);
    if constexpr (!ALIGN_EPI) { if (wr == 0) PG8_BAR; }
    PG8_BAR;
    if constexpr (Epi::AFTER_DRAIN) { E.fused(acc, cur, wr, wc, fr, fq, lds, wid, lane); S.done(cur); }
#undef PG8_SA
#undef PG8_SB
#undef PG8_STAGE
#undef PG8_LDA
#undef PG8_LDB
#undef PG8_MMA
#undef PG8_WAIT_V
#undef PG8_WAIT_L
#undef PG8_BAR
#undef PG8_SCHED
}
}

template <class F> struct Epi4 {
    static constexpr bool PERM = false, AFTER_DRAIN = false; F f;
    __device__ __forceinline__ void operator()(const f32x4 (&acc)[2][2][4][2], const pg8::Unit& u, int wr, int wc, int fr, int fq) const {
#pragma unroll
        for (int ai = 0; ai < 2; ++ai)
#pragma unroll
            for (int m = 0; m < 4; ++m)
#pragma unroll
                for (int bj = 0; bj < 2; ++bj)
#pragma unroll
                    for (int n = 0; n < 2; ++n) f(u.pm * 256 + ai * 128 + wr * 64 + m * 16 + fr, u.pn * 256 + bj * 128 + wc * 32 + n * 16 + fq * 4, acc[ai][bj][m][n]);
    }
};
template <class F> struct Epi8 {
    static constexpr bool PERM = true, AFTER_DRAIN = false; F f;
    __device__ __forceinline__ void operator()(const f32x4 (&acc)[2][2][4][2], const pg8::Unit& u, int wr, int wc, int fr, int fq) const {
#pragma unroll
        for (int ai = 0; ai < 2; ++ai)
#pragma unroll
            for (int m = 0; m < 4; ++m)
#pragma unroll
                for (int bj = 0; bj < 2; ++bj) f(u.pm * 256 + ai * 128 + wr * 64 + m * 16 + fr, u.pn * 256 + bj * 128 + wc * 32 + fq * 8, acc[ai][bj][m][0], acc[ai][bj][m][1]);
    }
};
template <class E>
__device__ __forceinline__ void big_gemm(const bf16_t* A, const bf16_t* Bt, int M, int N, int K, const E& e, char* lds, int bid, int nblk) {
    pg8::StaticOrder so; so.init(M, N, nblk, bid);
    pg8::gemm_phase<E, pg8::StaticOrder, true, true>((PG8_LAS unsigned char*)lds, pg8::Gemm{A, Bt, M, N, K}, so, e);
}

__device__ __forceinline__ void transpose_cvt(const float* __restrict__ src, int K, int N, int Npad, bf16_t* __restrict__ dst, const float* __restrict__ kscale, float* lds, int bid, int nblk)
{
    const int tid = get_tid();
    const int tk = K / 64, tn = Npad / 64, total = tk * tn;
    const int lk = tid >> 3, ln = (tid & 7) * 8;
    const int sn = tid >> 3, sk = (tid & 7) * 8;
    for (int t = bid; t < total; t += nblk) {
        const int k0 = (t / tn) * 64, n0 = (t % tn) * 64;
        f32x4 a = (f32x4){0.f, 0.f, 0.f, 0.f}, c = a;
        if (n0 + ln < N) { const float* sp = src + (size_t)(k0 + lk) * N + n0 + ln; a = *(const f32x4*)sp; c = *(const f32x4*)(sp + 4); if (kscale) { const float ks = kscale[k0 + lk]; a *= ks; c *= ks; } }
        __syncthreads();
#pragma unroll
        for (int j = 0; j < 4; ++j) { lds[lk * 65 + ln + j] = a[j]; lds[lk * 65 + ln + 4 + j] = c[j]; }
        __syncthreads();
        u32x4 w;
        w.x = pack_bf16(lds[(sk + 0) * 65 + sn], lds[(sk + 1) * 65 + sn]); w.y = pack_bf16(lds[(sk + 2) * 65 + sn], lds[(sk + 3) * 65 + sn]);
        w.z = pack_bf16(lds[(sk + 4) * 65 + sn], lds[(sk + 5) * 65 + sn]); w.w = pack_bf16(lds[(sk + 6) * 65 + sn], lds[(sk + 7) * 65 + sn]);
        *(u32x4*)(dst + (size_t)(n0 + sn) * K + k0 + sk) = w;
    }
}

__device__ __forceinline__ void phase_prologue(KP p, char* ldsc, int bid, int nblk)
{
    float* lds = (float*)ldsc;
    const int tid = get_tid();
    for (int l = 0; l < 2; ++l) {
        transpose_cvt(p->w_in + (size_t)l * DM * IN_COLS, DM, IN_COLS, NPROJ, ((bf16_t*)(p->ws + WS_WINT)) + (size_t)l * NPROJ * DM, nullptr, lds, bid, nblk);
        transpose_cvt(p->mla_wuq + (size_t)l * 256 * 384, 256, 384, 384, ((bf16_t*)(p->ws + WS_WUQT)) + (size_t)l * 384 * 256, p->mla_qn + l * 256, lds, bid, nblk);
        transpose_cvt(p->mla_wukv + (size_t)l * 128 * 512, 128, 512, 512, ((bf16_t*)(p->ws + WS_WUKVT)) + (size_t)l * 512 * 128, p->mla_kvn + l * 128, lds, bid, nblk);
        for (int i = 0; i < 4; ++i)
            transpose_cvt(p->w_branch + (size_t)(l * 4 + i) * 256 * DM, 256, DM, DM, ((bf16_t*)(p->ws + WS_WBT)) + (size_t)(l * 4 + i) * DM * 256, nullptr, lds, bid, nblk);
        transpose_cvt(p->w_out + (size_t)l * DM * DM, DM, DM, DM, ((bf16_t*)(p->ws + WS_WOUTT)) + (size_t)l * DM * DM, nullptr, lds, bid, nblk);
        transpose_cvt(p->peer_wq + (size_t)l * DM * DM, DM, DM, DM, ((bf16_t*)(p->ws + WS_WQT)) + (size_t)l * DM * DM, nullptr, lds, bid, nblk);
    }
    {
        float* sil = lds;
        float* red = lds + 17 * 1024;
        __syncthreads();
        for (int e = tid; e < 17 * 1024; e += NTHREADS) { const int r = e >> 10, k = e & 1023; const float v = (r < 16) ? p->c[r * 1024 + k] : p->c_ctx[k]; sil[e] = siluf(v); }
        __syncthreads();
        for (int u = bid; u < 2 * 96; u += nblk) {
            const int l = u / 96, j0 = (u % 96) * 64, kg = tid >> 6, j = tid & 63;
            float a[17];
#pragma unroll
            for (int r = 0; r < 17; ++r) a[r] = 0.f;
            const float* w = p->mod_w + (size_t)l * DM * 6144 + j0 + j;
#pragma unroll 1
            for (int k0 = kg * 128; k0 < kg * 128 + 128; k0 += 16) {
                float wv[16];
#pragma unroll
                for (int kk = 0; kk < 16; ++kk) wv[kk] = w[(size_t)(k0 + kk) * 6144];
#pragma unroll
                for (int kk = 0; kk < 16; ++kk)
#pragma unroll
                    for (int r = 0; r < 17; ++r) a[r] += sil[r * 1024 + k0 + kk] * wv[kk];
            }
#pragma unroll
            for (int r = 0; r < 17; ++r) red[(kg * 17 + r) * 64 + j] = a[r];
            __syncthreads();
            for (int e = tid; e < 17 * 64; e += NTHREADS) {
                const int r = e >> 6, jj = e & 63; float s = 0.f;
                for (int q = 0; q < 8; ++q) s += red[(q * 17 + r) * 64 + jj];
                ((float*)(p->ws + WS_MOD))[((size_t)l * 17 + r) * 6144 + j0 + jj] = s + p->mod_b[l * 6144 + j0 + jj];
            }
            __syncthreads();
        }
    }
    {
        const size_t n16 = (size_t)2 * 16384 * DM / 16;
        for (size_t i = (size_t)bid * NTHREADS + tid; i < n16; i += (size_t)nblk * NTHREADS) {
            f32x4 a[4], c[4];
#pragma unroll
            for (int q = 0; q < 4; ++q) { a[q] = ((const f32x4*)p->peer_u)[4 * i + q]; c[q] = ((const f32x4*)p->peer_v)[4 * i + q]; }
            float mu = 0.f, mv = 0.f;
#pragma unroll
            for (int q = 0; q < 4; ++q)
#pragma unroll
                for (int j = 0; j < 4; ++j) { mu = fmaxf(mu, fabsf(a[q][j])); mv = fmaxf(mv, fabsf(c[q][j])); }
            mu = wave_max(mu); mv = wave_max(mv);
            const float su = mu > 0.f ? mu * (0.8f / 7.f) : 1.f, sv = mv > 0.f ? mv * (1.f / 6.f) : 1.f, iu = 1.f / su, iv = 1.f / sv;
            u32x2 wu = (u32x2){0u, 0u}, wv = (u32x2){0u, 0u};
            float rsum = 0.f;
#pragma unroll
            for (int q = 0; q < 4; ++q) {
                unsigned tu = wu[q >> 1], tv = wv[q >> 1];
#pragma unroll
                for (int j = 0; j < 4; ++j) { const float qv = fminf(fmaxf(__builtin_rintf(a[q][j] * iu), -8.f), 7.f); rsum += qv; tu |= ((unsigned)(int)qv & 15u) << (4 * ((4 * q + j) & 7)); }
                if ((q & 1) == 0) {
                    tv = __builtin_amdgcn_cvt_scalef32_pk_fp4_f32(tv, c[q][0] * iv, c[q][1] * iv, 1.0f, 0); tv = __builtin_amdgcn_cvt_scalef32_pk_fp4_f32(tv, c[q][2] * iv, c[q][3] * iv, 1.0f, 1);
                } else {
                    tv = __builtin_amdgcn_cvt_scalef32_pk_fp4_f32(tv, c[q][0] * iv, c[q][1] * iv, 1.0f, 2); tv = __builtin_amdgcn_cvt_scalef32_pk_fp4_f32(tv, c[q][2] * iv, c[q][3] * iv, 1.0f, 3);
                }
                wu[q >> 1] = tu; wv[q >> 1] = tv;
            }
            rsum = wave_sum(rsum);
            ((u32x2*)(p->ws + WS_UB))[i] = wu; ((u32x2*)(p->ws + WS_VB))[i] = wv;
            if ((tid & 63) == 0) { ((float*)(p->ws + WS_USC))[i >> 6] = su; ((float*)(p->ws + WS_VSC))[i >> 6] = sv; ((float*)(p->ws + WS_URS))[i >> 6] = 8.f * rsum; }
        }
        const size_t k8 = (size_t)2 * 8 * 2 * 128 * 64 / 8;
        for (size_t i = (size_t)bid * NTHREADS + tid; i < k8; i += (size_t)nblk * NTHREADS) {
            const f32x4 a = ((const f32x4*)p->peer_keys)[2 * i], b = ((const f32x4*)p->peer_keys)[2 * i + 1];
            u32x4 w; w.x = pack_bf16(a[0], a[1]); w.y = pack_bf16(a[2], a[3]); w.z = pack_bf16(b[0], b[1]); w.w = pack_bf16(b[2], b[3]);
            ((u32x4*)(p->ws + WS_KEYB))[i] = w;
        }
    }
}

__device__ __forceinline__ const float* state_row(KP p, int g, int r, int& modrow, bool from_input) {
    const int bl = r / LTOK, t = r - bl * LTOK, b = g * NB + bl;
    if (t < CTXL) { modrow = 16; return (from_input ? p->ctx : (const float*)(p->ws + WS_CTXS)) + ((size_t)b * CTXL + t) * DM; }
    modrow = b; return (from_input ? p->x : (const float*)p->out) + ((size_t)b * SEQ + (t - CTXL)) * DM;
}

__device__ __forceinline__ void phase_norm(KP p, int l, int g, int which, int bid, int nblk)
{
    const int lane = get_tid() & 63, wid = get_tid() >> 6;
    const float* nw = (which ? p->norm2_w : p->norm1_w) + l * DM;
    const int shoff = which ? 3072 : 0, scoff = which ? 4096 : 1024;
    for (int r = bid * 8 + wid; r < TG; r += nblk * 8) {
        int mr; const float* src = state_row(p, g, r, mr, l == 0 && which == 0);
        const float* md = ((float*)(p->ws + WS_MOD)) + ((size_t)l * 17 + mr) * 6144;
        f32x4 v[4]; float ss = 0.f;
#pragma unroll
        for (int i = 0; i < 4; ++i) { v[i] = *(const f32x4*)(src + i * 256 + lane * 4); ss += v[i][0] * v[i][0] + v[i][1] * v[i][1] + v[i][2] * v[i][2] + v[i][3] * v[i][3]; }
        ss = wave_sum(ss);
        const float rstd = rsqrtf(ss * (1.f / DM) + EPSF);
#pragma unroll
        for (int i = 0; i < 4; ++i) {
            const int c = i * 256 + lane * 4;
            const f32x4 w = *(const f32x4*)(nw + c), sc = *(const f32x4*)(md + scoff + c), sh = *(const f32x4*)(md + shoff + c);
            f32x4 y;
#pragma unroll
            for (int j = 0; j < 4; ++j) y[j] = v[i][j] * rstd * w[j] * (1.f + sc[j]) + sh[j];
            store_bf16x4(HG(p, g) + (size_t)r * DM + c, y);
        }
    }
}

struct EpiProj8 {
    bf16_t* O; unsigned char* G8;
    __device__ __forceinline__ void operator()(int row, int col, f32x4 a, f32x4 b) const {
        if (col >= C_GATE) {
            const int gi = col - C_GATE; if (gi >= 4096) return;
            unsigned w0 = 0u, w1 = 0u;
#pragma unroll
            for (int j = 0; j < 4; ++j) {
                w0 |= (unsigned)__builtin_amdgcn_cvt_pk_u8_f32(sigmf(a[j]) * 255.f, j, 0);
                w1 |= (unsigned)__builtin_amdgcn_cvt_pk_u8_f32(sigmf(b[j]) * 255.f, j, 0);
            }
            const int gp_ = (gi & ~63) | (((gi >> 2) & 3) << 4) | (((gi >> 4) & 3) << 2);
            *(unsigned*)(G8 + (size_t)row * 4096 + gp_) = w0; *(unsigned*)(G8 + (size_t)row * 4096 + gp_ + 16) = w1;
            return;
        }
        if (col >= C_NQ && col < C_NK) { a *= (0.125f * 1.4426950408889634f); b *= (0.125f * 1.4426950408889634f); }
        u32x4 w; w.x = pack_bf16(a[0], a[1]); w.y = pack_bf16(a[2], a[3]); w.z = pack_bf16(b[0], b[1]); w.w = pack_bf16(b[2], b[3]);
        *(u32x4*)(O + (size_t)row * PLD + col) = w;
    }
};
struct EpiStore8 { bf16_t* O; int ld;
    __device__ __forceinline__ void operator()(int row, int col, f32x4 a, f32x4 b) const {
        u32x4 w; w.x = pack_bf16(a[0], a[1]); w.y = pack_bf16(a[2], a[3]); w.z = pack_bf16(b[0], b[1]); w.w = pack_bf16(b[2], b[3]);
        *(u32x4*)(O + (size_t)row * ld + col) = w; } };
struct EpiStore { bf16_t* O; int ld; __device__ __forceinline__ void operator()(int row, int col, f32x4 v) const { store_bf16x4(O + (size_t)row * ld + col, v); } };

__device__ __forceinline__ float log_sigmoidf(float x) { return fminf(x, 0.f) - log1pf(__expf(-fabsf(x))); }

__device__ __forceinline__ int ret_jb(int rb) { return rb == 0 ? 1 : (rb == 1 ? 0 : 35 - rb); }

__device__ __forceinline__ bf16x8 tr_frag_nat(const char* img, int PT, int k0, int col0, int lane) {
    const int i16 = lane & 15, blk = (lane >> 4) & 1, h5 = lane >> 5, q4 = i16 >> 2, p4 = i16 & 3;
    const char* a = img + (k0 + 8 * h5 + q4) * PT + (col0 + 16 * blk) * 2 + 8 * p4;
    const s16x4 lo = __builtin_amdgcn_ds_read_tr16_b64_v4i16((LAS s16x4*)a), hi = __builtin_amdgcn_ds_read_tr16_b64_v4i16((LAS s16x4*)(a + 4 * PT));
    return __builtin_shufflevector(lo, hi, 0, 1, 2, 3, 4, 5, 6, 7);
}
__device__ __forceinline__ bf16x8 tr_frag_acc(const char* img, int PT, int k0, int col0, int lane) {
    const int i16 = lane & 15, blk = (lane >> 4) & 1, h5 = lane >> 5, q4 = i16 >> 2, p4 = i16 & 3;
    const char* a = img + (k0 + 4 * h5 + q4) * PT + (col0 + 16 * blk) * 2 + 8 * p4;
    const s16x4 lo = __builtin_amdgcn_ds_read_tr16_b64_v4i16((LAS s16x4*)a), hi = __builtin_amdgcn_ds_read_tr16_b64_v4i16((LAS s16x4*)(a + 8 * PT));
    return __builtin_shufflevector(lo, hi, 0, 1, 2, 3, 4, 5, 6, 7);
}
#define RT_PT 144
__device__ __forceinline__ void ret_kv_unit(KP p, int l, int bl, int h, int rb, char* lds)
{
    const int tid = get_tid(), lane = tid & 63, wid = tid >> 6, r = lane & 31, h5 = lane >> 5;
    const bf16_t* PR = (const bf16_t*)(p->ws + WS_PROJ);
    const size_t R0 = (size_t)bl * LTOK + rb * 128;
    const float lgf = log_sigmoidf(p->ret_logit[(l * 2 + 0) * 4 + h]) * 1.4426950408889634f, lgb = log_sigmoidf(p->ret_logit[(l * 2 + 1) * 4 + h]) * 1.4426950408889634f;
    char* KF = lds; char* KBk = lds + 128 * RT_PT; char* VV = lds + 2 * 128 * RT_PT;
    __syncthreads();
#pragma unroll
    for (int q = 0; q < 2; ++q) {
        const int c = tid + 512 * q, row = c >> 3, cc = c & 7;
        const u32x4 kw = *(const u32x4*)(PR + (R0 + row) * PLD + C_RK + h * 64 + cc * 8), vw = *(const u32x4*)(PR + (R0 + row) * PLD + C_RV + h * 64 + cc * 8);
        const float wf = 0.125f * __builtin_amdgcn_exp2f(lgf * (float)(127 - row)), wb = 0.125f * __builtin_amdgcn_exp2f(lgb * (float)row);
        u32x4 of, ob;
#pragma unroll
        for (int j = 0; j < 4; ++j) { const float lo = bflo(kw[j]), hi = bfhi(kw[j]); of[j] = pack_bf16(lo * wf, hi * wf); ob[j] = pack_bf16(lo * wb, hi * wb); }
        *(u32x4*)(KF + row * RT_PT + cc * 16) = of; *(u32x4*)(KBk + row * RT_PT + cc * 16) = ob; *(u32x4*)(VV + row * RT_PT + cc * 16) = vw;
    }
    __syncthreads();
    const int dir = wid >> 2, dt = (wid >> 1) & 1, et = wid & 1;
    const char* Ks = dir ? KBk : KF;
    f32x16 acc;
#pragma unroll
    for (int i = 0; i < 16; ++i) acc[i] = 0.f;
#pragma unroll
    for (int s2 = 0; s2 < 8; ++s2) {
        const bf16x8 af = tr_frag_nat(Ks, RT_PT, 16 * s2, dt * 32, lane), bfv = tr_frag_nat(VV, RT_PT, 16 * s2, et * 32, lane);
        acc = __builtin_amdgcn_mfma_f32_32x32x16_bf16(af, bfv, acc, 0, 0, 0);
    }
    const int j = dir ? ret_jb(rb) : rb;
    float* dst = ((float*)(p->ws + WS_RKV)) + ((((size_t)bl * 4 + h) * 2 + dir) * 34 + j) * 4096 + et * 32 + r;
#pragma unroll
    for (int i = 0; i < 16; ++i) dst[(dt * 32 + (i & 3) + 8 * (i >> 2) + 4 * h5) * 64] = acc[i];
}

__device__ __forceinline__ void phase_p3a(KP p, int l, int bid, int nblk, char* lds)
{
    gemm_phase(((bf16_t*)(p->ws + WS_PROJ)) + C_CQ, PLD, ((bf16_t*)(p->ws + WS_WUQT)) + (size_t)l * 384 * 256, 256, TG, 384, 256, EpiStore{((bf16_t*)(p->ws + WS_QRAW)), 384}, lds, bid, nblk);
    gemm_phase(((bf16_t*)(p->ws + WS_PROJ)) + C_CKV, PLD, ((bf16_t*)(p->ws + WS_WUKVT)) + (size_t)l * 512 * 128, 128, TG, 512, 128, EpiStore{((bf16_t*)(p->ws + WS_KVRAW)), 512}, lds, bid, nblk);
    for (int u = bid; u < NB * 4 * 34; u += nblk) { const int rb = u % 34, h = (u / 34) & 3, bl = u / 136; ret_kv_unit(p, l, bl, h, rb, lds); }
}

#define LOG2_THETA 13.287712379549449f
__device__ __forceinline__ float rope_freq(int i, int half) { return exp2f(-LOG2_THETA * (float)i / (float)half); }

__device__ __forceinline__ void phase_p3b(KP p, int l, int bid, int nblk)
{
    {
        const int gt = bid * NTHREADS + get_tid();
        for (int it = gt; it < NB * 4 * 2 * 1024; it += nblk * NTHREADS) {
            const int e4 = it & 1023, bhd = it >> 10, dir = bhd & 1, h = (bhd >> 1) & 3;
            const float dec = __builtin_amdgcn_exp2f(log_sigmoidf(p->ret_logit[(l * 2 + dir) * 4 + h]) * 1.4426950408889634f * 128.f);
            f32x4* base = (f32x4*)((float*)(p->ws + WS_RKV) + (size_t)bhd * 34 * 4096) + e4;
            f32x4 st = (f32x4){0.f, 0.f, 0.f, 0.f};
            f32x4 kv[34];
#pragma unroll
            for (int j = 0; j < 34; ++j) kv[j] = base[(size_t)j * 1024];
#pragma unroll
            for (int j = 0; j < 34; ++j) { base[(size_t)j * 1024] = st; st = st * dec + kv[j]; }
        }
    }
    const int lane = get_tid() & 63, wid = get_tid() >> 6;
    const float mla_scale = 0.10206207261596575f * 1.4426950408889634f;
    auto load_row = [&](unsigned (&rw)[40], int r) {
        const bf16_t* pr = ((bf16_t*)(p->ws + WS_PROJ)) + (size_t)r * PLD;
        const bf16_t* qraw = ((bf16_t*)(p->ws + WS_QRAW)) + (size_t)r * 384;
        const bf16_t* kvraw = ((bf16_t*)(p->ws + WS_KVRAW)) + (size_t)r * 512;
#pragma unroll
        for (int i = 0; i < 4; ++i) rw[i] = pr[C_CQ + lane + 64 * i];
#pragma unroll
        for (int i = 0; i < 2; ++i) rw[4 + i] = pr[C_CKV + lane + 64 * i];
#pragma unroll
        for (int i = 0; i < 6; ++i) {
            const int idx = lane + 64 * i, h = idx / 96, d = idx % 96, dd = d >= 64 ? d - 64 : 0;
            rw[6 + i] = qraw[idx];
            rw[12 + i] = qraw[(unsigned)(d >= 64 ? idx - dd + (dd ^ 8) : idx)];
            rw[18 + i] = d < 64 ? kvraw[h * 128 + d] : pr[C_KPE + dd];
            rw[24 + i] = pr[C_KPE + (unsigned)(dd ^ 8)];
        }
#pragma unroll
        for (int i = 0; i < 4; ++i) { const int idx = lane + 64 * i, h = idx >> 6, e = idx & 63; rw[30 + i] = kvraw[h * 128 + 64 + e]; }
#pragma unroll
        for (int hh = 0; hh < 6; ++hh) rw[34 + hh] = pr[(hh < 4 ? C_GQ + hh * 64 : C_GK + (hh - 4) * 64) + lane];
    };
    auto proc_row = [&](const unsigned (&rw)[40], int r) {
        const int t = r % LTOK;
        const bool lat = t >= CTXL;
        const float prow = lat ? (float)((t - CTXL) >> 6) : 0.f, pcol = lat ? (float)((t - CTXL) & 63) : 0.f;
        float sq = 0.f, skv = 0.f;
#pragma unroll
        for (int i = 0; i < 4; ++i) { const float v = bf2f((bf16_t)rw[i]); sq += v * v; }
#pragma unroll
        for (int i = 0; i < 2; ++i) { const float v = bf2f((bf16_t)rw[4 + i]); skv += v * v; }
        sq = wave_sum(sq); skv = wave_sum(skv);
        const float rq = rsqrtf(sq * (1.f / 256.f) + EPSF), rkv = rsqrtf(skv * (1.f / 128.f) + EPSF);
#pragma unroll
        for (int i = 0; i < 6; ++i) {
            const int idx = lane + 64 * i, d = idx % 96;
            float qv = bf2f((bf16_t)rw[6 + i]), kv = bf2f((bf16_t)rw[18 + i]);
            if (d < 64) kv *= rkv;
            else if (lat) {
                const int dd = d - 64, blk = dd >> 4, w = dd & 15, fi = w & 7; const bool first = w < 8;
                const float rev = (blk ? pcol : prow) * rope_freq(fi, 8) * 0.15915494309189535f; const float sn = __builtin_amdgcn_sinf(rev), cs = __builtin_amdgcn_cosf(rev);
                const float qo = bf2f((bf16_t)rw[12 + i]), ko = bf2f((bf16_t)rw[24 + i]);
                qv = first ? (qv * cs - qo * sn) : (qo * sn + qv * cs);
                kv = first ? (kv * cs - ko * sn) : (ko * sn + kv * cs);
            }
            ((bf16_t*)(p->ws + WS_QA))[(size_t)r * 384 + idx] = f2bf(qv * rq * mla_scale);
            ((bf16_t*)(p->ws + WS_KA))[(size_t)r * 384 + idx] = f2bf(kv);
        }
#pragma unroll
        for (int i = 0; i < 4; ++i) ((bf16_t*)(p->ws + WS_VA))[(size_t)r * 256 + lane + 64 * i] = f2bf(bf2f((bf16_t)rw[30 + i]) * rkv);
        const int blk = lane >> 5, w = lane & 31, fi = w & 15; const bool first = w < 16;
        float sn = 0.f, cs = 1.f;
        if (lat) { const float rev = (blk ? pcol : prow) * rope_freq(fi, 16) * 0.15915494309189535f; sn = __builtin_amdgcn_sinf(rev); cs = __builtin_amdgcn_cosf(rev); }
        const float nwq = p->gqa_qn[l * 64 + lane], nwk = p->gqa_kn[l * 64 + lane];
#pragma unroll
        for (int hh = 0; hh < 6; ++hh) {
            const bool isq = hh < 4;
            const float v = bf2f((bf16_t)rw[34 + hh]);
            const float ss = wave_sum(v * v);
            const float n = v * rsqrtf(ss * (1.f / 64.f) + EPSF) * (isq ? nwq : nwk);
            const float other = xor_swz<16>(n);
            float val = n;
            if (lat) val = first ? (n * cs - other * sn) : (other * sn + n * cs);
            if (isq) ((bf16_t*)(p->ws + WS_GQ))[(size_t)r * 256 + hh * 64 + lane] = f2bf(val * (0.125f * 1.4426950408889634f));
            else ((bf16_t*)(p->ws + WS_GK))[(size_t)r * 128 + (hh - 4) * 64 + lane] = f2bf(val);
        }
    };
    const int rstep = nblk * 8;
    int r = bid * 8 + wid;
    if (r < TG) {
        unsigned ra[40], rb[40];
        load_row(ra, r);
        for (;;) {
            const bool m1 = r + rstep < TG;
            if (m1) load_row(rb, r + rstep);
            proc_row(ra, r);
            if (!m1) break;
            r += rstep;
            const bool m2 = r + rstep < TG;
            if (m2) load_row(ra, r + rstep);
            proc_row(rb, r);
            if (!m2) break;
            r += rstep;
        }
    }
}

template <int DQ>
__device__ __forceinline__ void attn_unit(const bf16_t* __restrict__ Qb, int qld, const bf16_t* __restrict__ Kb, int kld, const bf16_t* __restrict__ Vb, int vld,
                                          int nq, int nk, bf16_t* __restrict__ Ob, int old_, char* lds)
{
    constexpr int NS = DQ / 16, CPR = DQ / 8, KP = DQ * 2 + 16, VP = 144, KB = 64 * KP, VB = 64 * VP, STG = KB + VB, KCH = 64 * CPR;
    const int tid = get_tid(), lane = tid & 63, wid = tid >> 6, r = lane & 31, h = lane >> 5;
    int qrow[2]; bool qvalid[2];
    bf16x8 qf[2][NS];
#pragma unroll
    for (int qb = 0; qb < 2; ++qb) {
        qrow[qb] = wid * 64 + qb * 32 + r; qvalid[qb] = qrow[qb] < nq; if (!qvalid[qb]) qrow[qb] = 0;
#pragma unroll
        for (int s2 = 0; s2 < NS; ++s2) qf[qb][s2] = *(const bf16x8*)(Qb + (size_t)qrow[qb] * qld + 16 * s2 + 8 * h);
    }
    f32x16 o0[2], o1[2];
    float m[2] = {0.f, 0.f}, l[2] = {0.f, 0.f};
#pragma unroll
    for (int qb = 0; qb < 2; ++qb)
#pragma unroll
        for (int i = 0; i < 16; ++i) { o0[qb][i] = 0.f; o1[qb][i] = 0.f; }
    const int kr0 = tid / CPR, kc0 = tid % CPR, kr1 = (tid + 512) / CPR, kc1 = (tid + 512) % CPR; const bool k1 = (tid + 512) < KCH;
    const int vr = tid >> 3, vc = tid & 7;
    const bf16_t* kg0 = Kb + (size_t)kr0 * kld + kc0 * 8; const bf16_t* kg1 = Kb + (size_t)kr1 * kld + kc1 * 8; const bf16_t* vg = Vb + (size_t)vr * vld + vc * 8;
    const int kl0 = kr0 * KP + kc0 * 16, kl1 = kr1 * KP + kc1 * 16, vl = KB + vr * VP + vc * 16;
    u32x4 rk0, rk1 = (u32x4){0u, 0u, 0u, 0u}, rv;
    rk0 = *(const u32x4*)kg0; if (k1) rk1 = *(const u32x4*)kg1; rv = *(const u32x4*)vg;
    __syncthreads();
    *(u32x4*)(lds + kl0) = rk0; if (k1) *(u32x4*)(lds + kl1) = rk1; *(u32x4*)(lds + vl) = rv;
    __syncthreads();
    const int i16 = lane & 15, blk = (lane >> 4) & 1, q4 = i16 >> 2, p4 = i16 & 3;
    const int koff = r * KP + 16 * h, voff = KB + (4 * h + q4) * VP + 32 * blk + 8 * p4;
    const int nt = nk >> 6;
    for (int kt = 0; kt < nt; ++kt) {
        const int cur = (kt & 1) * STG, nxt = ((kt + 1) & 1) * STG;
        const bool more = kt + 1 < nt;
        if (more) {
            const size_t adv = (size_t)(kt + 1) * 64;
            rk0 = *(const u32x4*)(kg0 + adv * kld); if (k1) rk1 = *(const u32x4*)(kg1 + adv * kld); rv = *(const u32x4*)(vg + adv * vld);
        }
#pragma unroll
        for (int sub = 0; sub < 2; ++sub) {
            f32x16 sq[2];
#pragma unroll
            for (int i = 0; i < 16; ++i) { sq[0][i] = 0.f; sq[1][i] = 0.f; }
#pragma unroll
            for (int g0 = 0; g0 < NS; g0 += 4) {
                bf16x8 kfr[4];
#pragma unroll
                for (int s2 = 0; s2 < 4; ++s2) if (g0 + s2 < NS) kfr[s2] = *(const bf16x8*)(lds + cur + koff + sub * 32 * KP + (g0 + s2) * 32);
                __builtin_amdgcn_sched_barrier(0);
#pragma unroll
                for (int s2 = 0; s2 < 4; ++s2) if (g0 + s2 < NS) {
                    sq[0] = __builtin_amdgcn_mfma_f32_32x32x16_bf16(kfr[s2], qf[0][g0 + s2], sq[0], 0, 0, 0);
                    sq[1] = __builtin_amdgcn_mfma_f32_32x32x16_bf16(kfr[s2], qf[1][g0 + s2], sq[1], 0, 0, 0);
                }
            }
            bf16x8 vfr[2][2];
#pragma unroll
            for (int s2 = 0; s2 < 1; ++s2) {
                const int vb = cur + voff + (sub * 32 + 16 * s2) * VP;
                const s16x4 lo0 = __builtin_amdgcn_ds_read_tr16_b64_v4i16((LAS s16x4*)(lds + vb));
                const s16x4 hi0 = __builtin_amdgcn_ds_read_tr16_b64_v4i16((LAS s16x4*)(lds + vb + 8 * VP));
                const s16x4 lo1 = __builtin_amdgcn_ds_read_tr16_b64_v4i16((LAS s16x4*)(lds + vb + 64));
                const s16x4 hi1 = __builtin_amdgcn_ds_read_tr16_b64_v4i16((LAS s16x4*)(lds + vb + 8 * VP + 64));
                vfr[s2][0] = __builtin_shufflevector(lo0, hi0, 0, 1, 2, 3, 4, 5, 6, 7); vfr[s2][1] = __builtin_shufflevector(lo1, hi1, 0, 1, 2, 3, 4, 5, 6, 7);
            }
            bf16x8 pf[2][2];
#pragma unroll
            for (int qb = 0; qb < 2; ++qb) {
                f32x16& st = sq[qb];
                if (__builtin_amdgcn_ballot_w64(m[qb] != 0.f) != 0ull) {
#pragma unroll
                    for (int i = 0; i < 16; ++i) st[i] -= m[qb];
                }
                float mx = fmaxf(st[0], st[1]);
#pragma unroll
                for (int i = 2; i < 16; i += 2) mx = fmaxf(fmaxf(mx, st[i]), st[i + 1]);
                { const u32x2 sw = __builtin_amdgcn_permlane32_swap(__float_as_uint(mx), __float_as_uint(mx), false, false); mx = fmaxf(__uint_as_float(sw.x), __uint_as_float(sw.y)); }
                const bool first = (kt == 0) && (sub == 0);
                const bool mv = mx > 24.f || (first && mx < -24.f);
                if (__builtin_amdgcn_ballot_w64(mv) != 0ull) {
                    const float dlt = mv ? mx : 0.f, alpha = __builtin_amdgcn_exp2f(-dlt);
                    m[qb] += dlt; l[qb] *= alpha;
#pragma unroll
                    for (int i = 0; i < 16; ++i) { st[i] -= dlt; o0[qb][i] *= alpha; o1[qb][i] *= alpha; }
                }
                f32x2 rs2 = (f32x2){0.f, 0.f};
#pragma unroll
                for (int i = 0; i < 16; i += 2) { st[i] = __builtin_amdgcn_exp2f(st[i]); st[i + 1] = __builtin_amdgcn_exp2f(st[i + 1]); rs2 += (f32x2){st[i], st[i + 1]}; }
                l[qb] += rs2.x + rs2.y;
                u32x4 pw0, pw1;
                pw0.x = pack_bf16(st[0], st[1]); pw0.y = pack_bf16(st[2], st[3]); pw0.z = pack_bf16(st[4], st[5]); pw0.w = pack_bf16(st[6], st[7]);
                pw1.x = pack_bf16(st[8], st[9]); pw1.y = pack_bf16(st[10], st[11]); pw1.z = pack_bf16(st[12], st[13]); pw1.w = pack_bf16(st[14], st[15]);
                pf[qb][0] = __builtin_bit_cast(bf16x8, pw0); pf[qb][1] = __builtin_bit_cast(bf16x8, pw1);
            }
            {
                const int vb = cur + voff + (sub * 32 + 16) * VP;
                const s16x4 lo0 = __builtin_amdgcn_ds_read_tr16_b64_v4i16((LAS s16x4*)(lds + vb));
                const s16x4 hi0 = __builtin_amdgcn_ds_read_tr16_b64_v4i16((LAS s16x4*)(lds + vb + 8 * VP));
                const s16x4 lo1 = __builtin_amdgcn_ds_read_tr16_b64_v4i16((LAS s16x4*)(lds + vb + 64));
                const s16x4 hi1 = __builtin_amdgcn_ds_read_tr16_b64_v4i16((LAS s16x4*)(lds + vb + 8 * VP + 64));
                vfr[1][0] = __builtin_shufflevector(lo0, hi0, 0, 1, 2, 3, 4, 5, 6, 7); vfr[1][1] = __builtin_shufflevector(lo1, hi1, 0, 1, 2, 3, 4, 5, 6, 7);
            }
#pragma unroll
            for (int s2 = 0; s2 < 2; ++s2)
#pragma unroll
                for (int qb = 0; qb < 2; ++qb) {
                    o0[qb] = __builtin_amdgcn_mfma_f32_32x32x16_bf16(vfr[s2][0], pf[qb][s2], o0[qb], 0, 0, 0);
                    o1[qb] = __builtin_amdgcn_mfma_f32_32x32x16_bf16(vfr[s2][1], pf[qb][s2], o1[qb], 0, 0, 0);
                }
        }
        if (more) { *(u32x4*)(lds + nxt + kl0) = rk0; if (k1) *(u32x4*)(lds + nxt + kl1) = rk1; *(u32x4*)(lds + nxt + vl) = rv; }
        __syncthreads();
    }
#pragma unroll
    for (int qb = 0; qb < 2; ++qb) {
        float lt = sum_xor32(l[qb]);
        if (qvalid[qb]) {
            const float inv = 1.f / lt;
            bf16_t* op = Ob + (size_t)qrow[qb] * old_ + 4 * h;
#pragma unroll
            for (int g4 = 0; g4 < 4; ++g4) {
                store_bf16x4(op + 8 * g4, (f32x4){o0[qb][4 * g4] * inv, o0[qb][4 * g4 + 1] * inv, o0[qb][4 * g4 + 2] * inv, o0[qb][4 * g4 + 3] * inv});
                store_bf16x4(op + 32 + 8 * g4, (f32x4){o1[qb][4 * g4] * inv, o1[qb][4 * g4 + 1] * inv, o1[qb][4 * g4 + 2] * inv, o1[qb][4 * g4 + 3] * inv});
            }
        }
    }
}

__device__ __forceinline__ void ld8(const bf16_t* p, float (&o)[8]) {
    const u32x4 w = *(const u32x4*)p;
    o[0] = bflo(w.x); o[1] = bfhi(w.x); o[2] = bflo(w.y); o[3] = bfhi(w.y); o[4] = bflo(w.z); o[5] = bfhi(w.z); o[6] = bflo(w.w); o[7] = bfhi(w.w);
}

__device__ __forceinline__ void na_unit(KP p, int l, int bl, int h, int rg, char* lds)
{
    constexpr int KP_ = 144, VP = 144, KB = 64 * KP_, VB = 64 * VP, STG = KB + VB, LBIAS = 2 * STG;
    const int tid = get_tid(), lane = tid & 63, wid = tid >> 6, r = lane & 31, h5 = lane >> 5;
    const bf16_t* PR = (const bf16_t*)(p->ws + WS_PROJ);
    const size_t Rb = (size_t)bl * LTOK;
    const int grow = rg * 4 + (wid >> 1), c = (wid & 1) * 32 + r;
    const int rs = min(max(grow - 4, 0), 56), cs = min(max(c - 8, 0), 48);
    const int Rlo = min(max(rg * 4 - 4, 0), 56), Rhi = min(max(rg * 4 + 3 - 4, 0), 56) + 7, nrow = Rhi - Rlo + 1, nt = nrow + 4;
    const size_t qrow = Rb + CTXL + (size_t)grow * 64 + c;
    bf16x8 qf[4];
#pragma unroll
    for (int s2 = 0; s2 < 4; ++s2) qf[s2] = *(const bf16x8*)(PR + qrow * PLD + C_NQ + h * 64 + 16 * s2 + 8 * h5);
    f32x16 o0, o1;
#pragma unroll
    for (int i = 0; i < 16; ++i) { o0[i] = 0.f; o1[i] = 0.f; }
    float m = -1e30f, lsum = 0.f;
    const int kr = tid >> 3, kc = tid & 7;
    const int kl = kr * KP_ + kc * 16, vl = KB + kr * VP + kc * 16;
    auto tile_row = [&](int t) -> size_t { return t < nrow ? Rb + CTXL + (size_t)(Rlo + t) * 64 : Rb + (size_t)(t - nrow) * 64; };
    u32x4 rk, rv;
    { const size_t R = tile_row(0) + kr; rk = *(const u32x4*)(PR + R * PLD + C_NK + h * 64 + kc * 8); rv = *(const u32x4*)(PR + R * PLD + C_NV + h * 64 + kc * 8); }
    __syncthreads();
    *(u32x4*)(lds + kl) = rk; *(u32x4*)(lds + vl) = rv;
    { float* sb = (float*)(lds + LBIAS); const float* bias = p->na_bias + ((size_t)l * 4 + h) * 465; if (tid < 465) sb[tid] = bias[tid] * 1.4426950408889634f; }
    __syncthreads();
    const float* sb = (const float*)(lds + LBIAS);
    const int i16 = lane & 15, blk = (lane >> 4) & 1, q4 = i16 >> 2, p4 = i16 & 3;
    const int koff = r * KP_ + 16 * h5, voff = KB + (4 * h5 + q4) * VP + 32 * blk + 8 * p4;
    for (int t = 0; t < nt; ++t) {
        const int cur = (t & 1) * STG, nxt = ((t + 1) & 1) * STG;
        const bool more = t + 1 < nt;
        if (more) { const size_t R = tile_row(t + 1) + kr; rk = *(const u32x4*)(PR + R * PLD + C_NK + h * 64 + kc * 8); rv = *(const u32x4*)(PR + R * PLD + C_NV + h * 64 + kc * 8); }
        const bool win = t < nrow; const int R = Rlo + t;
        const bool mine = !win || (R >= rs && R <= rs + 7);
        if (mine) {
#pragma unroll
            for (int sub = 0; sub < 2; ++sub) {
                f32x16 st;
#pragma unroll
                for (int i = 0; i < 16; ++i) st[i] = 0.f;
#pragma unroll
                for (int s2 = 0; s2 < 4; ++s2) {
                    const bf16x8 kf = *(const bf16x8*)(lds + cur + koff + sub * 32 * KP_ + s2 * 32);
                    st = __builtin_amdgcn_mfma_f32_32x32x16_bf16(kf, qf[s2], st, 0, 0, 0);
                }
                if (win) {
                    const int brow = (R - grow + 7) * 31 + 15 - c;
#pragma unroll
                    for (int i = 0; i < 16; ++i) {
                        const int kcol = sub * 32 + (i & 3) + 8 * (i >> 2) + 4 * h5;
                        const bool ok = kcol >= cs && kcol < cs + 16;
                        const float bv = sb[ok ? brow + kcol : 0];
                        st[i] = ok ? st[i] + bv : -INFINITY;
                    }
                }
                float mx = fmaxf(st[0], st[1]);
#pragma unroll
                for (int i = 2; i < 16; i += 2) mx = fmaxf(fmaxf(mx, st[i]), st[i + 1]);
                mx = max_xor32(mx);
                const float mn = fmaxf(m, mx), alpha = __builtin_amdgcn_exp2f(m - mn);
                m = mn;
                f32x2 rs2 = (f32x2){0.f, 0.f};
#pragma unroll
                for (int i = 0; i < 16; i += 2) { st[i] = __builtin_amdgcn_exp2f(st[i] - mn); st[i + 1] = __builtin_amdgcn_exp2f(st[i + 1] - mn); rs2 += (f32x2){st[i], st[i + 1]}; }
                lsum = lsum * alpha + (rs2.x + rs2.y);
                if (__builtin_amdgcn_ballot_w64(alpha != 1.f) != 0ull) {
#pragma unroll
                    for (int i = 0; i < 16; ++i) { o0[i] *= alpha; o1[i] *= alpha; }
                }
                u32x4 pw0, pw1;
                pw0.x = pack_bf16(st[0], st[1]); pw0.y = pack_bf16(st[2], st[3]); pw0.z = pack_bf16(st[4], st[5]); pw0.w = pack_bf16(st[6], st[7]);
                pw1.x = pack_bf16(st[8], st[9]); pw1.y = pack_bf16(st[10], st[11]); pw1.z = pack_bf16(st[12], st[13]); pw1.w = pack_bf16(st[14], st[15]);
                const bf16x8 pf0 = __builtin_bit_cast(bf16x8, pw0), pf1 = __builtin_bit_cast(bf16x8, pw1);
#pragma unroll
                for (int s2 = 0; s2 < 2; ++s2) {
                    const int vb = cur + voff + (sub * 32 + 16 * s2) * VP;
                    const s16x4 lo0 = __builtin_amdgcn_ds_read_tr16_b64_v4i16((LAS s16x4*)(lds + vb));
                    const s16x4 hi0 = __builtin_amdgcn_ds_read_tr16_b64_v4i16((LAS s16x4*)(lds + vb + 8 * VP));
                    const s16x4 lo1 = __builtin_amdgcn_ds_read_tr16_b64_v4i16((LAS s16x4*)(lds + vb + 64));
                    const s16x4 hi1 = __builtin_amdgcn_ds_read_tr16_b64_v4i16((LAS s16x4*)(lds + vb + 8 * VP + 64));
                    const bf16x8 vf0 = __builtin_shufflevector(lo0, hi0, 0, 1, 2, 3, 4, 5, 6, 7), vf1 = __builtin_shufflevector(lo1, hi1, 0, 1, 2, 3, 4, 5, 6, 7);
                    o0 = __builtin_amdgcn_mfma_f32_32x32x16_bf16(vf0, s2 ? pf1 : pf0, o0, 0, 0, 0);
                    o1 = __builtin_amdgcn_mfma_f32_32x32x16_bf16(vf1, s2 ? pf1 : pf0, o1, 0, 0, 0);
                }
            }
        }
        if (more) { *(u32x4*)(lds + nxt + kl) = rk; *(u32x4*)(lds + nxt + vl) = rv; }
        __syncthreads();
    }
    lsum = sum_xor32(lsum);
    const float inv = 1.f / lsum;
    bf16_t* op = ((bf16_t*)(p->ws + WS_OUTS)) + ((size_t)2 * TG + qrow) * 256 + h * 64 + 4 * h5;
#pragma unroll
    for (int g4 = 0; g4 < 4; ++g4) {
        store_bf16x4(op + 8 * g4, (f32x4){o0[4 * g4] * inv, o0[4 * g4 + 1] * inv, o0[4 * g4 + 2] * inv, o0[4 * g4 + 3] * inv});
        store_bf16x4(op + 32 + 8 * g4, (f32x4){o1[4 * g4] * inv, o1[4 * g4 + 1] * inv, o1[4 * g4 + 2] * inv, o1[4 * g4 + 3] * inv});
    }
}

__device__ __forceinline__ void ret_out_unit(KP p, int l, int bl, int h, int rb, char* lds)
{
    const int tid = get_tid(), lane = tid & 63, wid = tid >> 6, r = lane & 31, h5 = lane >> 5;
    const bf16_t* PR = (const bf16_t*)(p->ws + WS_PROJ);
    const size_t R0 = (size_t)bl * LTOK + rb * 128;
    const float lgf = log_sigmoidf(p->ret_logit[(l * 2 + 0) * 4 + h]) * 1.4426950408889634f, lgb = log_sigmoidf(p->ret_logit[(l * 2 + 1) * 4 + h]) * 1.4426950408889634f;
    char* KK = lds; char* VV = lds + 128 * RT_PT; char* SS = lds + 2 * 128 * RT_PT;
    float* YB = (float*)lds;
    __syncthreads();
#pragma unroll
    for (int q = 0; q < 2; ++q) {
        const int c = tid + 512 * q, row = c >> 3, cc = c & 7;
        const u32x4 kw = *(const u32x4*)(PR + (R0 + row) * PLD + C_RK + h * 64 + cc * 8), vw = *(const u32x4*)(PR + (R0 + row) * PLD + C_RV + h * 64 + cc * 8);
        u32x4 ok;
#pragma unroll
        for (int j = 0; j < 4; ++j) ok[j] = pack_bf16(bflo(kw[j]) * 0.125f, bfhi(kw[j]) * 0.125f);
        *(u32x4*)(KK + row * RT_PT + cc * 16) = ok; *(u32x4*)(VV + row * RT_PT + cc * 16) = vw;
    }
    {
        const int jf = rb, jb = ret_jb(rb);
#pragma unroll
        for (int q = 0; q < 2; ++q) {
            const int e = tid + 512 * q, dir = e >> 9, dk = (e >> 3) & 63, e0 = (e & 7) * 8, j = dir ? jb : jf;
            const float* src = ((float*)(p->ws + WS_RKV)) + ((((size_t)bl * 4 + h) * 2 + dir) * 34 + j) * 4096 + dk * 64 + e0;
            const f32x4 s0 = *(const f32x4*)src, s1 = *(const f32x4*)(src + 4);
            u32x4 o; o.x = pack_bf16(s0[0], s0[1]); o.y = pack_bf16(s0[2], s0[3]); o.z = pack_bf16(s1[0], s1[1]); o.w = pack_bf16(s1[2], s1[3]);
            *(u32x4*)(SS + (dir * 64 + dk) * RT_PT + e0 * 2) = o;
        }
    }
    __syncthreads();
    const int dir = wid >> 2, mt = wid & 3;
    const float lg = dir ? lgb : lgf;
    const int qi = mt * 32 + r;
    bf16x8 qf[4];
#pragma unroll
    for (int s2 = 0; s2 < 4; ++s2) qf[s2] = *(const bf16x8*)(PR + (R0 + qi) * PLD + C_RQ + h * 64 + 16 * s2 + 8 * h5);
    f32x16 o0, o1;
#pragma unroll
    for (int i = 0; i < 16; ++i) { o0[i] = 0.f; o1[i] = 0.f; }
    {
        const char* Sd = SS + dir * 64 * RT_PT;
#pragma unroll
        for (int s2 = 0; s2 < 4; ++s2) {
            const bf16x8 a0 = tr_frag_nat(Sd, RT_PT, 16 * s2, 0, lane), a1 = tr_frag_nat(Sd, RT_PT, 16 * s2, 32, lane);
            o0 = __builtin_amdgcn_mfma_f32_32x32x16_bf16(a0, qf[s2], o0, 0, 0, 0);
            o1 = __builtin_amdgcn_mfma_f32_32x32x16_bf16(a1, qf[s2], o1, 0, 0, 0);
        }
        const int pos = dir ? 127 - qi : qi;
        const float qd = __builtin_amdgcn_exp2f(lg * (float)(pos + 1));
#pragma unroll
        for (int i = 0; i < 16; ++i) { o0[i] *= qd; o1[i] *= qd; }
    }
    const int kt0 = dir ? mt : 0, kt1 = dir ? 3 : mt;
    for (int kt = kt0; kt <= kt1; ++kt) {
        f32x16 st;
#pragma unroll
        for (int i = 0; i < 16; ++i) st[i] = 0.f;
#pragma unroll
        for (int s2 = 0; s2 < 4; ++s2) {
            const bf16x8 kf = *(const bf16x8*)(KK + (kt * 32 + r) * RT_PT + s2 * 32 + 16 * h5);
            st = __builtin_amdgcn_mfma_f32_32x32x16_bf16(kf, qf[s2], st, 0, 0, 0);
        }
#pragma unroll
        for (int i = 0; i < 16; ++i) {
            const int ki = kt * 32 + (i & 3) + 8 * (i >> 2) + 4 * h5;
            const int diff = dir ? ki - qi : qi - ki;
            st[i] = diff >= 0 ? st[i] * __builtin_amdgcn_exp2f(lg * (float)diff) : 0.f;
        }
        u32x4 pw0, pw1;
        pw0.x = pack_bf16(st[0], st[1]); pw0.y = pack_bf16(st[2], st[3]); pw0.z = pack_bf16(st[4], st[5]); pw0.w = pack_bf16(st[6], st[7]);
        pw1.x = pack_bf16(st[8], st[9]); pw1.y = pack_bf16(st[10], st[11]); pw1.z = pack_bf16(st[12], st[13]); pw1.w = pack_bf16(st[14], st[15]);
        const bf16x8 pf0 = __builtin_bit_cast(bf16x8, pw0), pf1 = __builtin_bit_cast(bf16x8, pw1);
#pragma unroll
        for (int s2 = 0; s2 < 2; ++s2) {
            const bf16x8 v0 = tr_frag_acc(VV, RT_PT, kt * 32 + 16 * s2, 0, lane), v1 = tr_frag_acc(VV, RT_PT, kt * 32 + 16 * s2, 32, lane);
            o0 = __builtin_amdgcn_mfma_f32_32x32x16_bf16(v0, s2 ? pf1 : pf0, o0, 0, 0, 0);
            o1 = __builtin_amdgcn_mfma_f32_32x32x16_bf16(v1, s2 ? pf1 : pf0, o1, 0, 0, 0);
        }
    }
    float sm = 0.f;
#pragma unroll
    for (int i = 0; i < 16; ++i) sm += o0[i] + o1[i];
    sm = sum_xor32(sm);
    const float mu = sm * (1.f / 64.f);
    float vs = 0.f;
#pragma unroll
    for (int i = 0; i < 16; ++i) { const float a0 = o0[i] - mu, a1 = o1[i] - mu; vs += a0 * a0 + a1 * a1; }
    vs = sum_xor32(vs);
    const float rstd = rsqrtf(vs * (1.f / 64.f) + EPSF);
    const bf16_t* gp = PR + (R0 + qi) * PLD + (dir ? C_RGB : C_RGF) + h * 64 + 4 * h5;
    const float* gw = p->ret_gnw + l * 256 + h * 64 + 4 * h5;
    __syncthreads();
#pragma unroll
    for (int t = 0; t < 2; ++t)
#pragma unroll
        for (int g4 = 0; g4 < 4; ++g4) {
            const u32x2 gg = *(const u32x2*)(gp + 32 * t + 8 * g4); const f32x4 ww = *(const f32x4*)(gw + 32 * t + 8 * g4);
            const float g0 = bflo(gg.x), g1 = bfhi(gg.x), g2 = bflo(gg.y), g3 = bfhi(gg.y);
            f32x4 y;
            y[0] = ((t ? o1[4 * g4] : o0[4 * g4]) - mu) * rstd * ww[0] * siluf(g0);
            y[1] = ((t ? o1[4 * g4 + 1] : o0[4 * g4 + 1]) - mu) * rstd * ww[1] * siluf(g1);
            y[2] = ((t ? o1[4 * g4 + 2] : o0[4 * g4 + 2]) - mu) * rstd * ww[2] * siluf(g2);
            y[3] = ((t ? o1[4 * g4 + 3] : o0[4 * g4 + 3]) - mu) * rstd * ww[3] * siluf(g3);
            *(f32x4*)(YB + (dir * 128 + qi) * 68 + 32 * t + 8 * g4 + 4 * h5) = y;
        }
    __syncthreads();
#pragma unroll
    for (int q = 0; q < 2; ++q) {
        const int e = tid + 512 * q, row = e >> 3, c8 = (e & 7) * 8;
        const f32x4 a0 = *(const f32x4*)(YB + row * 68 + c8), a1 = *(const f32x4*)(YB + row * 68 + c8 + 4), b0 = *(const f32x4*)(YB + (128 + row) * 68 + c8), b1 = *(const f32x4*)(YB + (128 + row) * 68 + c8 + 4);
        u32x4 o; o.x = pack_bf16(a0[0] + b0[0], a0[1] + b0[1]); o.y = pack_bf16(a0[2] + b0[2], a0[3] + b0[3]); o.z = pack_bf16(a1[0] + b1[0], a1[1] + b1[1]); o.w = pack_bf16(a1[2] + b1[2], a1[3] + b1[3]);
        *(u32x4*)(((bf16_t*)(p->ws + WS_OUTS)) + ((size_t)3 * TG + R0 + row) * 256 + h * 64 + c8) = o;
    }
}

#define U_MLA (NB * 32)
#define U_GQA (NB * 32)
#define U_NA (NB * 64)
#define U_RET (NB * 136)
#define U_CTX (NB * 12)
__device__ __forceinline__ int wq_next(unsigned* counter, LAS unsigned* wq) {
    __syncthreads();
    if (get_tid() == 0) *wq = atomicAdd(counter, 1u);
    __syncthreads();
    return (int)*wq;
}
__device__ __forceinline__ void phase_p4(KP p, int l, int g, char* ldsc, int bid, int nblk)
{
    float* lds = (float*)ldsc;
    LAS unsigned* wq = (LAS unsigned*)(smem + 32);
    unsigned* counter = ((unsigned*)(p->ws + WS_CNT)) + (l * NGROUP + g) * 64 * 8;
    (void)bid; (void)nblk;
    for (;;) {
        const int u = wq_next(counter, wq); if (u >= U_MLA) break;
        const int qb = u & 7, h = (u >> 3) & 3, bl = u >> 5; const size_t Rb = (size_t)bl * LTOK, Rq = Rb + CTXL + qb * 512;
        attn_unit<96>(((bf16_t*)(p->ws + WS_QA)) + Rq * 384 + h * 96, 384, ((bf16_t*)(p->ws + WS_KA)) + Rb * 384 + h * 96, 384, ((bf16_t*)(p->ws + WS_VA)) + Rb * 256 + h * 64, 256, 512, LTOK, ((bf16_t*)(p->ws + WS_OUTS)) + ((size_t)0 * TG + Rq) * 256 + h * 64, 256, ldsc);
    }
    for (;;) {
        const int u = wq_next(counter + 64, wq); if (u >= U_GQA) break;
        const int qb = u & 7, h = (u >> 3) & 3, bl = u >> 5; const size_t Rb = (size_t)bl * LTOK, Rq = Rb + CTXL + qb * 512; const int kvh = h >> 1;
        attn_unit<64>(((bf16_t*)(p->ws + WS_GQ)) + Rq * 256 + h * 64, 256, ((bf16_t*)(p->ws + WS_GK)) + Rb * 128 + kvh * 64, 128, ((bf16_t*)(p->ws + WS_PROJ)) + Rb * PLD + C_GV + kvh * 64, PLD, 512, LTOK, ((bf16_t*)(p->ws + WS_OUTS)) + ((size_t)1 * TG + Rq) * 256 + h * 64, 256, ldsc);
    }
    for (;;) {
        const int u = wq_next(counter + 128, wq); if (u >= U_NA) break;
        na_unit(p, l, u >> 6, (u >> 4) & 3, u & 15, ldsc);
    }
    for (;;) {
        const int u = wq_next(counter + 192, wq); if (u >= U_RET) break;
        const int rb = u % 34, h = (u / 34) & 3, bl = u / 136; ret_out_unit(p, l, bl, h, rb, ldsc);
    }
    if (l == 0) {
        for (;;) {
            const int u = wq_next(counter + 256, wq); if (u >= NB * 4) break;
            const int h = u & 3, bl = u >> 2; const size_t Rb = (size_t)bl * LTOK;
            attn_unit<96>(((bf16_t*)(p->ws + WS_QA)) + Rb * 384 + h * 96, 384, ((bf16_t*)(p->ws + WS_KA)) + Rb * 384 + h * 96, 384, ((bf16_t*)(p->ws + WS_VA)) + Rb * 256 + h * 64, 256, 256, CTXL, ((bf16_t*)(p->ws + WS_OUTS)) + ((size_t)0 * TG + Rb) * 256 + h * 64, 256, ldsc);
        }
        for (;;) {
            const int u = wq_next(counter + 320, wq); if (u >= NB * 8) break;
            const int ty = u & 1, h = (u >> 1) & 3, bl = u >> 3; const size_t Rb = (size_t)bl * LTOK;
            const bf16_t* Q = ty ? ((bf16_t*)(p->ws + WS_PROJ)) + Rb * PLD + C_NQ + h * 64 : ((bf16_t*)(p->ws + WS_GQ)) + Rb * 256 + h * 64;
            const bf16_t* K = ty ? ((bf16_t*)(p->ws + WS_PROJ)) + Rb * PLD + C_NK + h * 64 : ((bf16_t*)(p->ws + WS_GK)) + Rb * 128 + (h >> 1) * 64;
            const bf16_t* V = ty ? ((bf16_t*)(p->ws + WS_PROJ)) + Rb * PLD + C_NV + h * 64 : ((bf16_t*)(p->ws + WS_PROJ)) + Rb * PLD + C_GV + (h >> 1) * 64;
            attn_unit<64>(Q, ty ? PLD : 256, K, ty ? PLD : 128, V, PLD, 256, CTXL, ((bf16_t*)(p->ws + WS_OUTS)) + ((size_t)(1 + ty) * TG + Rb) * 256 + h * 64, 256, ldsc);
        }
    }
}

template <int MI>
__device__ __forceinline__ void p5_tile(KP p, int l, char* lds, int pm, int pn, int rsub)
{
    const int tid = get_tid(), lane = tid & 63, wid = tid >> 6, wm = wid >> 1, wn = wid & 1, fr = lane & 15, fq = lane >> 4;
    const int arow = tid >> 3, akc = tid & 7, a_l = arow * G_LDP + akc * 16;
    const int aoff = (wm * 16 * MI + fr) * G_LDP + fq * 16, boff = G_ABYTES + (wn * 64 + fr) * G_LDP + fq * 16;
    const bf16_t* OUTS = (const bf16_t*)(p->ws + WS_OUTS);
    const bf16_t* WB = (const bf16_t*)(p->ws + WS_WBT) + (size_t)l * 4 * DM * 256;
    const int rbase = pm * 256 + rsub;
    {
        const bf16_t* ag = OUTS + ((size_t)rbase + arow) * 256 + akc * 8;
        const bf16_t* bg = WB + ((size_t)pn * G_BN + arow) * 256 + akc * 8;
        const unsigned char* gp = (const unsigned char*)(p->ws + WS_GATE8) + (size_t)(rbase + wm * 16 * MI + fr) * 4096 + pn * G_BN + wn * 64 + fq * 16;
        f32x4 acc[MI][4]; zero_acc<MI>(acc);
        u32x2 totp[MI][4];
#pragma unroll
        for (int mi = 0; mi < MI; ++mi)
#pragma unroll
            for (int ni = 0; ni < 4; ++ni) totp[mi][ni] = (u32x2){0u, 0u};
        u32x4 sa[2][MI], sb[2][2];
        u32x4 gwv[MI];
#define P5_LOAD(SET, KT) do { const bf16_t* a2_ = ag + (size_t)((KT) >> 2) * TG * 256 + ((KT) & 3) * 64; const bf16_t* b2_ = bg + (size_t)((KT) >> 2) * DM * 256 + ((KT) & 3) * 64; \
            _Pragma("unroll") for (int i_ = 0; i_ < MI; ++i_) sa[SET][i_] = *(const u32x4*)(a2_ + (size_t)(64 * i_) * 256); \
            _Pragma("unroll") for (int i_ = 0; i_ < 2; ++i_) sb[SET][i_] = *(const u32x4*)(b2_ + (size_t)(64 * i_) * 256); } while (0)
#define P5_STORE(SET, BO) do { \
            _Pragma("unroll") for (int i_ = 0; i_ < MI; ++i_) *(u32x4*)(lds + (BO) + a_l + i_ * 64 * G_LDP) = sa[SET][i_]; \
            _Pragma("unroll") for (int i_ = 0; i_ < 2; ++i_) *(u32x4*)(lds + (BO) + G_ABYTES + a_l + i_ * 64 * G_LDP) = sb[SET][i_]; } while (0)
        P5_LOAD(0, 0);
        __syncthreads();
        P5_STORE(0, 0);
        P5_LOAD(0, 1); P5_LOAD(1, 2);
        __syncthreads();
#pragma unroll 1
        for (int sg = 0; sg < 4; ++sg) {
#pragma unroll
            for (int q4 = 0; q4 < 4; ++q4) {
                const int par = q4 & 1, kt = 4 * sg + q4, cur = par * G_STAGE, nxt = (par ^ 1) * G_STAGE;
#pragma unroll
                for (int ks = 0; ks < 2; ++ks) {
                    bf16x8 af[MI], bfr[4];
#pragma unroll
                    for (int mi = 0; mi < MI; ++mi) af[mi] = *(const bf16x8*)(lds + cur + aoff + mi * 16 * G_LDP + ks * 64);
#pragma unroll
                    for (int ni = 0; ni < 4; ++ni) bfr[ni] = *(const bf16x8*)(lds + cur + boff + ni * 16 * G_LDP + ks * 64);
#pragma unroll
                    for (int mi = 0; mi < MI; ++mi)
#pragma unroll
                        for (int ni = 0; ni < 4; ++ni) acc[mi][ni] = __builtin_amdgcn_mfma_f32_16x16x32_bf16(bfr[ni], af[mi], acc[mi][ni], 0, 0, 0);
                }
                if (q4 == 1) {
#pragma unroll
                    for (int mi = 0; mi < MI; ++mi)
                        gwv[mi] = *(const u32x4*)(gp + (size_t)(mi * 16) * 4096 + sg * DM);
                    __builtin_amdgcn_sched_barrier(0);
                }
                P5_STORE(par, nxt);
                { const int kn = (kt + 3 < 16) ? kt + 3 : 15; P5_LOAD(par, kn); }
                __syncthreads();
                if (q4 == 3) {
                    __builtin_amdgcn_sched_barrier(0);
#pragma unroll
                    for (int mi = 0; mi < MI; ++mi)
#pragma unroll
                        for (int ni = 0; ni < 4; ++ni) {
                            const unsigned gw = gwv[mi][ni];
                            const u32x2 tp = totp[mi][ni];
                            const float t0 = fmaf((float)((gw >> 0) & 255u), acc[mi][ni][0], bflo(tp.x)), t1 = fmaf((float)((gw >> 8) & 255u), acc[mi][ni][1], bfhi(tp.x));
                            const float t2 = fmaf((float)((gw >> 16) & 255u), acc[mi][ni][2], bflo(tp.y)), t3 = fmaf((float)((gw >> 24) & 255u), acc[mi][ni][3], bfhi(tp.y));
                            totp[mi][ni] = (u32x2){pack_bf16(t0, t1), pack_bf16(t2, t3)};
                            acc[mi][ni] = (f32x4){0.f, 0.f, 0.f, 0.f};
                        }
                }
            }
        }
#undef P5_LOAD
#undef P5_STORE
#pragma unroll
        for (int mi = 0; mi < MI; ++mi)
#pragma unroll
            for (int ni = 0; ni < 4; ++ni) {
                const u32x2 tp = totp[mi][ni]; const float k255 = 1.f / 255.f;
                *(u32x2*)(((bf16_t*)(p->ws + WS_ACC)) + (size_t)(rbase + wm * 16 * MI + mi * 16 + fr) * DM + pn * G_BN + wn * 64 + ni * 16 + fq * 4) =
                    (u32x2){pack_bf16(bflo(tp.x) * k255, bfhi(tp.x) * k255), pack_bf16(bflo(tp.y) * k255, bfhi(tp.y) * k255)};
            }
    }
}

__device__ __forceinline__ void phase_p5(KP p, int l, char* lds, int bid, int nblk)
{
    constexpr int tn = DM / G_BN, total = (TG / 256) * tn, NG8 = (TG / 256) / 8;
    const bool xord = (nblk == 256) && (tn == 8) && ((TG / 256) % 8 == 0);
    if (xord) {
        constexpr int NFULL = (NG8 % 4 == 1) ? NG8 / 4 : (NG8 + 3) / 4;
#pragma unroll 1
        for (int it = 0; it < NFULL; ++it) {
            const int g8 = it * 4 + (bid >> 6); if (g8 >= NG8) break;
            p5_tile<4>(p, l, lds, g8 * 8 + (bid & 7), (bid >> 3) & 7, 0);
        }
        if (NG8 % 4 == 1) p5_tile<1>(p, l, lds, (NG8 - 1) * 8 + (bid & 7), (bid >> 3) & 7, (bid >> 6) * 64);
    } else {
        for (int t = bid; t < total; t += nblk) p5_tile<4>(p, l, lds, t / tn, t % tn, 0);
    }
}

struct EpiResid {
    KP p; int l, g, goff;
    __device__ __forceinline__ void operator()(int row, int col, f32x4 v) const {
        const int bl = row / LTOK, t = row - bl * LTOK, b = g * NB + bl;
        float* dst; const float* src; int mr;
        if (t < CTXL) { if (l != 0) return; const size_t o = ((size_t)b * CTXL + t) * DM + col; dst = ((float*)(p->ws + WS_CTXS)) + o; src = p->ctx + o; mr = 16; }
        else { const size_t o = ((size_t)b * SEQ + (t - CTXL)) * DM + col; dst = p->out + o; src = (l == 0) ? p->x + o : (const float*)dst; mr = b; }
        const f32x4 gg = *(const f32x4*)(((float*)(p->ws + WS_MOD)) + ((size_t)l * 17 + mr) * 6144 + goff + col);
        f32x4 s = *(const f32x4*)src;
#pragma unroll
        for (int j = 0; j < 4; ++j) s[j] += gg[j] * v[j];
        *(f32x4*)dst = s;
    }
};

__device__ __forceinline__ void grid_barrier();
#if MK_ONE_LAUNCH
#define P9_GRID_SYNC() grid_barrier()
#else
#define P9_GRID_SYNC() __syncthreads()
#endif
typedef __bf16 bf16pair __attribute__((ext_vector_type(2)));
__device__ __forceinline__ unsigned row_off(unsigned w, unsigned lane8) { unsigned o; asm("v_and_or_b32 %0, %1, %2, %3" : "=v"(o) : "v"(w >> 7), "s"(0x1FFFE00u), "v"(lane8)); return o; }
__device__ __forceinline__ float dot2bf(unsigned a, unsigned b, float c) { return __builtin_amdgcn_fdot2_f32_bf16(__builtin_bit_cast(bf16pair, a), __builtin_bit_cast(bf16pair, b), c, false); }
__device__ __forceinline__ unsigned f2ord(float f) { const unsigned b = __float_as_uint(f); return b ^ ((unsigned)((int)b >> 31) | 0x80000000u); }
__device__ __forceinline__ int mbcnt64(unsigned long long m) { return (int)__builtin_amdgcn_mbcnt_hi((unsigned)(m >> 32), __builtin_amdgcn_mbcnt_lo((unsigned)m, 0u)); }

__device__ __forceinline__ float ord2f(unsigned u) { return __uint_as_float((u & 0x80000000u) ? (u ^ 0x80000000u) : ~u); }

__device__ __forceinline__ void cx_desc(unsigned& a, unsigned& b) { const unsigned hi = a > b ? a : b, lo = a > b ? b : a; a = hi; b = lo; }
template <int N, int OFF, bool DESC, int M>
__device__ __forceinline__ void bitonic_sort(unsigned (&a)[M]) {
#pragma unroll
    for (int k = 2; k <= N; k <<= 1)
#pragma unroll
        for (int j = k >> 1; j > 0; j >>= 1)
#pragma unroll
            for (int i = 0; i < N; ++i) {
                const int l = i ^ j;
                if (l > i) { const bool up = ((i & k) == 0) != DESC; if (up) cx_desc(a[OFF + l], a[OFF + i]); else cx_desc(a[OFF + i], a[OFF + l]); }
            }
}
__device__ __forceinline__ void bitonic_merge16_desc(unsigned (&a)[16]) {
#pragma unroll
    for (int j = 8; j > 0; j >>= 1)
#pragma unroll
        for (int i = 0; i < 16; ++i) { const int l = i ^ j; if (l > i) cx_desc(a[i], a[l]); }
}
template <int XM>
__device__ __forceinline__ void merge_partner16(unsigned (&a)[16], bool upper) {
    unsigned b[16];
#pragma unroll
    for (int i = 0; i < 16; ++i) b[i] = (XM == 32) ? get_xor32_u(a[15 - i], upper) : xor_swz_u<XM & 31>(a[15 - i]);
#pragma unroll
    for (int i = 0; i < 16; ++i) a[i] = a[i] > b[i] ? a[i] : b[i];
    bitonic_merge16_desc(a);
}

#define P9_KEYP 144
#define P9_NTOK 136
#define P9_HG 3
#define P9_LKEY 0
#define P9_LIDX (P9_HG * 2 * 128 * P9_KEYP)
#define P9_LSTASH 0
__device__ __forceinline__ constexpr int p9_pair_i(int pi) {
    return pi < 16 ? 0 : pi < 24 ? 1 : pi < 29 ? 2 : pi < 33 ? 3 : pi < 36 ? 4 : pi < 38 ? 5 : pi < 40 ? 6 : pi < 42 ? 7 : pi < 50 ? pi - 34 : 0;
}
__device__ __forceinline__ constexpr int p9_pair_j(int pi) {
    return pi < 16 ? pi : pi < 24 ? pi - 16 : pi < 29 ? pi - 24 : pi < 33 ? pi - 29 : pi < 36 ? pi - 33 : pi < 38 ? pi - 36 : pi < 40 ? pi - 38 : pi < 42 ? pi - 40 : 0;
}
__device__ __forceinline__ void phase_p9(KP p, int l, int g, char* lds, int bid, int nblk)
{
    const int tid = get_tid(), wid = tid >> 6;
    const bf16_t* KEYB = (const bf16_t*)(p->ws + WS_KEYB) + (size_t)l * 8 * 2 * 128 * 64;
    const bf16_t* PQ = (const bf16_t*)(p->ws + WS_PQ);
    unsigned* stash = (unsigned*)(lds + P9_LSTASH);
    const int nit = (TG / P9_NTOK + nblk - 1) / nblk;
    for (int it = 0; it < nit; ++it) {
        const int blk = bid + it * nblk;
        if (blk >= TG / P9_NTOK) { P9_GRID_SYNC(); P9_GRID_SYNC(); continue; }
        const int row0 = blk * P9_NTOK;
        unsigned* gst = (unsigned*)(p->ws + WS_PROJ) + (size_t)row0 * 128;
#pragma unroll 1
        for (int h0 = 0; h0 < 8; h0 += P9_HG) {
            const int nh = (8 - h0) < P9_HG ? (8 - h0) : P9_HG;
            __syncthreads();
            for (int c = tid; c < nh * 2048; c += NTHREADS) { const int row = c >> 3, cc = c & 7;
                *(u32x4*)(lds + P9_LKEY + row * P9_KEYP + cc * 16) = *(const u32x4*)(KEYB + ((size_t)h0 * 256 + row) * 64 + cc * 8); }
            __syncthreads();
#pragma unroll 1
            for (int item = wid; item < 9 * nh; item += 8) {
                const int tile = item % 9, hh = item / 9, h = h0 + hh;
                const int LK = P9_LKEY + hh * 256 * P9_KEYP;
                const int tidh = get_tid(), tk = tidh & 15, qd = (tidh >> 4) & 3;
                const int ntile = (P9_NTOK - 16 * tile) < 16 ? (P9_NTOK - 16 * tile) : 16;
                const int trow = row0 + 16 * tile + (tk < ntile ? tk : ntile - 1);
                unsigned* idxl = (unsigned*)(lds + P9_LIDX) + (wid * 16 + tk) * 33;
                unsigned top[2][16];
#pragma unroll
                for (int pp = 0; pp < 2; ++pp) {
                    f32x4 acc[8];
#pragma unroll
                    for (int t = 0; t < 8; ++t) acc[t] = (f32x4){0.f, 0.f, 0.f, 0.f};
#pragma unroll
                    for (int ks = 0; ks < 2; ++ks) {
                        const bf16x8 qfr = *(const bf16x8*)(PQ + (size_t)trow * DM + h * 128 + pp * 64 + ks * 32 + qd * 8);
#pragma unroll
                        for (int t = 0; t < 8; ++t) {
                            const bf16x8 kfr = *(const bf16x8*)(lds + LK + (pp * 128 + t * 16 + tk) * P9_KEYP + ks * 64 + qd * 16);
                            acc[t] = __builtin_amdgcn_mfma_f32_16x16x32_bf16(kfr, qfr, acc[t], 0, 0, 0);
                        }
                    }
                    unsigned ck[32];
#pragma unroll
                    for (int t = 0; t < 8; ++t)
#pragma unroll
                        for (int jj = 0; jj < 4; ++jj) ck[t * 4 + jj] = (f2ord(acc[t][jj]) & 0xFFFFFF80u) | (unsigned)(16 * t + jj) | ((unsigned)qd << 2);
                    bitonic_sort<16, 0, true>(ck);
                    bitonic_sort<16, 16, false>(ck);
                    unsigned (&tp)[16] = top[pp];
#pragma unroll
                    for (int i = 0; i < 16; ++i) tp[i] = ck[i] > ck[16 + i] ? ck[i] : ck[16 + i];
                    bitonic_merge16_desc(tp);
                    merge_partner16<16>(tp, false); merge_partner16<32>(tp, (qd & 2) != 0);
                    if (qd == 0) {
#pragma unroll
                        for (int i = 0; i < 16; ++i) idxl[pp * 16 + i] = tp[i] & 127u;
                    }
                }
                float v1[16], v2[16];
#pragma unroll
                for (int i = 0; i < 16; ++i) { v1[i] = ord2f(top[0][i] & 0xFFFFFF80u); v2[i] = ord2f(top[1][i] & 0xFFFFFF80u); }
                unsigned cand[16];
#pragma unroll
                for (int n = 0; n < 13; ++n) {
                    const unsigned k0 = (f2ord(v1[p9_pair_i(4 * n)] + v2[p9_pair_j(4 * n)]) & 0xFFFFFF00u) | (unsigned)(p9_pair_i(4 * n) * 16 + p9_pair_j(4 * n));
                    const unsigned k1 = (f2ord(v1[p9_pair_i(4 * n + 1)] + v2[p9_pair_j(4 * n + 1)]) & 0xFFFFFF00u) | (unsigned)(p9_pair_i(4 * n + 1) * 16 + p9_pair_j(4 * n + 1));
                    const unsigned k2 = (4 * n + 2 < 50) ? ((f2ord(v1[p9_pair_i(4 * n + 2)] + v2[p9_pair_j(4 * n + 2)]) & 0xFFFFFF00u) | (unsigned)(p9_pair_i(4 * n + 2) * 16 + p9_pair_j(4 * n + 2))) : 0u;
                    const unsigned k3 = (4 * n + 3 < 50) ? ((f2ord(v1[p9_pair_i(4 * n + 3)] + v2[p9_pair_j(4 * n + 3)]) & 0xFFFFFF00u) | (unsigned)(p9_pair_i(4 * n + 3) * 16 + p9_pair_j(4 * n + 3))) : 0u;
                    cand[n] = qd == 0 ? k0 : (qd == 1 ? k1 : (qd == 2 ? k2 : k3));
                }
                cand[13] = 0u; cand[14] = 0u; cand[15] = 0u;
                bitonic_sort<16, 0, true>(cand);
                merge_partner16<16>(cand, false); merge_partner16<32>(cand, (qd & 2) != 0);
                const float mx = ord2f(cand[0] & 0xFFFFFF00u);
                float ex[16], den = 0.f;
#pragma unroll
                for (int k = 0; k < 16; ++k) { ex[k] = __expf(ord2f(cand[k] & 0xFFFFFF00u) - mx); den += ex[k]; }
                const float inv = 1.f / den;
                if (qd == 0 && tk < ntile) {
#pragma unroll
                    for (int k = 0; k < 16; ++k) {
                        const unsigned e = idxl[(cand[k] >> 4) & 15u] * 128u + idxl[16 + (cand[k] & 15u)];
                        gst[((16 * tile + tk) * 8 + h) * 16 + k] = (e << 16) | (unsigned)f2bf(ex[k] * inv);
                    }
                }
            }
        }
        P9_GRID_SYNC();
        {
            const u32x4* src = (const u32x4*)gst; u32x4* dstl = (u32x4*)(lds + P9_LSTASH);
            for (int c = get_tid(); c < P9_NTOK * 128 / 4; c += NTHREADS) dstl[c] = src[c];
            __syncthreads();
        }
        {
            const int tid2 = get_tid(), lane = tid2 & 63, wid2 = tid2 >> 6;
            KP p2 = get_kp();
            const unsigned char* UB = (const unsigned char*)(p2->ws + WS_UB) + (size_t)l * 16384 * (DM / 2);
            const float* USC = (const float*)(p2->ws + WS_USC) + (size_t)l * 16384; const float* VSC = (const float*)(p2->ws + WS_VSC) + (size_t)l * 16384;
            const float* URS = (const float*)(p2->ws + WS_URS) + (size_t)l * 16384;
            const bf16_t* Hh = HG(p2, g);
            const unsigned lane8 = (unsigned)lane * 8u;
#pragma unroll 1
            for (int slot = wid2; slot < P9_NTOK; slot += 8) {
                const int r = row0 + slot;
                if ((r % LTOK) < CTXL && l != 0) continue;
                const u32x4 x0 = *(const u32x4*)(Hh + (size_t)r * DM + lane * 16), x1 = *(const u32x4*)(Hh + (size_t)r * DM + lane * 16 + 8);
                unsigned HW0 = 0u, HW1 = 0u, LW0 = 0u, LW1 = 0u; float sx;
                {
                    float xf[16];
                    xf[0] = bflo(x0.x); xf[1] = bfhi(x0.x); xf[2] = bflo(x0.y); xf[3] = bfhi(x0.y); xf[4] = bflo(x0.z); xf[5] = bfhi(x0.z); xf[6] = bflo(x0.w); xf[7] = bfhi(x0.w);
                    xf[8] = bflo(x1.x); xf[9] = bfhi(x1.x); xf[10] = bflo(x1.y); xf[11] = bfhi(x1.y); xf[12] = bflo(x1.z); xf[13] = bfhi(x1.z); xf[14] = bflo(x1.w); xf[15] = bfhi(x1.w);
                    float am = 0.f;
#pragma unroll
                    for (int i = 0; i < 16; ++i) am = fmaxf(am, fabsf(xf[i]));
                    am = wave_max(am);
                    sx = am > 0.f ? am * (1.f / 127.f) : 1.f;
                    const float ix = 1.f / sx;
#pragma unroll
                    for (int i = 0; i < 16; ++i) {
                        const int v_ = (int)fminf(fmaxf(__builtin_rintf(xf[i] * ix), -128.f), 127.f) + 128;
                        const unsigned hs = (unsigned)((v_ >> 4) - 8) & 15u, ls = (unsigned)((v_ & 15) - 8) & 15u;
                        if (i < 8) { HW0 |= hs << (4 * i); LW0 |= ls << (4 * i); } else { HW1 |= hs << (4 * (i - 8)); LW1 |= ls << (4 * (i - 8)); }
                    }
                }
#pragma unroll 1
                for (int h = 0; h < 8; ++h) {
                    unsigned* st = stash + (slot * 8 + h) * 16;
                    int d[16];
                    const int kk = (lane >> 2) & 15;
                    const unsigned sk = st[kk];
                    const float su = USC[sk >> 16], svs = VSC[sk >> 16], urs = URS[sk >> 16];
                    {
                        u32x2 ua[16];
#pragma unroll
                        for (int k = 0; k < 16; ++k) ua[k] = *(const u32x2*)(UB + row_off(st[k], lane8));
#pragma unroll
                        for (int k = 0; k < 16; ++k) {
                            int dh = __builtin_amdgcn_sdot8((int)ua[k].x, (int)HW0, 0, false); dh = __builtin_amdgcn_sdot8((int)ua[k].y, (int)HW1, dh, false);
                            int dl = __builtin_amdgcn_sdot8((int)ua[k].x, (int)LW0, 0, false); dl = __builtin_amdgcn_sdot8((int)ua[k].y, (int)LW1, dl, false);
                            d[k] = 16 * dh + dl;
                        }
                    }
                    int r8[8], r4[4], r2[2], ri;
#pragma unroll
                    for (int i = 0; i < 8; ++i) { const u32x2 sw = __builtin_amdgcn_permlane32_swap((unsigned)d[i], (unsigned)d[i + 8], false, false); r8[i] = (int)sw.x + (int)sw.y; }
#pragma unroll
                    for (int i = 0; i < 4; ++i) { const u32x2 sw = __builtin_amdgcn_permlane16_swap((unsigned)r8[i], (unsigned)r8[i + 4], false, false); r4[i] = (int)sw.x + (int)sw.y; }
                    { const bool bb = (lane & 8) != 0;
#pragma unroll
                      for (int i = 0; i < 2; ++i) { const int snd = bb ? r4[i] : r4[i + 2], keep = bb ? r4[i + 2] : r4[i]; r2[i] = keep + (int)xor_swz_u<8>((unsigned)snd); } }
                    { const bool bb = (lane & 4) != 0; const int snd = bb ? r2[0] : r2[1], keep = bb ? r2[1] : r2[0]; ri = keep + (int)xor_swz_u<4>((unsigned)snd); }
                    ri += (int)xor_swz_u<2>((unsigned)ri); ri += (int)xor_swz_u<1>((unsigned)ri);
                    float r1 = ((float)ri + urs) * (su * sx);
                    const float cf = bflo(sk) * 0.5f * r1 * (1.f + erff(r1 * 0.70710678118654752f)) * svs;
                    if ((lane & 3) == 0) st[kk] = (sk & 0xffff0000u) | (unsigned)f2bf(cf);
                }
            }
        }
        P9_GRID_SYNC();
        {
            const int tid2 = get_tid(), lane = tid2 & 63, wid2 = tid2 >> 6;
            KP p2 = get_kp();
            const unsigned char* VB = (const unsigned char*)(p2->ws + WS_VB) + (size_t)l * 16384 * (DM / 2);
            const unsigned lane8 = (unsigned)lane * 8u;
#pragma unroll 1
            for (int slot = wid2; slot < P9_NTOK; slot += 8) {
                const int r = row0 + slot;
                const int bl = r / LTOK, t = r - bl * LTOK, b = g * NB + bl;
                if (t < CTXL && l != 0) continue;
                float* dst; int mr;
                if (t < CTXL) { dst = ((float*)(p2->ws + WS_CTXS)) + ((size_t)b * CTXL + t) * DM; mr = 16; } else { dst = p2->out + ((size_t)b * SEQ + (t - CTXL)) * DM; mr = b; }
                const float* g2 = ((float*)(p2->ws + WS_MOD)) + ((size_t)l * 17 + mr) * 6144 + 5120;
                f32x4 sv[4];
#pragma unroll
                for (int i = 0; i < 4; ++i) sv[i] = *(const f32x4*)(dst + lane * 16 + i * 4);
                float outv[16];
#pragma unroll
                for (int i = 0; i < 16; ++i) outv[i] = 0.f;
#pragma unroll 1
                for (int h = 0; h < 8; ++h) {
                    const unsigned* st = stash + (slot * 8 + h) * 16;
                    u32x2 va[16]; unsigned sk[16];
#pragma unroll
                    for (int k = 0; k < 16; ++k) { sk[k] = st[k]; va[k] = *(const u32x2*)(VB + row_off(sk[k], lane8)); }
#pragma unroll
                    for (int k = 0; k < 16; ++k) {
                        const float ck = bflo(sk[k]);
#define P9_VFMA(W, B) { const f32x2 t_ = __builtin_amdgcn_cvt_scalef32_pk_f32_fp4(va[k][W], 1.0f, B); outv[8 * (W) + 2 * (B)] += ck * t_.x; outv[8 * (W) + 2 * (B) + 1] += ck * t_.y; }
                        P9_VFMA(0, 0) P9_VFMA(0, 1) P9_VFMA(0, 2) P9_VFMA(0, 3) P9_VFMA(1, 0) P9_VFMA(1, 1) P9_VFMA(1, 2) P9_VFMA(1, 3)
#undef P9_VFMA
                        if ((k & 3) == 3) __builtin_amdgcn_sched_barrier(0);
                    }
                }
                const int lane = get_tid() & 63;
                float ss = 0.f;
#pragma unroll
                for (int i = 0; i < 4; ++i) {
                    const f32x4 gg = *(const f32x4*)(g2 + lane * 16 + i * 4);
#pragma unroll
                    for (int jj = 0; jj < 4; ++jj) { sv[i][jj] += gg[jj] * outv[i * 4 + jj]; ss += sv[i][jj] * sv[i][jj]; }
                }
                if (l == 0) {
                    const float rstd0 = rsqrtf(wave_sum(ss) * (1.f / DM) + EPSF);
                    const float* md1 = ((float*)(p2->ws + WS_MOD)) + ((size_t)17 + mr) * 6144;
                    bf16_t* hrow = HG(p2, g) + (size_t)r * DM + lane * 16;
#pragma unroll
                    for (int i = 0; i < 4; ++i) {
                        const int c = lane * 16 + i * 4;
                        const f32x4 w1 = *(const f32x4*)(p2->norm1_w + DM + c), sc = *(const f32x4*)(md1 + 1024 + c), sh = *(const f32x4*)(md1 + c);
                        f32x4 y;
#pragma unroll
                        for (int jj = 0; jj < 4; ++jj) y[jj] = sv[i][jj] * rstd0 * w1[jj] * (1.f + sc[jj]) + sh[jj];
                        store_bf16x4(hrow + i * 4, y);
                    }
                }
                if (l == 1) {
                    ss = wave_sum(ss);
                    const float rstd = rsqrtf(ss * (1.f / DM) + EPSF);
#pragma unroll
                    for (int i = 0; i < 4; ++i) { const f32x4 fw = *(const f32x4*)(p2->final_w + lane * 16 + i * 4);
#pragma unroll
                        for (int jj = 0; jj < 4; ++jj) sv[i][jj] *= rstd * fw[jj]; }
                }
#pragma unroll
                for (int i = 0; i < 4; ++i) *(f32x4*)(dst + lane * 16 + i * 4) = sv[i];
            }
        }
    }
}

__device__ __forceinline__ void phase_final(KP p, int bid, int nblk)
{
    const int lane = get_tid() & 63, wid = get_tid() >> 6;
    for (int r = bid * 8 + wid; r < NBATCH * SEQ; r += nblk * 8) {
        float* src = p->out + (size_t)r * DM;
        f32x4 v[4]; float ss = 0.f;
#pragma unroll
        for (int i = 0; i < 4; ++i) { v[i] = *(const f32x4*)(src + i * 256 + lane * 4); ss += v[i][0] * v[i][0] + v[i][1] * v[i][1] + v[i][2] * v[i][2] + v[i][3] * v[i][3]; }
        ss = wave_sum(ss);
        const float rstd = rsqrtf(ss * (1.f / DM) + EPSF);
#pragma unroll
        for (int i = 0; i < 4; ++i) {
            const f32x4 w = *(const f32x4*)(p->final_w + i * 256 + lane * 4);
            f32x4 y;
#pragma unroll
            for (int j = 0; j < 4; ++j) y[j] = v[i][j] * rstd * w[j];
            *(f32x4*)(src + i * 256 + lane * 4) = y;
        }
    }
}

template <int PH>
__device__ __forceinline__ void run_phase(KP p, int l, int g, char* lds, int bid, int nblk)
{
    asm volatile("" : "+s"(l), "+s"(g), "+s"(bid), "+s"(nblk));
    if constexpr (PH == 0) phase_prologue(p, lds, bid, nblk);
    if constexpr (PH == 1) { for (int gg = 0; gg < NGROUP; ++gg) phase_norm(p, 0, gg, 0, bid, nblk); }
    if constexpr (PH == 2) big_gemm(HG(p, g), ((bf16_t*)(p->ws + WS_WINT)) + (size_t)l * NPROJ * DM, TG, NPROJ, DM, Epi8<EpiProj8>{EpiProj8{((bf16_t*)(p->ws + WS_PROJ)), (unsigned char*)(p->ws + WS_GATE8)}}, lds, bid, nblk);
    if constexpr (PH == 3) phase_p3a(p, l, bid, nblk, lds);
    if constexpr (PH == 4) phase_p3b(p, l, bid, nblk);
    if constexpr (PH == 6) phase_p4(p, l, g, lds, bid, nblk);
    if constexpr (PH == 7) phase_p5(p, l, lds, bid, nblk);
    if constexpr (PH == 8) big_gemm(((bf16_t*)(p->ws + WS_ACC)), ((bf16_t*)(p->ws + WS_WOUTT)) + (size_t)l * DM * DM, TG, DM, DM, Epi4<EpiResid>{EpiResid{p, l, g, 2048}}, lds, bid, nblk);
    if constexpr (PH == 9) phase_norm(p, l, g, 1, bid, nblk);
    if constexpr (PH == 10) big_gemm(HG(p, g), ((bf16_t*)(p->ws + WS_WQT)) + (size_t)l * DM * DM, TG, DM, DM, Epi8<EpiStore8>{EpiStore8{((bf16_t*)(p->ws + WS_PQ)), DM}}, lds, bid, nblk);
    if constexpr (PH == 11) phase_p9(p, l, g, lds, bid, nblk);
    if constexpr (PH == 12) phase_final(p, bid, nblk);
}


__device__ __forceinline__ void grid_barrier() {
    XcdBarrier b; b.bar = (unsigned*)(get_kp()->ws + WS_BAR); b.x = xb_xcc_id(); b.st = (volatile LAS unsigned*)smem;
    xcd_barrier(b);
}

template <int PH>
__global__ void __launch_bounds__(NTHREADS, 2) k_phase(Params p_unused, int l, int g)
{
    (void)p_unused;
    tid_setup();
    run_phase<PH>(get_kp(), l, g, smem + 512, blockIdx.x, gridDim.x);
}

#if MK_ONE_LAUNCH
__global__ void __launch_bounds__(NTHREADS, 2) k_mega(Params p_unused)
{
    (void)p_unused;
    tid_setup();
    if (get_tid() == 0) *(uint4*)smem = make_uint4(0u, 0u, 0u, 0u);
    __syncthreads();
    (void)xcd_barrier_post((unsigned*)(get_kp()->ws + WS_BAR), (volatile LAS unsigned*)smem);
    char* lds = smem + 512;
    const int bid = blockIdx.x, nblk = gridDim.x;
    run_phase<0>(get_kp(), 0, 0, lds, bid, nblk);
    grid_barrier();
#define MK_LG(L_, G_) do { \
        run_phase<2>(get_kp(), L_, G_, lds, bid, nblk); grid_barrier(); \
        run_phase<3>(get_kp(), L_, G_, lds, bid, nblk); grid_barrier(); \
        run_phase<4>(get_kp(), L_, G_, lds, bid, nblk); grid_barrier(); \
        run_phase<6>(get_kp(), L_, G_, lds, bid, nblk); grid_barrier(); \
        run_phase<7>(get_kp(), L_, G_, lds, bid, nblk); grid_barrier(); \
        run_phase<8>(get_kp(), L_, G_, lds, bid, nblk); grid_barrier(); \
        run_phase<9>(get_kp(), L_, G_, lds, bid, nblk); grid_barrier(); \
        run_phase<10>(get_kp(), L_, G_, lds, bid, nblk); grid_barrier(); \
        run_phase<11>(get_kp(), L_, G_, lds, bid, nblk); grid_barrier(); } while (0)
    run_phase<1>(get_kp(), 0, 0, lds, bid, nblk); grid_barrier();
    static_assert(NGROUP == 2, "phase program written out for two groups");
    MK_LG(0, 0); MK_LG(0, 1); MK_LG(1, 0); MK_LG(1, 1);
#undef MK_LG
}
#endif

static inline size_t al256(size_t x) { return (x + 255) & ~(size_t)255; }

template <int PH>
static void launch_phase(const Params& p, int l, int g, int grid, hipStream_t s)
{
    static bool attr = false;
    if (!attr) { (void)hipFuncSetAttribute((const void*)k_phase<PH>, hipFuncAttributeMaxDynamicSharedMemorySize, LDS_BYTES); attr = true; }
    hipLaunchKernelGGL(k_phase<PH>, dim3(grid), dim3(NTHREADS), LDS_BYTES, s, p, l, g);
}

extern "C" void kernel_launch(void* const* d_in, const int* in_sizes, int n_in, void* d_out, int out_size, void* d_ws, size_t ws_size, hipStream_t stream)
{
    (void)in_sizes; (void)n_in; (void)out_size;
    Params p{};
    p.x = (const float*)d_in[0]; p.c = (const float*)d_in[1]; p.ctx = (const float*)d_in[2]; p.c_ctx = (const float*)d_in[3];
    p.mod_w = (const float*)d_in[4]; p.mod_b = (const float*)d_in[5]; p.norm1_w = (const float*)d_in[6]; p.norm2_w = (const float*)d_in[7];
    p.w_in = (const float*)d_in[8]; p.mla_qn = (const float*)d_in[9]; p.mla_wuq = (const float*)d_in[10]; p.mla_kvn = (const float*)d_in[11];
    p.mla_wukv = (const float*)d_in[12]; p.gqa_qn = (const float*)d_in[13]; p.gqa_kn = (const float*)d_in[14]; p.na_bias = (const float*)d_in[15];
    p.ret_logit = (const float*)d_in[16]; p.ret_gnw = (const float*)d_in[17]; p.w_branch = (const float*)d_in[18]; p.w_out = (const float*)d_in[19];
    p.peer_wq = (const float*)d_in[20]; p.peer_keys = (const float*)d_in[21]; p.peer_u = (const float*)d_in[22]; p.peer_v = (const float*)d_in[23];
    p.final_w = (const float*)d_in[24];
    p.out = (float*)d_out;
    p.ws = (char*)d_ws;
    if (WS_TOTAL > ws_size) { fprintf(stderr, "workspace too small: need %zu have %zu\n", (size_t)WS_TOTAL, ws_size); return; }
    (void)hipMemsetAsync(d_ws, 0, WS_ZERO_END, stream);

    static int ncu = 0;
    if (!ncu) { int dev = 0; (void)hipGetDevice(&dev); (void)hipDeviceGetAttribute(&ncu, hipDeviceAttributeMultiprocessorCount, dev); if (ncu <= 0) ncu = 256; }
#if MK_ONE_LAUNCH
    static bool attr = false;
    if (!attr) { (void)hipFuncSetAttribute((const void*)k_mega, hipFuncAttributeMaxDynamicSharedMemorySize, LDS_BYTES); attr = true; }
    hipLaunchKernelGGL(k_mega, dim3(ncu), dim3(NTHREADS), LDS_BYTES, stream, p);
#else
    const int grid = ncu;
    launch_phase<0>(p, 0, 0, grid, stream);
    for (int l = 0; l < 2; ++l)
        for (int g = 0; g < NGROUP; ++g) {
            if (l == 0 && g == 0) launch_phase<1>(p, l, g, grid, stream);
            launch_phase<2>(p, l, g, grid, stream);
            launch_phase<3>(p, l, g, grid, stream);
            launch_phase<4>(p, l, g, grid, stream);
            launch_phase<6>(p, l, g, grid, stream);
            launch_phase<7>(p, l, g, grid, stream);
            launch_phase<8>(p, l, g, grid, stream);
            launch_phase<9>(p, l, g, grid, stream);
            launch_phase<10>(p, l, g, grid, stream);
            launch_phase<11>(p, l, g, grid, stream);
        }
#endif
}
```
